# Optimizing an MI355X kernel written in HIP

```python
import jax, jax.numpy as jnp
from jax import lax
import numpy as np

D_MODEL = 2048
BATCH = 4
SEQ = 2048
DEPTH = 4
DEC_BATCH = 128
DEC_SEQ = 1
PAST_LEN = 16384
PAGE_SIZE = 128

N_MEM = 256
X_HEADS = 4
X_HEAD_DIM = 128
X_DIM = X_HEADS * X_HEAD_DIM
MIX = D_MODEL - X_DIM
A_HEAD_DIM = 128
A_HEADS = MIX // A_HEAD_DIM
A_CHUNK = 64
A_MIX_COLS = 4 * MIX
A_IN = A_MIX_COLS + X_DIM
F_FLOOR = 1e-30
B_HEAD_DIM = 64
B_HEADS = MIX // B_HEAD_DIM
B_DECAY_LORA = 64
B_AAA_LORA = 64
B_GATE_LORA = 224
B_MIX_COLS = 3 * MIX + B_DECAY_LORA + B_AAA_LORA + B_GATE_LORA
B_IN = B_MIX_COLS + X_DIM
D_FF = 4 * D_MODEL
N_A_LAYERS = (DEPTH + 1) // 2
N_B_LAYERS = DEPTH // 2
RMS_EPS = 1e-6
GN_EPS = 64e-5

kernel_name = 'hybrid_hgrn2_rwkv7_memxattn_step'


def rms_norm(x, g):
    xf = x.astype(jnp.float32)
    y = xf * lax.rsqrt(jnp.mean(xf * xf, axis=-1, keepdims=True) + RMS_EPS)
    return (y * g).astype(x.dtype)


def hgrn_lower_bounds(logits):
    p = jax.nn.softmax(logits.astype(jnp.float32), axis=0)
    return jnp.cumsum(p, axis=0) - p[0]


def cross_attend(q, mem_k, mem_v):
    B, T, _ = q.shape
    qh = q.reshape(B, T, X_HEADS, X_HEAD_DIM)
    s = jnp.einsum('bthe,bmhe->bhtm', qh, mem_k).astype(jnp.float32) * (X_HEAD_DIM ** -0.5)
    p = jax.nn.softmax(s, axis=-1).astype(mem_v.dtype)
    return jnp.einsum('bhtm,bmhe->bthe', p, mem_v).reshape(B, T, X_DIM)


def hgrn2_chunk_scan(q, k, v, log_f, s0):
    B, T, H, K = q.shape
    V = v.shape[-1]
    C = min(A_CHUNK, T)
    pad = (-T) % C
    f32 = jnp.float32
    q, k, v, log_f = (t.astype(f32) for t in (q, k, v, log_f))
    if pad:
        widths = ((0, 0), (0, pad), (0, 0), (0, 0))
        q, k, v, log_f = (jnp.pad(t, widths) for t in (q, k, v, log_f))
    n = (T + pad) // C

    def to_chunks(t):
        return t.reshape(B, n, C, H, t.shape[-1]).transpose(1, 0, 3, 2, 4)

    causal = jnp.tril(jnp.ones((C, C), dtype=bool))[:, :, None]

    def step(s, inp):
        qc, kc, vc, gc = inp
        b = jnp.cumsum(gc, axis=2)
        diff = b[:, :, :, None, :] - b[:, :, None, :, :]
        dec = jnp.where(causal, jnp.exp(jnp.where(causal, diff, 0.0)), 0.0)
        att = jnp.einsum('bhtk,bhsk,bhtsk->bhts', qc, kc, dec)
        o = jnp.einsum('bhts,bhsv->bhtv', att, vc) + jnp.einsum('bhtk,bhkv->bhtv', qc * jnp.exp(b), s)
        b_end = b[:, :, -1:, :]
        s = s * jnp.exp(b_end[:, :, 0, :, None]) + jnp.einsum('bhsk,bhsv->bhkv', kc * jnp.exp(b_end - b), vc)
        return s, o

    s_T, o = lax.scan(step, s0.astype(f32), tuple(to_chunks(t) for t in (q, k, v, log_f)))
    o = o.transpose(1, 0, 3, 2, 4).reshape(B, n * C, H, V)[:, :T]
    return o, s_T


def hgrn2_mix(P, lb, onorm_g, s0):
    B, T, _ = P.shape
    q, f, i, g = jnp.split(P, 4, axis=-1)
    ff = f.astype(jnp.float32)
    f_gate = lb + (1.0 - lb) * jax.nn.sigmoid(ff)
    log_f = jnp.log(jnp.maximum(f_gate, F_FLOOR))
    k = (1.0 - lb) * jax.nn.sigmoid(-ff)
    heads = lambda t: t.reshape(B, T, A_HEADS, A_HEAD_DIM)
    o, s_T = hgrn2_chunk_scan(heads(jax.nn.silu(q)), heads(k), heads(i), heads(log_f), s0)
    o = rms_norm(o, onorm_g.reshape(A_HEADS, A_HEAD_DIM)).reshape(B, T, MIX).astype(P.dtype)
    return o * jax.nn.silu(g), s_T.astype(s0.dtype)


def rwkv7_mix(P, P_prev, mu, w0, w2, a0, a2, g2, k_k, k_a, r_k, lnx_g, lnx_b, s0):
    B, T, _ = P.shape
    f32 = jnp.float32
    xs = P + (P_prev - P) * mu
    r, k, v, wl, al, gl = jnp.split(
        xs, [MIX, 2 * MIX, 3 * MIX, 3 * MIX + B_DECAY_LORA, 3 * MIX + B_DECAY_LORA + B_AAA_LORA], axis=-1)
    w_raw = -jax.nn.softplus(-(w0 + jnp.tanh(wl) @ w2).astype(f32)) - 0.5
    decay = jnp.exp(-jnp.exp(w_raw))
    a = jax.nn.sigmoid((a0 + al @ a2).astype(f32))
    g = jax.nn.sigmoid(gl) @ g2
    heads = lambda t: t.reshape(B, T, B_HEADS, B_HEAD_DIM)
    ph = lambda t: t.reshape(B_HEADS, B_HEAD_DIM)
    rf, kf, vf, a, decay = (heads(t.astype(f32)) for t in (r, k, v, a, decay))
    kk = kf * ph(k_k)
    kk = kk / jnp.maximum(jnp.sqrt(jnp.sum(kk * kk, axis=-1, keepdims=True)), 1e-12)
    kf = kf * (1.0 + (a - 1.0) * ph(k_a))

    def step(S, inp):
        r_t, k_t, v_t, kk_t, a_t, w_t = inp
        sa = jnp.einsum('bhvk,bhk->bhv', S, -kk_t)
        S = (S * w_t[:, :, None, :] + sa[..., None] * (kk_t * a_t)[:, :, None, :]
             + v_t[..., None] * k_t[:, :, None, :])
        return S, jnp.einsum('bhvk,bhk->bhv', S, r_t)

    seqs = tuple(t.transpose(1, 0, 2, 3) for t in (rf, kf, vf, kk, a, decay))
    S_T, o = lax.scan(step, s0.astype(f32), seqs)
    o = o.transpose(1, 0, 2, 3)
    mean = jnp.mean(o, axis=-1, keepdims=True)
    var = jnp.mean(jnp.square(o - mean), axis=-1, keepdims=True)
    on = (o - mean) * lax.rsqrt(var + GN_EPS) * ph(lnx_g) + ph(lnx_b)
    bonus = jnp.sum(rf * kf * r_k, axis=-1, keepdims=True) * vf
    out = (on + bonus).reshape(B, T, MIX).astype(P.dtype) * g
    return out, S_T.astype(s0.dtype)


def setup_inputs(seed: int = 0) -> dict:
    key = jax.random.key(seed)
    ks = iter(jax.random.split(key, 48))
    f32 = jnp.float32
    nrm = lambda shape, scale: jax.random.normal(next(ks), shape, f32) * scale
    gain = lambda shape: 1.0 + 0.02 * jax.random.normal(next(ks), shape, f32)
    return {
        'x_prompt': nrm((BATCH, SEQ, D_MODEL), 1.0),
        'x_sample': nrm((DEC_BATCH, DEC_SEQ, D_MODEL), 1.0),
        'cache_mem_k': nrm((DEPTH, DEC_BATCH, N_MEM, X_HEADS, X_HEAD_DIM), 1.0),
        'cache_mem_v': nrm((DEPTH, DEC_BATCH, N_MEM, X_HEADS, X_HEAD_DIM), 1.0),
        'state_hgrn': nrm((N_A_LAYERS, DEC_BATCH, A_HEADS, A_HEAD_DIM, A_HEAD_DIM), 0.5),
        'state_rwkv': nrm((N_B_LAYERS, DEC_BATCH, B_HEADS, B_HEAD_DIM, B_HEAD_DIM), 0.5),
        'state_rwkv_shift': nrm((N_B_LAYERS, DEC_BATCH, D_MODEL), 1.0),
        'mem_prompt': nrm((BATCH, N_MEM, D_MODEL), 1.0),
        'attn_norm_g': gain((DEPTH, D_MODEL)),
        'mlp_norm_g': gain((DEPTH, D_MODEL)),
        'final_norm_g': gain((D_MODEL,)),
        'mem_norm_g': gain((D_MODEL,)),
        'wk_mem': nrm((DEPTH, D_MODEL, X_DIM), D_MODEL ** -0.5),
        'wv_mem': nrm((DEPTH, D_MODEL, X_DIM), D_MODEL ** -0.5),
        'a_w_in': nrm((N_A_LAYERS, D_MODEL, A_IN), D_MODEL ** -0.5),
        'a_w_out': nrm((N_A_LAYERS, D_MODEL, D_MODEL), D_MODEL ** -0.5),
        'a_lb_logits': nrm((N_A_LAYERS, MIX), 1.0),
        'a_onorm_g': gain((N_A_LAYERS, MIX)),
        'b_w_in': nrm((N_B_LAYERS, D_MODEL, B_IN), D_MODEL ** -0.5),
        'b_w_out': nrm((N_B_LAYERS, D_MODEL, D_MODEL), D_MODEL ** -0.5),
        'b_mu': jax.random.uniform(next(ks), (N_B_LAYERS, B_MIX_COLS), f32),
        'b_w0': nrm((N_B_LAYERS, MIX), 0.5),
        'b_w2': nrm((N_B_LAYERS, B_DECAY_LORA, MIX), 0.5 * B_DECAY_LORA ** -0.5),
        'b_a0': nrm((N_B_LAYERS, MIX), 0.1),
        'b_a2': nrm((N_B_LAYERS, B_AAA_LORA, MIX), 0.5 * B_AAA_LORA ** -0.5),
        'b_g2': nrm((N_B_LAYERS, B_GATE_LORA, MIX), B_GATE_LORA ** -0.5),
        'b_k_k': 0.85 * gain((N_B_LAYERS, MIX)),
        'b_k_a': gain((N_B_LAYERS, MIX)),
        'b_r_k': nrm((N_B_LAYERS, B_HEADS, B_HEAD_DIM), 0.1),
        'b_lnx_g': gain((N_B_LAYERS, MIX)),
        'b_lnx_b': nrm((N_B_LAYERS, MIX), 0.01),
        'mlp_w1': nrm((DEPTH, D_MODEL, D_FF), D_MODEL ** -0.5),
        'mlp_w2': nrm((DEPTH, D_FF, D_MODEL), 0.5 * D_FF ** -0.5),
    }


def reference(x_prompt, x_sample, cache_mem_k, cache_mem_v, state_hgrn, state_rwkv, state_rwkv_shift,
              mem_prompt, attn_norm_g, mlp_norm_g, final_norm_g, mem_norm_g, wk_mem, wv_mem,
              a_w_in, a_w_out, a_lb_logits, a_onorm_g,
              b_w_in, b_w_out, b_mu, b_w0, b_w2, b_a0, b_a2, b_g2, b_k_k, b_k_a, b_r_k, b_lnx_g, b_lnx_b,
              mlp_w1, mlp_w2):
    lower_bounds = hgrn_lower_bounds(a_lb_logits)

    def trunk(x, mem_k, mem_v, s_a, s_b, shift):
        new_a, new_b, new_shift = [], [], []
        for layer in range(DEPTH):
            j = layer // 2
            h = rms_norm(x, attn_norm_g[layer])
            if layer % 2 == 0:
                proj = h @ a_w_in[j]
                mix, s_new = hgrn2_mix(proj[..., :A_MIX_COLS], lower_bounds[j], a_onorm_g[j], s_a[j])
                new_a.append(s_new)
                w_out = a_w_out[j]
            else:
                h_ext = jnp.concatenate([shift[j][:, None, :].astype(h.dtype), h], axis=1)
                proj_ext = h_ext @ b_w_in[j]
                proj = proj_ext[:, 1:]
                mix, s_new = rwkv7_mix(proj[..., :B_MIX_COLS], proj_ext[:, :-1, :B_MIX_COLS], b_mu[j],
                                       b_w0[j], b_w2[j], b_a0[j], b_a2[j], b_g2[j], b_k_k[j], b_k_a[j],
                                       b_r_k[j], b_lnx_g[j], b_lnx_b[j], s_b[j])
                new_b.append(s_new)
                new_shift.append(h[:, -1])
                w_out = b_w_out[j]
            xo = cross_attend(proj[..., -X_DIM:], mem_k[layer], mem_v[layer])
            x = x + jnp.concatenate([mix, xo.astype(mix.dtype)], axis=-1) @ w_out
            u = rms_norm(x, mlp_norm_g[layer]) @ mlp_w1[layer]
            x = x + jnp.square(jax.nn.relu(u)) @ mlp_w2[layer]
        return rms_norm(x, final_norm_g), jnp.stack(new_a), jnp.stack(new_b), jnp.stack(new_shift)

    bp, n_mem = mem_prompt.shape[0], mem_prompt.shape[1]
    m = rms_norm(mem_prompt, mem_norm_g)
    mem_k_prompt = jnp.einsum('bmd,lde->lbme', m, wk_mem).reshape(DEPTH, bp, n_mem, X_HEADS, X_HEAD_DIM)
    mem_v_prompt = jnp.einsum('bmd,lde->lbme', m, wv_mem).reshape(DEPTH, bp, n_mem, X_HEADS, X_HEAD_DIM)
    zeros_a = jnp.zeros((N_A_LAYERS, bp, A_HEADS, A_HEAD_DIM, A_HEAD_DIM), x_prompt.dtype)
    zeros_b = jnp.zeros((N_B_LAYERS, bp, B_HEADS, B_HEAD_DIM, B_HEAD_DIM), x_prompt.dtype)
    zeros_shift = jnp.zeros((N_B_LAYERS, bp, D_MODEL), x_prompt.dtype)
    y_prompt, state_hgrn_prompt, state_rwkv_prompt, state_rwkv_shift_prompt = trunk(
        x_prompt, mem_k_prompt, mem_v_prompt, zeros_a, zeros_b, zeros_shift)

    y_sample, state_hgrn_sample, state_rwkv_sample, state_rwkv_shift_sample = trunk(
        x_sample, cache_mem_k, cache_mem_v, state_hgrn, state_rwkv, state_rwkv_shift)

    return (y_prompt, y_sample, mem_k_prompt, mem_v_prompt, state_hgrn_prompt, state_rwkv_prompt,
            state_rwkv_shift_prompt, state_hgrn_sample, state_rwkv_sample, state_rwkv_shift_sample)
```

```cpp
#include <hip/hip_runtime.h>
#include <cstdio>
#include <cstdint>
#define MK_N_LAUNCHES 1

#define PROBE_K 0
#define PROBE_P0 0
#define PROBE_SUB 0
namespace pg8 {
#define PG8_LAS __attribute__((address_space(3)))
typedef unsigned short bf16_t;
typedef short bf16x8 __attribute__((ext_vector_type(8)));
typedef float f32x4 __attribute__((ext_vector_type(4)));
typedef unsigned u32x4 __attribute__((ext_vector_type(4)));
constexpr int BM = 256, BK = 64, HALF = 128, HTB = HALF * BK * 2  , STAGE_BYTES = 8 * HTB, NXCD = 8, WGM = 4;

__host__ __device__ __forceinline__ int lds_byte(int r, int c) { const int st = (r >> 4) * 2 + (c >> 5), rr = r & 15, cc = c & 31, ob = rr * 64 + cc * 2; return st * 1024 + (ob ^ (((ob >> 9) & 1) << 5)); }
__host__ __device__ __forceinline__ void stage_rc(int b, int& R, int& C) { const int st = b / 1024, sb = b % 1024, swz = sb ^ (((sb >> 9) & 1) << 5); R = (st >> 1) * 16 + swz / 64; C = (st & 1) * 32 + (swz % 64) / 2; }
__host__ __device__ __forceinline__ int perm32(int rho) { const int n = rho >> 4, i = rho & 15; return 8 * (i >> 2) + 4 * n + (i & 3); }

struct Unit { int pm, pn; };
struct Gemm { const bf16_t* A; const bf16_t* Bt; int M, N, K; };

struct StaticOrder {
    int nM, nN, nwg, G, c;
    __host__ __device__ void init(int M, int N, int G_, int c_) { nM = M / BM; nN = N / BM; nwg = nM * nN; G = G_; c = c_; }
    __host__ __device__ bool next(int i, Unit& u) const {
        const long L = (long)i * G + c; if (L >= nwg) return false;
        int wgid = (int)L; { const int q = nwg / NXCD, r = nwg % NXCD, xcd = wgid % NXCD, off = wgid / NXCD; wgid = (xcd < r ? xcd * (q + 1) : r * (q + 1) + (xcd - r) * q) + off; }
        const int nig = WGM * nN, gid = wgid / nig, fm = gid * WGM, gsz = (nM - fm) < WGM ? (nM - fm) : WGM;
        u.pm = fm + ((wgid % nig) % gsz); u.pn = (wgid % nig) / gsz; return true;
    }
    __device__ __forceinline__ void a_ready(const Unit&) const {}
    __device__ __forceinline__ void done(const Unit&) const {}
};

__device__ __forceinline__ unsigned cvt_pk_bf16(float lo, float hi) { unsigned r; asm volatile("v_cvt_pk_bf16_f32 %0, %1, %2" : "=v"(r) : "v"(lo), "v"(hi)); return r; }
typedef float f32x2 __attribute__((ext_vector_type(2)));
template <class Epi, class Sched, bool ALIGN_EPI = false, bool SP2 = false>
__device__ __forceinline__ void gemm_phase(PG8_LAS unsigned char* lds, const Gemm g, const Sched& S, const Epi& E) {
    int tid_ = threadIdx.x; asm volatile("" : "+v"(tid_));
    const int tid = tid_, wid = __builtin_amdgcn_readfirstlane(tid >> 6), lane = tid & 63, wr = wid >> 2, wc = wid & 3, fr = lane & 15, fq = lane >> 4;
    const int K = g.K, nt = K / BK;
    unsigned voffA[2], voffB[2];
#pragma unroll
    for (int i = 0; i < 2; ++i) { int R, C; stage_rc(tid * 16 + i * 8192, R, C); const int Rb = Epi::PERM ? ((R & ~31) + perm32(R & 31)) : R;
        voffA[i] = (unsigned)(R * K + C) * 2u; voffB[i] = (unsigned)(Rb * K + C) * 2u; }
    const size_t kstep = (size_t)(BK * 2);
    const size_t hstep = (size_t)HALF * K * 2;
    const size_t tstep = 2 * hstep;
    const unsigned ldsw = (unsigned)wid * 1024u;
    const int aoff = lds_byte(wr * 64 + fr, fq * 8), boff = lds_byte(wc * 32 + fr, fq * 8);
#define PG8_SA(b, h) (((b) * 2 + (h)) * HTB)
#define PG8_SB(b, h) ((4 + (b) * 2 + (h)) * HTB)
#define PG8_STAGE(bufoff, gbase, voff) do { _Pragma("unroll") for (int _i = 0; _i < 2; ++_i) \
        __builtin_amdgcn_global_load_lds((const unsigned*)((const char*)(gbase) + (voff)[_i]), (PG8_LAS unsigned*)(lds + (bufoff) + ldsw + _i * 8192), 16, 0, 0); } while (0)
#define PG8_LDA(dst, b, h) do { _Pragma("unroll") for (int m = 0; m < 4; ++m) _Pragma("unroll") for (int k = 0; k < 2; ++k) dst[m][k] = *(const PG8_LAS bf16x8*)(lds + PG8_SA(b, h) + aoff + m * 2048 + k * 1024); } while (0)
#define PG8_LDB(dst, b, h) do { _Pragma("unroll") for (int n = 0; n < 2; ++n) _Pragma("unroll") for (int k = 0; k < 2; ++k) dst[n][k] = *(const PG8_LAS bf16x8*)(lds + PG8_SB(b, h) + boff + n * 2048 + k * 1024); } while (0)
#define PG8_MMA(ai, bj, At, Bt) do { __builtin_amdgcn_s_setprio(1); _Pragma("unroll") for (int m = 0; m < 4; ++m) _Pragma("unroll") for (int n = 0; n < 2; ++n) _Pragma("unroll") for (int k = 0; k < 2; ++k) \
        acc[ai][bj][m][n] = __builtin_amdgcn_mfma_f32_16x16x32_bf16(Bt[n][k], At[m][k], acc[ai][bj][m][n], 0, 0, 0); __builtin_amdgcn_s_setprio(0); } while (0)
#define PG8_WAIT_V(n) asm volatile("s_waitcnt vmcnt(" #n ")" ::: "memory")
#define PG8_WAIT_L(n) asm volatile("s_waitcnt lgkmcnt(" #n ")" ::: "memory")
#define PG8_BAR __builtin_amdgcn_s_barrier()
#define PG8_SCHED __builtin_amdgcn_sched_barrier(0)
    Unit cur, nxt; int ui = 0;
    if (!S.next(0, cur)) return;
    f32x4 acc[2][2][4][2];
#pragma unroll
    for (int a = 0; a < 2; ++a)
#pragma unroll
        for (int b = 0; b < 2; ++b)
#pragma unroll
            for (int m = 0; m < 4; ++m)
#pragma unroll
                for (int n = 0; n < 2; ++n) acc[a][b][m][n] = (f32x4){0.f, 0.f, 0.f, 0.f};
    bf16x8 At[4][2], B0[2][2], B1[2][2];
    const char* cA = (const char*)g.A + (size_t)cur.pm * tstep; const char* cB = (const char*)g.Bt + (size_t)cur.pn * tstep;
    S.a_ready(cur);
    if constexpr (SP2) {
        PG8_STAGE(PG8_SB(0, 0), cB, voffB); PG8_STAGE(PG8_SB(0, 1), cB + hstep, voffB); PG8_STAGE(PG8_SA(0, 0), cA, voffA); PG8_STAGE(PG8_SA(0, 1), cA + hstep, voffA);
        if (wr == 1) PG8_BAR;
        PG8_WAIT_V(2); PG8_BAR;
        PG8_STAGE(PG8_SB(1, 0), cB + kstep, voffB); PG8_STAGE(PG8_SA(1, 0), cA + kstep, voffA); PG8_STAGE(PG8_SB(1, 1), cB + hstep + kstep, voffB);
        PG8_WAIT_V(6); PG8_BAR;
    } else {
        PG8_STAGE(PG8_SB(0, 0), cB, voffB); PG8_STAGE(PG8_SA(0, 0), cA, voffA); PG8_STAGE(PG8_SB(0, 1), cB + hstep, voffB); PG8_STAGE(PG8_SA(0, 1), cA + hstep, voffA);
        if (wr == 1) PG8_BAR;
        PG8_WAIT_V(4); PG8_BAR;
        PG8_STAGE(PG8_SB(1, 0), cB + kstep, voffB); PG8_STAGE(PG8_SA(1, 0), cA + kstep, voffA); PG8_STAGE(PG8_SB(1, 1), cB + hstep + kstep, voffB);
        PG8_WAIT_V(6); PG8_BAR;
    }
    for (;;) {
        const bool has_next = S.next(ui + 1, nxt);
        const char* nA = has_next ? (const char*)g.A + (size_t)nxt.pm * tstep : cA; const char* nB = has_next ? (const char*)g.Bt + (size_t)nxt.pn * tstep : cB;
        for (int t = 0; t < nt; t += 2) {
            const bool last = (t == nt - 2);
            const char* a1 = cA + (size_t)(t + 1) * kstep;
            const char* a2 = last ? nA : cA + (size_t)(t + 2) * kstep; const char* b2 = last ? nB : cB + (size_t)(t + 2) * kstep;
            const char* a3 = a2 + kstep; const char* b3 = b2 + kstep;
            if (last && has_next) S.a_ready(nxt);
            if constexpr (SP2) {
            PG8_LDB(B0, 0, 0); PG8_LDB(B1, 0, 1); PG8_SCHED; PG8_LDA(At, 0, 0); PG8_STAGE(PG8_SA(1, 1), a1 + hstep, voffA);
            PG8_WAIT_V(8); PG8_WAIT_L(0); PG8_BAR; PG8_MMA(0, 0, At, B0); PG8_MMA(0, 1, At, B1); PG8_BAR; PG8_SCHED;
            PG8_LDA(At, 0, 1); PG8_STAGE(PG8_SB(0, 0), b2, voffB); PG8_STAGE(PG8_SB(0, 1), b2 + hstep, voffB); PG8_STAGE(PG8_SA(0, 0), a2, voffA);
            PG8_WAIT_V(8); PG8_WAIT_L(0); PG8_BAR; PG8_MMA(1, 0, At, B0); PG8_MMA(1, 1, At, B1); PG8_BAR; PG8_SCHED;
            PG8_LDB(B0, 1, 0); PG8_LDB(B1, 1, 1); PG8_SCHED; PG8_LDA(At, 1, 0); PG8_STAGE(PG8_SA(0, 1), a2 + hstep, voffA);
            PG8_WAIT_V(8); PG8_WAIT_L(0); PG8_BAR; PG8_MMA(0, 0, At, B0); PG8_MMA(0, 1, At, B1); PG8_BAR; PG8_SCHED;
            PG8_LDA(At, 1, 1); PG8_STAGE(PG8_SB(1, 0), b3, voffB); PG8_STAGE(PG8_SB(1, 1), b3 + hstep, voffB); PG8_STAGE(PG8_SA(1, 0), a3, voffA);
            PG8_WAIT_V(8); PG8_WAIT_L(0); PG8_BAR; PG8_MMA(1, 0, At, B0); PG8_MMA(1, 1, At, B1); PG8_BAR; PG8_SCHED;
            } else {
            PG8_LDB(B0, 0, 0); PG8_SCHED; PG8_LDA(At, 0, 0); PG8_STAGE(PG8_SA(1, 1), a1 + hstep, voffA);
            PG8_WAIT_L(8); PG8_BAR; PG8_WAIT_L(0); PG8_MMA(0, 0, At, B0); PG8_BAR; PG8_SCHED;
            PG8_LDB(B1, 0, 1); PG8_STAGE(PG8_SB(0, 0), b2, voffB);
            PG8_BAR; PG8_WAIT_L(0); PG8_MMA(0, 1, At, B1); PG8_BAR;
            PG8_LDA(At, 0, 1); PG8_STAGE(PG8_SA(0, 0), a2, voffA);
            PG8_BAR; PG8_WAIT_L(0); PG8_MMA(1, 0, At, B0); PG8_BAR; PG8_SCHED;
            PG8_STAGE(PG8_SB(0, 1), b2 + hstep, voffB);
            PG8_WAIT_V(6); PG8_BAR; PG8_MMA(1, 1, At, B1); PG8_BAR;
            PG8_LDB(B0, 1, 0); PG8_SCHED; PG8_LDA(At, 1, 0); PG8_STAGE(PG8_SA(0, 1), a2 + hstep, voffA);
            PG8_WAIT_L(8); PG8_BAR; PG8_WAIT_L(0); PG8_MMA(0, 0, At, B0); PG8_BAR; PG8_SCHED;
            PG8_LDB(B1, 1, 1); PG8_STAGE(PG8_SB(1, 0), b3, voffB);
            PG8_BAR; PG8_WAIT_L(0); PG8_MMA(0, 1, At, B1); PG8_BAR;
            PG8_LDA(At, 1, 1); PG8_STAGE(PG8_SA(1, 0), a3, voffA);
            PG8_BAR; PG8_WAIT_L(0); PG8_MMA(1, 0, At, B0); PG8_BAR; PG8_SCHED;
            PG8_STAGE(PG8_SB(1, 1), b3 + hstep, voffB);
            PG8_WAIT_V(6); PG8_BAR; PG8_MMA(1, 1, At, B1); PG8_BAR;
            }
        }
        if constexpr (ALIGN_EPI) { if (wr == 0) PG8_BAR; }
        if constexpr (!Epi::AFTER_DRAIN) { E(acc, cur, wr, wc, fr, fq); S.done(cur); }
        if (!has_next) break;
#pragma unroll
        for (int a = 0; a < 2; ++a)
#pragma unroll
            for (int b = 0; b < 2; ++b)
#pragma unroll
                for (int m = 0; m < 4; ++m)
#pragma unroll
                    for (int n = 0; n < 2; ++n) acc[a][b][m][n] = (f32x4){0.f, 0.f, 0.f, 0.f};
        cur = nxt; cA = nA; cB = nB; ++ui;
        if constexpr (ALIGN_EPI) { if (wr == 1) PG8_BAR; }
    }
    PG8_WAIT_V(0);
    if constexpr (!ALIGN_EPI) { if (wr == 0) PG8_BAR; }
    PG8_BAR;
    if constexpr (Epi::AFTER_DRAIN) { E.fused(acc, cur, wr, wc, fr, fq, lds, wid, lane); S.done(cur); }
#undef PG8_SA
#undef PG8_SB
#undef PG8_STAGE
#undef PG8_LDA
#undef PG8_LDB
#undef PG8_MMA
#undef PG8_WAIT_V
#undef PG8_WAIT_L
#undef PG8_BAR
#undef PG8_SCHED
}
}


#define GAS __attribute__((address_space(1)))
#define LAS __attribute__((address_space(3)))
typedef unsigned short bf16;
typedef unsigned v4u __attribute__((ext_vector_type(4)));
typedef unsigned v2u __attribute__((ext_vector_type(2)));
typedef float f32x4 __attribute__((ext_vector_type(4)));
typedef float f32x2 __attribute__((ext_vector_type(2)));
typedef short bf16x8 __attribute__((ext_vector_type(8)));
typedef LAS unsigned char* ldsp;

constexpr int NWAVES = 8, NTHR = 512;
constexpr int D = 2048, SEQ = 2048, NB = 4, MP = 8192, NSMP = 128, MR = 8320, MT = 8448;
constexpr int NMEM = 256, XH = 4, XD = 128, XDIM = 512, MIX = 1536;
constexpr int AH = 12, AHD = 128, A_IN = 6656, LDP = 6656;
constexpr int BH = 24, BHD = 64, B_IN = 5472, B_INP = 5632, B_MIXC = 4960;
constexpr int DFF = 8192;
constexpr int LORA_K = 352;
constexpr int A_XQ_OFF = 6144;
constexpr int B_XQ_OFF = 4608;
constexpr int B_LORA_OFF = 5120;
constexpr float RMS_EPS = 1e-6f, GN_EPS = 64e-5f;

constexpr size_t O_YP = 0, O_YS = 16777216, O_MK = 17039360, O_MV = 19136512, O_SHP = 21233664, O_SRP = 22806528,
                 O_SSP = 23592960, O_SHS = 23609344, O_SRS = 73940992, O_SSS = 99106816, O_END = 99631104;

constexpr size_t al256(size_t x) { return (x + 255) & ~(size_t)255; }
constexpr size_t WS_CTL = 0, CTL_BYTES = 1u << 20;
constexpr size_t SZ_WINA = (size_t)A_IN * D * 2, SZ_WSQ = (size_t)D * D * 2, SZ_WINB = (size_t)B_INP * D * 2, SZ_WFF = (size_t)DFF * D * 2,
                 SZ_WKV = (size_t)1024 * D * 2, SZ_LW = (size_t)MIX * LORA_K * 2;
constexpr size_t WS_WINA = WS_CTL + CTL_BYTES;
constexpr size_t WS_WOUTA = WS_WINA + 2 * SZ_WINA;
constexpr size_t WS_WINB = WS_WOUTA + 2 * SZ_WSQ;
constexpr size_t WS_WOUTB = WS_WINB + 2 * SZ_WINB;
constexpr size_t WS_W1 = WS_WOUTB + 2 * SZ_WSQ;
constexpr size_t WS_W2 = WS_W1 + 4 * SZ_WFF;
constexpr size_t WS_WKV = WS_W2 + 4 * SZ_WFF;
constexpr size_t WS_LW = WS_WKV + 4 * SZ_WKV;
constexpr size_t WS_X = al256(WS_LW + 2 * SZ_LW);
constexpr size_t WS_H = WS_X + (size_t)MT * D * 4;
constexpr size_t WS_PROJ = WS_H + (size_t)MT * D * 2;
constexpr size_t WS_MIXC = WS_PROJ + (size_t)MT * LDP * 2;
constexpr size_t WS_ACT = WS_MIXC + (size_t)MT * D * 2;
constexpr size_t WS_MEMN = WS_ACT + (size_t)MT * DFF * 2;
constexpr size_t SZ_RW = (size_t)MT * MIX * 4;
constexpr size_t WS_RR = WS_MEMN + (size_t)1024 * D * 2;
constexpr size_t WS_RK = WS_RR + SZ_RW, WS_RV = WS_RK + SZ_RW, WS_RKK = WS_RV + SZ_RW, WS_RKA = WS_RKK + SZ_RW, WS_RW = WS_RKA + SZ_RW,
                 WS_RG = WS_RW + SZ_RW, WS_RO = WS_RG + SZ_RW;
constexpr size_t WS_BONUS = WS_RO + SZ_RW;
constexpr size_t WS_REC = al256(WS_BONUS + (size_t)MT * BH * 4);
constexpr size_t REC_BYTES = 7 * 8192;
constexpr size_t WS_END = al256(WS_REC + (size_t)NB * BH * 32 * REC_BYTES);

constexpr int CW_BAR = 4096;
constexpr int CW_CQ = 3072;
constexpr int CW_PDONE = 2560;
#ifndef HG_SPLIT
#define HG_SPLIT 16
#endif
constexpr int CW_SFLAG = 2048;
constexpr size_t CTL_SS = 65536;
typedef unsigned long long u64;
constexpr float SS_FIX = 1048576.f, SS_UNFIX = 1.f / 1048576.f;
__device__ __forceinline__ u64* ss_slot(unsigned char* ws, int s) { return (u64*)(ws + WS_CTL + CTL_SS) + (size_t)s * MT; }

constexpr int RING_BYTES = 159744, LDSCTL_OFF = RING_BYTES, MISC_OFF = LDSCTL_OFF + 320, LDS_BYTES = RING_BYTES + 1024;

#define LDS_WAIT() asm volatile("s_waitcnt lgkmcnt(0)" ::: "memory")
#define LDS_BARRIER() do { asm volatile("s_waitcnt lgkmcnt(0)" ::: "memory"); __builtin_amdgcn_s_barrier(); asm volatile("" ::: "memory"); } while (0)
#define VM_WAIT() asm volatile("s_waitcnt vmcnt(0)" ::: "memory")
typedef __bf16 bf16x2_t __attribute__((ext_vector_type(2)));
__device__ __forceinline__ unsigned pk2_hw(float lo, float hi) { f32x2 v = {lo, hi}; const bf16x2_t b = __builtin_convertvector(v, bf16x2_t); return __builtin_bit_cast(unsigned, b); }
__device__ __forceinline__ unsigned f2bf(float f) { return (__builtin_bit_cast(unsigned, f) + 0x8000u) >> 16; }
__device__ __forceinline__ unsigned pk2(float lo, float hi) { return __builtin_amdgcn_perm(__builtin_bit_cast(unsigned, hi) + 0x8000u, __builtin_bit_cast(unsigned, lo) + 0x8000u, 0x07060302u); }
__device__ __forceinline__ float bf2f(unsigned short b) { return __builtin_bit_cast(float, ((unsigned)b) << 16); }
__device__ __forceinline__ float bflo(unsigned w) { return __builtin_bit_cast(float, w << 16); }
__device__ __forceinline__ float bfhi(unsigned w) { return __builtin_bit_cast(float, w & 0xffff0000u); }
__device__ __forceinline__ f32x4 bf4(v2u w) { return (f32x4){bflo(w.x), bfhi(w.x), bflo(w.y), bfhi(w.y)}; }
__device__ __forceinline__ v2u pk4(f32x4 v) { v2u r; r.x = pk2(v.x, v.y); r.y = pk2(v.z, v.w); return r; }
__device__ __forceinline__ float wave_sum(float v) {
#pragma unroll
    for (int o = 1; o < 64; o <<= 1) v += __shfl_xor(v, o);
    return v;
}
__device__ __forceinline__ float wave_max(float v) {
#pragma unroll
    for (int o = 1; o < 64; o <<= 1) v = fmaxf(v, __shfl_xor(v, o));
    return v;
}
__device__ __forceinline__ float fsigmoid(float x) { return __builtin_amdgcn_rcpf(1.f + __expf(-x)); }
__device__ __forceinline__ int sw128(int r, int c) { return r * 256 + ((c ^ (r & 15)) << 4); }
__device__ __forceinline__ int sw64(int r, int c) { return r * 128 + ((c ^ ((r >> 1) & 7)) << 4); }
__device__ __forceinline__ int sw256(int r, int c) { return r * 512 + ((c ^ (r & 15)) << 4); }
#define MFMA16(a, b, c) __builtin_amdgcn_mfma_f32_16x16x32_bf16((a), (b), (c), 0, 0, 0)

#define XB_TMO      128
#define XB_XCNT(j)  (256  + 64 * (j))
#define XB_XSUB(j)  (1280 + 64 * (j))
#define XB_XGEN(j)  (2304 + 64 * (j))
#define XB_TOP      3328
#define XB_TOPGEN   3392
#define XCD_BAR_WORDS 3456
#define XB_SPIN_CAP (1u << 18)
__device__ __forceinline__ unsigned xb_ld(unsigned* p)              { return __hip_atomic_load(p, __ATOMIC_RELAXED, __HIP_MEMORY_SCOPE_AGENT); }
__device__ __forceinline__ unsigned xb_add(unsigned* p, unsigned v) { return __hip_atomic_fetch_add(p, v, __ATOMIC_RELAXED, __HIP_MEMORY_SCOPE_AGENT); }
__device__ __forceinline__ unsigned xb_xcc_id() { return (unsigned)__builtin_amdgcn_s_getreg((3 << 11) | 20) & 0xFu; }
#define XB_SPIN(cond, bar) do { unsigned _sp = 0; while (cond) { __builtin_amdgcn_s_sleep(1); \
    if ((++_sp & 255u) == 0u) { if (xb_ld(&(bar)[XB_TMO])) break; if (_sp > XB_SPIN_CAP) { atomicAdd(&(bar)[XB_TMO], 1u); break; } } } } while (0)
struct XcdBarrier { unsigned* bar; unsigned x; volatile LAS unsigned* st; };
__device__ __forceinline__ XcdBarrier xcd_barrier_post(unsigned* bar, volatile LAS unsigned* st) {
    XcdBarrier b; b.bar = bar; b.x = xb_xcc_id(); b.st = st;
    if (threadIdx.x == 0) (void)xb_add(&bar[XB_XCNT(b.x)], 1u);
    return b;
}
__device__ __forceinline__ void xcd_barrier_complete(unsigned* bar, unsigned x, unsigned& nloc, unsigned& nx) {
    const unsigned G = gridDim.x * gridDim.y * gridDim.z;
    unsigned sum, cnt, mine, sp = 0u;
    for (;;) {
        sum = 0u; cnt = 0u; mine = 0u;
#pragma unroll
        for (unsigned j = 0; j < 16; ++j) { const unsigned c = xb_ld(&bar[XB_XCNT(j)]); sum += c; cnt += (c > 0u) ? 1u : 0u; mine = (j == x) ? c : mine; }
        if (sum == G) break;
        __builtin_amdgcn_s_sleep(1);
        if ((++sp & 255u) == 0u) { if (xb_ld(&bar[XB_TMO])) break; if (sp > XB_SPIN_CAP) { atomicAdd(&bar[XB_TMO], 1u); break; } }
    }
    nloc = mine > 0u ? mine : 1u; nx = cnt > 0u ? cnt : 1u;
}
__device__ __forceinline__ void xcd_barrier(const XcdBarrier& b) {
    asm volatile("s_waitcnt vmcnt(0)" ::: "memory");
    __syncthreads();
    if (threadIdx.x == 0) {
        unsigned* bar = b.bar;
        __builtin_amdgcn_s_waitcnt(0);
        unsigned nloc = b.st[0], nx = b.st[1];
        if (nloc == 0u) { xcd_barrier_complete(bar, b.x, nloc, nx); b.st[0] = nloc; b.st[1] = nx; }
        const unsigned old = xb_add(&bar[XB_XSUB(b.x)], 1u);
        const unsigned gen = old / nloc;
        if (old + 1u == (gen + 1u) * nloc) {
            __builtin_amdgcn_fence(__ATOMIC_RELEASE, "agent");
            asm volatile("s_waitcnt vmcnt(0)" ::: "memory");
            const unsigned og = xb_add(&bar[XB_TOP], 1u);
            const unsigned tg = og / nx;
            if (og + 1u == (tg + 1u) * nx) xb_add(&bar[XB_TOPGEN], 1u);
            else XB_SPIN(xb_ld(&bar[XB_TOPGEN]) == tg, bar);
            __builtin_amdgcn_fence(__ATOMIC_ACQUIRE, "agent");
            xb_add(&bar[XB_XGEN(b.x)], 1u);
            asm volatile("s_waitcnt vmcnt(0)" ::: "memory");
        } else {
            XB_SPIN(xb_ld(&bar[XB_XGEN(b.x)]) == gen, bar);
            __builtin_amdgcn_fence(__ATOMIC_ACQUIRE, "agent");
            asm volatile("s_waitcnt vmcnt(0)" ::: "memory");
        }
    }
    __syncthreads();
}

__device__ __forceinline__ float atomic_add_agent(float* p, float v) { return __hip_atomic_fetch_add(p, v, __ATOMIC_RELAXED, __HIP_MEMORY_SCOPE_AGENT); }
template <int ACT> struct EpiBf {
    static constexpr bool PERM = true, AFTER_DRAIN = false;
    bf16* O; int ldc; const u64* ss;
    __device__ __forceinline__ void operator()(const pg8::f32x4 (&acc)[2][2][4][2], const pg8::Unit& u, int wr, int wc, int fr, int fq) const {
        const int row0 = u.pm * 256 + wr * 64 + fr, col0 = u.pn * 256 + wc * 32 + 8 * fq;
#pragma unroll
        for (int ai = 0; ai < 2; ++ai)
#pragma unroll
            for (int m = 0; m < 4; ++m) { const int row = row0 + ai * 128 + m * 16; bf16* rowp = O + (size_t)row * ldc + col0;
                const float rs = (ACT == 2) ? 1.f : __builtin_amdgcn_rsqf((float)ss[row] * (SS_UNFIX / D) + RMS_EPS);
#pragma unroll
                for (int bj = 0; bj < 2; ++bj) { pg8::f32x4 v0 = acc[ai][bj][m][0] * rs, v1 = acc[ai][bj][m][1] * rs;
                    if (ACT >= 1) {
#pragma unroll
                        for (int q = 0; q < 4; ++q) { const float a = fmaxf(v0[q], 0.f), b = fmaxf(v1[q], 0.f); v0[q] = a * a; v1[q] = b * b; } }
                    pg8::u32x4 w; w.x = pg8::cvt_pk_bf16(v0[0], v0[1]); w.y = pg8::cvt_pk_bf16(v0[2], v0[3]); w.z = pg8::cvt_pk_bf16(v1[0], v1[1]); w.w = pg8::cvt_pk_bf16(v1[2], v1[3]);
                    *(pg8::u32x4*)(rowp + bj * 128) = w; }
                __builtin_amdgcn_sched_barrier(0); }
    }
};
template <bool SCL> struct EpiResid {
    static constexpr bool PERM = false, AFTER_DRAIN = false;
    float* X; int ldc; bf16* Hb; u64* ssq; const u64* scl;
    __device__ __forceinline__ void operator()(const pg8::f32x4 (&acc)[2][2][4][2], const pg8::Unit& u, int wr, int wc, int fr, int fq) const {
        const int row0 = u.pm * 256 + wr * 64 + fr, col0 = u.pn * 256 + wc * 32 + 4 * fq; u64 ret = 0;
#pragma unroll
        for (int ai = 0; ai < 2; ++ai)
#pragma unroll
            for (int m = 0; m < 4; ++m) { const int row = row0 + ai * 128 + m * 16; float* rowp = X + (size_t)row * ldc + col0; bf16* hp = Hb + (size_t)row * ldc + col0;
                const float r2 = SCL ? __builtin_amdgcn_rcpf((float)scl[row] * (SS_UNFIX / D) + RMS_EPS) : 1.f;
                float s = 0.f;
#pragma unroll
                for (int bj = 0; bj < 2; ++bj)
#pragma unroll
                    for (int n = 0; n < 2; ++n) { pg8::f32x4* p = (pg8::f32x4*)(rowp + bj * 128 + n * 16); const pg8::f32x4 x = *p + acc[ai][bj][m][n] * r2; *p = x;
                        v2u hw; hw.x = pg8::cvt_pk_bf16(x[0], x[1]); hw.y = pg8::cvt_pk_bf16(x[2], x[3]); *(v2u*)(hp + bj * 128 + n * 16) = hw;
                        s += (x[0] * x[0] + x[1] * x[1]) + (x[2] * x[2] + x[3] * x[3]); }
                s += __shfl_xor(s, 16); s += __shfl_xor(s, 32);
                if (fq == 0) ret += __hip_atomic_fetch_add(ssq + row, (u64)(s * SS_FIX + 0.5f), __ATOMIC_RELAXED, __HIP_MEMORY_SCOPE_AGENT); }
        asm volatile("" :: "v"(ret));
    }
};
struct EpiMemKV {
    static constexpr bool PERM = false, AFTER_DRAIN = false;
    float* out;
    __device__ __forceinline__ void operator()(const pg8::f32x4 (&acc)[2][2][4][2], const pg8::Unit& u, int wr, int wc, int fr, int fq) const {
        const int layer = u.pn >> 2, kv = (u.pn >> 1) & 1, c0 = (u.pn & 1) * 256 + wc * 32 + 4 * fq;
        float* base = out + (kv ? O_MV : O_MK) + (size_t)layer * (1024 * 512);
        const int row0 = u.pm * 256 + wr * 64 + fr;
#pragma unroll
        for (int ai = 0; ai < 2; ++ai)
#pragma unroll
            for (int m = 0; m < 4; ++m) { float* rowp = base + (size_t)(row0 + ai * 128 + m * 16) * 512 + c0;
#pragma unroll
                for (int bj = 0; bj < 2; ++bj)
#pragma unroll
                    for (int n = 0; n < 2; ++n) *(pg8::f32x4*)(rowp + bj * 128 + n * 16) = acc[ai][bj][m][n]; }
    }
};
struct EpiDummy {
    static constexpr bool PERM = false, AFTER_DRAIN = false;
    float* C; int ldc;
    __device__ __forceinline__ void operator()(const pg8::f32x4 (&acc)[2][2][4][2], const pg8::Unit& u, int wr, int wc, int fr, int fq) const {
        const int row0 = u.pm * 256 + wr * 64 + fr, col0 = u.pn * 256 + wc * 32 + 4 * fq;
#pragma unroll
        for (int ai = 0; ai < 2; ++ai)
#pragma unroll
            for (int m = 0; m < 4; ++m) { float* rowp = C + (size_t)(row0 + ai * 128 + m * 16) * ldc + col0;
#pragma unroll
                for (int bj = 0; bj < 2; ++bj)
#pragma unroll
                    for (int n = 0; n < 2; ++n) *(pg8::f32x4*)(rowp + bj * 128 + n * 16) = acc[ai][bj][m][n]; }
    }
};
struct RotOrder : pg8::StaticOrder {};

struct Job { const float* src; bf16* dst; const float* gain; int ldw, K, ncols, ldt, koff, row_off, item0, pad; };
constexpr int NJOBS = 34;
struct Args { const float* in[33]; float* out; unsigned char* ws; Job jobs[NJOBS]; int git[6]; int njobs, nitems, ph_lo, ph_hi, pad2[2]; };

__device__ __forceinline__ int fresh_tid() { int t = threadIdx.x; asm volatile("" : "+v"(t)); return t; }
struct Frame {
    ldsp lds;
    int tid, lane, wave, G, vcu;
    unsigned char* ws; float* out;
};


__device__ __forceinline__ void norm_row(const float* src, const float* g, int lane, bf16* hdst, float* fdst, float* xcopy, float* f2) {
    const f32x4* xr = (const f32x4*)src + lane; const f32x4* gr = (const f32x4*)g + lane;
    f32x4 v[8]; float s = 0.f;
#pragma unroll
    for (int j = 0; j < 8; ++j) { v[j] = xr[64 * j]; s += (v[j].x * v[j].x + v[j].y * v[j].y) + (v[j].z * v[j].z + v[j].w * v[j].w); }
    s = wave_sum(s);
    const float rstd = 1.f / sqrtf(s * (1.f / D) + RMS_EPS);
    if (xcopy) {
#pragma unroll
        for (int j = 0; j < 8; ++j) ((f32x4*)xcopy + lane)[64 * j] = v[j]; }
#pragma unroll
    for (int j = 0; j < 8; ++j) { const f32x4 y = v[j] * rstd * gr[64 * j];
        if (hdst) ((v2u*)hdst + lane)[64 * j] = pk4(y);
        if (fdst) ((f32x4*)fdst + lane)[64 * j] = y;
        if (f2) ((f32x4*)f2 + lane)[64 * j] = y; }
}

__device__ __forceinline__ void norm_phase(Frame& F0, const Args& A, const float* g, bool first, bool final, int shift_j) {
    Frame F = F0; F.tid = fresh_tid(); F.lane = F.tid & 63; F.wave = __builtin_amdgcn_readfirstlane(F.tid >> 6);
    const int gw = F.vcu * NWAVES + F.wave, NGW = F.G * NWAVES;
    float* X = (float*)(F.ws + WS_X); bf16* H = (bf16*)(F.ws + WS_H);
    for (int row = gw; row < MR; row += NGW) {
        const float* src = first ? (row < MP ? A.in[0] + (size_t)row * D : A.in[1] + (size_t)(row - MP) * D) : X + (size_t)row * D;
        float* f2 = nullptr;
        if (shift_j >= 0) {
            if (row < MP) { if ((row & (SEQ - 1)) == SEQ - 1) f2 = F.out + O_SSP + (size_t)(shift_j * NB + (row >> 11)) * D; }
            else f2 = F.out + O_SSS + (size_t)(shift_j * NSMP + (row - MP)) * D;
        }
        norm_row(src, g, F.lane, final ? nullptr : H + (size_t)row * D, final ? F.out + O_YP + (size_t)row * D : nullptr, first ? X + (size_t)row * D : nullptr, f2);
    }
    if (shift_j >= 0) {
        const float* sh = A.in[6] + (size_t)shift_j * NSMP * D;
        for (int r = gw; r < NSMP; r += NGW) { const f32x4* xr = (const f32x4*)(sh + (size_t)r * D) + F.lane; v2u* o = (v2u*)(H + (size_t)(MR + r) * D) + F.lane;
#pragma unroll
            for (int j = 0; j < 8; ++j) o[64 * j] = pk4(xr[64 * j]); }
    }
}

struct CvtMeta { int j, k0, n0, hg; };
__device__ __forceinline__ CvtMeta cvt_load(const Args& A, int it, int lane, f32x4 (&v0)[8], f32x4 (&v1)[8], float (&g0)[8], float (&g1)[8]) {
    int j = 0;
    for (int q = 1; q < A.njobs; ++q) if (it >= A.jobs[q].item0) j = q;
    const Job& J = A.jobs[j]; const int item = it - J.item0;
    const int nblk = (J.ncols + 63) / 64, kb = item / nblk, nb = item - kb * nblk, k0 = 64 * kb, n0 = 64 * nb;
    const int n4 = 4 * (lane & 15), kp = lane >> 4; const float* gp = J.gain ? J.gain : J.src;
    const int nc = min(n0 + n4, J.ncols - 4);
#pragma unroll
    for (int i = 0; i < 8; ++i) { const int k = min(k0 + 8 * i + 2 * kp, J.K - 2);
        v0[i] = *(const f32x4*)(J.src + (size_t)k * J.ldw + nc);
        v1[i] = *(const f32x4*)(J.src + (size_t)(k + 1) * J.ldw + nc);
        g0[i] = gp[k]; g1[i] = gp[k + 1]; }
    return CvtMeta{j, k0, n0, J.gain != nullptr ? 1 : 0};
}
__device__ __forceinline__ void convert_items(Frame& F, const Args& A, int it_lo, int it_hi, int wk, int nworkers) {
    const int tid = fresh_tid(), lane = tid & 63, w = __builtin_amdgcn_readfirstlane(tid >> 6);
    LAS unsigned* scr = (LAS unsigned*)(F.lds + w * 8448);
    const int n4 = 4 * (lane & 15), kp = lane >> 4, c = lane & 7;
    f32x4 v0[8], v1[8]; float g0[8], g1[8]; CvtMeta m{0, 0, 0, 0};
    int it = it_lo + wk;
    if (it < it_hi) m = cvt_load(A, it, lane, v0, v1, g0, g1);
    while (it < it_hi) {
#pragma unroll
        for (int i = 0; i < 8; ++i) { LAS unsigned* s = scr + n4 * 33 + 4 * i + kp; const f32x4 x0 = v0[i] * (m.hg ? g0[i] : 1.f), x1 = v1[i] * (m.hg ? g1[i] : 1.f);
            s[0] = pk2(x0.x, x1.x); s[33] = pk2(x0.y, x1.y); s[66] = pk2(x0.z, x1.z); s[99] = pk2(x0.w, x1.w); }
        const CvtMeta cur = m; const int nxt = it + nworkers;
        if (nxt < it_hi) m = cvt_load(A, nxt, lane, v0, v1, g0, g1);
        LDS_WAIT(); asm volatile("" ::: "memory");
        const Job& J = A.jobs[cur.j];
        if (cur.k0 + 8 * c < J.K) {
#pragma unroll
            for (int jn = 0; jn < 8; ++jn) { const int n = jn * 8 + (lane >> 3); const LAS unsigned* s = scr + n * 33 + 4 * c;
                v4u o; o.x = s[0]; o.y = s[1]; o.z = s[2]; o.w = s[3];
                if (cur.n0 + n < J.ncols) *(v4u*)(J.dst + (size_t)(J.row_off + cur.n0 + n) * J.ldt + J.koff + cur.k0 + 8 * c) = o; } }
        LDS_WAIT(); asm volatile("" ::: "memory");
        it = nxt;
    }
}
__device__ __forceinline__ void cvt_store(const Args& A, const CvtMeta cur, LAS unsigned* scr, int lane, int c) {
    const Job& J = A.jobs[cur.j];
    if (cur.k0 + 8 * c < J.K) {
#pragma unroll
        for (int jn = 0; jn < 8; ++jn) { const int n = jn * 8 + (lane >> 3); const LAS unsigned* s = scr + n * 33 + 4 * c;
            v4u o; o.x = s[0]; o.y = s[1]; o.z = s[2]; o.w = s[3];
            if (cur.n0 + n < J.ncols) *(v4u*)(J.dst + (size_t)(J.row_off + cur.n0 + n) * J.ldt + J.koff + cur.k0 + 8 * c) = o; } }
}
__device__ __forceinline__ void convert_items_dyn(Frame& F, const Args& A, int it_lo, int it_hi, unsigned* ctr, int q) {
    const int tid = fresh_tid(), lane = tid & 63, w = __builtin_amdgcn_readfirstlane(tid >> 6);
    LAS unsigned* scr = (LAS unsigned*)(F.lds + w * 8448);
    const int n4 = 4 * (lane & 15), kp = lane >> 4, c = lane & 7;
    f32x4 v0[8], v1[8]; float g0[8], g1[8]; CvtMeta m{0, 0, 0, 0};
    unsigned av = 0u;
    if (lane == 0) av = __hip_atomic_fetch_add(ctr, 2u, __ATOMIC_RELAXED, __HIP_MEMORY_SCOPE_AGENT);
    const int first = (int)__builtin_amdgcn_readfirstlane(av);
    int it = it_lo + 2 * (8 * first + q), tnext = first + 1;
    if (lane == 0) av = __hip_atomic_fetch_add(ctr, 1u, __ATOMIC_RELAXED, __HIP_MEMORY_SCOPE_AGENT);
    if (it < it_hi) m = cvt_load(A, it, lane, v0, v1, g0, g1);
    while (it < it_hi) {
#pragma unroll
        for (int i = 0; i < 8; ++i) { LAS unsigned* s = scr + n4 * 33 + 4 * i + kp; const f32x4 x0 = v0[i] * (m.hg ? g0[i] : 1.f), x1 = v1[i] * (m.hg ? g1[i] : 1.f);
            s[0] = pk2(x0.x, x1.x); s[33] = pk2(x0.y, x1.y); s[66] = pk2(x0.z, x1.z); s[99] = pk2(x0.w, x1.w); }
        const CvtMeta cur = m;
        int nxt;
        if (((it - it_lo) & 1) == 0) nxt = it + 1;
        else { nxt = it_lo + 2 * (8 * tnext + q);
            tnext = (int)__builtin_amdgcn_readfirstlane(av);
            if (lane == 0) av = __hip_atomic_fetch_add(ctr, 1u, __ATOMIC_RELAXED, __HIP_MEMORY_SCOPE_AGENT); }
        if (nxt < it_hi) m = cvt_load(A, nxt, lane, v0, v1, g0, g1);
        LDS_WAIT(); asm volatile("" ::: "memory");
        cvt_store(A, cur, scr, lane, c);
        LDS_WAIT(); asm volatile("" ::: "memory");
        it = nxt;
    }
}
__device__ __forceinline__ void p0_prologue(Frame& F0, const Args& A) {
    Frame F = F0; F.tid = fresh_tid(); F.lane = F.tid & 63; F.wave = __builtin_amdgcn_readfirstlane(F.tid >> 6);
    const int gw = F.vcu * NWAVES + F.wave, NGW = F.G * NWAVES;
    convert_items(F, A, 0, A.git[1], gw, NGW);
    for (int jj = 0; jj < 2; ++jj) { v4u* z = (v4u*)(F.ws + WS_WINB + jj * SZ_WINB + (size_t)B_IN * D * 2); const int n16 = (B_INP - B_IN) * D * 2 / 16;
        for (int i = gw * 64 + F.lane; i < n16; i += NGW * 64) z[i] = (v4u){0u, 0u, 0u, 0u}; }
    bf16* MEMN = (bf16*)(F.ws + WS_MEMN);
    for (int row = gw; row < NB * NMEM; row += NGW) norm_row(A.in[7] + (size_t)row * D, A.in[11], F.lane, MEMN + (size_t)row * D, nullptr, nullptr, nullptr);
    { float* X = (float*)(F.ws + WS_X); bf16* H = (bf16*)(F.ws + WS_H); u64* ss0 = ss_slot(F.ws, 0);
      for (int row = gw; row < MR; row += NGW) {
          const float* src = row < MP ? A.in[0] + (size_t)row * D : A.in[1] + (size_t)(row - MP) * D;
          const f32x4* xr = (const f32x4*)src + F.lane; float s = 0.f;
#pragma unroll
          for (int jj = 0; jj < 8; ++jj) { const f32x4 v = xr[64 * jj]; s += (v.x * v.x + v.y * v.y) + (v.z * v.z + v.w * v.w);
              ((f32x4*)(X + (size_t)row * D) + F.lane)[64 * jj] = v; ((v2u*)(H + (size_t)row * D) + F.lane)[64 * jj] = pk4(v); }
          s = wave_sum(s); if (F.lane == 0) ss0[row] = (u64)(s * SS_FIX + 0.5f); } }
}

#ifndef GEMM_ALIGN
#define GEMM_ALIGN true
#endif
#ifndef GEMM_SP2
#define GEMM_SP2 true
#endif
template <class Epi> __device__ __forceinline__ void run_gemm(Frame& F, const bf16* Am, const bf16* Bt, int M, int N, int K, const Epi& E, int rot) {
    pg8::Gemm g{Am, Bt, M, N, K}; pg8::StaticOrder S; S.init(M, N, F.G, (int)((blockIdx.x + rot) % F.G));
    pg8::gemm_phase<Epi, pg8::StaticOrder, GEMM_ALIGN, GEMM_SP2>(F.lds, g, S, E);
}

constexpr int SK_RED = 0, SK_SSQ = 131072;
template <int AMODE, int EMODE> __device__ __forceinline__ void skinny_gemm(Frame& F, const void* Aptr, int lda, const float* gain, const bf16* Bt, int ldb, int n0, int rh, int k0, int klen, void* outp, int ldc, int orow0) {
    const ldsp L = F.lds; const int tid = fresh_tid(), w = __builtin_amdgcn_readfirstlane(tid >> 6), lane = tid & 63, fr = lane & 15, q4 = lane >> 4;
    const int kw = klen >> 3, kb = k0 + w * kw, nks = kw >> 5;
    f32x4 acc[4][4]; float ssq[4];
#pragma unroll
    for (int rt = 0; rt < 4; ++rt) { ssq[rt] = 0.f;
#pragma unroll
        for (int ct = 0; ct < 4; ++ct) acc[rt][ct] = (f32x4){0.f, 0.f, 0.f, 0.f}; }
    const bf16* bp = Bt + (size_t)(n0 + fr) * ldb + kb + q4 * 8;
    __syncthreads();
#pragma unroll 2
    for (int ks = 0; ks < nks; ++ks) {
        bf16x8 bq[4];
#pragma unroll
        for (int ct = 0; ct < 4; ++ct) bq[ct] = *(const bf16x8*)(bp + (size_t)ct * 16 * ldb + ks * 32);
        bf16x8 a[4];
        if (AMODE == 0) { const bf16* ap = (const bf16*)Aptr + (size_t)(rh * 64 + fr) * lda + kb + q4 * 8 + ks * 32;
#pragma unroll
            for (int rt = 0; rt < 4; ++rt) a[rt] = *(const bf16x8*)(ap + (size_t)rt * 16 * lda); }
        else { const float* ap = (const float*)Aptr + (size_t)(rh * 64 + fr) * lda + kb + q4 * 8 + ks * 32;
            f32x4 g0 = (f32x4){1.f, 1.f, 1.f, 1.f}, g1 = g0;
            if (AMODE == 2) { const f32x4 t0 = *(const f32x4*)(gain + kb + q4 * 8 + ks * 32), t1 = *(const f32x4*)(gain + kb + q4 * 8 + ks * 32 + 4);
                g0 = (f32x4){__builtin_amdgcn_rcpf(t0.x), __builtin_amdgcn_rcpf(t0.y), __builtin_amdgcn_rcpf(t0.z), __builtin_amdgcn_rcpf(t0.w)};
                g1 = (f32x4){__builtin_amdgcn_rcpf(t1.x), __builtin_amdgcn_rcpf(t1.y), __builtin_amdgcn_rcpf(t1.z), __builtin_amdgcn_rcpf(t1.w)}; }
            f32x4 x0[4], x1[4];
#pragma unroll
            for (int rt = 0; rt < 4; ++rt) { x0[rt] = *(const f32x4*)(ap + (size_t)rt * 16 * lda); x1[rt] = *(const f32x4*)(ap + (size_t)rt * 16 * lda + 4); }
#pragma unroll
            for (int rt = 0; rt < 4; ++rt) { f32x4 y0 = x0[rt], y1 = x1[rt];
                if (AMODE == 2) { y0 = y0 * g0; y1 = y1 * g1; }
                if (AMODE == 1) ssq[rt] += (y0.x * y0.x + y0.y * y0.y) + (y0.z * y0.z + y0.w * y0.w) + (y1.x * y1.x + y1.y * y1.y) + (y1.z * y1.z + y1.w * y1.w);
                v4u aw; aw.x = pk2(y0.x, y0.y); aw.y = pk2(y0.z, y0.w); aw.z = pk2(y1.x, y1.y); aw.w = pk2(y1.z, y1.w);
                a[rt] = __builtin_bit_cast(bf16x8, aw); } }
#pragma unroll
        for (int rt = 0; rt < 4; ++rt)
#pragma unroll
            for (int ct = 0; ct < 4; ++ct) acc[rt][ct] = MFMA16(bq[ct], a[rt], acc[rt][ct]);
    }
#pragma unroll
    for (int rt = 0; rt < 4; ++rt)
#pragma unroll
        for (int ct = 0; ct < 4; ++ct) *(LAS f32x4*)(L + SK_RED + ((w * 16 + rt * 4 + ct) * 64 + lane) * 16) = acc[rt][ct];
    if (AMODE == 1) {
#pragma unroll
        for (int rt = 0; rt < 4; ++rt) { float s = ssq[rt]; s += __shfl_xor(s, 16); s += __shfl_xor(s, 32); if (q4 == 0) ((LAS float*)(L + SK_SSQ))[(w * 4 + rt) * 16 + fr] = s; } }
    __syncthreads();
    const int rto = w >> 1, cto = 2 * (w & 1);
    f32x4 r0 = (f32x4){0.f, 0.f, 0.f, 0.f}, r1 = r0; float st = 0.f;
#pragma unroll
    for (int sw = 0; sw < 8; ++sw) { r0 = r0 + *(LAS f32x4*)(L + SK_RED + ((sw * 16 + rto * 4 + cto) * 64 + lane) * 16); r1 = r1 + *(LAS f32x4*)(L + SK_RED + ((sw * 16 + rto * 4 + cto + 1) * 64 + lane) * 16);
        if (AMODE == 1) st += ((LAS float*)(L + SK_SSQ))[(sw * 4 + rto) * 16 + fr]; }
    if (AMODE == 1) { const float rs = __builtin_amdgcn_rsqf(st * (1.f / D) + RMS_EPS); r0 = r0 * rs; r1 = r1 * rs; }
    const int m = orow0 + rh * 64 + 16 * rto + fr, c0 = n0 + cto * 16 + q4 * 4;
    if (EMODE == 2) { float* o = (float*)outp + (size_t)m * ldc + c0; float ret = 0.f;
#pragma unroll
        for (int r = 0; r < 4; ++r) { ret += atomic_add_agent(o + r, r0[r]); ret += atomic_add_agent(o + 16 + r, r1[r]); }
        asm volatile("" :: "v"(ret)); }
    else { if (EMODE == 1) {
#pragma unroll
            for (int r = 0; r < 4; ++r) { const float x0 = fmaxf(r0[r], 0.f), x1 = fmaxf(r1[r], 0.f); r0[r] = x0 * x0; r1[r] = x1 * x1; } }
        bf16* o = (bf16*)outp + (size_t)m * ldc + c0; *(v2u*)o = pk4(r0); *(v2u*)(o + 16) = pk4(r1); }
    __syncthreads();
}

constexpr int SN_BLOCKS = 16;
__device__ __forceinline__ void sample_rows_prepare(Frame& F, const float* shift, const float* gain, u64* ssq, unsigned* flag, int wv) {
    const int tid = fresh_tid(), lane = tid & 63;
    const float* X = (const float*)(F.ws + WS_X); bf16* H = (bf16*)(F.ws + WS_H);
    { const int row = MP + wv; const f32x4* xr = (const f32x4*)(X + (size_t)row * D) + lane; float s = 0.f;
#pragma unroll
      for (int jj = 0; jj < 8; ++jj) { const f32x4 v = xr[64 * jj]; s += (v.x * v.x + v.y * v.y) + (v.z * v.z + v.w * v.w); ((v2u*)(H + (size_t)row * D) + lane)[64 * jj] = pk4(v); }
      s = wave_sum(s); if (lane == 0) ssq[row] = (u64)(s * SS_FIX + 0.5f); }
    if (shift) { const int row = MR + wv; const f32x4* xr = (const f32x4*)(shift + (size_t)wv * D) + lane; const f32x4* gr = (const f32x4*)gain + lane;
#pragma unroll
        for (int jj = 0; jj < 8; ++jj) { const f32x4 v = xr[64 * jj], g = gr[64 * jj];
            ((v2u*)(H + (size_t)row * D) + lane)[64 * jj] = pk4((f32x4){v.x * __builtin_amdgcn_rcpf(g.x), v.y * __builtin_amdgcn_rcpf(g.y), v.z * __builtin_amdgcn_rcpf(g.z), v.w * __builtin_amdgcn_rcpf(g.w)}); }
        if (lane == 0) { u64 one = (u64)((double)D * (1.0 - (double)RMS_EPS) * (double)SS_FIX + 0.5); asm volatile("" : "+s"(one)); ssq[row] = one; } }
    asm volatile("s_waitcnt vmcnt(0)" ::: "memory");
    __syncthreads();
    if (tid == 0) { __builtin_amdgcn_fence(__ATOMIC_RELEASE, "agent"); asm volatile("s_waitcnt vmcnt(0)" ::: "memory");
        (void)__hip_atomic_fetch_add(flag, 1u, __ATOMIC_RELAXED, __HIP_MEMORY_SCOPE_AGENT); }
}
struct SampleOrder : pg8::StaticOrder {
    const unsigned* flag;
    __device__ __forceinline__ void a_ready(const pg8::Unit& u) const {
        if (u.pm == MP / 256) {
            if (__builtin_amdgcn_readfirstlane(threadIdx.x >> 6) == 0) {
                int polls = 0;
                while ((unsigned)__builtin_amdgcn_readfirstlane(__hip_atomic_load(flag, __ATOMIC_RELAXED, __HIP_MEMORY_SCOPE_AGENT)) < (unsigned)SN_BLOCKS) { polls = __builtin_amdgcn_readfirstlane(polls + 1); if (polls > (1 << 18)) break; __builtin_amdgcn_s_sleep(2); }
                __builtin_amdgcn_fence(__ATOMIC_ACQUIRE, "agent");
                asm volatile("s_waitcnt vmcnt(0)" ::: "memory"); }
            asm volatile("" ::: "memory"); __builtin_amdgcn_s_barrier(); asm volatile("" ::: "memory");
        }
    }
};
struct SampleOrderEarly : SampleOrder {
    unsigned* donectr;
    __device__ bool next(int i, pg8::Unit& u) const {
        long Lq = (long)i * G + c; if (Lq >= nwg) return false;
        if (Lq >= 214 && Lq < 214 + nN) { u.pm = nM - 1; u.pn = (int)Lq - 214; return true; }
        if (Lq >= 551 && ((Lq - 551) & 7) == 0 && (Lq - 551) / 8 < nN) Lq = 214 + (Lq - 551) / 8;
        int wgid = (int)Lq; { const int q = nwg / pg8::NXCD, r = nwg % pg8::NXCD, xcd = wgid % pg8::NXCD, off = wgid / pg8::NXCD; wgid = (xcd < r ? xcd * (q + 1) : r * (q + 1) + (xcd - r) * q) + off; }
        const int nig = pg8::WGM * nN, gid = wgid / nig, fm = gid * pg8::WGM, gsz = (nM - fm) < pg8::WGM ? (nM - fm) : pg8::WGM;
        u.pm = fm + ((wgid % nig) % gsz); u.pn = (wgid % nig) / gsz; return true;
    }
    __device__ __forceinline__ void done(const pg8::Unit& u) const {
        if (u.pm == MP / 256) {
            asm volatile("s_waitcnt vmcnt(0)" ::: "memory"); __builtin_amdgcn_s_barrier(); asm volatile("" ::: "memory");
            if (threadIdx.x == 0) { __builtin_amdgcn_fence(__ATOMIC_RELEASE, "agent"); asm volatile("s_waitcnt vmcnt(0)" ::: "memory");
                (void)__hip_atomic_fetch_add(donectr, 1u, __ATOMIC_RELAXED, __HIP_MEMORY_SCOPE_AGENT); }
        }
    }
};
template <class Epi> __device__ __forceinline__ void run_gemm_sample_early(Frame& F, const bf16* Am, const bf16* Bt, int N, int K, const Epi& E, const unsigned* flag, unsigned* donectr) {
    pg8::Gemm g{Am, Bt, MT, N, K}; SampleOrderEarly S; S.init(MT, N, F.G, (int)blockIdx.x); S.flag = flag; S.donectr = donectr;
    pg8::gemm_phase<Epi, SampleOrderEarly, GEMM_ALIGN, GEMM_SP2>(F.lds, g, S, E);
}
__device__ __forceinline__ void wait_counter(const unsigned* ctr, unsigned target) {
    if (__builtin_amdgcn_readfirstlane(threadIdx.x >> 6) == 0) { int polls = 0;
        while ((unsigned)__builtin_amdgcn_readfirstlane(__hip_atomic_load(ctr, __ATOMIC_RELAXED, __HIP_MEMORY_SCOPE_AGENT)) < target) { polls = __builtin_amdgcn_readfirstlane(polls + 1); if (polls > (1 << 18)) break; __builtin_amdgcn_s_sleep(2); }
        __builtin_amdgcn_fence(__ATOMIC_ACQUIRE, "agent"); asm volatile("s_waitcnt vmcnt(0)" ::: "memory"); }
    __syncthreads();
    __builtin_amdgcn_fence(__ATOMIC_ACQUIRE, "agent"); asm volatile("s_waitcnt vmcnt(0)" ::: "memory");
}
template <class Epi> __device__ __forceinline__ void run_gemm_sample(Frame& F, const bf16* Am, const bf16* Bt, int N, int K, const Epi& E, const unsigned* flag) {
    pg8::Gemm g{Am, Bt, MT, N, K}; SampleOrder S; S.init(MT, N, F.G, (int)blockIdx.x); S.flag = flag;
    pg8::gemm_phase<Epi, SampleOrder, GEMM_ALIGN, GEMM_SP2>(F.lds, g, S, E);
}

constexpr int HG_QT = 0, HG_KT = 16384, HG_QH = 32768, HG_KHT = 49152, HG_VT = 65536, HG_ATT = 81920, HG_ST = 90112, HG_TOT = 122880, HG_DEC = 124928, HG_SS = 125440, HG_DEC2 = 126976;

__device__ __forceinline__ float lower_bound(const float* lb_logits, int j, int ch) {
    if (j == 0) return 0.f;
    const float l0 = lb_logits[ch], l1 = lb_logits[MIX + ch];
    return 1.f / (1.f + __expf(l0 - l1));
}
__device__ __forceinline__ void sig2(float x, float& sp, float& sn) { const float e = __expf(-fabsf(x)), r = __builtin_amdgcn_rcpf(1.f + e); const float big = r, small = e * r; sp = x >= 0.f ? big : small; sn = x >= 0.f ? small : big; }
__device__ __forceinline__ float fsilu(float x) { float sp, sn; sig2(x, sp, sn); return x * sp; }

__device__ __forceinline__ void hgrn_prompt_unit(Frame& F, const bf16* PROJ, bf16* MIXC, const float* lb_logits, const float* onorm_g, float* state_out, int j, int b, int h, int c_lo, int c_hi) {
    const ldsp L = F.lds; const int tid = fresh_tid(), w = __builtin_amdgcn_readfirstlane(tid >> 6), lane = tid & 63, fr = lane & 15, q4 = lane >> 4;
    const int ek = tid & 127, etq = tid >> 7;
    const float lbk = lower_bound(lb_logits, j, h * 128 + ek), oml = 1.f - lbk;
    f32x4 Sacc[8];
#pragma unroll
    for (int i = 0; i < 8; ++i) Sacc[i] = (f32x4){0.f, 0.f, 0.f, 0.f};
    for (int i = tid; i < 32768 / 16; i += NTHR) *(LAS v4u*)(L + HG_ST + i * 16) = (v4u){0u, 0u, 0u, 0u};
    __syncthreads();
    const int tt = w & 3, vh = w >> 2;
    unsigned short rq[16], rf[16], rv[16];
    if (c_lo > 0) {
        { const bf16* pq = PROJ + ((size_t)b * SEQ + etq * 16) * LDP + h * 128 + ek;
#pragma unroll
          for (int i = 0; i < 16; ++i) { rf[i] = pq[(size_t)i * LDP + 1536]; rv[i] = pq[(size_t)i * LDP + 3072]; } }
#pragma unroll 1
        for (int c = 0; c < c_lo; ++c) {
            int tl_ = tid; asm volatile("" : "+v"(tl_));
            const int lane = tl_ & 63, fr = lane & 15, q4 = lane >> 4, ek = tl_ & 127, etq = tl_ >> 7;
            const int kbuf = (c & 1) ? HG_QT : HG_KHT, vbuf = (c & 1) ? HG_KT : HG_VT, dbuf = (c & 1) ? HG_DEC2 : HG_DEC;
            float fv[16], vv[16];
#pragma unroll
            for (int i = 0; i < 16; ++i) { fv[i] = bf2f(rf[i]); vv[i] = bf2f(rv[i]); }
            float bl[16], kv[16]; float run = 0.f;
#pragma unroll
            for (int i = 0; i < 16; ++i) { float sp, sn; sig2(fv[i], sp, sn); const float fg = lbk + oml * sp; run += __logf(fmaxf(fg, 1e-30f)); bl[i] = run; kv[i] = oml * sn; }
            ((LAS float*)(L + HG_TOT))[etq * 128 + ek] = run;
            LDS_BARRIER();
            const float t0 = ((LAS float*)(L + HG_TOT))[ek], t1 = ((LAS float*)(L + HG_TOT))[128 + ek], t2 = ((LAS float*)(L + HG_TOT))[256 + ek], t3 = ((LAS float*)(L + HG_TOT))[384 + ek];
            const float bend = (t0 + t1) + (t2 + t3);
            const float rem = bend - ((etq > 0 ? t0 : 0.f) + (etq > 1 ? t1 : 0.f) + (etq > 2 ? t2 : 0.f));
            float kh[16];
#pragma unroll
            for (int i = 0; i < 16; ++i) kh[i] = kv[i] * __expf(fminf(rem - bl[i], 0.f));
            { v4u o0, o1;
              o0.x = pk2(kh[0], kh[1]); o0.y = pk2(kh[2], kh[3]); o0.z = pk2(kh[4], kh[5]); o0.w = pk2(kh[6], kh[7]);
              o1.x = pk2(kh[8], kh[9]); o1.y = pk2(kh[10], kh[11]); o1.z = pk2(kh[12], kh[13]); o1.w = pk2(kh[14], kh[15]);
              *(LAS v4u*)(L + kbuf + sw64(ek, etq * 2)) = o0; *(LAS v4u*)(L + kbuf + sw64(ek, etq * 2 + 1)) = o1;
              o0.x = pk2(vv[0], vv[1]); o0.y = pk2(vv[2], vv[3]); o0.z = pk2(vv[4], vv[5]); o0.w = pk2(vv[6], vv[7]);
              o1.x = pk2(vv[8], vv[9]); o1.y = pk2(vv[10], vv[11]); o1.z = pk2(vv[12], vv[13]); o1.w = pk2(vv[14], vv[15]);
              *(LAS v4u*)(L + vbuf + sw64(ek, etq * 2)) = o0; *(LAS v4u*)(L + vbuf + sw64(ek, etq * 2 + 1)) = o1; }
            if (etq == 0) ((LAS float*)(L + dbuf))[ek] = __expf(bend);
            LDS_BARRIER();
            if (c + 1 < c_lo) { const bf16* pq = PROJ + ((size_t)b * SEQ + (c + 1) * 64 + etq * 16) * LDP + h * 128 + ek;
#pragma unroll
                for (int i = 0; i < 16; ++i) { rf[i] = pq[(size_t)i * LDP + 1536]; rv[i] = pq[(size_t)i * LDP + 3072]; } }
            { const f32x4 dec = *(LAS f32x4*)(L + dbuf + (16 * w + q4 * 4) * 4);
#pragma unroll
              for (int vt = 0; vt < 8; ++vt) Sacc[vt] = Sacc[vt] * dec;
#pragma unroll
              for (int ks = 0; ks < 2; ++ks) { const bf16x8 a = *(LAS bf16x8*)(L + kbuf + sw64(16 * w + fr, ks * 4 + q4));
#pragma unroll
                  for (int vt = 0; vt < 8; ++vt) { const bf16x8 bv = *(LAS bf16x8*)(L + vbuf + sw64(16 * vt + fr, ks * 4 + q4)); Sacc[vt] = MFMA16(a, bv, Sacc[vt]); } } }
            __builtin_amdgcn_sched_barrier(0);
        }
        { int tl_ = tid; asm volatile("" : "+v"(tl_)); const int lane = tl_ & 63, fr = lane & 15, q4 = lane >> 4; const int k0 = 16 * w + q4 * 4;
#pragma unroll
          for (int vt = 0; vt < 8; ++vt) *(LAS v2u*)(L + HG_ST + sw128(16 * vt + fr, k0 >> 3) + (k0 & 7) * 2) = pk4(Sacc[vt]); }
    }
    { const bf16* pq = PROJ + ((size_t)b * SEQ + c_lo * 64 + etq * 16) * LDP + h * 128 + ek;
#pragma unroll
      for (int i = 0; i < 16; ++i) { rq[i] = pq[(size_t)i * LDP]; rf[i] = pq[(size_t)i * LDP + 1536]; rv[i] = pq[(size_t)i * LDP + 3072]; } }
#pragma unroll 1
    for (int c = c_lo; c < c_hi; ++c) {
        int tl_ = tid; asm volatile("" : "+v"(tl_));
        const int lane = tl_ & 63, fr = lane & 15, q4 = lane >> 4, ek = tl_ & 127, etq = tl_ >> 7;
        const size_t row0 = (size_t)b * SEQ + c * 64;
        float qv[16], fv[16], vv[16];
#pragma unroll
        for (int i = 0; i < 16; ++i) { qv[i] = bf2f(rq[i]); fv[i] = bf2f(rf[i]); vv[i] = bf2f(rv[i]); }
        float bl[16], kv[16]; float run = 0.f;
#pragma unroll
        for (int i = 0; i < 16; ++i) { float sp, sn; sig2(fv[i], sp, sn); const float fg = lbk + oml * sp; run += __logf(fmaxf(fg, 1e-30f)); bl[i] = run; kv[i] = oml * sn; }
        ((LAS float*)(L + HG_TOT))[etq * 128 + ek] = run;
        LDS_BARRIER();
        const float t0 = ((LAS float*)(L + HG_TOT))[ek], t1 = ((LAS float*)(L + HG_TOT))[128 + ek], t2 = ((LAS float*)(L + HG_TOT))[256 + ek], t3 = ((LAS float*)(L + HG_TOT))[384 + ek];
        const float off = (etq > 0 ? t0 : 0.f) + (etq > 1 ? t1 : 0.f) + (etq > 2 ? t2 : 0.f);
        const float mref = t0 + t1, bend = mref + t2 + t3, ebm = __expf(t2 + t3);
        float kh[16];
#pragma unroll
        for (int i = 0; i < 16; ++i) { const int t = etq * 16 + i; const float bt = off + bl[i];
            const float d = fminf(fmaxf(bt - mref, -60.f), 60.f), e1 = __expf(d), e2 = __builtin_amdgcn_rcpf(e1);
            const float sq = fsilu(qv[i]);
            const int a = sw128(t, ek >> 3) + (ek & 7) * 2;
            *(LAS unsigned short*)(L + HG_QT + a) = (unsigned short)f2bf(sq * e1);
            *(LAS unsigned short*)(L + HG_KT + a) = (unsigned short)f2bf(kv[i] * e2);
            *(LAS unsigned short*)(L + HG_QH + a) = (unsigned short)f2bf(sq * __expf(bt));
            kh[i] = kv[i] * (ebm * e2); }
        { v4u o0, o1;
          o0.x = pk2(kh[0], kh[1]); o0.y = pk2(kh[2], kh[3]); o0.z = pk2(kh[4], kh[5]); o0.w = pk2(kh[6], kh[7]);
          o1.x = pk2(kh[8], kh[9]); o1.y = pk2(kh[10], kh[11]); o1.z = pk2(kh[12], kh[13]); o1.w = pk2(kh[14], kh[15]);
          *(LAS v4u*)(L + HG_KHT + sw64(ek, etq * 2)) = o0; *(LAS v4u*)(L + HG_KHT + sw64(ek, etq * 2 + 1)) = o1;
          o0.x = pk2(vv[0], vv[1]); o0.y = pk2(vv[2], vv[3]); o0.z = pk2(vv[4], vv[5]); o0.w = pk2(vv[6], vv[7]);
          o1.x = pk2(vv[8], vv[9]); o1.y = pk2(vv[10], vv[11]); o1.z = pk2(vv[12], vv[13]); o1.w = pk2(vv[14], vv[15]);
          *(LAS v4u*)(L + HG_VT + sw64(ek, etq * 2)) = o0; *(LAS v4u*)(L + HG_VT + sw64(ek, etq * 2 + 1)) = o1; }
        if (etq == 0) ((LAS float*)(L + HG_DEC))[ek] = __expf(bend);
        LDS_BARRIER();
        v2u gate_raw[4];
#pragma unroll
        for (int i = 0; i < 4; ++i) gate_raw[i] = *(const v2u*)(PROJ + (row0 + tt * 16 + fr) * LDP + 4608 + h * 128 + (4 * vh + i) * 16 + q4 * 4);
        if (c + 1 < c_hi) { const bf16* pq = PROJ + (row0 + 64 + etq * 16) * LDP + h * 128 + ek;
#pragma unroll
            for (int i = 0; i < 16; ++i) { rq[i] = pq[(size_t)i * LDP]; rf[i] = pq[(size_t)i * LDP + 1536]; rv[i] = pq[(size_t)i * LDP + 3072]; } }
#pragma unroll
        for (int u = 0; u < 2; ++u) { const int st = w >> 1, ttl = 2 * (w & 1) + u;
            f32x4 acc = (f32x4){0.f, 0.f, 0.f, 0.f};
            if (st <= ttl) {
#pragma unroll
                for (int ks = 0; ks < 4; ++ks) { const bf16x8 a = *(LAS bf16x8*)(L + HG_KT + sw128(st * 16 + fr, ks * 4 + q4)); const bf16x8 bq = *(LAS bf16x8*)(L + HG_QT + sw128(ttl * 16 + fr, ks * 4 + q4)); acc = MFMA16(a, bq, acc); } }
            const int t = ttl * 16 + fr, s0 = st * 16 + q4 * 4;
#pragma unroll
            for (int r = 0; r < 4; ++r) if (s0 + r > t) acc[r] = 0.f;
            *(LAS v2u*)(L + HG_ATT + sw64(t, s0 >> 3) + (s0 & 7) * 2) = pk4(acc); }
        f32x4 oT[4];
#pragma unroll
        for (int i = 0; i < 4; ++i) oT[i] = (f32x4){0.f, 0.f, 0.f, 0.f};
#pragma unroll
        for (int ks = 0; ks < 4; ++ks) { const bf16x8 bq = *(LAS bf16x8*)(L + HG_QH + sw128(tt * 16 + fr, ks * 4 + q4));
#pragma unroll
            for (int i = 0; i < 4; ++i) { const bf16x8 a = *(LAS bf16x8*)(L + HG_ST + sw128((4 * vh + i) * 16 + fr, ks * 4 + q4)); oT[i] = MFMA16(a, bq, oT[i]); } }
        { const f32x4 dec = *(LAS f32x4*)(L + HG_DEC + (16 * w + q4 * 4) * 4);
#pragma unroll
          for (int vt = 0; vt < 8; ++vt) Sacc[vt] = Sacc[vt] * dec;
#pragma unroll
          for (int ks = 0; ks < 2; ++ks) { const bf16x8 a = *(LAS bf16x8*)(L + HG_KHT + sw64(16 * w + fr, ks * 4 + q4));
#pragma unroll
              for (int vt = 0; vt < 8; ++vt) { const bf16x8 bv = *(LAS bf16x8*)(L + HG_VT + sw64(16 * vt + fr, ks * 4 + q4)); Sacc[vt] = MFMA16(a, bv, Sacc[vt]); } } }
        LDS_BARRIER();
        { const int k0 = 16 * w + q4 * 4;
#pragma unroll
          for (int vt = 0; vt < 8; ++vt) *(LAS v2u*)(L + HG_ST + sw128(16 * vt + fr, k0 >> 3) + (k0 & 7) * 2) = pk4(Sacc[vt]); }
#pragma unroll
        for (int ks = 0; ks < 2; ++ks) { const bf16x8 bq = *(LAS bf16x8*)(L + HG_ATT + sw64(tt * 16 + fr, ks * 4 + q4));
#pragma unroll
            for (int i = 0; i < 4; ++i) { const bf16x8 a = *(LAS bf16x8*)(L + HG_VT + sw64((4 * vh + i) * 16 + fr, ks * 4 + q4)); oT[i] = MFMA16(a, bq, oT[i]); } }
        float ss = 0.f;
#pragma unroll
        for (int i = 0; i < 4; ++i) ss += (oT[i].x * oT[i].x + oT[i].y * oT[i].y) + (oT[i].z * oT[i].z + oT[i].w * oT[i].w);
        ss += __shfl_xor(ss, 16); ss += __shfl_xor(ss, 32);
        if (q4 == 0) ((LAS float*)(L + HG_SS))[w * 16 + fr] = ss;
        LDS_BARRIER();
        const float tot = ((LAS float*)(L + HG_SS))[w * 16 + fr] + ((LAS float*)(L + HG_SS))[(w ^ 4) * 16 + fr];
        const float rstd = 1.f / sqrtf(tot * (1.f / 128.f) + RMS_EPS);
        const size_t row = row0 + tt * 16 + fr;
#pragma unroll
        for (int i = 0; i < 4; ++i) { const int ch = h * 128 + (4 * vh + i) * 16 + q4 * 4;
            const f32x4 gon = *(const f32x4*)(onorm_g + ch); const f32x4 gate = bf4(gate_raw[i]);
            f32x4 o = oT[i] * rstd * gon;
            o.x *= fsilu(gate.x); o.y *= fsilu(gate.y); o.z *= fsilu(gate.z); o.w *= fsilu(gate.w);
            *(v2u*)(MIXC + row * D + ch) = pk4(o); }
    }
    if (c_hi == SEQ / 64) {
#pragma unroll
        for (int vt = 0; vt < 8; ++vt)
#pragma unroll
            for (int r = 0; r < 4; ++r) state_out[(size_t)(16 * w + q4 * 4 + r) * 128 + 16 * vt + fr] = Sacc[vt][r]; }
    __syncthreads();
}

__device__ __forceinline__ void hgrn_sample_unit(int lane, const bf16* PROJ, bf16* MIXC, const float* lb_logits, const float* onorm_g, const float* S0, float* S1, int j, int b, int h) {
    const size_t row = MP + b; const int vq = lane & 31, kr = lane >> 5;
    float fg[2], kvv[2], sq[2];
#pragma unroll
    for (int u = 0; u < 2; ++u) { const int k = lane + 64 * u; const bf16* p = PROJ + row * LDP + h * 128 + k;
        const float q = bf2f(p[0]), f = bf2f(p[1536]); const float lbk = lower_bound(lb_logits, j, h * 128 + k);
        float sp, sn; sig2(f, sp, sn); fg[u] = fmaxf(lbk + (1.f - lbk) * sp, 1e-30f); kvv[u] = (1.f - lbk) * sn; sq[u] = fsilu(q); }
    const f32x4 v4 = bf4(*(const v2u*)(PROJ + row * LDP + 3072 + h * 128 + 4 * vq));
    f32x4 o = (f32x4){0.f, 0.f, 0.f, 0.f};
#pragma unroll 16
    for (int it = 0; it < 64; ++it) { const int k = 2 * it + kr; const int src = k & 63;
        const float fgk = __shfl(it < 32 ? fg[0] : fg[1], src), kvk = __shfl(it < 32 ? kvv[0] : kvv[1], src), sqk = __shfl(it < 32 ? sq[0] : sq[1], src);
        const f32x4 S = *(const f32x4*)(S0 + (size_t)k * 128 + 4 * vq);
        const f32x4 Sn = S * fgk + v4 * kvk;
        *(f32x4*)(S1 + (size_t)k * 128 + 4 * vq) = Sn;
        o = o + Sn * sqk; }
    o.x += __shfl_xor(o.x, 32); o.y += __shfl_xor(o.y, 32); o.z += __shfl_xor(o.z, 32); o.w += __shfl_xor(o.w, 32);
    float ss = (o.x * o.x + o.y * o.y) + (o.z * o.z + o.w * o.w);
#pragma unroll
    for (int m = 1; m < 32; m <<= 1) ss += __shfl_xor(ss, m);
    const float rstd = 1.f / sqrtf(ss * (1.f / 128.f) + RMS_EPS);
    if (lane < 32) { const int ch = h * 128 + 4 * vq;
        const f32x4 gon = *(const f32x4*)(onorm_g + ch); const f32x4 gate = bf4(*(const v2u*)(PROJ + row * LDP + 4608 + ch));
        f32x4 r = o * rstd * gon; r.x *= fsilu(gate.x); r.y *= fsilu(gate.y); r.z *= fsilu(gate.z); r.w *= fsilu(gate.w);
        *(v2u*)(MIXC + row * D + ch) = pk4(r); }
}

constexpr int XA_K = 0, XA_KLD = 272, XA_VT = 256 * 272, XA_VLD = 520;
__device__ __forceinline__ void xattn_prompt_unit(Frame& F, const bf16* PROJ, int xq_off, bf16* MIXC, const float* Kb, const float* Vb, int b, int head, int qpart) {
    const ldsp L = F.lds; const int tid = fresh_tid(), w = __builtin_amdgcn_readfirstlane(tid >> 6), lane = tid & 63, fr = lane & 15, q4 = lane >> 4;
    __syncthreads();
#pragma unroll 8
    for (int it = 0; it < 16; ++it) { const int idx = it * NTHR + tid, m = idx >> 5, e4 = idx & 31;
        const f32x4 kx = *(const f32x4*)(Kb + (size_t)m * XDIM + head * XD + 4 * e4);
        *(LAS v2u*)(L + XA_K + m * XA_KLD + e4 * 8) = pk4(kx);
        const f32x4 vx = *(const f32x4*)(Vb + (size_t)m * XDIM + head * XD + 4 * e4);
#pragma unroll
        for (int q = 0; q < 4; ++q) { const int e = 4 * e4 + q; *(LAS unsigned short*)(L + XA_VT + e * XA_VLD + m * 2) = (unsigned short)f2bf(vx[q]); } }
    __syncthreads();
    const float scale = 0.08838834764831845f;
    const ldsp kbase = L + XA_K + fr * XA_KLD + q4 * 16; const ldsp vbase = L + XA_VT + fr * XA_VLD + q4 * 8;
#pragma unroll 1
    for (int qt = 0; qt < 2; ++qt) {
        const size_t r = (size_t)b * SEQ + qpart * 256 + qt * 128 + w * 16 + fr;
        bf16x8 qf[4];
#pragma unroll
        for (int ks = 0; ks < 4; ++ks) qf[ks] = *(const bf16x8*)(PROJ + r * LDP + xq_off + head * XD + ks * 32 + q4 * 8);
        f32x4 sT[16];
#pragma unroll
        for (int mt = 0; mt < 16; ++mt) { f32x4 acc = (f32x4){0.f, 0.f, 0.f, 0.f};
#pragma unroll
            for (int ks = 0; ks < 4; ++ks) { const bf16x8 a = *(LAS bf16x8*)(kbase + mt * 16 * XA_KLD + ks * 64); acc = MFMA16(a, qf[ks], acc); }
            sT[mt] = acc; __builtin_amdgcn_sched_barrier(0); }
        float mx = -3.0e38f;
#pragma unroll
        for (int mt = 0; mt < 16; ++mt) mx = fmaxf(mx, fmaxf(fmaxf(sT[mt].x, sT[mt].y), fmaxf(sT[mt].z, sT[mt].w)));
        mx = fmaxf(mx, __shfl_xor(mx, 16)); mx = fmaxf(mx, __shfl_xor(mx, 32));
        float l = 0.f;
#pragma unroll
        for (int mt = 0; mt < 16; ++mt) {
#pragma unroll
            for (int q = 0; q < 4; ++q) { const float p = __expf((sT[mt][q] - mx) * scale); sT[mt][q] = p; l += p; } }
        l += __shfl_xor(l, 16); l += __shfl_xor(l, 32);
        const float inv = 1.f / l;
        f32x4 oT[8];
#pragma unroll
        for (int et = 0; et < 8; ++et) oT[et] = (f32x4){0.f, 0.f, 0.f, 0.f};
#pragma unroll
        for (int s = 0; s < 8; ++s) {
            v4u pw; pw.x = pk2(sT[2 * s].x, sT[2 * s].y); pw.y = pk2(sT[2 * s].z, sT[2 * s].w); pw.z = pk2(sT[2 * s + 1].x, sT[2 * s + 1].y); pw.w = pk2(sT[2 * s + 1].z, sT[2 * s + 1].w);
            const bf16x8 pf = __builtin_bit_cast(bf16x8, pw);
#pragma unroll
            for (int et = 0; et < 8; ++et) {
                const v2u a0 = *(LAS v2u*)(vbase + et * 16 * XA_VLD + s * 64);
                const v2u a1 = *(LAS v2u*)(vbase + et * 16 * XA_VLD + s * 64 + 32);
                v4u aw; aw.x = a0.x; aw.y = a0.y; aw.z = a1.x; aw.w = a1.y;
                oT[et] = MFMA16(__builtin_bit_cast(bf16x8, aw), pf, oT[et]); }
            __builtin_amdgcn_sched_barrier(0); }
#pragma unroll
        for (int et = 0; et < 8; ++et) *(v2u*)(MIXC + r * D + MIX + head * XD + et * 16 + q4 * 4) = pk4(oT[et] * inv);
    }
    __syncthreads();
}
__device__ __forceinline__ void xattn_sample_pair(Frame& F, const bf16* PROJ, int xq_off, bf16* MIXC, const float* Kall, const float* Vall, int unit0) {
    const ldsp L = F.lds; const int tid = fresh_tid(), w = __builtin_amdgcn_readfirstlane(tid >> 6), lane = tid & 63;
    const int unit = unit0 + (w >> 2), mp = w & 3, b = unit >> 2, head = unit & 3;
    const size_t row = MP + b; const int fr = lane & 15, q4 = lane >> 4, e4 = lane & 31, mr = lane >> 5;
    const float* Kb = Kall + (size_t)b * NMEM * XDIM; const float* Vb = Vall + (size_t)b * NMEM * XDIM;
    const float scale = 0.08838834764831845f;
    bf16x8 qf[4];
#pragma unroll
    for (int ks = 0; ks < 4; ++ks) { const v4u raw = *(const v4u*)(PROJ + row * LDP + xq_off + head * XD + ks * 32 + q4 * 8);
        v4u o; o.x = pk2_hw(bflo(raw.x) * scale, bfhi(raw.x) * scale); o.y = pk2_hw(bflo(raw.y) * scale, bfhi(raw.y) * scale); o.z = pk2_hw(bflo(raw.z) * scale, bfhi(raw.z) * scale); o.w = pk2_hw(bflo(raw.w) * scale, bfhi(raw.w) * scale);
        qf[ks] = __builtin_bit_cast(bf16x8, o); }
    f32x4 sT[4];
#pragma unroll
    for (int i = 0; i < 4; ++i) { f32x4 acc = (f32x4){0.f, 0.f, 0.f, 0.f};
        const float* kp = Kb + (size_t)(mp * 64 + i * 16 + fr) * XDIM + head * XD + q4 * 8;
        f32x4 x0[4], x1[4];
#pragma unroll
        for (int ks = 0; ks < 4; ++ks) { x0[ks] = *(const f32x4*)(kp + ks * 32); x1[ks] = *(const f32x4*)(kp + ks * 32 + 4); }
#pragma unroll
        for (int ks = 0; ks < 4; ++ks) { v4u aw; aw.x = pk2_hw(x0[ks].x, x0[ks].y); aw.y = pk2_hw(x0[ks].z, x0[ks].w); aw.z = pk2_hw(x1[ks].x, x1[ks].y); aw.w = pk2_hw(x1[ks].z, x1[ks].w);
            acc = MFMA16(__builtin_bit_cast(bf16x8, aw), qf[ks], acc); }
        sT[i] = acc; }
    float mx = -3.0e38f;
#pragma unroll
    for (int i = 0; i < 4; ++i) mx = fmaxf(mx, fmaxf(fmaxf(sT[i].x, sT[i].y), fmaxf(sT[i].z, sT[i].w)));
    mx = fmaxf(mx, __shfl_xor(mx, 16)); mx = fmaxf(mx, __shfl_xor(mx, 32));
    float l = 0.f;
#pragma unroll
    for (int i = 0; i < 4; ++i) {
#pragma unroll
        for (int q = 0; q < 4; ++q) { const float p = __expf(sT[i][q] - mx); sT[i][q] = p; l += p; } }
    l += __shfl_xor(l, 16); l += __shfl_xor(l, 32);
    f32x4 o = (f32x4){0.f, 0.f, 0.f, 0.f};
    const float* vp = Vb + head * XD + 4 * e4;
#pragma unroll
    for (int i = 0; i < 4; ++i) {
#pragma unroll
        for (int ii = 0; ii < 8; ++ii) { const int m0 = mp * 64 + i * 16 + 2 * ii; const int src = ((2 * ii) >> 2) * 16;
            const float pa = __shfl(sT[i][2 * (ii & 1)], src), pb = __shfl(sT[i][2 * (ii & 1) + 1], src);
            const f32x4 vx = *(const f32x4*)(vp + (size_t)(m0 + mr) * XDIM);
            o = o + vx * (mr ? pb : pa); } }
    o.x += __shfl_xor(o.x, 32); o.y += __shfl_xor(o.y, 32); o.z += __shfl_xor(o.z, 32); o.w += __shfl_xor(o.w, 32);
    LAS float* slot = (LAS float*)(L + w * 528);
    if (lane == 0) { slot[0] = mx; slot[1] = l; }
    if (lane < 32) *(LAS f32x4*)(slot + 4 + 4 * e4) = o;
    LDS_BARRIER();
    if (mp == 0 && lane < 32) { float M = -3.0e38f;
#pragma unroll
        for (int i = 0; i < 4; ++i) M = fmaxf(M, ((LAS float*)(L + (w + i) * 528))[0]);
        float Lsum = 0.f; f32x4 O = (f32x4){0.f, 0.f, 0.f, 0.f};
#pragma unroll
        for (int i = 0; i < 4; ++i) { const LAS float* s = (const LAS float*)(L + (w + i) * 528); const float f = __expf(s[0] - M); Lsum += s[1] * f; O = O + *(const LAS f32x4*)(s + 4 + 4 * e4) * f; }
        *(v2u*)(MIXC + row * D + MIX + head * XD + 4 * e4) = pk4(O * (1.f / Lsum)); }
    LDS_BARRIER();
}

__device__ __forceinline__ void xattn_sample_unit(int lane, const bf16* PROJ, int xq_off, bf16* MIXC, const float* Kb, const float* Vb, int b, int head) {
    const size_t row = MP + b; const int fr = lane & 15, q4 = lane >> 4, e4 = lane & 31, mr = lane >> 5;
    const float scale = 0.08838834764831845f;
    bf16x8 qf[4];
#pragma unroll
    for (int ks = 0; ks < 4; ++ks) { const v4u raw = *(const v4u*)(PROJ + row * LDP + xq_off + head * XD + ks * 32 + q4 * 8);
        v4u o; o.x = pk2_hw(bflo(raw.x) * scale, bfhi(raw.x) * scale); o.y = pk2_hw(bflo(raw.y) * scale, bfhi(raw.y) * scale); o.z = pk2_hw(bflo(raw.z) * scale, bfhi(raw.z) * scale); o.w = pk2_hw(bflo(raw.w) * scale, bfhi(raw.w) * scale);
        qf[ks] = __builtin_bit_cast(bf16x8, o); }
    f32x4 sT[16];
#pragma unroll
    for (int mt = 0; mt < 16; ++mt) { f32x4 acc = (f32x4){0.f, 0.f, 0.f, 0.f};
        const float* kp = Kb + (size_t)(mt * 16 + fr) * XDIM + head * XD + q4 * 8;
        f32x4 x0[4], x1[4];
#pragma unroll
        for (int ks = 0; ks < 4; ++ks) { x0[ks] = *(const f32x4*)(kp + ks * 32); x1[ks] = *(const f32x4*)(kp + ks * 32 + 4); }
#pragma unroll
        for (int ks = 0; ks < 4; ++ks) { v4u aw; aw.x = pk2_hw(x0[ks].x, x0[ks].y); aw.y = pk2_hw(x0[ks].z, x0[ks].w); aw.z = pk2_hw(x1[ks].x, x1[ks].y); aw.w = pk2_hw(x1[ks].z, x1[ks].w);
            acc = MFMA16(__builtin_bit_cast(bf16x8, aw), qf[ks], acc); }
        sT[mt] = acc; }
    float mx = -3.0e38f;
#pragma unroll
    for (int mt = 0; mt < 16; ++mt) mx = fmaxf(mx, fmaxf(fmaxf(sT[mt].x, sT[mt].y), fmaxf(sT[mt].z, sT[mt].w)));
    mx = fmaxf(mx, __shfl_xor(mx, 16)); mx = fmaxf(mx, __shfl_xor(mx, 32));
    float l = 0.f;
#pragma unroll
    for (int mt = 0; mt < 16; ++mt) {
#pragma unroll
        for (int q = 0; q < 4; ++q) { const float p = __expf(sT[mt][q] - mx); sT[mt][q] = p; l += p; } }
    l += __shfl_xor(l, 16); l += __shfl_xor(l, 32);
    f32x4 o = (f32x4){0.f, 0.f, 0.f, 0.f};
    const float* vp = Vb + head * XD + 4 * e4;
#pragma unroll
    for (int mt = 0; mt < 16; ++mt) {
#pragma unroll
        for (int i = 0; i < 8; ++i) { const int m0 = mt * 16 + 2 * i;
            const int src = ((2 * i) >> 2) * 16;
            const float pa = __shfl(sT[mt][2 * (i & 1)], src);
            const float pb = __shfl(sT[mt][2 * (i & 1) + 1], src);
            const f32x4 vx = *(const f32x4*)(vp + (size_t)(m0 + mr) * XDIM);
            o = o + vx * (mr ? pb : pa); } }
    o.x += __shfl_xor(o.x, 32); o.y += __shfl_xor(o.y, 32); o.z += __shfl_xor(o.z, 32); o.w += __shfl_xor(o.w, 32);
    if (lane < 32) *(v2u*)(MIXC + row * D + MIX + head * XD + 4 * e4) = pk4(o * (1.f / l));
}


__device__ __forceinline__ long rw_prev_row(int row) { return row < MP ? (((row & (SEQ - 1)) == 0) ? -1L : (long)row - 1) : (long)row + NSMP; }
__device__ __forceinline__ f32x4 ld_bf4(const bf16* p) { return bf4(*(const v2u*)p); }
__device__ __forceinline__ f32x4 ld_bf4_prev(const bf16* PROJ, long prow, int col) { return prow >= 0 ? bf4(*(const v2u*)(PROJ + (size_t)prow * LDP + col)) : (f32x4){0.f, 0.f, 0.f, 0.f}; }
__device__ __forceinline__ float ftanh(float x) { return 1.f - 2.f * __builtin_amdgcn_rcpf(1.f + __expf(2.f * x)); }
__device__ __forceinline__ float quad_sum(float x) {
    x += __builtin_bit_cast(float, __builtin_amdgcn_mov_dpp(__builtin_bit_cast(int, x), 0xB1, 0xF, 0xF, true));
    x += __builtin_bit_cast(float, __builtin_amdgcn_mov_dpp(__builtin_bit_cast(int, x), 0x4E, 0xF, 0xF, true));
    return x;
}

constexpr int RC_LI = 0, RC_RAW = 46080, RC_XCH = RC_RAW + 3 * 9216;
__device__ __forceinline__ void rwkv_prep_unit(Frame& F, const Args& A, int j, int r0, int h_lo, int h_hi) {
    const ldsp L = F.lds; const int tid = fresh_tid(), w = __builtin_amdgcn_readfirstlane(tid >> 6), lane = tid & 63, fr = lane & 15, q4 = lane >> 4;
    const int it = w >> 1, jh = w & 1;
    constexpr bool sample = true;
    const bf16* PROJ = (const bf16*)(F.ws + WS_PROJ);
    const float* mu = A.in[20] + (size_t)j * B_MIXC; const float* w0 = A.in[21] + (size_t)j * MIX; const float* a0 = A.in[23] + (size_t)j * MIX;
    const float* k_k = A.in[26] + (size_t)j * MIX; const float* k_a = A.in[27] + (size_t)j * MIX; const float* r_k = A.in[28] + (size_t)j * MIX;
    const bf16* LW = (const bf16*)(F.ws + WS_LW) + (size_t)j * MIX * LORA_K;
    float* RR = (float*)(F.ws + WS_RR); float* RK = (float*)(F.ws + WS_RK); float* RV = (float*)(F.ws + WS_RV); float* RKK = (float*)(F.ws + WS_RKK);
    float* RKA = (float*)(F.ws + WS_RKA); float* RWd = (float*)(F.ws + WS_RW); float* RG = (float*)(F.ws + WS_RG); float* BON = (float*)(F.ws + WS_BONUS);
    __syncthreads();
    for (int itr = 0; itr < 11; ++itr) { const int idx = itr * NTHR + tid;
        if (idx < 64 * 88) { const int t = idx / 88, c4 = idx - t * 88, col = 4 * c4; const int row = r0 + t; const long prow = rw_prev_row(row);
            const f32x4 P = ld_bf4(PROJ + (size_t)row * LDP + B_LORA_OFF + col), Pp = ld_bf4_prev(PROJ, prow, B_LORA_OFF + col);
            const f32x4 m4 = *(const f32x4*)(mu + 4608 + col);
            f32x4 xs = P + (Pp - P) * m4;
            if (col < 64) { xs.x = ftanh(xs.x); xs.y = ftanh(xs.y); xs.z = ftanh(xs.z); xs.w = ftanh(xs.w); }
            else if (col >= 128) { xs.x = fsigmoid(xs.x); xs.y = fsigmoid(xs.y); xs.z = fsigmoid(xs.z); xs.w = fsigmoid(xs.w); }
            *(LAS v2u*)(L + RC_LI + t * 720 + col * 2) = pk4(xs); } }
#pragma unroll 1
    for (int h = h_lo; h < h_hi; ++h) {
        __syncthreads();
        { const int row = tid >> 3, c8 = tid & 7;
#pragma unroll
          for (int x = 0; x < 3; ++x) { const v4u val = *(const v4u*)(PROJ + (size_t)(r0 + row) * LDP + x * 1536 + h * 64 + c8 * 8);
              *(LAS v4u*)(L + RC_RAW + x * 9216 + (row + 1) * 128 + c8 * 16) = val; }
          if (tid < 8) { const long prow = sample ? -1L : rw_prev_row(r0);
#pragma unroll
              for (int x = 0; x < 3; ++x) { v4u val = (v4u){0u, 0u, 0u, 0u}; if (prow >= 0) val = *(const v4u*)(PROJ + (size_t)prow * LDP + x * 1536 + h * 64 + tid * 8);
                  *(LAS v4u*)(L + RC_RAW + x * 9216 + tid * 16) = val; } } }
        f32x4 aw[2], aa[2], ag[2];
#pragma unroll
        for (int u = 0; u < 2; ++u) { aw[u] = (f32x4){0.f, 0.f, 0.f, 0.f}; aa[u] = aw[u]; ag[u] = aw[u]; }
        { const bf16* lw0 = LW + (size_t)(h * 64 + (2 * jh) * 16 + fr) * LORA_K + q4 * 8; const ldsp li = L + RC_LI + (it * 16 + fr) * 720 + q4 * 16;
#pragma unroll
          for (int ks = 0; ks < 11; ++ks) { const bf16x8 afr = *(LAS bf16x8*)(li + ks * 64);
#pragma unroll
              for (int u = 0; u < 2; ++u) { const bf16x8 bfr = *(const bf16x8*)(lw0 + (size_t)u * 16 * LORA_K + ks * 32);
                  if (ks < 2) aw[u] = MFMA16(afr, bfr, aw[u]); else if (ks < 4) aa[u] = MFMA16(afr, bfr, aa[u]); else ag[u] = MFMA16(afr, bfr, ag[u]); } } }
        __syncthreads();
        float xr[2][4], xk[2][4], xv[2][4], dw[2][4], av[2][4], kkr[2][4];
        float nrm[4] = {0.f, 0.f, 0.f, 0.f}, bon[4] = {0.f, 0.f, 0.f, 0.f};
#pragma unroll
        for (int u = 0; u < 2; ++u) { const int c = (2 * jh + u) * 16 + fr, ch = h * 64 + c;
            const float mur = mu[ch], muk = mu[1536 + ch], muv = mu[3072 + ch], w0c = w0[ch], a0c = a0[ch], kkc = k_k[ch], kac = k_a[ch], rkc = r_k[ch];
#pragma unroll
            for (int e = 0; e < 4; ++e) { const int t = it * 16 + 4 * q4 + e;
                const float cr = bf2f(*(LAS unsigned short*)(L + RC_RAW + (t + 1) * 128 + c * 2)), ck = bf2f(*(LAS unsigned short*)(L + RC_RAW + 9216 + (t + 1) * 128 + c * 2)),
                            cv = bf2f(*(LAS unsigned short*)(L + RC_RAW + 18432 + (t + 1) * 128 + c * 2));
                float pr, pk, pv;
                if (sample) { const bf16* pp = PROJ + (size_t)(r0 + t + NSMP) * LDP + ch; pr = bf2f(pp[0]); pk = bf2f(pp[1536]); pv = bf2f(pp[3072]); }
                else { pr = bf2f(*(LAS unsigned short*)(L + RC_RAW + t * 128 + c * 2)); pk = bf2f(*(LAS unsigned short*)(L + RC_RAW + 9216 + t * 128 + c * 2)); pv = bf2f(*(LAS unsigned short*)(L + RC_RAW + 18432 + t * 128 + c * 2)); }
                const float r_ = cr + (pr - cr) * mur, k_ = ck + (pk - ck) * muk, v_ = cv + (pv - cv) * muv;
                const float x = -(w0c + aw[u][e]);
                const float sp = fmaxf(x, 0.f) + __logf(1.f + __expf(-fabsf(x)));
                dw[u][e] = -__expf(-sp - 0.5f);
                const float a = fsigmoid(a0c + aa[u][e]);
                const float kr_ = k_ * kkc, kp = k_ * (1.f + (a - 1.f) * kac);
                xr[u][e] = r_; xk[u][e] = kp; xv[u][e] = v_; av[u][e] = a; kkr[u][e] = kr_;
                nrm[e] += kr_ * kr_; bon[e] += r_ * kp * rkc; } }
#pragma unroll
        for (int e = 0; e < 4; ++e) {
#pragma unroll
            for (int m = 1; m < 16; m <<= 1) { nrm[e] += __shfl_xor(nrm[e], m); bon[e] += __shfl_xor(bon[e], m); } }
        if (fr == 0) {
#pragma unroll
            for (int e = 0; e < 4; ++e) { ((LAS float*)(L + RC_XCH))[(w * 2 + 0) * 16 + 4 * q4 + e] = nrm[e]; ((LAS float*)(L + RC_XCH))[(w * 2 + 1) * 16 + 4 * q4 + e] = bon[e]; } }
        __syncthreads();
#pragma unroll
        for (int e = 0; e < 4; ++e) { nrm[e] += ((LAS float*)(L + RC_XCH))[((w ^ 1) * 2 + 0) * 16 + 4 * q4 + e]; bon[e] += ((LAS float*)(L + RC_XCH))[((w ^ 1) * 2 + 1) * 16 + 4 * q4 + e];
            nrm[e] = 1.f / fmaxf(sqrtf(nrm[e]), 1e-12f); }
#pragma unroll
        for (int u = 0; u < 2; ++u) { const int c = (2 * jh + u) * 16 + fr, ch = h * 64 + c;
#pragma unroll
            for (int e = 0; e < 4; ++e) { const size_t o = (size_t)(r0 + it * 16 + 4 * q4 + e) * MIX + ch;
                const float kk = kkr[u][e] * nrm[e];
                RR[o] = xr[u][e]; RK[o] = xk[u][e]; RV[o] = xv[u][e]; RKK[o] = kk; RKA[o] = kk * av[u][e]; RWd[o] = __expf(dw[u][e]); RG[o] = ag[u][e]; } }
        if (fr == 0 && jh == 0) {
#pragma unroll
            for (int e = 0; e < 4; ++e) BON[(size_t)(r0 + it * 16 + 4 * q4 + e) * BH + h] = bon[e]; }
    }
    __syncthreads();
}

__device__ __forceinline__ void rwkv_sample_unit(Frame& F, const Args& A, int lane, int j, int b, int h) {
    const float* RWd = (const float*)(F.ws + WS_RW); const float* RKK = (const float*)(F.ws + WS_RKK); const float* RKA = (const float*)(F.ws + WS_RKA);
    const float* RK = (const float*)(F.ws + WS_RK); const float* RR = (const float*)(F.ws + WS_RR); const float* RV = (const float*)(F.ws + WS_RV);
    const float* RG = (const float*)(F.ws + WS_RG); const float* BON = (const float*)(F.ws + WS_BONUS); bf16* MIXC = (bf16*)(F.ws + WS_MIXC);
    const float* lnx_g = A.in[29] + (size_t)j * MIX; const float* lnx_b = A.in[30] + (size_t)j * MIX;
    const size_t row = MP + b; const int chan = h * BHD; const int vr = lane >> 4, kc = lane & 15;
    const size_t vo = row * MIX + chan + 4 * kc;
    const f32x4 w4 = *(const f32x4*)(RWd + vo), kk4 = *(const f32x4*)(RKK + vo), ka4 = *(const f32x4*)(RKA + vo), k4 = *(const f32x4*)(RK + vo), r4 = *(const f32x4*)(RR + vo);
    const float* S0 = A.in[5] + ((size_t)(j * NSMP + b) * BH + h) * (BHD * BHD);
    float* S1 = F.out + O_SRS + ((size_t)(j * NSMP + b) * BH + h) * (BHD * BHD);
    float myo = 0.f, osum = 0.f, osq = 0.f;
#pragma unroll
    for (int vb = 0; vb < 16; ++vb) { const int v = 4 * vb + vr;
        f32x4 S = *(const f32x4*)(S0 + (size_t)v * BHD + 4 * kc);
        float sa = (S.x * kk4.x + S.y * kk4.y) + (S.z * kk4.z + S.w * kk4.w);
#pragma unroll
        for (int m = 1; m < 16; m <<= 1) sa += __shfl_xor(sa, m);
        sa = -sa;
        const float vv = RV[row * MIX + chan + v];
        S = S * w4 + ka4 * sa + k4 * vv;
        *(f32x4*)(S1 + (size_t)v * BHD + 4 * kc) = S;
        float o = (S.x * r4.x + S.y * r4.y) + (S.z * r4.z + S.w * r4.w);
#pragma unroll
        for (int m = 1; m < 16; m <<= 1) o += __shfl_xor(o, m);
        osum += o; osq += o * o;
        myo = (kc == vb) ? o : myo; }
    osum += __shfl_xor(osum, 16); osum += __shfl_xor(osum, 32); osq += __shfl_xor(osq, 16); osq += __shfl_xor(osq, 32);
    const float mean = osum * (1.f / 64.f); const float var = fmaxf(osq * (1.f / 64.f) - mean * mean, 0.f);
    const float rstd = 1.f / sqrtf(var + GN_EPS);
    const int ch = chan + 4 * kc + vr;
    const float on = (myo - mean) * rstd * lnx_g[ch] + lnx_b[ch];
    const float bonus = BON[row * BH + h] * RV[row * MIX + ch];
    MIXC[row * D + ch] = (bf16)f2bf((on + bonus) * RG[row * MIX + ch]);
}


#ifndef PROBE_SUB
#define PROBE_SUB 0
#endif
constexpr int RK_LI = 0, RK_XCH = 46080, RK_TOT = 47104, RK_LD = 51200, RK_WC = 55296, RK_TILE = 55552, TBYTES = 9216;
#define TBUF(p) (L + RK_TILE + (p) * TBYTES)
__device__ __forceinline__ f32x4 mm_tile(ldsp Ab, ldsp Bb, int ia, int jb, int fr, int q4) {
    f32x4 acc = (f32x4){0.f, 0.f, 0.f, 0.f};
#pragma unroll
    for (int ks = 0; ks < 2; ++ks) { const bf16x8 a = *(LAS bf16x8*)(Ab + (ia * 16 + fr) * 144 + ks * 64 + q4 * 16); const bf16x8 b = *(LAS bf16x8*)(Bb + (jb * 16 + fr) * 144 + ks * 64 + q4 * 16); acc = MFMA16(a, b, acc); }
    return acc;
}
__device__ __forceinline__ void st_tileT(ldsp buf, int ia, int jb, int fr, int q4, f32x4 v) { *(LAS v2u*)(buf + (jb * 16 + fr) * 144 + (ia * 16 + 4 * q4) * 2) = pk4(v); }

__device__ __forceinline__ void rwkv_chunk_unit(Frame& F, const Args& A, int j, int b, int cidx, int h_lo, int h_hi) {
    const ldsp L = F.lds; const int tid = fresh_tid(), w = __builtin_amdgcn_readfirstlane(tid >> 6), lane = tid & 63, fr = lane & 15, q4 = lane >> 4;
    const int it = w >> 1, jh = w & 1, grp = it * 4 + q4, i0 = it * 16 + 4 * q4;
    const int r0 = b * SEQ + cidx * 64;
    const bf16* PROJ = (const bf16*)(F.ws + WS_PROJ);
    const float* mu = A.in[20] + (size_t)j * B_MIXC; const float* w0 = A.in[21] + (size_t)j * MIX; const float* a0 = A.in[23] + (size_t)j * MIX;
    const float* k_k = A.in[26] + (size_t)j * MIX; const float* k_a = A.in[27] + (size_t)j * MIX; const float* r_k = A.in[28] + (size_t)j * MIX;
    const float* lnx_b = A.in[30] + (size_t)j * MIX;
    const bf16* LW = (const bf16*)(F.ws + WS_LW) + (size_t)j * MIX * LORA_K;
    __syncthreads();
#pragma unroll 2
    for (int itr = 0; itr < 11; ++itr) { const int idx = itr * NTHR + tid;
        if (idx < 64 * 88) { const int t = idx / 88, c4 = idx - t * 88, col = 4 * c4; const int row = r0 + t; const long prow = rw_prev_row(row);
            const f32x4 P = ld_bf4(PROJ + (size_t)row * LDP + B_LORA_OFF + col), Pp = ld_bf4_prev(PROJ, prow, B_LORA_OFF + col);
            const f32x4 m4 = *(const f32x4*)(mu + 4608 + col);
            f32x4 xs = P + (Pp - P) * m4;
            if (col < 64) { xs.x = ftanh(xs.x); xs.y = ftanh(xs.y); xs.z = ftanh(xs.z); xs.w = ftanh(xs.w); }
            else if (col >= 128) { xs.x = fsigmoid(xs.x); xs.y = fsigmoid(xs.y); xs.z = fsigmoid(xs.z); xs.w = fsigmoid(xs.w); }
            *(LAS v2u*)(L + RK_LI + t * 720 + col * 2) = pk4(xs); } }
    for (int i = tid; i < TBYTES / 16; i += NTHR) *(LAS v4u*)(TBUF(7) + i * 16) = (v4u){0u, 0u, 0u, 0u};
#pragma unroll 1
    for (int h = h_lo; h < h_hi; ++h) {
        unsigned char* rec = F.ws + WS_REC + ((size_t)(b * BH + h) * 32 + cidx) * REC_BYTES;
        LDS_BARRIER();
        { const int row = tid >> 3, c8 = tid & 7;
#pragma unroll
          for (int x = 0; x < 3; ++x) { const v4u val = *(const v4u*)(PROJ + (size_t)(r0 + row) * LDP + x * 1536 + h * 64 + c8 * 8);
              *(LAS v4u*)(TBUF(8 + x) + (row + 1) * 128 + c8 * 16) = val; }
          if (tid < 8) { const long prow = rw_prev_row(r0);
#pragma unroll
              for (int x = 0; x < 3; ++x) { v4u val = (v4u){0u, 0u, 0u, 0u}; if (prow >= 0) val = *(const v4u*)(PROJ + (size_t)prow * LDP + x * 1536 + h * 64 + tid * 8);
                  *(LAS v4u*)(TBUF(8 + x) + tid * 16) = val; } } }
        f32x4 aw[2], aa[2], ag[2];
#pragma unroll
        for (int u = 0; u < 2; ++u) { aw[u] = (f32x4){0.f, 0.f, 0.f, 0.f}; aa[u] = aw[u]; ag[u] = aw[u]; }
        { const bf16* lw0 = LW + (size_t)(h * 64 + (2 * jh) * 16 + fr) * LORA_K + q4 * 8; const ldsp li = L + RK_LI + (it * 16 + fr) * 720 + q4 * 16;
#pragma unroll
          for (int ks = 0; ks < 11; ++ks) { const bf16x8 afr = *(LAS bf16x8*)(li + ks * 64);
#pragma unroll
              for (int u = 0; u < 2; ++u) { const bf16x8 bfr = *(const bf16x8*)(lw0 + (size_t)u * 16 * LORA_K + ks * 32);
                  if (ks < 2) aw[u] = MFMA16(afr, bfr, aw[u]); else if (ks < 4) aa[u] = MFMA16(afr, bfr, aa[u]); else ag[u] = MFMA16(afr, bfr, ag[u]); }
          } }
        LDS_BARRIER();
        float xr[2][4], kp[2][4], xv[2][4], dw[2][4], av[2][4], kkr[2][4];
        float nrm[4] = {0.f, 0.f, 0.f, 0.f}, bon[4] = {0.f, 0.f, 0.f, 0.f};
#pragma unroll
        for (int u = 0; u < 2; ++u) { const int c = (2 * jh + u) * 16 + fr, ch = h * 64 + c;
            const float mur = mu[ch], muk = mu[1536 + ch], muv = mu[3072 + ch], w0c = w0[ch], a0c = a0[ch], kkc = k_k[ch], kac = k_a[ch], rkc = r_k[ch];
            float run = 0.f;
#pragma unroll
            for (int e = 0; e < 4; ++e) { const int t = i0 + e;
                const float cr = bf2f(*(LAS unsigned short*)(TBUF(8) + (t + 1) * 128 + c * 2)), ck = bf2f(*(LAS unsigned short*)(TBUF(9) + (t + 1) * 128 + c * 2)), cv = bf2f(*(LAS unsigned short*)(TBUF(10) + (t + 1) * 128 + c * 2));
                const float pr = bf2f(*(LAS unsigned short*)(TBUF(8) + t * 128 + c * 2)), pk = bf2f(*(LAS unsigned short*)(TBUF(9) + t * 128 + c * 2)), pv = bf2f(*(LAS unsigned short*)(TBUF(10) + t * 128 + c * 2));
                const float r_ = cr + (pr - cr) * mur, k_ = ck + (pk - ck) * muk, v_ = cv + (pv - cv) * muv;
                const float x = -(w0c + aw[u][e]);
                const float sp = fmaxf(x, 0.f) + __logf(1.f + __expf(-fabsf(x)));
                const float lw = -__expf(-sp - 0.5f);
                run += lw; dw[u][e] = lw;
                const float a = fsigmoid(a0c + aa[u][e]);
                const float kr_ = k_ * kkc, kp_ = k_ * (1.f + (a - 1.f) * kac);
                xr[u][e] = r_; kp[u][e] = kp_; xv[u][e] = v_; av[u][e] = a; kkr[u][e] = kr_;
                nrm[e] += kr_ * kr_; bon[e] += r_ * kp_ * rkc; }
            ((LAS float*)(L + RK_TOT))[grp * 64 + c] = run; __builtin_amdgcn_sched_barrier(0); }
#pragma unroll
        for (int e = 0; e < 4; ++e) {
#pragma unroll
            for (int m = 1; m < 16; m <<= 1) { nrm[e] += __shfl_xor(nrm[e], m); bon[e] += __shfl_xor(bon[e], m); } }
        if (fr == 0) {
#pragma unroll
            for (int e = 0; e < 4; ++e) { ((LAS float*)(L + RK_XCH))[(w * 2 + 0) * 16 + 4 * q4 + e] = nrm[e]; ((LAS float*)(L + RK_XCH))[(w * 2 + 1) * 16 + 4 * q4 + e] = bon[e]; } }
        LDS_BARRIER();
#pragma unroll
        for (int e = 0; e < 4; ++e) { nrm[e] += ((LAS float*)(L + RK_XCH))[((w ^ 1) * 2 + 0) * 16 + 4 * q4 + e]; bon[e] += ((LAS float*)(L + RK_XCH))[((w ^ 1) * 2 + 1) * 16 + 4 * q4 + e];
            nrm[e] = 1.f / fmaxf(sqrtf(nrm[e]), 1e-12f); }
        f32x4 gbar[2];
#pragma unroll
        for (int u = 0; u < 2; ++u) { const int jt = 2 * jh + u, c = jt * 16 + fr, ch = h * 64 + c;
            float off = 0.f, tot = 0.f;
#pragma unroll
            for (int gp = 0; gp < 16; ++gp) { const float tv = ((LAS float*)(L + RK_TOT))[gp * 64 + c]; tot += tv; off += (gp < grp) ? tv : 0.f; }
            const float lnb = lnx_b[ch];
            f32x4 al, bb, vv4, gv, bv; float cum = off;
#pragma unroll
            for (int e = 0; e < 4; ++e) { const int t = i0 + e;
                cum += dw[u][e];
                const float eW = __expf(cum), eWm = __expf(cum - dw[u][e]), eInv = __expf(-cum), eBar = __expf(tot - cum);
                const float kk = kkr[u][e] * nrm[e], bq = kk * av[u][e];
                const float alpha = kk * eWm, rho = xr[u][e] * eW, beta = bq * eInv, gamma = kp[u][e] * eInv;
                *(LAS unsigned short*)(TBUF(0) + t * 144 + c * 2) = (unsigned short)f2bf(alpha);
                *(LAS unsigned short*)(TBUF(1) + t * 144 + c * 2) = (unsigned short)f2bf(beta);
                *(LAS unsigned short*)(TBUF(2) + t * 144 + c * 2) = (unsigned short)f2bf(gamma);
                *(LAS unsigned short*)(TBUF(3) + t * 144 + c * 2) = (unsigned short)f2bf(rho);
                al[e] = alpha; bb[e] = bq * eBar; gbar[u][e] = kp[u][e] * eBar; vv4[e] = xv[u][e];
                gv[e] = ag[u][e]; bv[e] = (lnb + bon[e] * xv[u][e]) * ag[u][e]; }
            *(LAS v2u*)(TBUF(4) + c * 144 + i0 * 2) = pk4(al);
            *(LAS v2u*)(TBUF(5) + c * 144 + i0 * 2) = pk4(bb);
            *(LAS v2u*)(TBUF(6) + c * 144 + i0 * 2) = pk4(vv4);
            if (grp == 0) ((LAS float*)(L + RK_WC))[c] = __expf(tot);
            const int ti = it * 4 + jt;
            *(v2u*)(rec + 4 * 8192 + (size_t)(ti * 64 + lane) * 8) = pk4(gv);
            *(v2u*)(rec + 5 * 8192 + (size_t)(ti * 64 + lane) * 8) = pk4(bv);
            __builtin_amdgcn_sched_barrier(0); }
        LDS_BARRIER();
        f32x4 n2r[2], etr[2], e2tr[2];
        { int tl_ = lane; asm volatile("" : "+v"(tl_)); const int fr = tl_ & 15, q4 = tl_ >> 4, i0 = it * 16 + 4 * q4; (void)i0;
        { bf16x8 aB[2], aA[2], aG[2];
#pragma unroll
          for (int ks = 0; ks < 2; ++ks) { const int o = (it * 16 + fr) * 144 + ks * 64 + q4 * 16; aA[ks] = *(LAS bf16x8*)(TBUF(0) + o); aB[ks] = *(LAS bf16x8*)(TBUF(1) + o); aG[ks] = *(LAS bf16x8*)(TBUF(2) + o); }
#pragma unroll
          for (int u = 0; u < 2; ++u) { const int jt = 2 * jh + u, jx = jt * 16 + fr;
              f32x4 m1 = (f32x4){0.f, 0.f, 0.f, 0.f}, m2 = m1, n1 = m1, n2 = m1;
#pragma unroll
              for (int ks = 0; ks < 2; ++ks) { const int o = (jt * 16 + fr) * 144 + ks * 64 + q4 * 16;
                  const bf16x8 bA = *(LAS bf16x8*)(TBUF(0) + o), bG = *(LAS bf16x8*)(TBUF(2) + o), bR = *(LAS bf16x8*)(TBUF(3) + o);
                  m1 = MFMA16(aB[ks], bA, m1); m2 = MFMA16(aA[ks], bG, m2); n1 = MFMA16(aB[ks], bR, n1); n2 = MFMA16(aG[ks], bR, n2); }
#pragma unroll
              for (int r = 0; r < 4; ++r) { const int ix = i0 + r; m1[r] = (ix < jx) ? m1[r] : 0.f; m2[r] = (jx < ix) ? m2[r] : 0.f; n1[r] = (ix <= jx) ? n1[r] : 0.f; n2[r] = (ix <= jx) ? n2[r] : 0.f; }
              if (it == jt) {
#pragma unroll
                  for (int r = 0; r < 4; ++r) ((LAS float*)(L + RK_LD))[(it * 16 + 4 * q4 + r) * 16 + fr] = m1[r];
                  m1 = (f32x4){0.f, 0.f, 0.f, 0.f}; }
              st_tileT(TBUF(8), it, jt, fr, q4, m1); st_tileT(TBUF(9), it, jt, fr, q4, m2); st_tileT(TBUF(10), it, jt, fr, q4, n1);
              n2r[u] = n2; } }
        LDS_BARRIER();
        for (int idx = tid; idx < 576; idx += NTHR) { const int row = idx / 9, chn = idx - row * 9; if ((chn >> 1) != (row >> 4)) *(LAS v4u*)(TBUF(2) + row * 144 + chn * 16) = (v4u){0u, 0u, 0u, 0u}; }
        if (w == 0) { const int bI = lane >> 4, cc = lane & 15; const LAS float* Ld = (const LAS float*)(L + RK_LD) + bI * 256;
            float x[16];
#pragma unroll
            for (int s = 15; s >= 0; --s) { float acc = (s == cc) ? 1.f : 0.f;
#pragma unroll
                for (int m = s + 1; m < 16; ++m) acc -= Ld[s * 16 + m] * x[m];
                x[s] = acc; __builtin_amdgcn_sched_barrier(0); }
            v4u o0, o1; o0.x = pk2(x[0], x[1]); o0.y = pk2(x[2], x[3]); o0.z = pk2(x[4], x[5]); o0.w = pk2(x[6], x[7]); o1.x = pk2(x[8], x[9]); o1.y = pk2(x[10], x[11]); o1.z = pk2(x[12], x[13]); o1.w = pk2(x[14], x[15]);
            *(LAS v4u*)(TBUF(7) + (bI * 16 + cc) * 144 + bI * 32) = o0; *(LAS v4u*)(TBUF(7) + (bI * 16 + cc) * 144 + bI * 32 + 16) = o1;
#pragma unroll
            for (int s = 0; s < 16; ++s) *(LAS unsigned short*)(TBUF(2) + (bI * 16 + s) * 144 + (bI * 16 + cc) * 2) = (unsigned short)f2bf(x[s]); }
        LDS_BARRIER();
        }
        { int tl_ = lane; asm volatile("" : "+v"(tl_)); const int fr = tl_ & 15, q4 = tl_ >> 4, i0 = it * 16 + 4 * q4; (void)i0;
#pragma unroll
        for (int u = 0; u < 2; ++u) { const int jt = 2 * jh + u;
            const f32x4 e1 = mm_tile(TBUF(2), TBUF(8), it, jt, fr, q4); st_tileT(TBUF(0), it, jt, fr, q4, e1);
            const f32x4 e2 = mm_tile(TBUF(8), TBUF(2), it, jt, fr, q4); st_tileT(TBUF(1), it, jt, fr, q4, e2); etr[u] = e2; }
        LDS_BARRIER();
#pragma unroll
        for (int u = 0; u < 2; ++u) { const int jt = 2 * jh + u; e2tr[u] = mm_tile(TBUF(0), TBUF(1), it, jt, fr, q4); st_tileT(TBUF(2), it, jt, fr, q4, e2tr[u]); }
        LDS_BARRIER();
#pragma unroll
        for (int u = 0; u < 2; ++u) { const int jt = 2 * jh + u; const f32x4 e3 = mm_tile(TBUF(0), TBUF(2), it, jt, fr, q4);
            f32x4 f = e2tr[u] - etr[u] - e3;
            if (it == jt) {
#pragma unroll
                for (int r = 0; r < 4; ++r) f[r] += (4 * q4 + r == fr) ? 1.f : 0.f; }
            st_tileT(TBUF(8), it, jt, fr, q4, f); }
        LDS_BARRIER();
#pragma unroll
        for (int u = 0; u < 2; ++u) { const int jt = 2 * jh + u; st_tileT(TBUF(2), it, jt, fr, q4, mm_tile(TBUF(8), TBUF(7), it, jt, fr, q4)); }
        LDS_BARRIER();
        }
        { int tl_ = lane; asm volatile("" : "+v"(tl_)); const int fr = tl_ & 15, q4 = tl_ >> 4, i0 = it * 16 + 4 * q4; (void)i0;
#pragma unroll
        for (int u = 0; u < 2; ++u) { const int jt = 2 * jh + u;
            st_tileT(TBUF(0), it, jt, fr, q4, mm_tile(TBUF(2), TBUF(4), it, jt, fr, q4));
            st_tileT(TBUF(1), it, jt, fr, q4, mm_tile(TBUF(2), TBUF(9), it, jt, fr, q4)); }
        LDS_BARRIER();
#pragma unroll
        for (int u = 0; u < 2; ++u) { const int jt = 2 * jh + u;
            const f32x4 g1n = mm_tile(TBUF(0), TBUF(10), it, jt, fr, q4), g2n = mm_tile(TBUF(1), TBUF(10), it, jt, fr, q4);
            const f32x4 g1b = mm_tile(TBUF(0), TBUF(5), it, jt, fr, q4), g2b = mm_tile(TBUF(1), TBUF(5), it, jt, fr, q4);
            const f32x4 rterm = bf4(*(LAS v2u*)(TBUF(3) + (jt * 16 + fr) * 144 + i0 * 2));
            f32x4 q1 = -g1b;
            if (it == jt) { const float wc = ((LAS float*)(L + RK_WC))[jt * 16 + fr];
#pragma unroll
                for (int r = 0; r < 4; ++r) q1[r] += (4 * q4 + r == fr) ? wc : 0.f; }
            st_tileT(TBUF(8), it, jt, fr, q4, rterm - g1n);
            st_tileT(TBUF(9), it, jt, fr, q4, q1);
            st_tileT(TBUF(2), it, jt, fr, q4, n2r[u] - g2n);
            st_tileT(TBUF(4), it, jt, fr, q4, gbar[u] - g2b); }
        LDS_BARRIER();
#pragma unroll
        for (int u = 0; u < 2; ++u) { const int jt = 2 * jh + u, ti = it * 4 + jt;
            *(v2u*)(rec + 2 * 8192 + (size_t)(ti * 64 + lane) * 8) = pk4(mm_tile(TBUF(4), TBUF(6), it, jt, fr, q4));
            *(v2u*)(rec + 3 * 8192 + (size_t)(ti * 64 + lane) * 8) = pk4(mm_tile(TBUF(2), TBUF(6), it, jt, fr, q4)); }
        { const int row = tid >> 3, c8 = tid & 7;
          *(v4u*)(rec + row * 128 + c8 * 16) = *(LAS v4u*)(TBUF(8) + row * 144 + c8 * 16);
          *(v4u*)(rec + 8192 + row * 128 + c8 * 16) = *(LAS v4u*)(TBUF(9) + row * 144 + c8 * 16); }
        }
    }
    __syncthreads();
}

constexpr int CH_S = 0, CH_Q = 9216;
__device__ __forceinline__ void rwkv_chain_unit(Frame& F, int b, int h, float* state_out) {
    const ldsp L = F.lds; const int tid = fresh_tid(), w = __builtin_amdgcn_readfirstlane(tid >> 6), lane = tid & 63, fr = lane & 15, q4 = lane >> 4;
    const int it = w >> 1, jh = w & 1;
    unsigned char* recb = F.ws + WS_REC + ((size_t)(b * BH + h) * 32) * REC_BYTES;
    const int row = tid >> 3, c8 = tid & 7;
    const size_t qoff = 8192 + row * 128 + c8 * 16, uoff0 = 2 * 8192 + (size_t)((it * 4 + 2 * jh) * 64 + lane) * 8, uoff1 = uoff0 + 512, soff = 6 * 8192 + row * 128 + c8 * 16;
    __syncthreads();
    for (int i = tid; i < TBYTES / 16; i += NTHR) *(LAS v4u*)(L + CH_S + i * 16) = (v4u){0u, 0u, 0u, 0u};
    v4u qreg[4]; v2u ureg[4][2];
#pragma unroll
    for (int i = 0; i < 3; ++i) { const unsigned char* rc = recb + (size_t)i * REC_BYTES; qreg[i] = *(const v4u*)(rc + qoff); ureg[i][0] = *(const v2u*)(rc + uoff0); ureg[i][1] = *(const v2u*)(rc + uoff1); }
    f32x4 acc[2];
#pragma unroll 1
    for (int cc = 0; cc < 8; ++cc) {
#pragma unroll
        for (int i = 0; i < 4; ++i) { const int c = 4 * cc + i;
            unsigned char* rec = recb + (size_t)c * REC_BYTES;
            *(LAS v4u*)(L + CH_Q + row * 144 + c8 * 16) = qreg[i];
            const f32x4 uu0 = bf4(ureg[i][0]), uu1 = bf4(ureg[i][1]);
            if (c + 3 < 32) { const unsigned char* rn = rec + 3 * REC_BYTES; const int s3 = (i + 3) & 3;
                qreg[s3] = *(const v4u*)(rn + qoff); ureg[s3][0] = *(const v2u*)(rn + uoff0); ureg[s3][1] = *(const v2u*)(rn + uoff1); }
            LDS_BARRIER();
            *(v4u*)(rec + soff) = *(LAS v4u*)(L + CH_S + row * 144 + c8 * 16);
            acc[0] = uu0 + mm_tile(L + CH_Q, L + CH_S, it, 2 * jh, fr, q4);
            acc[1] = uu1 + mm_tile(L + CH_Q, L + CH_S, it, 2 * jh + 1, fr, q4);
            LDS_BARRIER();
            st_tileT(L + CH_S, it, 2 * jh, fr, q4, acc[0]); st_tileT(L + CH_S, it, 2 * jh + 1, fr, q4, acc[1]); }
    }
#pragma unroll
    for (int u = 0; u < 2; ++u) *(f32x4*)(state_out + (size_t)((2 * jh + u) * 16 + fr) * BHD + it * 16 + 4 * q4) = acc[u];
    __syncthreads();
}

constexpr int RO_STG = 0, RO_LD = 1552;
__device__ __forceinline__ void rwkv_out_unit(Frame& F, const Args& A, int j, int b, int cidx, int h_lo) {
    const ldsp L = F.lds; const int tid = fresh_tid(), w = __builtin_amdgcn_readfirstlane(tid >> 6), lane = tid & 63, fr = lane & 15, q4 = lane >> 4;
    const int it = w & 3, hsel = w >> 2;
    const float* lnx_g = A.in[29] + (size_t)j * MIX;
    bf16* MIXC = (bf16*)(F.ws + WS_MIXC);
    const int r0 = b * SEQ + cidx * 64;
    __syncthreads();
#pragma unroll 1
    for (int hp = 0; hp < 6; ++hp) { const int hl = 2 * hp + hsel, h = h_lo + hl;
        const unsigned char* rec = F.ws + WS_REC + ((size_t)(b * BH + h) * 32 + cidx) * REC_BYTES;
        bf16x8 pa[2];
#pragma unroll
        for (int ks = 0; ks < 2; ++ks) pa[ks] = *(const bf16x8*)(rec + (it * 16 + fr) * 128 + ks * 64 + q4 * 16);
        f32x4 o[4]; float s1[4] = {0.f, 0.f, 0.f, 0.f}, s2[4] = {0.f, 0.f, 0.f, 0.f};
#pragma unroll
        for (int jt = 0; jt < 4; ++jt) { f32x4 acc = bf4(*(const v2u*)(rec + 3 * 8192 + (size_t)((it * 4 + jt) * 64 + lane) * 8));
#pragma unroll
            for (int ks = 0; ks < 2; ++ks) { const bf16x8 sb = *(const bf16x8*)(rec + 6 * 8192 + (jt * 16 + fr) * 128 + ks * 64 + q4 * 16); acc = MFMA16(pa[ks], sb, acc); }
            o[jt] = acc;
#pragma unroll
            for (int r = 0; r < 4; ++r) { s1[r] += acc[r]; s2[r] += acc[r] * acc[r]; } }
#pragma unroll
        for (int r = 0; r < 4; ++r) {
#pragma unroll
            for (int m = 1; m < 16; m <<= 1) { s1[r] += __shfl_xor(s1[r], m); s2[r] += __shfl_xor(s2[r], m); } }
        float mean[4], rstd[4];
#pragma unroll
        for (int r = 0; r < 4; ++r) { mean[r] = s1[r] * (1.f / 64.f); const float var = fmaxf(s2[r] * (1.f / 64.f) - mean[r] * mean[r], 0.f); rstd[r] = 1.f / sqrtf(var + GN_EPS); }
#pragma unroll
        for (int jt = 0; jt < 4; ++jt) { const int vch = jt * 16 + fr; const float lg = lnx_g[h * 64 + vch];
            const f32x4 gv = bf4(*(const v2u*)(rec + 4 * 8192 + (size_t)((it * 4 + jt) * 64 + lane) * 8)), bv = bf4(*(const v2u*)(rec + 5 * 8192 + (size_t)((it * 4 + jt) * 64 + lane) * 8));
#pragma unroll
            for (int r = 0; r < 4; ++r) { const float val = (o[jt][r] - mean[r]) * rstd[r] * lg * gv[r] + bv[r];
                *(LAS unsigned short*)(L + RO_STG + (it * 16 + 4 * q4 + r) * RO_LD + (hl * 64 + vch) * 2) = (unsigned short)f2bf(val); } }
    }
    __syncthreads();
    for (int i = tid; i < 64 * 96; i += NTHR) { const int t = i / 96, c16 = i - t * 96;
        *(v4u*)(MIXC + (size_t)(r0 + t) * D + h_lo * 64 + c16 * 8) = *(LAS v4u*)(L + RO_STG + t * RO_LD + c16 * 16); }
    __syncthreads();
}


constexpr int PH_PER_PAIR = 12, N_PHASES = 1 + 2 * PH_PER_PAIR + 1;
#ifndef MK_N_LAUNCHES
#define MK_N_LAUNCHES 1


#endif
#ifndef PROBE_K
#define PROBE_K 0
#endif
#ifndef PROBE_P0
#define PROBE_P0 0
#endif
#ifndef PROBE_SUB
#define PROBE_SUB 0
#endif

__global__ void __launch_bounds__(NTHR, 2) fwd_kernel(Args args) {
    extern __shared__ __attribute__((aligned(16))) unsigned char lds_raw[];
    Frame F;
    F.lds = (ldsp)lds_raw;
    F.tid = threadIdx.x; F.lane = F.tid & 63; F.wave = __builtin_amdgcn_readfirstlane(F.tid >> 6);
    F.G = gridDim.x; { const int bx = blockIdx.x; F.vcu = (F.G % 8 == 0) ? (bx % 8) * (F.G / 8) + bx / 8 : bx; }
    F.ws = args.ws; F.out = args.out;
    volatile LAS unsigned* MISC = (volatile LAS unsigned*)(F.lds + MISC_OFF);
    for (int u = F.tid; u < (LDS_BYTES - LDSCTL_OFF) / 4; u += NTHR) ((LAS unsigned*)(F.lds + LDSCTL_OFF))[u] = 0u;
    __syncthreads();
    const int lo = args.ph_lo, hi = args.ph_hi;
    const bool multi = (hi - lo) > 1;
    XcdBarrier bar; bar.bar = (unsigned*)(F.ws + WS_CTL) + CW_BAR; bar.x = 0; bar.st = nullptr;
    if (multi) bar = xcd_barrier_post((unsigned*)(F.ws + WS_CTL) + CW_BAR, MISC + 8);
#define IN(k) (lo <= (k) && (k) < hi)
#define SEAM(k) do { if (IN((k) + 1)) xcd_barrier(bar); } while (0)

    bf16* const H = (bf16*)(F.ws + WS_H); bf16* const PROJ = (bf16*)(F.ws + WS_PROJ); bf16* const MIXC = (bf16*)(F.ws + WS_MIXC); bf16* const ACT = (bf16*)(F.ws + WS_ACT);
    float* const X = (float*)(F.ws + WS_X); const float* const Xs = X + (size_t)MP * D;
    const int blk = blockIdx.x;

#define PH(k, ...) if (IN(base + (k))) { __VA_ARGS__ if constexpr (((PROBE_K) >> (k)) & 1) { __VA_ARGS__ } SEAM(base + (k)); }
    if (IN(0)) { p0_prologue(F, args); if constexpr (PROBE_P0) { p0_prologue(F, args); } SEAM(0); }

    for (int j = 0; j < 2; ++j) {
        const int base = 1 + j * PH_PER_PAIR;
        const int la = 2 * j, lb = 2 * j + 1;
        const bf16* const WinA = (const bf16*)(F.ws + WS_WINA + (size_t)j * SZ_WINA); const bf16* const WoutA = (const bf16*)(F.ws + WS_WOUTA + (size_t)j * SZ_WSQ);
        const bf16* const WinB = (const bf16*)(F.ws + WS_WINB + (size_t)j * SZ_WINB); const bf16* const WoutB = (const bf16*)(F.ws + WS_WOUTB + (size_t)j * SZ_WSQ);
        PH(0,
            { unsigned* sflag = (unsigned*)(F.ws + WS_CTL) + CW_SFLAG + 64 * la;
              if (blk >= 256 - SN_BLOCKS) { const int ftw = fresh_tid(); sample_rows_prepare(F, nullptr, nullptr, ss_slot(F.ws, 2 * la), sflag, (blk - (256 - SN_BLOCKS)) * NWAVES + __builtin_amdgcn_readfirstlane(ftw >> 6)); }
              run_gemm_sample(F, H, WinA, A_IN, D, EpiBf<0>{PROJ, LDP, ss_slot(F.ws, 2 * la)}, sflag); }
            if (j == 0) run_gemm(F, (const bf16*)(F.ws + WS_MEMN), (const bf16*)(F.ws + WS_WKV), 1024, 4096, D, EpiMemKV{F.out}, 128);
        )
        PH(1,
            { const float* Kp = F.out + O_MK + (size_t)la * (1024 * 512); const float* Vp = F.out + O_MV + (size_t)la * (1024 * 512);
            if (blk < 96) { const int bh = blk < 48 ? blk : blk - 48, b = bh / AH, h = bh % AH;
                hgrn_prompt_unit(F, PROJ, MIXC, args.in[16], args.in[17] + (size_t)j * MIX, F.out + O_SHP + ((size_t)(j * NB + b) * AH + h) * (AHD * AHD), j, b, h, blk < 48 ? HG_SPLIT : 0, blk < 48 ? SEQ / 64 : HG_SPLIT);
                if (PROBE_SUB == 10) hgrn_prompt_unit(F, PROJ, MIXC, args.in[16], args.in[17] + (size_t)j * MIX, F.out + O_SHP + ((size_t)(j * NB + b) * AH + h) * (AHD * AHD), j, b, h, blk < 48 ? HG_SPLIT : 0, blk < 48 ? SEQ / 64 : HG_SPLIT); }
            else { if (blk < 224) { const int u = blk - 96, b = u >> 5, head = (u >> 3) & 3, qp = u & 7;
                    xattn_prompt_unit(F, PROJ, A_XQ_OFF, MIXC, Kp + (size_t)b * NMEM * XDIM, Vp + (size_t)b * NMEM * XDIM, b, head, qp); }
                const int nw = (F.G - 96) * NWAVES; const int ft = fresh_tid(); F.lane = ft & 63; F.wave = __builtin_amdgcn_readfirstlane(ft >> 6);
                const int prio = blk >= 224 ? blk - 224 : blk - 96 + 32;
                for (int rep14 = 0; rep14 < (PROBE_SUB == 14 ? 2 : 1); ++rep14)
                for (int u = prio * NWAVES + F.wave; u < NSMP * AH + NSMP * XH; u += nw) {
                    if (u < NSMP * AH) { const int b = u / AH, h = u % AH;
                        hgrn_sample_unit(F.lane, PROJ, MIXC, args.in[16], args.in[17] + (size_t)j * MIX, args.in[4] + ((size_t)(j * NSMP + b) * AH + h) * (AHD * AHD),
                                         F.out + O_SHS + ((size_t)(j * NSMP + b) * AH + h) * (AHD * AHD), j, b, h); }
                    else { const int q = u - NSMP * AH, b = q >> 2, head = q & 3;
                        xattn_sample_unit(F.lane, PROJ, A_XQ_OFF, MIXC, args.in[2] + ((size_t)(la * NSMP + b) * NMEM) * XDIM, args.in[3] + ((size_t)(la * NSMP + b) * NMEM) * XDIM, b, head); } } }
            { __syncthreads();
                convert_items_dyn(F, args, args.git[2 + 2 * j], args.git[3 + 2 * j], (unsigned*)(F.ws + WS_CTL) + CW_CQ + 512 * j + 64 * (blk & 7), blk & 7); __syncthreads(); } }
        )
        if (IN(base + 2)) { run_gemm(F, MIXC, WoutA, MP, D, D, EpiResid<false>{X, D, H, ss_slot(F.ws, 2 * la + 1), nullptr}, 0);
              skinny_gemm<0, 2>(F, MIXC + (size_t)MP * D, D, nullptr, WoutA, D, 64 * (blk & 31), (blk >> 5) & 1, 512 * (blk >> 6), 512, X, D, MP); SEAM(base + 2); }
        if (PROBE_SUB == 12 && IN(base + 3)) { run_gemm(F, H, WoutA, MP, D, D, EpiDummy{(float*)PROJ, D}, 0); }
        if (PROBE_SUB == 13 && IN(base + 3)) { run_gemm(F, H, (const bf16*)(F.ws + WS_W1 + (size_t)la * SZ_WFF), MP, 4096, D, EpiDummy{(float*)PROJ, 4096}, 0); }
        PH(3, if (blk & 1) skinny_gemm<1, 1>(F, Xs, D, nullptr, (const bf16*)(F.ws + WS_W1 + (size_t)la * SZ_WFF), D, 64 * (blk >> 1), blk & 1, 0, D, ACT, DFF, MP);
              run_gemm(F, H, (const bf16*)(F.ws + WS_W1 + (size_t)la * SZ_WFF), MP, DFF, D, EpiBf<2>{ACT, DFF, nullptr}, 0);
              if (!(blk & 1)) skinny_gemm<1, 1>(F, Xs, D, nullptr, (const bf16*)(F.ws + WS_W1 + (size_t)la * SZ_WFF), D, 64 * (blk >> 1), blk & 1, 0, D, ACT, DFF, MP);
              if (PROBE_SUB == 5) skinny_gemm<1, 1>(F, Xs, D, nullptr, (const bf16*)(F.ws + WS_W1 + (size_t)la * SZ_WFF), D, 64 * (blk >> 1), blk & 1, 0, D, ACT, DFF, MP); )
        if (IN(base + 4)) { if (PROBE_SUB == 9) run_gemm(F, ACT, (const bf16*)(F.ws + WS_W2 + (size_t)la * SZ_WFF), MP, D, DFF, EpiDummy{(float*)PROJ, D}, 0);
              run_gemm(F, ACT, (const bf16*)(F.ws + WS_W2 + (size_t)la * SZ_WFF), MP, D, DFF, EpiResid<true>{X, D, H, ss_slot(F.ws, 2 * lb), ss_slot(F.ws, 2 * la + 1)}, 0);
              skinny_gemm<0, 2>(F, ACT + (size_t)MP * DFF, DFF, nullptr, (const bf16*)(F.ws + WS_W2 + (size_t)la * SZ_WFF), DFF, 64 * (blk & 31), (blk >> 5) & 1, 2048 * (blk >> 6), 2048, X, D, MP); SEAM(base + 4); }
        PH(5, { unsigned* sflag = (unsigned*)(F.ws + WS_CTL) + CW_SFLAG + 64 * lb;
              if (blk >= 256 - SN_BLOCKS) { const int ftw = fresh_tid(); sample_rows_prepare(F, args.in[6] + (size_t)j * NSMP * D, args.in[8] + (size_t)lb * D, ss_slot(F.ws, 2 * lb), sflag, (blk - (256 - SN_BLOCKS)) * NWAVES + __builtin_amdgcn_readfirstlane(ftw >> 6)); }
              run_gemm_sample_early(F, H, WinB, B_INP, D, EpiBf<0>{PROJ, LDP, ss_slot(F.ws, 2 * lb)}, sflag, (unsigned*)(F.ws + WS_CTL) + CW_PDONE + 64 * j); }
              if (blk >= 192) {
                  const int ft = fresh_tid(); const int ln = ft & 63, gwv = (blk - 192) * NWAVES + __builtin_amdgcn_readfirstlane(ft >> 6);
                  for (int r = gwv; r < NB + NSMP; r += 64 * NWAVES) { const int row = r < NB ? r * SEQ + SEQ - 1 : MP + (r - NB);
                      float* dst = r < NB ? F.out + O_SSP + (size_t)(j * NB + r) * D : F.out + O_SSS + (size_t)(j * NSMP + (r - NB)) * D;
                      norm_row(X + (size_t)row * D, args.in[8] + (size_t)lb * D, ln, nullptr, dst, nullptr, nullptr); } }
              if (blk >= 214) { wait_counter((const unsigned*)(F.ws + WS_CTL) + CW_PDONE + 64 * j, B_INP / 256);
                  const int idx = blk - 214, h0 = idx < 36 ? idx : 36 + 2 * (idx - 36), nh = idx < 36 ? 1 : 2;
                  rwkv_prep_unit(F, args, j, (128 + h0 / 24) * 64, h0 % 24, h0 % 24 + nh); } )
        PH(6,
            rwkv_chunk_unit(F, args, j, blk >> 6, (blk >> 1) & 31, (blk & 1) * 12, (blk & 1) * 12 + 12);
        )
        PH(7,
            { const float* Kp = F.out + O_MK + (size_t)lb * (1024 * 512); const float* Vp = F.out + O_MV + (size_t)lb * (1024 * 512);
            if (blk < 96) { const int b = blk / BH, h = blk % BH; rwkv_chain_unit(F, b, h, F.out + O_SRP + ((size_t)(j * NB + b) * BH + h) * (BHD * BHD));
                if (PROBE_SUB == 7) rwkv_chain_unit(F, b, h, F.out + O_SRP + ((size_t)(j * NB + b) * BH + h) * (BHD * BHD)); }
            else if (blk < 224) { const int u = blk - 96, b = u >> 5, head = (u >> 3) & 3, qp = u & 7;
                    xattn_prompt_unit(F, PROJ, B_XQ_OFF, MIXC, Kp + (size_t)b * NMEM * XDIM, Vp + (size_t)b * NMEM * XDIM, b, head, qp);
                    if (PROBE_SUB == 17) xattn_prompt_unit(F, PROJ, B_XQ_OFF, MIXC, Kp + (size_t)b * NMEM * XDIM, Vp + (size_t)b * NMEM * XDIM, b, head, qp); }
            __syncthreads();
            xattn_sample_pair(F, PROJ, B_XQ_OFF, MIXC, args.in[2] + (size_t)lb * NSMP * NMEM * XDIM, args.in[3] + (size_t)lb * NSMP * NMEM * XDIM, 2 * blk);
            { const int nw = F.G * NWAVES; const int ft = fresh_tid(); F.lane = ft & 63; F.wave = __builtin_amdgcn_readfirstlane(ft >> 6);
              const int prio = blk >= 224 ? blk - 224 : (blk >= 96 ? blk - 96 + 128 : blk + 32);
              for (int u = prio * NWAVES + F.wave; u < NSMP * BH; u += nw) rwkv_sample_unit(F, args, F.lane, j, u / BH, u % BH); } }
        )
        PH(8, rwkv_out_unit(F, args, j, blk >> 6, (blk >> 1) & 31, (blk & 1) * 12); )
        if (IN(base + 9)) { run_gemm(F, MIXC, WoutB, MP, D, D, EpiResid<false>{X, D, H, ss_slot(F.ws, 2 * lb + 1), nullptr}, 0);
               skinny_gemm<0, 2>(F, MIXC + (size_t)MP * D, D, nullptr, WoutB, D, 64 * (blk & 31), (blk >> 5) & 1, 512 * (blk >> 6), 512, X, D, MP); SEAM(base + 9); }
        PH(10, if (blk & 1) skinny_gemm<1, 1>(F, Xs, D, nullptr, (const bf16*)(F.ws + WS_W1 + (size_t)lb * SZ_WFF), D, 64 * (blk >> 1), blk & 1, 0, D, ACT, DFF, MP);
              run_gemm(F, H, (const bf16*)(F.ws + WS_W1 + (size_t)lb * SZ_WFF), MP, DFF, D, EpiBf<2>{ACT, DFF, nullptr}, 0);
              if (!(blk & 1)) skinny_gemm<1, 1>(F, Xs, D, nullptr, (const bf16*)(F.ws + WS_W1 + (size_t)lb * SZ_WFF), D, 64 * (blk >> 1), blk & 1, 0, D, ACT, DFF, MP);
               if (PROBE_SUB == 5) skinny_gemm<1, 1>(F, Xs, D, nullptr, (const bf16*)(F.ws + WS_W1 + (size_t)lb * SZ_WFF), D, 64 * (blk >> 1), blk & 1, 0, D, ACT, DFF, MP); )
        if (IN(base + 11)) { if (PROBE_SUB == 9) run_gemm(F, ACT, (const bf16*)(F.ws + WS_W2 + (size_t)lb * SZ_WFF), MP, D, DFF, EpiDummy{(float*)PROJ, D}, 0);
              run_gemm(F, ACT, (const bf16*)(F.ws + WS_W2 + (size_t)lb * SZ_WFF), MP, D, DFF, EpiResid<true>{X, D, H, ss_slot(F.ws, 2 * lb + 2), ss_slot(F.ws, 2 * lb + 1)}, 0);
               skinny_gemm<0, 2>(F, ACT + (size_t)MP * DFF, DFF, nullptr, (const bf16*)(F.ws + WS_W2 + (size_t)lb * SZ_WFF), DFF, 64 * (blk & 31), (blk >> 5) & 1, 2048 * (blk >> 6), 2048, X, D, MP); SEAM(base + 11); }
    }
    if (IN(N_PHASES - 1)) { norm_phase(F, args, args.in[10], false, true, -1); }
#undef PH
#undef IN
#undef SEAM
}

static int add_job(Job* jobs, int& n, int& items, const float* src, bf16* dst, int ldw, int K, int ncols, int ldt, int koff, int row_off, const float* gain = nullptr) {
    Job J{}; J.src = src; J.dst = dst; J.gain = gain; J.ldw = ldw; J.K = K; J.ncols = ncols; J.ldt = ldt; J.koff = koff; J.row_off = row_off; J.item0 = items; J.pad = 0;
    jobs[n++] = J; items += ((K + 63) / 64) * ((ncols + 63) / 64); return n;
}

extern "C" void kernel_launch(void* const* d_in, const int* in_sizes, int n_in, void* d_out, int out_size, void* d_ws, size_t ws_size, hipStream_t stream) {
    static int ready = 0;
    if (ready == 0) {
        if (n_in != 33 || (size_t)out_size != O_END || ws_size < WS_END) { fprintf(stderr, "kernel_launch: unexpected shapes: n_in %d out %d ws %zu (need %zu)\n", n_in, out_size, ws_size, (size_t)WS_END); ready = -1; return; }
        if (hipFuncSetAttribute((const void*)fwd_kernel, hipFuncAttributeMaxDynamicSharedMemorySize, LDS_BYTES) != hipSuccess) { fprintf(stderr, "kernel_launch: hipFuncSetAttribute failed\n"); ready = -1; return; }
        int per_cu = 0;
        if (hipOccupancyMaxActiveBlocksPerMultiprocessor(&per_cu, (const void*)fwd_kernel, NTHR, LDS_BYTES) != hipSuccess || per_cu < 1) fprintf(stderr, "kernel_launch: occupancy query says %d\n", per_cu);
        (void)hipGetLastError();
        ready = 1;
    }
    if (ready < 0) return;
    unsigned char* ws = (unsigned char*)d_ws;
    (void)hipMemsetAsync(ws + WS_CTL, 0, CTL_BYTES, stream);
    Args a{};
    for (int i = 0; i < 33; ++i) a.in[i] = (const float*)d_in[i];
    a.out = (float*)d_out; a.ws = ws;
    int n = 0, items = 0;
    const float* a_w_in = a.in[14]; const float* a_w_out = a.in[15]; const float* b_w_in = a.in[18]; const float* b_w_out = a.in[19];
    const float* w1 = a.in[31]; const float* w2 = a.in[32]; const float* wk = a.in[12]; const float* wv = a.in[13];
    auto job_a_in = [&](int j) { add_job(a.jobs, n, items, a_w_in + (size_t)j * D * A_IN, (bf16*)(ws + WS_WINA + j * SZ_WINA), A_IN, D, A_IN, D, 0, 0, a.in[8] + (size_t)(2 * j) * D); };
    auto job_a_out = [&](int j) { add_job(a.jobs, n, items, a_w_out + (size_t)j * D * D, (bf16*)(ws + WS_WOUTA + j * SZ_WSQ), D, D, D, D, 0, 0); };
    auto job_b = [&](int j) {
        const float* bw = b_w_in + (size_t)j * D * B_IN; bf16* bd = (bf16*)(ws + WS_WINB + j * SZ_WINB); const float* gB = a.in[8] + (size_t)(2 * j + 1) * D;
        add_job(a.jobs, n, items, bw, bd, B_IN, D, 4608, D, 0, 0, gB);
        add_job(a.jobs, n, items, bw + B_MIXC, bd, B_IN, D, XDIM, D, 0, B_XQ_OFF, gB);
        add_job(a.jobs, n, items, bw + 4608, bd, B_IN, D, LORA_K, D, 0, B_LORA_OFF, gB);
        add_job(a.jobs, n, items, b_w_out + (size_t)j * D * D, (bf16*)(ws + WS_WOUTB + j * SZ_WSQ), D, D, D, D, 0, 0);
        bf16* lw = (bf16*)(ws + WS_LW + j * SZ_LW);
        add_job(a.jobs, n, items, a.in[22] + (size_t)j * 64 * MIX, lw, MIX, 64, MIX, LORA_K, 0, 0);
        add_job(a.jobs, n, items, a.in[24] + (size_t)j * 64 * MIX, lw, MIX, 64, MIX, LORA_K, 64, 0);
        add_job(a.jobs, n, items, a.in[25] + (size_t)j * 224 * MIX, lw, MIX, 224, MIX, LORA_K, 128, 0); };
    auto job_mlp = [&](int l) {
        add_job(a.jobs, n, items, w1 + (size_t)l * D * DFF, (bf16*)(ws + WS_W1 + l * SZ_WFF), DFF, D, DFF, D, 0, 0, a.in[9] + (size_t)l * D);
        add_job(a.jobs, n, items, w2 + (size_t)l * DFF * D, (bf16*)(ws + WS_W2 + l * SZ_WFF), D, DFF, D, DFF, 0, 0); };
    a.git[0] = 0;
    job_a_in(0);
    for (int l = 0; l < 4; ++l) {
        add_job(a.jobs, n, items, wk + (size_t)l * D * XDIM, (bf16*)(ws + WS_WKV + l * SZ_WKV), XDIM, D, XDIM, D, 0, 0);
        add_job(a.jobs, n, items, wv + (size_t)l * D * XDIM, (bf16*)(ws + WS_WKV + l * SZ_WKV), XDIM, D, XDIM, D, 0, XDIM); }
    a.git[1] = items;
    job_a_out(0); job_mlp(0); job_b(0); job_mlp(1); job_a_in(1);
    a.git[3] = items; a.git[2] = a.git[1] + (int)((a.git[3] - a.git[1]) * 0.0f);
    job_a_out(1); job_mlp(2); job_b(1); job_mlp(3);
    a.git[5] = items; a.git[4] = a.git[3] + (int)((a.git[5] - a.git[3]) * 0.0f);
    a.njobs = n; a.nitems = items;
    const int grid = 256;
#if MK_N_LAUNCHES == 1
    a.ph_lo = 0; a.ph_hi = N_PHASES;
    hipLaunchKernelGGL(fwd_kernel, dim3(grid), dim3(NTHR), LDS_BYTES, stream, a);
#else
    for (int p = 0; p < N_PHASES; ++p) { a.ph_lo = p; a.ph_hi = p + 1; hipLaunchKernelGGL(fwd_kernel, dim3(grid), dim3(NTHR), LDS_BYTES, stream, a); }
#endif
    const hipError_t le = hipPeekAtLastError();
    if (le != hipSuccess) fprintf(stderr, "kernel_launch: launch failed: %s\n", hipGetErrorName(le));
}
```

```cpp
#include <hip/hip_runtime.h>
#include <cstdio>
#include <cstdint>
#define MK_N_LAUNCHES 1
#define PROBE_K 0
#define PROBE_P0 0
#define PROBE_SUB 0
namespace pg8 {
#define PG8_LAS __attribute__((address_space(3)))
typedef unsigned short bf16_t;
typedef short bf16x8 __attribute__((ext_vector_type(8)));
typedef float f32x4 __attribute__((ext_vector_type(4)));
typedef unsigned u32x4 __attribute__((ext_vector_type(4)));
constexpr int BM = 256, BK = 64, HALF = 128, HTB = HALF * BK * 2  , STAGE_BYTES = 8 * HTB, NXCD = 8, WGM = 4;

__host__ __device__ __forceinline__ int lds_byte(int r, int c) { const int st = (r >> 4) * 2 + (c >> 5), rr = r & 15, cc = c & 31, ob = rr * 64 + cc * 2; return st * 1024 + (ob ^ (((ob >> 9) & 1) << 5)); }
__host__ __device__ __forceinline__ void stage_rc(int b, int& R, int& C) { const int st = b / 1024, sb = b % 1024, swz = sb ^ (((sb >> 9) & 1) << 5); R = (st >> 1) * 16 + swz / 64; C = (st & 1) * 32 + (swz % 64) / 2; }
__host__ __device__ __forceinline__ int perm32(int rho) { const int n = rho >> 4, i = rho & 15; return 8 * (i >> 2) + 4 * n + (i & 3); }

struct Unit { int pm, pn; };
struct Gemm { const bf16_t* A; const bf16_t* Bt; int M, N, K; };

struct StaticOrder {
    int nM, nN, nwg, G, c;
    __host__ __device__ void init(int M, int N, int G_, int c_) { nM = M / BM; nN = N / BM; nwg = nM * nN; G = G_; c = c_; }
    __host__ __device__ bool next(int i, Unit& u) const {
        const long L = (long)i * G + c; if (L >= nwg) return false;
        int wgid = (int)L; { const int q = nwg / NXCD, r = nwg % NXCD, xcd = wgid % NXCD, off = wgid / NXCD; wgid = (xcd < r ? xcd * (q + 1) : r * (q + 1) + (xcd - r) * q) + off; }
        const int nig = WGM * nN, gid = wgid / nig, fm = gid * WGM, gsz = (nM - fm) < WGM ? (nM - fm) : WGM;
        u.pm = fm + ((wgid % nig) % gsz); u.pn = (wgid % nig) / gsz; return true;
    }
    __device__ __forceinline__ void a_ready(const Unit&) const {}
    __device__ __forceinline__ void done(const Unit&) const {}
};

__device__ __forceinline__ unsigned cvt_pk_bf16(float lo, float hi) { unsigned r; asm volatile("v_cvt_pk_bf16_f32 %0, %1, %2" : "=v"(r) : "v"(lo), "v"(hi)); return r; }
typedef float f32x2 __attribute__((ext_vector_type(2)));
template <class Epi, class Sched, bool ALIGN_EPI = false, bool SP2 = false>
__device__ __forceinline__ void gemm_phase(PG8_LAS unsigned char* lds, const Gemm g, const Sched& S, const Epi& E) {
    int tid_ = threadIdx.x; asm volatile("" : "+v"(tid_));
    const int tid = tid_, wid = __builtin_amdgcn_readfirstlane(tid >> 6), lane = tid & 63, wr = wid >> 2, wc = wid & 3, fr = lane & 15, fq = lane >> 4;
    const int K = g.K, nt = K / BK;
    unsigned voffA[2], voffB[2];
#pragma unroll
    for (int i = 0; i < 2; ++i) { int R, C; stage_rc(tid * 16 + i * 8192, R, C); const int Rb = Epi::PERM ? ((R & ~31) + perm32(R & 31)) : R;
        voffA[i] = (unsigned)(R * K + C) * 2u; voffB[i] = (unsigned)(Rb * K + C) * 2u; }
    const size_t kstep = (size_t)(BK * 2);
    const size_t hstep = (size_t)HALF * K * 2;
    const size_t tstep = 2 * hstep;
    const unsigned ldsw = (unsigned)wid * 1024u;
    const int aoff = lds_byte(wr * 64 + fr, fq * 8), boff = lds_byte(wc * 32 + fr, fq * 8);
#define PG8_SA(b, h) (((b) * 2 + (h)) * HTB)
#define PG8_SB(b, h) ((4 + (b) * 2 + (h)) * HTB)
#define PG8_STAGE(bufoff, gbase, voff) do { _Pragma("unroll") for (int _i = 0; _i < 2; ++_i) \
        __builtin_amdgcn_global_load_lds((const unsigned*)((const char*)(gbase) + (voff)[_i]), (PG8_LAS unsigned*)(lds + (bufoff) + ldsw + _i * 8192), 16, 0, 0); } while (0)
#define PG8_LDA(dst, b, h) do { _Pragma("unroll") for (int m = 0; m < 4; ++m) _Pragma("unroll") for (int k = 0; k < 2; ++k) dst[m][k] = *(const PG8_LAS bf16x8*)(lds + PG8_SA(b, h) + aoff + m * 2048 + k * 1024); } while (0)
#define PG8_LDB(dst, b, h) do { _Pragma("unroll") for (int n = 0; n < 2; ++n) _Pragma("unroll") for (int k = 0; k < 2; ++k) dst[n][k] = *(const PG8_LAS bf16x8*)(lds + PG8_SB(b, h) + boff + n * 2048 + k * 1024); } while (0)
#define PG8_MMA(ai, bj, At, Bt) do { __builtin_amdgcn_s_setprio(1); _Pragma("unroll") for (int m = 0; m < 4; ++m) _Pragma("unroll") for (int n = 0; n < 2; ++n) _Pragma("unroll") for (int k = 0; k < 2; ++k) \
        acc[ai][bj][m][n] = __builtin_amdgcn_mfma_f32_16x16x32_bf16(Bt[n][k], At[m][k], acc[ai][bj][m][n], 0, 0, 0); __builtin_amdgcn_s_setprio(0); } while (0)
#define PG8_WAIT_V(n) asm volatile("s_waitcnt vmcnt(" #n ")" ::: "memory")
#define PG8_WAIT_L(n) asm volatile("s_waitcnt lgkmcnt(" #n ")" ::: "memory")
#define PG8_BAR __builtin_amdgcn_s_barrier()
#define PG8_SCHED __builtin_amdgcn_sched_barrier(0)
    Unit cur, nxt; int ui = 0;
    if (!S.next(0, cur)) return;
    f32x4 acc[2][2][4][2];
#pragma unroll
    for (int a = 0; a < 2; ++a)
#pragma unroll
        for (int b = 0; b < 2; ++b)
#pragma unroll
            for (int m = 0; m < 4; ++m)
#pragma unroll
                for (int n = 0; n < 2; ++n) acc[a][b][m][n] = (f32x4){0.f, 0.f, 0.f, 0.f};
    bf16x8 At[4][2], B0[2][2], B1[2][2];
    const char* cA = (const char*)g.A + (size_t)cur.pm * tstep; const char* cB = (const char*)g.Bt + (size_t)cur.pn * tstep;
    S.a_ready(cur);
    if constexpr (SP2) {
        PG8_STAGE(PG8_SB(0, 0), cB, voffB); PG8_STAGE(PG8_SB(0, 1), cB + hstep, voffB); PG8_STAGE(PG8_SA(0, 0), cA, voffA); PG8_STAGE(PG8_SA(0, 1), cA + hstep, voffA);
        if (wr == 1) PG8_BAR;
        PG8_WAIT_V(2); PG8_BAR;
        PG8_STAGE(PG8_SB(1, 0), cB + kstep, voffB); PG8_STAGE(PG8_SA(1, 0), cA + kstep, voffA); PG8_STAGE(PG8_SB(1, 1), cB + hstep + kstep, voffB);
        PG8_WAIT_V(6); PG8_BAR;
    } else {
        PG8_STAGE(PG8_SB(0, 0), cB, voffB); PG8_STAGE(PG8_SA(0, 0), cA, voffA); PG8_STAGE(PG8_SB(0, 1), cB + hstep, voffB); PG8_STAGE(PG8_SA(0, 1), cA + hstep, voffA);
        if (wr == 1) PG8_BAR;
        PG8_WAIT_V(4); PG8_BAR;
        PG8_STAGE(PG8_SB(1, 0), cB + kstep, voffB); PG8_STAGE(PG8_SA(1, 0), cA + kstep, voffA); PG8_STAGE(PG8_SB(1, 1), cB + hstep + kstep, voffB);
        PG8_WAIT_V(6); PG8_BAR;
    }
    for (;;) {
        const bool has_next = S.next(ui + 1, nxt);
        const char* nA = has_next ? (const char*)g.A + (size_t)nxt.pm * tstep : cA; const char* nB = has_next ? (const char*)g.Bt + (size_t)nxt.pn * tstep : cB;
        for (int t = 0; t < nt; t += 2) {
            const bool last = (t == nt - 2);
            const char* a1 = cA + (size_t)(t + 1) * kstep;
            const char* a2 = last ? nA : cA + (size_t)(t + 2) * kstep; const char* b2 = last ? nB : cB + (size_t)(t + 2) * kstep;
            const char* a3 = a2 + kstep; const char* b3 = b2 + kstep;
            if (last && has_next) S.a_ready(nxt);
            if constexpr (SP2) {
            PG8_LDB(B0, 0, 0); PG8_LDB(B1, 0, 1); PG8_SCHED; PG8_LDA(At, 0, 0); PG8_STAGE(PG8_SA(1, 1), a1 + hstep, voffA);
            PG8_WAIT_V(8); PG8_WAIT_L(0); PG8_BAR; PG8_MMA(0, 0, At, B0); PG8_MMA(0, 1, At, B1); PG8_BAR; PG8_SCHED;
            PG8_LDA(At, 0, 1); PG8_STAGE(PG8_SB(0, 0), b2, voffB); PG8_STAGE(PG8_SB(0, 1), b2 + hstep, voffB); PG8_STAGE(PG8_SA(0, 0), a2, voffA);
            PG8_WAIT_V(8); PG8_WAIT_L(0); PG8_BAR; PG8_MMA(1, 0, At, B0); PG8_MMA(1, 1, At, B1); PG8_BAR; PG8_SCHED;
            PG8_LDB(B0, 1, 0); PG8_LDB(B1, 1, 1); PG8_SCHED; PG8_LDA(At, 1, 0); PG8_STAGE(PG8_SA(0, 1), a2 + hstep, voffA);
            PG8_WAIT_V(8); PG8_WAIT_L(0); PG8_BAR; PG8_MMA(0, 0, At, B0); PG8_MMA(0, 1, At, B1); PG8_BAR; PG8_SCHED;
            PG8_LDA(At, 1, 1); PG8_STAGE(PG8_SB(1, 0), b3, voffB); PG8_STAGE(PG8_SB(1, 1), b3 + hstep, voffB); PG8_STAGE(PG8_SA(1, 0), a3, voffA);
            PG8_WAIT_V(8); PG8_WAIT_L(0); PG8_BAR; PG8_MMA(1, 0, At, B0); PG8_MMA(1, 1, At, B1); PG8_BAR; PG8_SCHED;
            } else {
            PG8_LDB(B0, 0, 0); PG8_SCHED; PG8_LDA(At, 0, 0); PG8_STAGE(PG8_SA(1, 1), a1 + hstep, voffA);
            PG8_WAIT_L(8); PG8_BAR; PG8_WAIT_L(0); PG8_MMA(0, 0, At, B0); PG8_BAR; PG8_SCHED;
            PG8_LDB(B1, 0, 1); PG8_STAGE(PG8_SB(0, 0), b2, voffB);
            PG8_BAR; PG8_WAIT_L(0); PG8_MMA(0, 1, At, B1); PG8_BAR;
            PG8_LDA(At, 0, 1); PG8_STAGE(PG8_SA(0, 0), a2, voffA);
            PG8_BAR; PG8_WAIT_L(0); PG8_MMA(1, 0, At, B0); PG8_BAR; PG8_SCHED;
            PG8_STAGE(PG8_SB(0, 1), b2 + hstep, voffB);
            PG8_WAIT_V(6); PG8_BAR; PG8_MMA(1, 1, At, B1); PG8_BAR;
            PG8_LDB(B0, 1, 0); PG8_SCHED; PG8_LDA(At, 1, 0); PG8_STAGE(PG8_SA(0, 1), a2 + hstep, voffA);
            PG8_WAIT_L(8); PG8_BAR; PG8_WAIT_L(0); PG8_MMA(0, 0, At, B0); PG8_BAR; PG8_SCHED;
            PG8_LDB(B1, 1, 1); PG8_STAGE(PG8_SB(1, 0), b3, voffB);
            PG8_BAR; PG8_WAIT_L(0); PG8_MMA(0, 1, At, B1); PG8_BAR;
            PG8_LDA(At, 1, 1); PG8_STAGE(PG8_SA(1, 0), a3, voffA);
            PG8_BAR; PG8_WAIT_L(0); PG8_MMA(1, 0, At, B0); PG8_BAR; PG8_SCHED;
            PG8_STAGE(PG8_SB(1, 1), b3 + hstep, voffB);
            PG8_WAIT_V(6); PG8_BAR; PG8_MMA(1, 1, At, B1); PG8_BAR;
            }
        }
        if constexpr (ALIGN_EPI) { if (wr == 0) PG8_BAR; }
        if constexpr (!Epi::AFTER_DRAIN) { E(acc, cur, wr, wc, fr, fq); S.done(cur); }
        if (!has_next) break;
#pragma unroll
        for (int a = 0; a < 2; ++a)
#pragma unroll
            for (int b = 0; b < 2; ++b)
#pragma unroll
                for (int m = 0; m < 4; ++m)
#pragma unroll
                    for (int n = 0; n < 2; ++n) acc[a][b][m][n] = (f32x4){0.f, 0.f, 0.f, 0.f};
        cur = nxt; cA = nA; cB = nB; ++ui;
        if constexpr (ALIGN_EPI) { if (wr == 1) PG8_BAR; }
    }
    PG8_WAIT_V(0);
    if constexpr (!ALIGN_EPI) { if (wr == 0) PG8_BAR; }
    PG8_BAR;
    if constexpr (Epi::AFTER_DRAIN) { E.fused(acc, cur, wr, wc, fr, fq, lds, wid, lane); S.done(cur); }
#undef PG8_SA
#undef PG8_SB
#undef PG8_STAGE
#undef PG8_LDA
#undef PG8_LDB
#undef PG8_MMA
#undef PG8_WAIT_V
#undef PG8_WAIT_L
#undef PG8_BAR
#undef PG8_SCHED
}
}


#define GAS __attribute__((address_space(1)))
#define LAS __attribute__((address_space(3)))
typedef unsigned short bf16;
typedef unsigned v4u __attribute__((ext_vector_type(4)));
typedef unsigned v2u __attribute__((ext_vector_type(2)));
typedef float f32x4 __attribute__((ext_vector_type(4)));
typedef float f32x2 __attribute__((ext_vector_type(2)));
typedef short bf16x8 __attribute__((ext_vector_type(8)));
typedef LAS unsigned char* ldsp;

constexpr int NWAVES = 8, NTHR = 512;
constexpr int D = 2048, SEQ = 2048, NB = 4, MP = 8192, NSMP = 128, MR = 8320, MT = 8448;
constexpr int NMEM = 256, XH = 4, XD = 128, XDIM = 512, MIX = 1536;
constexpr int AH = 12, AHD = 128, A_IN = 6656, LDP = 6656;
constexpr int BH = 24, BHD = 64, B_IN = 5472, B_INP = 5632, B_MIXC = 4960;
constexpr int DFF = 8192;
constexpr int LORA_K = 352;
constexpr int A_XQ_OFF = 6144;
constexpr int B_XQ_OFF = 4608;
constexpr int B_LORA_OFF = 5120;
constexpr float RMS_EPS = 1e-6f, GN_EPS = 64e-5f;

constexpr size_t O_YP = 0, O_YS = 16777216, O_MK = 17039360, O_MV = 19136512, O_SHP = 21233664, O_SRP = 22806528,
                 O_SSP = 23592960, O_SHS = 23609344, O_SRS = 73940992, O_SSS = 99106816, O_END = 99631104;

constexpr size_t al256(size_t x) { return (x + 255) & ~(size_t)255; }
constexpr size_t WS_CTL = 0, CTL_BYTES = 1u << 20;
constexpr size_t SZ_WINA = (size_t)A_IN * D * 2, SZ_WSQ = (size_t)D * D * 2, SZ_WINB = (size_t)B_INP * D * 2, SZ_WFF = (size_t)DFF * D * 2,
                 SZ_WKV = (size_t)1024 * D * 2, SZ_LW = (size_t)MIX * LORA_K * 2;
constexpr size_t WS_WINA = WS_CTL + CTL_BYTES;
constexpr size_t WS_WOUTA = WS_WINA + 2 * SZ_WINA;
constexpr size_t WS_WINB = WS_WOUTA + 2 * SZ_WSQ;
constexpr size_t WS_WOUTB = WS_WINB + 2 * SZ_WINB;
constexpr size_t WS_W1 = WS_WOUTB + 2 * SZ_WSQ;
constexpr size_t WS_W2 = WS_W1 + 4 * SZ_WFF;
constexpr size_t WS_WKV = WS_W2 + 4 * SZ_WFF;
constexpr size_t WS_LW = WS_WKV + 4 * SZ_WKV;
constexpr size_t WS_X = al256(WS_LW + 2 * SZ_LW);
constexpr size_t WS_H = WS_X + (size_t)MT * D * 4;
constexpr size_t WS_PROJ = WS_H + (size_t)MT * D * 2;
constexpr size_t WS_MIXC = WS_PROJ + (size_t)MT * LDP * 2;
constexpr size_t WS_ACT = WS_MIXC + (size_t)MT * D * 2;
constexpr size_t WS_MEMN = WS_ACT + (size_t)MT * DFF * 2;
constexpr size_t SZ_RW = (size_t)MT * MIX * 4;
constexpr size_t WS_RR = WS_MEMN + (size_t)1024 * D * 2;
constexpr size_t WS_RK = WS_RR + SZ_RW, WS_RV = WS_RK + SZ_RW, WS_RKK = WS_RV + SZ_RW, WS_RKA = WS_RKK + SZ_RW, WS_RW = WS_RKA + SZ_RW,
                 WS_RG = WS_RW + SZ_RW, WS_RO = WS_RG + SZ_RW;
constexpr size_t WS_BONUS = WS_RO + SZ_RW;
constexpr size_t WS_REC = al256(WS_BONUS + (size_t)MT * BH * 4);
constexpr size_t REC_BYTES = 7 * 8192;
constexpr size_t WS_END = al256(WS_REC + (size_t)NB * BH * 32 * REC_BYTES);

constexpr int CW_BAR = 4096;
constexpr int CW_CQ = 3072;
constexpr int CW_PDONE = 2560;
#ifndef HG_SPLIT
#define HG_SPLIT 16
#endif
constexpr int CW_SFLAG = 2048;
constexpr size_t CTL_SS = 65536;
typedef unsigned long long u64;
constexpr float SS_FIX = 1048576.f, SS_UNFIX = 1.f / 1048576.f;
__device__ __forceinline__ u64* ss_slot(unsigned char* ws, int s) { return (u64*)(ws + WS_CTL + CTL_SS) + (size_t)s * MT; }

constexpr int RING_BYTES = 159744, LDSCTL_OFF = RING_BYTES, MISC_OFF = LDSCTL_OFF + 320, LDS_BYTES = RING_BYTES + 1024;

#define LDS_WAIT() asm volatile("s_waitcnt lgkmcnt(0)" ::: "memory")
#define LDS_BARRIER() do { asm volatile("s_waitcnt lgkmcnt(0)" ::: "memory"); __builtin_amdgcn_s_barrier(); asm volatile("" ::: "memory"); } while (0)
#define VM_WAIT() asm volatile("s_waitcnt vmcnt(0)" ::: "memory")
typedef __bf16 bf16x2_t __attribute__((ext_vector_type(2)));
__device__ __forceinline__ unsigned pk2_hw(float lo, float hi) { f32x2 v = {lo, hi}; const bf16x2_t b = __builtin_convertvector(v, bf16x2_t); return __builtin_bit_cast(unsigned, b); }
__device__ __forceinline__ unsigned f2bf(float f) { return (__builtin_bit_cast(unsigned, f) + 0x8000u) >> 16; }
__device__ __forceinline__ unsigned pk2(float lo, float hi) { return __builtin_amdgcn_perm(__builtin_bit_cast(unsigned, hi) + 0x8000u, __builtin_bit_cast(unsigned, lo) + 0x8000u, 0x07060302u); }
__device__ __forceinline__ float bf2f(unsigned short b) { return __builtin_bit_cast(float, ((unsigned)b) << 16); }
__device__ __forceinline__ float bflo(unsigned w) { return __builtin_bit_cast(float, w << 16); }
__device__ __forceinline__ float bfhi(unsigned w) { return __builtin_bit_cast(float, w & 0xffff0000u); }
__device__ __forceinline__ f32x4 bf4(v2u w) { return (f32x4){bflo(w.x), bfhi(w.x), bflo(w.y), bfhi(w.y)}; }
__device__ __forceinline__ v2u pk4(f32x4 v) { v2u r; r.x = pk2(v.x, v.y); r.y = pk2(v.z, v.w); return r; }
__device__ __forceinline__ float wave_sum(float v) {
#pragma unroll
    for (int o = 1; o < 64; o <<= 1) v += __shfl_xor(v, o);
    return v;
}
__device__ __forceinline__ float wave_max(float v) {
#pragma unroll
    for (int o = 1; o < 64; o <<= 1) v = fmaxf(v, __shfl_xor(v, o));
    return v;
}
__device__ __forceinline__ float fsigmoid(float x) { return __builtin_amdgcn_rcpf(1.f + __expf(-x)); }
__device__ __forceinline__ int sw128(int r, int c) { return r * 256 + ((c ^ (r & 15)) << 4); }
__device__ __forceinline__ int sw64(int r, int c) { return r * 128 + ((c ^ ((r >> 1) & 7)) << 4); }
__device__ __forceinline__ int sw256(int r, int c) { return r * 512 + ((c ^ (r & 15)) << 4); }
#define MFMA16(a, b, c) __builtin_amdgcn_mfma_f32_16x16x32_bf16((a), (b), (c), 0, 0, 0)

#define XB_TMO      128
#define XB_XCNT(j)  (256  + 64 * (j))
#define XB_XSUB(j)  (1280 + 64 * (j))
#define XB_XGEN(j)  (2304 + 64 * (j))
#define XB_TOP      3328
#define XB_TOPGEN   3392
#define XCD_BAR_WORDS 3456
#define XB_SPIN_CAP (1u << 18)
__device__ __forceinline__ unsigned xb_ld(unsigned* p)              { return __hip_atomic_load(p, __ATOMIC_RELAXED, __HIP_MEMORY_SCOPE_AGENT); }
__device__ __forceinline__ unsigned xb_add(unsigned* p, unsigned v) { return __hip_atomic_fetch_add(p, v, __ATOMIC_RELAXED, __HIP_MEMORY_SCOPE_AGENT); }
__device__ __forceinline__ unsigned xb_xcc_id() { return (unsigned)__builtin_amdgcn_s_getreg((3 << 11) | 20) & 0xFu; }
#define XB_SPIN(cond, bar) do { unsigned _sp = 0; while (cond) { __builtin_amdgcn_s_sleep(1); \
    if ((++_sp & 255u) == 0u) { if (xb_ld(&(bar)[XB_TMO])) break; if (_sp > XB_SPIN_CAP) { atomicAdd(&(bar)[XB_TMO], 1u); break; } } } } while (0)
struct XcdBarrier { unsigned* bar; unsigned x; volatile LAS unsigned* st; };
__device__ __forceinline__ XcdBarrier xcd_barrier_post(unsigned* bar, volatile LAS unsigned* st) {
    XcdBarrier b; b.bar = bar; b.x = xb_xcc_id(); b.st = st;
    if (threadIdx.x == 0) (void)xb_add(&bar[XB_XCNT(b.x)], 1u);
    return b;
}
__device__ __forceinline__ void xcd_barrier_complete(unsigned* bar, unsigned x, unsigned& nloc, unsigned& nx) {
    const unsigned G = gridDim.x * gridDim.y * gridDim.z;
    unsigned sum, cnt, mine, sp = 0u;
    for (;;) {
        sum = 0u; cnt = 0u; mine = 0u;
#pragma unroll
        for (unsigned j = 0; j < 16; ++j) { const unsigned c = xb_ld(&bar[XB_XCNT(j)]); sum += c; cnt += (c > 0u) ? 1u : 0u; mine = (j == x) ? c : mine; }
        if (sum == G) break;
        __builtin_amdgcn_s_sleep(1);
        if ((++sp & 255u) == 0u) { if (xb_ld(&bar[XB_TMO])) break; if (sp > XB_SPIN_CAP) { atomicAdd(&bar[XB_TMO], 1u); break; } }
    }
    nloc = mine > 0u ? mine : 1u; nx = cnt > 0u ? cnt : 1u;
}
__device__ __forceinline__ void xcd_barrier(const XcdBarrier& b) {
    asm volatile("s_waitcnt vmcnt(0)" ::: "memory");
    __syncthreads();
    if (threadIdx.x == 0) {
        unsigned* bar = b.bar;
        __builtin_amdgcn_s_waitcnt(0);
        unsigned nloc = b.st[0], nx = b.st[1];
        if (nloc == 0u) { xcd_barrier_complete(bar, b.x, nloc, nx); b.st[0] = nloc; b.st[1] = nx; }
        const unsigned old = xb_add(&bar[XB_XSUB(b.x)], 1u);
        const unsigned gen = old / nloc;
        if (old + 1u == (gen + 1u) * nloc) {
            __builtin_amdgcn_fence(__ATOMIC_RELEASE, "agent");
            asm volatile("s_waitcnt vmcnt(0)" ::: "memory");
            const unsigned og = xb_add(&bar[XB_TOP], 1u);
            const unsigned tg = og / nx;
            if (og + 1u == (tg + 1u) * nx) xb_add(&bar[XB_TOPGEN], 1u);
            else XB_SPIN(xb_ld(&bar[XB_TOPGEN]) == tg, bar);
            __builtin_amdgcn_fence(__ATOMIC_ACQUIRE, "agent");
            xb_add(&bar[XB_XGEN(b.x)], 1u);
            asm volatile("s_waitcnt vmcnt(0)" ::: "memory");
        } else {
            XB_SPIN(xb_ld(&bar[XB_XGEN(b.x)]) == gen, bar);
            __builtin_amdgcn_fence(__ATOMIC_ACQUIRE, "agent");
            asm volatile("s_waitcnt vmcnt(0)" ::: "memory");
        }
    }
    __syncthreads();
}

__device__ __forceinline__ float atomic_add_agent(float* p, float v) { return __hip_atomic_fetch_add(p, v, __ATOMIC_RELAXED, __HIP_MEMORY_SCOPE_AGENT); }
template <int ACT> struct EpiBf {
    static constexpr bool PERM = true, AFTER_DRAIN = false;
    bf16* O; int ldc; const u64* ss;
    __device__ __forceinline__ void operator()(const pg8::f32x4 (&acc)[2][2][4][2], const pg8::Unit& u, int wr, int wc, int fr, int fq) const {
        const int row0 = u.pm * 256 + wr * 64 + fr, col0 = u.pn * 256 + wc * 32 + 8 * fq;
#pragma unroll
        for (int ai = 0; ai < 2; ++ai)
#pragma unroll
            for (int m = 0; m < 4; ++m) { const int row = row0 + ai * 128 + m * 16; bf16* rowp = O + (size_t)row * ldc + col0;
                const float rs = (ACT == 2) ? 1.f : __builtin_amdgcn_rsqf((float)ss[row] * (SS_UNFIX / D) + RMS_EPS);
#pragma unroll
                for (int bj = 0; bj < 2; ++bj) { pg8::f32x4 v0 = acc[ai][bj][m][0] * rs, v1 = acc[ai][bj][m][1] * rs;
                    if (ACT >= 1) {
#pragma unroll
                        for (int q = 0; q < 4; ++q) { const float a = fmaxf(v0[q], 0.f), b = fmaxf(v1[q], 0.f); v0[q] = a * a; v1[q] = b * b; } }
                    pg8::u32x4 w; w.x = pg8::cvt_pk_bf16(v0[0], v0[1]); w.y = pg8::cvt_pk_bf16(v0[2], v0[3]); w.z = pg8::cvt_pk_bf16(v1[0], v1[1]); w.w = pg8::cvt_pk_bf16(v1[2], v1[3]);
                    *(pg8::u32x4*)(rowp + bj * 128) = w; }
                __builtin_amdgcn_sched_barrier(0); }
    }
};
template <bool SCL> struct EpiResid {
    static constexpr bool PERM = false, AFTER_DRAIN = false;
    float* X; int ldc; bf16* Hb; u64* ssq; const u64* scl;
    __device__ __forceinline__ void operator()(const pg8::f32x4 (&acc)[2][2][4][2], const pg8::Unit& u, int wr, int wc, int fr, int fq) const {
        const int row0 = u.pm * 256 + wr * 64 + fr, col0 = u.pn * 256 + wc * 32 + 4 * fq; u64 rets[8];
#pragma unroll
        for (int ai = 0; ai < 2; ++ai) {
            pg8::f32x4 xin[4][4]; float r2v[4];
#pragma unroll
            for (int m = 0; m < 4; ++m) { const int row = row0 + ai * 128 + m * 16; const float* rowp = X + (size_t)row * ldc + col0;
                r2v[m] = SCL ? (float)scl[row] : 0.f;
#pragma unroll
                for (int q = 0; q < 4; ++q) xin[m][q] = *(const pg8::f32x4*)(rowp + (q >> 1) * 128 + (q & 1) * 16); }
            __builtin_amdgcn_sched_barrier(0);
#pragma unroll
            for (int m = 0; m < 4; ++m) { const int row = row0 + ai * 128 + m * 16; float* rowp = X + (size_t)row * ldc + col0; bf16* hp = Hb + (size_t)row * ldc + col0;
                const float r2 = SCL ? __builtin_amdgcn_rcpf(r2v[m] * (SS_UNFIX / D) + RMS_EPS) : 1.f;
                float s = 0.f;
#pragma unroll
                for (int bj = 0; bj < 2; ++bj)
#pragma unroll
                    for (int n = 0; n < 2; ++n) { const pg8::f32x4 x = xin[m][bj * 2 + n] + acc[ai][bj][m][n] * r2; *(pg8::f32x4*)(rowp + bj * 128 + n * 16) = x;
                        v2u hw; hw.x = pg8::cvt_pk_bf16(x[0], x[1]); hw.y = pg8::cvt_pk_bf16(x[2], x[3]); *(v2u*)(hp + bj * 128 + n * 16) = hw;
                        s += (x[0] * x[0] + x[1] * x[1]) + (x[2] * x[2] + x[3] * x[3]); }
                s += __shfl_xor(s, 16); s += __shfl_xor(s, 32);
                rets[ai * 4 + m] = 0;
                if (fq == 0) rets[ai * 4 + m] = __hip_atomic_fetch_add(ssq + row, (u64)(s * SS_FIX + 0.5f), __ATOMIC_RELAXED, __HIP_MEMORY_SCOPE_AGENT); }
            __builtin_amdgcn_sched_barrier(0); }
#pragma unroll
        for (int g = 0; g < 8; ++g) asm volatile("" :: "v"(rets[g]));
    }
};
struct EpiMemKV {
    static constexpr bool PERM = false, AFTER_DRAIN = false;
    float* out;
    __device__ __forceinline__ void operator()(const pg8::f32x4 (&acc)[2][2][4][2], const pg8::Unit& u, int wr, int wc, int fr, int fq) const {
        const int layer = u.pn >> 2, kv = (u.pn >> 1) & 1, c0 = (u.pn & 1) * 256 + wc * 32 + 4 * fq;
        float* base = out + (kv ? O_MV : O_MK) + (size_t)layer * (1024 * 512);
        const int row0 = u.pm * 256 + wr * 64 + fr;
#pragma unroll
        for (int ai = 0; ai < 2; ++ai)
#pragma unroll
            for (int m = 0; m < 4; ++m) { float* rowp = base + (size_t)(row0 + ai * 128 + m * 16) * 512 + c0;
#pragma unroll
                for (int bj = 0; bj < 2; ++bj)
#pragma unroll
                    for (int n = 0; n < 2; ++n) *(pg8::f32x4*)(rowp + bj * 128 + n * 16) = acc[ai][bj][m][n]; }
    }
};
struct EpiDummy {
    static constexpr bool PERM = false, AFTER_DRAIN = false;
    float* C; int ldc;
    __device__ __forceinline__ void operator()(const pg8::f32x4 (&acc)[2][2][4][2], const pg8::Unit& u, int wr, int wc, int fr, int fq) const {
        const int row0 = u.pm * 256 + wr * 64 + fr, col0 = u.pn * 256 + wc * 32 + 4 * fq;
#pragma unroll
        for (int ai = 0; ai < 2; ++ai)
#pragma unroll
            for (int m = 0; m < 4; ++m) { float* rowp = C + (size_t)(row0 + ai * 128 + m * 16) * ldc + col0;
#pragma unroll
                for (int bj = 0; bj < 2; ++bj)
#pragma unroll
                    for (int n = 0; n < 2; ++n) *(pg8::f32x4*)(rowp + bj * 128 + n * 16) = acc[ai][bj][m][n]; }
    }
};
struct RotOrder : pg8::StaticOrder {};

struct Job { const float* src; bf16* dst; const float* gain; int ldw, K, ncols, ldt, koff, row_off, item0, pad; };
constexpr int NJOBS = 34;
struct Args { const float* in[33]; float* out; unsigned char* ws; Job jobs[NJOBS]; int git[6]; int njobs, nitems, ph_lo, ph_hi, pad2[2]; };

__device__ __forceinline__ int fresh_tid() { int t = threadIdx.x; asm volatile("" : "+v"(t)); return t; }
struct Frame {
    ldsp lds;
    int tid, lane, wave, G, vcu;
    unsigned char* ws; float* out;
};


__device__ __forceinline__ void norm_row(const float* src, const float* g, int lane, bf16* hdst, float* fdst, float* xcopy, float* f2) {
    const f32x4* xr = (const f32x4*)src + lane; const f32x4* gr = (const f32x4*)g + lane;
    f32x4 v[8]; float s = 0.f;
#pragma unroll
    for (int j = 0; j < 8; ++j) { v[j] = xr[64 * j]; s += (v[j].x * v[j].x + v[j].y * v[j].y) + (v[j].z * v[j].z + v[j].w * v[j].w); }
    s = wave_sum(s);
    const float rstd = 1.f / sqrtf(s * (1.f / D) + RMS_EPS);
    if (xcopy) {
#pragma unroll
        for (int j = 0; j < 8; ++j) ((f32x4*)xcopy + lane)[64 * j] = v[j]; }
#pragma unroll
    for (int j = 0; j < 8; ++j) { const f32x4 y = v[j] * rstd * gr[64 * j];
        if (hdst) ((v2u*)hdst + lane)[64 * j] = pk4(y);
        if (fdst) ((f32x4*)fdst + lane)[64 * j] = y;
        if (f2) ((f32x4*)f2 + lane)[64 * j] = y; }
}

__device__ __forceinline__ void norm_phase(Frame& F0, const Args& A, const float* g, bool first, bool final, int shift_j) {
    Frame F = F0; F.tid = fresh_tid(); F.lane = F.tid & 63; F.wave = __builtin_amdgcn_readfirstlane(F.tid >> 6);
    const int gw = F.vcu * NWAVES + F.wave, NGW = F.G * NWAVES;
    float* X = (float*)(F.ws + WS_X); bf16* H = (bf16*)(F.ws + WS_H);
    for (int row = gw; row < MR; row += NGW) {
        const float* src = first ? (row < MP ? A.in[0] + (size_t)row * D : A.in[1] + (size_t)(row - MP) * D) : X + (size_t)row * D;
        float* f2 = nullptr;
        if (shift_j >= 0) {
            if (row < MP) { if ((row & (SEQ - 1)) == SEQ - 1) f2 = F.out + O_SSP + (size_t)(shift_j * NB + (row >> 11)) * D; }
            else f2 = F.out + O_SSS + (size_t)(shift_j * NSMP + (row - MP)) * D;
        }
        norm_row(src, g, F.lane, final ? nullptr : H + (size_t)row * D, final ? F.out + O_YP + (size_t)row * D : nullptr, first ? X + (size_t)row * D : nullptr, f2);
    }
    if (shift_j >= 0) {
        const float* sh = A.in[6] + (size_t)shift_j * NSMP * D;
        for (int r = gw; r < NSMP; r += NGW) { const f32x4* xr = (const f32x4*)(sh + (size_t)r * D) + F.lane; v2u* o = (v2u*)(H + (size_t)(MR + r) * D) + F.lane;
#pragma unroll
            for (int j = 0; j < 8; ++j) o[64 * j] = pk4(xr[64 * j]); }
    }
}

struct CvtMeta { int j, k0, n0, hg; };
__device__ __forceinline__ CvtMeta cvt_load(const Args& A, int it, int lane, f32x4 (&v0)[8], f32x4 (&v1)[8], float (&g0)[8], float (&g1)[8]) {
    int j = 0;
    for (int q = 1; q < A.njobs; ++q) if (it >= A.jobs[q].item0) j = q;
    const Job& J = A.jobs[j]; const int item = it - J.item0;
    const int nblk = (J.ncols + 63) / 64, kb = item / nblk, nb = item - kb * nblk, k0 = 64 * kb, n0 = 64 * nb;
    const int n4 = 4 * (lane & 15), kp = lane >> 4; const float* gp = J.gain ? J.gain : J.src;
    const int nc = min(n0 + n4, J.ncols - 4);
#pragma unroll
    for (int i = 0; i < 8; ++i) { const int k = min(k0 + 8 * i + 2 * kp, J.K - 2);
        v0[i] = *(const f32x4*)(J.src + (size_t)k * J.ldw + nc);
        v1[i] = *(const f32x4*)(J.src + (size_t)(k + 1) * J.ldw + nc);
        g0[i] = gp[k]; g1[i] = gp[k + 1]; }
    return CvtMeta{j, k0, n0, J.gain != nullptr ? 1 : 0};
}
__device__ __forceinline__ void convert_items(Frame& F, const Args& A, int it_lo, int it_hi, int wk, int nworkers) {
    const int tid = fresh_tid(), lane = tid & 63, w = __builtin_amdgcn_readfirstlane(tid >> 6);
    LAS unsigned* scr = (LAS unsigned*)(F.lds + w * 8448);
    const int n4 = 4 * (lane & 15), kp = lane >> 4, c = lane & 7;
    f32x4 v0[8], v1[8]; float g0[8], g1[8]; CvtMeta m{0, 0, 0, 0};
    int it = it_lo + wk;
    if (it < it_hi) m = cvt_load(A, it, lane, v0, v1, g0, g1);
    while (it < it_hi) {
#pragma unroll
        for (int i = 0; i < 8; ++i) { LAS unsigned* s = scr + n4 * 33 + 4 * i + kp; const f32x4 x0 = v0[i] * (m.hg ? g0[i] : 1.f), x1 = v1[i] * (m.hg ? g1[i] : 1.f);
            s[0] = pk2(x0.x, x1.x); s[33] = pk2(x0.y, x1.y); s[66] = pk2(x0.z, x1.z); s[99] = pk2(x0.w, x1.w); }
        const CvtMeta cur = m; const int nxt = it + nworkers;
        if (nxt < it_hi) m = cvt_load(A, nxt, lane, v0, v1, g0, g1);
        LDS_WAIT(); asm volatile("" ::: "memory");
        const Job& J = A.jobs[cur.j];
        if (cur.k0 + 8 * c < J.K) {
#pragma unroll
            for (int jn = 0; jn < 8; ++jn) { const int n = jn * 8 + (lane >> 3); const LAS unsigned* s = scr + n * 33 + 4 * c;
                v4u o; o.x = s[0]; o.y = s[1]; o.z = s[2]; o.w = s[3];
                if (cur.n0 + n < J.ncols) *(v4u*)(J.dst + (size_t)(J.row_off + cur.n0 + n) * J.ldt + J.koff + cur.k0 + 8 * c) = o; } }
        LDS_WAIT(); asm volatile("" ::: "memory");
        it = nxt;
    }
}
__device__ __forceinline__ void cvt_store(const Args& A, const CvtMeta cur, LAS unsigned* scr, int lane, int c) {
    const Job& J = A.jobs[cur.j];
    if (cur.k0 + 8 * c < J.K) {
#pragma unroll
        for (int jn = 0; jn < 8; ++jn) { const int n = jn * 8 + (lane >> 3); const LAS unsigned* s = scr + n * 33 + 4 * c;
            v4u o; o.x = s[0]; o.y = s[1]; o.z = s[2]; o.w = s[3];
            if (cur.n0 + n < J.ncols) *(v4u*)(J.dst + (size_t)(J.row_off + cur.n0 + n) * J.ldt + J.koff + cur.k0 + 8 * c) = o; } }
}
__device__ __forceinline__ void convert_items_dyn(Frame& F, const Args& A, int it_lo, int it_hi, unsigned* ctr, int q) {
    const int tid = fresh_tid(), lane = tid & 63, w = __builtin_amdgcn_readfirstlane(tid >> 6);
    LAS unsigned* scr = (LAS unsigned*)(F.lds + w * 8448);
    const int n4 = 4 * (lane & 15), kp = lane >> 4, c = lane & 7;
    f32x4 v0[8], v1[8]; float g0[8], g1[8]; CvtMeta m{0, 0, 0, 0};
    unsigned av = 0u;
    if (lane == 0) av = __hip_atomic_fetch_add(ctr, 2u, __ATOMIC_RELAXED, __HIP_MEMORY_SCOPE_AGENT);
    const int first = (int)__builtin_amdgcn_readfirstlane(av);
    int it = it_lo + 2 * (8 * first + q), tnext = first + 1;
    if (lane == 0) av = __hip_atomic_fetch_add(ctr, 1u, __ATOMIC_RELAXED, __HIP_MEMORY_SCOPE_AGENT);
    if (it < it_hi) m = cvt_load(A, it, lane, v0, v1, g0, g1);
    while (it < it_hi) {
#pragma unroll
        for (int i = 0; i < 8; ++i) { LAS unsigned* s = scr + n4 * 33 + 4 * i + kp; const f32x4 x0 = v0[i] * (m.hg ? g0[i] : 1.f), x1 = v1[i] * (m.hg ? g1[i] : 1.f);
            s[0] = pk2(x0.x, x1.x); s[33] = pk2(x0.y, x1.y); s[66] = pk2(x0.z, x1.z); s[99] = pk2(x0.w, x1.w); }
        const CvtMeta cur = m;
        int nxt;
        if (((it - it_lo) & 1) == 0) nxt = it + 1;
        else { nxt = it_lo + 2 * (8 * tnext + q);
            tnext = (int)__builtin_amdgcn_readfirstlane(av);
            if (lane == 0) av = __hip_atomic_fetch_add(ctr, 1u, __ATOMIC_RELAXED, __HIP_MEMORY_SCOPE_AGENT); }
        if (nxt < it_hi) m = cvt_load(A, nxt, lane, v0, v1, g0, g1);
        LDS_WAIT(); asm volatile("" ::: "memory");
        cvt_store(A, cur, scr, lane, c);
        LDS_WAIT(); asm volatile("" ::: "memory");
        it = nxt;
    }
}
__device__ __forceinline__ void p0_prologue(Frame& F0, const Args& A) {
    Frame F = F0; F.tid = fresh_tid(); F.lane = F.tid & 63; F.wave = __builtin_amdgcn_readfirstlane(F.tid >> 6);
    const int gw = F.vcu * NWAVES + F.wave, NGW = F.G * NWAVES;
    convert_items(F, A, 0, A.git[1], gw, NGW);
    for (int jj = 0; jj < 2; ++jj) { v4u* z = (v4u*)(F.ws + WS_WINB + jj * SZ_WINB + (size_t)B_IN * D * 2); const int n16 = (B_INP - B_IN) * D * 2 / 16;
        for (int i = gw * 64 + F.lane; i < n16; i += NGW * 64) z[i] = (v4u){0u, 0u, 0u, 0u}; }
    bf16* MEMN = (bf16*)(F.ws + WS_MEMN);
    for (int row = gw; row < NB * NMEM; row += NGW) norm_row(A.in[7] + (size_t)row * D, A.in[11], F.lane, MEMN + (size_t)row * D, nullptr, nullptr, nullptr);
    { float* X = (float*)(F.ws + WS_X); bf16* H = (bf16*)(F.ws + WS_H); u64* ss0 = ss_slot(F.ws, 0);
      for (int row = gw; row < MR; row += NGW) {
          const float* src = row < MP ? A.in[0] + (size_t)row * D : A.in[1] + (size_t)(row - MP) * D;
          const f32x4* xr = (const f32x4*)src + F.lane; float s = 0.f;
#pragma unroll
          for (int jj = 0; jj < 8; ++jj) { const f32x4 v = xr[64 * jj]; s += (v.x * v.x + v.y * v.y) + (v.z * v.z + v.w * v.w);
              ((f32x4*)(X + (size_t)row * D) + F.lane)[64 * jj] = v; ((v2u*)(H + (size_t)row * D) + F.lane)[64 * jj] = pk4(v); }
          s = wave_sum(s); if (F.lane == 0) ss0[row] = (u64)(s * SS_FIX + 0.5f); } }
}

#ifndef GEMM_ALIGN
#define GEMM_ALIGN true
#endif
#ifndef GEMM_SP2
#define GEMM_SP2 true
#endif
template <class Epi> __device__ __forceinline__ void run_gemm(Frame& F, const bf16* Am, const bf16* Bt, int M, int N, int K, const Epi& E, int rot) {
    pg8::Gemm g{Am, Bt, M, N, K}; pg8::StaticOrder S; S.init(M, N, F.G, (int)((blockIdx.x + rot) % F.G));
    pg8::gemm_phase<Epi, pg8::StaticOrder, GEMM_ALIGN, GEMM_SP2>(F.lds, g, S, E);
}

constexpr int SK_RED = 0, SK_SSQ = 131072;
template <int AMODE, int EMODE> __device__ __forceinline__ void skinny_gemm(Frame& F, const void* Aptr, int lda, const float* gain, const bf16* Bt, int ldb, int n0, int rh, int k0, int klen, void* outp, int ldc, int orow0) {
    const ldsp L = F.lds; const int tid = fresh_tid(), w = __builtin_amdgcn_readfirstlane(tid >> 6), lane = tid & 63, fr = lane & 15, q4 = lane >> 4;
    const int kw = klen >> 3, kb = k0 + w * kw, nks = kw >> 5;
    f32x4 acc[4][4]; float ssq[4];
#pragma unroll
    for (int rt = 0; rt < 4; ++rt) { ssq[rt] = 0.f;
#pragma unroll
        for (int ct = 0; ct < 4; ++ct) acc[rt][ct] = (f32x4){0.f, 0.f, 0.f, 0.f}; }
    const bf16* bp = Bt + (size_t)(n0 + fr) * ldb + kb + q4 * 8;
    __syncthreads();
#pragma unroll 2
    for (int ks = 0; ks < nks; ++ks) {
        bf16x8 bq[4];
#pragma unroll
        for (int ct = 0; ct < 4; ++ct) bq[ct] = *(const bf16x8*)(bp + (size_t)ct * 16 * ldb + ks * 32);
        bf16x8 a[4];
        if (AMODE == 0) { const bf16* ap = (const bf16*)Aptr + (size_t)(rh * 64 + fr) * lda + kb + q4 * 8 + ks * 32;
#pragma unroll
            for (int rt = 0; rt < 4; ++rt) a[rt] = *(const bf16x8*)(ap + (size_t)rt * 16 * lda); }
        else { const float* ap = (const float*)Aptr + (size_t)(rh * 64 + fr) * lda + kb + q4 * 8 + ks * 32;
            f32x4 g0 = (f32x4){1.f, 1.f, 1.f, 1.f}, g1 = g0;
            if (AMODE == 2) { const f32x4 t0 = *(const f32x4*)(gain + kb + q4 * 8 + ks * 32), t1 = *(const f32x4*)(gain + kb + q4 * 8 + ks * 32 + 4);
                g0 = (f32x4){__builtin_amdgcn_rcpf(t0.x), __builtin_amdgcn_rcpf(t0.y), __builtin_amdgcn_rcpf(t0.z), __builtin_amdgcn_rcpf(t0.w)};
                g1 = (f32x4){__builtin_amdgcn_rcpf(t1.x), __builtin_amdgcn_rcpf(t1.y), __builtin_amdgcn_rcpf(t1.z), __builtin_amdgcn_rcpf(t1.w)}; }
            f32x4 x0[4], x1[4];
#pragma unroll
            for (int rt = 0; rt < 4; ++rt) { x0[rt] = *(const f32x4*)(ap + (size_t)rt * 16 * lda); x1[rt] = *(const f32x4*)(ap + (size_t)rt * 16 * lda + 4); }
#pragma unroll
            for (int rt = 0; rt < 4; ++rt) { f32x4 y0 = x0[rt], y1 = x1[rt];
                if (AMODE == 2) { y0 = y0 * g0; y1 = y1 * g1; }
                if (AMODE == 1) ssq[rt] += (y0.x * y0.x + y0.y * y0.y) + (y0.z * y0.z + y0.w * y0.w) + (y1.x * y1.x + y1.y * y1.y) + (y1.z * y1.z + y1.w * y1.w);
                v4u aw; aw.x = pk2(y0.x, y0.y); aw.y = pk2(y0.z, y0.w); aw.z = pk2(y1.x, y1.y); aw.w = pk2(y1.z, y1.w);
                a[rt] = __builtin_bit_cast(bf16x8, aw); } }
#pragma unroll
        for (int rt = 0; rt < 4; ++rt)
#pragma unroll
            for (int ct = 0; ct < 4; ++ct) acc[rt][ct] = MFMA16(bq[ct], a[rt], acc[rt][ct]);
    }
#pragma unroll
    for (int rt = 0; rt < 4; ++rt)
#pragma unroll
        for (int ct = 0; ct < 4; ++ct) *(LAS f32x4*)(L + SK_RED + ((w * 16 + rt * 4 + ct) * 64 + lane) * 16) = acc[rt][ct];
    if (AMODE == 1) {
#pragma unroll
        for (int rt = 0; rt < 4; ++rt) { float s = ssq[rt]; s += __shfl_xor(s, 16); s += __shfl_xor(s, 32); if (q4 == 0) ((LAS float*)(L + SK_SSQ))[(w * 4 + rt) * 16 + fr] = s; } }
    __syncthreads();
    const int rto = w >> 1, cto = 2 * (w & 1);
    f32x4 r0 = (f32x4){0.f, 0.f, 0.f, 0.f}, r1 = r0; float st = 0.f;
#pragma unroll
    for (int sw = 0; sw < 8; ++sw) { r0 = r0 + *(LAS f32x4*)(L + SK_RED + ((sw * 16 + rto * 4 + cto) * 64 + lane) * 16); r1 = r1 + *(LAS f32x4*)(L + SK_RED + ((sw * 16 + rto * 4 + cto + 1) * 64 + lane) * 16);
        if (AMODE == 1) st += ((LAS float*)(L + SK_SSQ))[(sw * 4 + rto) * 16 + fr]; }
    if (AMODE == 1) { const float rs = __builtin_amdgcn_rsqf(st * (1.f / D) + RMS_EPS); r0 = r0 * rs; r1 = r1 * rs; }
    const int m = orow0 + rh * 64 + 16 * rto + fr, c0 = n0 + cto * 16 + q4 * 4;
    if (EMODE == 2) { float* o = (float*)outp + (size_t)m * ldc + c0; float ret = 0.f;
#pragma unroll
        for (int r = 0; r < 4; ++r) { ret += atomic_add_agent(o + r, r0[r]); ret += atomic_add_agent(o + 16 + r, r1[r]); }
        asm volatile("" :: "v"(ret)); }
    else { if (EMODE == 1) {
#pragma unroll
            for (int r = 0; r < 4; ++r) { const float x0 = fmaxf(r0[r], 0.f), x1 = fmaxf(r1[r], 0.f); r0[r] = x0 * x0; r1[r] = x1 * x1; } }
        bf16* o = (bf16*)outp + (size_t)m * ldc + c0; *(v2u*)o = pk4(r0); *(v2u*)(o + 16) = pk4(r1); }
    __syncthreads();
}

constexpr int SN_BLOCKS = 16;
__device__ __forceinline__ void sample_rows_prepare(Frame& F, const float* shift, const float* gain, u64* ssq, unsigned* flag, int wv) {
    const int tid = fresh_tid(), lane = tid & 63;
    const float* X = (const float*)(F.ws + WS_X); bf16* H = (bf16*)(F.ws + WS_H);
    { const int row = MP + wv; const f32x4* xr = (const f32x4*)(X + (size_t)row * D) + lane; float s = 0.f;
#pragma unroll
      for (int jj = 0; jj < 8; ++jj) { const f32x4 v = xr[64 * jj]; s += (v.x * v.x + v.y * v.y) + (v.z * v.z + v.w * v.w); ((v2u*)(H + (size_t)row * D) + lane)[64 * jj] = pk4(v); }
      s = wave_sum(s); if (lane == 0) ssq[row] = (u64)(s * SS_FIX + 0.5f); }
    if (shift) { const int row = MR + wv; const f32x4* xr = (const f32x4*)(shift + (size_t)wv * D) + lane; const f32x4* gr = (const f32x4*)gain + lane;
#pragma unroll
        for (int jj = 0; jj < 8; ++jj) { const f32x4 v = xr[64 * jj], g = gr[64 * jj];
            ((v2u*)(H + (size_t)row * D) + lane)[64 * jj] = pk4((f32x4){v.x * __builtin_amdgcn_rcpf(g.x), v.y * __builtin_amdgcn_rcpf(g.y), v.z * __builtin_amdgcn_rcpf(g.z), v.w * __builtin_amdgcn_rcpf(g.w)}); }
        if (lane == 0) { u64 one = (u64)((double)D * (1.0 - (double)RMS_EPS) * (double)SS_FIX + 0.5); asm volatile("" : "+s"(one)); ssq[row] = one; } }
    asm volatile("s_waitcnt vmcnt(0)" ::: "memory");
    __syncthreads();
    if (tid == 0) { __builtin_amdgcn_fence(__ATOMIC_RELEASE, "agent"); asm volatile("s_waitcnt vmcnt(0)" ::: "memory");
        (void)__hip_atomic_fetch_add(flag, 1u, __ATOMIC_RELAXED, __HIP_MEMORY_SCOPE_AGENT); }
}
struct SampleOrder : pg8::StaticOrder {
    const unsigned* flag;
    __device__ __forceinline__ void a_ready(const pg8::Unit& u) const {
        if (u.pm == MP / 256) {
            if (__builtin_amdgcn_readfirstlane(threadIdx.x >> 6) == 0) {
                int polls = 0;
                while ((unsigned)__builtin_amdgcn_readfirstlane(__hip_atomic_load(flag, __ATOMIC_RELAXED, __HIP_MEMORY_SCOPE_AGENT)) < (unsigned)SN_BLOCKS) { polls = __builtin_amdgcn_readfirstlane(polls + 1); if (polls > (1 << 18)) break; __builtin_amdgcn_s_sleep(2); }
                __builtin_amdgcn_fence(__ATOMIC_ACQUIRE, "agent");
                asm volatile("s_waitcnt vmcnt(0)" ::: "memory"); }
            asm volatile("" ::: "memory"); __builtin_amdgcn_s_barrier(); asm volatile("" ::: "memory");
        }
    }
};
struct SampleOrderEarly : SampleOrder {
    unsigned* donectr;
    __device__ bool next(int i, pg8::Unit& u) const {
        long Lq = (long)i * G + c; if (Lq >= nwg) return false;
        if (Lq >= 214 && Lq < 214 + nN) { u.pm = nM - 1; u.pn = (int)Lq - 214; return true; }
        if (Lq >= 551 && ((Lq - 551) & 7) == 0 && (Lq - 551) / 8 < nN) Lq = 214 + (Lq - 551) / 8;
        int wgid = (int)Lq; { const int q = nwg / pg8::NXCD, r = nwg % pg8::NXCD, xcd = wgid % pg8::NXCD, off = wgid / pg8::NXCD; wgid = (xcd < r ? xcd * (q + 1) : r * (q + 1) + (xcd - r) * q) + off; }
        const int nig = pg8::WGM * nN, gid = wgid / nig, fm = gid * pg8::WGM, gsz = (nM - fm) < pg8::WGM ? (nM - fm) : pg8::WGM;
        u.pm = fm + ((wgid % nig) % gsz); u.pn = (wgid % nig) / gsz; return true;
    }
    __device__ __forceinline__ void done(const pg8::Unit& u) const {
        if (u.pm == MP / 256) {
            asm volatile("s_waitcnt vmcnt(0)" ::: "memory"); __builtin_amdgcn_s_barrier(); asm volatile("" ::: "memory");
            if (threadIdx.x == 0) { __builtin_amdgcn_fence(__ATOMIC_RELEASE, "agent"); asm volatile("s_waitcnt vmcnt(0)" ::: "memory");
                (void)__hip_atomic_fetch_add(donectr, 1u, __ATOMIC_RELAXED, __HIP_MEMORY_SCOPE_AGENT); }
        }
    }
};
template <class Epi> __device__ __forceinline__ void run_gemm_sample_early(Frame& F, const bf16* Am, const bf16* Bt, int N, int K, const Epi& E, const unsigned* flag, unsigned* donectr) {
    pg8::Gemm g{Am, Bt, MT, N, K}; SampleOrderEarly S; S.init(MT, N, F.G, (int)blockIdx.x); S.flag = flag; S.donectr = donectr;
    pg8::gemm_phase<Epi, SampleOrderEarly, GEMM_ALIGN, GEMM_SP2>(F.lds, g, S, E);
}
__device__ __forceinline__ void wait_counter(const unsigned* ctr, unsigned target) {
    if (__builtin_amdgcn_readfirstlane(threadIdx.x >> 6) == 0) { int polls = 0;
        while ((unsigned)__builtin_amdgcn_readfirstlane(__hip_atomic_load(ctr, __ATOMIC_RELAXED, __HIP_MEMORY_SCOPE_AGENT)) < target) { polls = __builtin_amdgcn_readfirstlane(polls + 1); if (polls > (1 << 18)) break; __builtin_amdgcn_s_sleep(2); }
        __builtin_amdgcn_fence(__ATOMIC_ACQUIRE, "agent"); asm volatile("s_waitcnt vmcnt(0)" ::: "memory"); }
    __syncthreads();
    __builtin_amdgcn_fence(__ATOMIC_ACQUIRE, "agent"); asm volatile("s_waitcnt vmcnt(0)" ::: "memory");
}
template <class Epi> __device__ __forceinline__ void run_gemm_sample(Frame& F, const bf16* Am, const bf16* Bt, int N, int K, const Epi& E, const unsigned* flag) {
    pg8::Gemm g{Am, Bt, MT, N, K}; SampleOrder S; S.init(MT, N, F.G, (int)blockIdx.x); S.flag = flag;
    pg8::gemm_phase<Epi, SampleOrder, GEMM_ALIGN, GEMM_SP2>(F.lds, g, S, E);
}

constexpr int HG_QT = 0, HG_KT = 16384, HG_QH = 32768, HG_KHT = 49152, HG_VT = 65536, HG_ATT = 81920, HG_ST = 90112, HG_TOT = 122880, HG_DEC = 124928, HG_SS = 125440, HG_DEC2 = 126976;

__device__ __forceinline__ float lower_bound(const float* lb_logits, int j, int ch) {
    if (j == 0) return 0.f;
    const float l0 = lb_logits[ch], l1 = lb_logits[MIX + ch];
    return 1.f / (1.f + __expf(l0 - l1));
}
__device__ __forceinline__ void sig2(float x, float& sp, float& sn) { const float e = __expf(-fabsf(x)), r = __builtin_amdgcn_rcpf(1.f + e); const float big = r, small = e * r; sp = x >= 0.f ? big : small; sn = x >= 0.f ? small : big; }
__device__ __forceinline__ float fsilu(float x) { float sp, sn; sig2(x, sp, sn); return x * sp; }

__device__ __forceinline__ void hgrn_prompt_unit(Frame& F, const bf16* PROJ, bf16* MIXC, const float* lb_logits, const float* onorm_g, float* state_out, int j, int b, int h, int c_lo, int c_hi) {
    const ldsp L = F.lds; const int tid = fresh_tid(), w = __builtin_amdgcn_readfirstlane(tid >> 6), lane = tid & 63, fr = lane & 15, q4 = lane >> 4;
    const int ek = tid & 127, etq = tid >> 7;
    const float lbk = lower_bound(lb_logits, j, h * 128 + ek), oml = 1.f - lbk;
    f32x4 Sacc[8];
#pragma unroll
    for (int i = 0; i < 8; ++i) Sacc[i] = (f32x4){0.f, 0.f, 0.f, 0.f};
    for (int i = tid; i < 32768 / 16; i += NTHR) *(LAS v4u*)(L + HG_ST + i * 16) = (v4u){0u, 0u, 0u, 0u};
    __syncthreads();
    const int tt = w & 3, vh = w >> 2;
    unsigned short rq[16], rf[16], rv[16];
    if (c_lo > 0) {
        { const bf16* pq = PROJ + ((size_t)b * SEQ + etq * 16) * LDP + h * 128 + ek;
#pragma unroll
          for (int i = 0; i < 16; ++i) { rf[i] = pq[(size_t)i * LDP + 1536]; rv[i] = pq[(size_t)i * LDP + 3072]; } }
#pragma unroll 1
        for (int c = 0; c < c_lo; ++c) {
            int tl_ = tid; asm volatile("" : "+v"(tl_));
            const int lane = tl_ & 63, fr = lane & 15, q4 = lane >> 4, ek = tl_ & 127, etq = tl_ >> 7;
            const int kbuf = (c & 1) ? HG_QT : HG_KHT, vbuf = (c & 1) ? HG_KT : HG_VT, dbuf = (c & 1) ? HG_DEC2 : HG_DEC;
            float fv[16], vv[16];
#pragma unroll
            for (int i = 0; i < 16; ++i) { fv[i] = bf2f(rf[i]); vv[i] = bf2f(rv[i]); }
            float bl[16], kv[16]; float run = 0.f;
#pragma unroll
            for (int i = 0; i < 16; ++i) { float sp, sn; sig2(fv[i], sp, sn); const float fg = lbk + oml * sp; run += __logf(fmaxf(fg, 1e-30f)); bl[i] = run; kv[i] = oml * sn; }
            ((LAS float*)(L + HG_TOT))[etq * 128 + ek] = run;
            LDS_BARRIER();
            const float t0 = ((LAS float*)(L + HG_TOT))[ek], t1 = ((LAS float*)(L + HG_TOT))[128 + ek], t2 = ((LAS float*)(L + HG_TOT))[256 + ek], t3 = ((LAS float*)(L + HG_TOT))[384 + ek];
            const float bend = (t0 + t1) + (t2 + t3);
            const float rem = bend - ((etq > 0 ? t0 : 0.f) + (etq > 1 ? t1 : 0.f) + (etq > 2 ? t2 : 0.f));
            float kh[16];
#pragma unroll
            for (int i = 0; i < 16; ++i) kh[i] = kv[i] * __expf(fminf(rem - bl[i], 0.f));
            { v4u o0, o1;
              o0.x = pk2(kh[0], kh[1]); o0.y = pk2(kh[2], kh[3]); o0.z = pk2(kh[4], kh[5]); o0.w = pk2(kh[6], kh[7]);
              o1.x = pk2(kh[8], kh[9]); o1.y = pk2(kh[10], kh[11]); o1.z = pk2(kh[12], kh[13]); o1.w = pk2(kh[14], kh[15]);
              *(LAS v4u*)(L + kbuf + sw64(ek, etq * 2)) = o0; *(LAS v4u*)(L + kbuf + sw64(ek, etq * 2 + 1)) = o1;
              o0.x = pk2(vv[0], vv[1]); o0.y = pk2(vv[2], vv[3]); o0.z = pk2(vv[4], vv[5]); o0.w = pk2(vv[6], vv[7]);
              o1.x = pk2(vv[8], vv[9]); o1.y = pk2(vv[10], vv[11]); o1.z = pk2(vv[12], vv[13]); o1.w = pk2(vv[14], vv[15]);
              *(LAS v4u*)(L + vbuf + sw64(ek, etq * 2)) = o0; *(LAS v4u*)(L + vbuf + sw64(ek, etq * 2 + 1)) = o1; }
            if (etq == 0) ((LAS float*)(L + dbuf))[ek] = __expf(bend);
            LDS_BARRIER();
            if (c + 1 < c_lo) { const bf16* pq = PROJ + ((size_t)b * SEQ + (c + 1) * 64 + etq * 16) * LDP + h * 128 + ek;
#pragma unroll
                for (int i = 0; i < 16; ++i) { rf[i] = pq[(size_t)i * LDP + 1536]; rv[i] = pq[(size_t)i * LDP + 3072]; } }
            { const f32x4 dec = *(LAS f32x4*)(L + dbuf + (16 * w + q4 * 4) * 4);
#pragma unroll
              for (int vt = 0; vt < 8; ++vt) Sacc[vt] = Sacc[vt] * dec;
#pragma unroll
              for (int ks = 0; ks < 2; ++ks) { const bf16x8 a = *(LAS bf16x8*)(L + kbuf + sw64(16 * w + fr, ks * 4 + q4));
#pragma unroll
                  for (int vt = 0; vt < 8; ++vt) { const bf16x8 bv = *(LAS bf16x8*)(L + vbuf + sw64(16 * vt + fr, ks * 4 + q4)); Sacc[vt] = MFMA16(a, bv, Sacc[vt]); } } }
            __builtin_amdgcn_sched_barrier(0);
        }
        { int tl_ = tid; asm volatile("" : "+v"(tl_)); const int lane = tl_ & 63, fr = lane & 15, q4 = lane >> 4; const int k0 = 16 * w + q4 * 4;
#pragma unroll
          for (int vt = 0; vt < 8; ++vt) *(LAS v2u*)(L + HG_ST + sw128(16 * vt + fr, k0 >> 3) + (k0 & 7) * 2) = pk4(Sacc[vt]); }
    }
    { const bf16* pq = PROJ + ((size_t)b * SEQ + c_lo * 64 + etq * 16) * LDP + h * 128 + ek;
#pragma unroll
      for (int i = 0; i < 16; ++i) { rq[i] = pq[(size_t)i * LDP]; rf[i] = pq[(size_t)i * LDP + 1536]; rv[i] = pq[(size_t)i * LDP + 3072]; } }
#pragma unroll 1
    for (int c = c_lo; c < c_hi; ++c) {
        int tl_ = tid; asm volatile("" : "+v"(tl_));
        const int lane = tl_ & 63, fr = lane & 15, q4 = lane >> 4, ek = tl_ & 127, etq = tl_ >> 7;
        const size_t row0 = (size_t)b * SEQ + c * 64;
        float qv[16], fv[16], vv[16];
#pragma unroll
        for (int i = 0; i < 16; ++i) { qv[i] = bf2f(rq[i]); fv[i] = bf2f(rf[i]); vv[i] = bf2f(rv[i]); }
        float bl[16], kv[16]; float run = 0.f;
#pragma unroll
        for (int i = 0; i < 16; ++i) { float sp, sn; sig2(fv[i], sp, sn); const float fg = lbk + oml * sp; run += __logf(fmaxf(fg, 1e-30f)); bl[i] = run; kv[i] = oml * sn; }
        ((LAS float*)(L + HG_TOT))[etq * 128 + ek] = run;
        LDS_BARRIER();
        const float t0 = ((LAS float*)(L + HG_TOT))[ek], t1 = ((LAS float*)(L + HG_TOT))[128 + ek], t2 = ((LAS float*)(L + HG_TOT))[256 + ek], t3 = ((LAS float*)(L + HG_TOT))[384 + ek];
        const float off = (etq > 0 ? t0 : 0.f) + (etq > 1 ? t1 : 0.f) + (etq > 2 ? t2 : 0.f);
        const float mref = t0 + t1, bend = mref + t2 + t3, ebm = __expf(t2 + t3);
        float kh[16];
#pragma unroll
        for (int i = 0; i < 16; ++i) { const int t = etq * 16 + i; const float bt = off + bl[i];
            const float d = fminf(fmaxf(bt - mref, -60.f), 60.f), e1 = __expf(d), e2 = __builtin_amdgcn_rcpf(e1);
            const float sq = fsilu(qv[i]);
            const int a = sw128(t, ek >> 3) + (ek & 7) * 2;
            *(LAS unsigned short*)(L + HG_QT + a) = (unsigned short)f2bf(sq * e1);
            *(LAS unsigned short*)(L + HG_KT + a) = (unsigned short)f2bf(kv[i] * e2);
            *(LAS unsigned short*)(L + HG_QH + a) = (unsigned short)f2bf(sq * __expf(bt));
            kh[i] = kv[i] * (ebm * e2); }
        { v4u o0, o1;
          o0.x = pk2(kh[0], kh[1]); o0.y = pk2(kh[2], kh[3]); o0.z = pk2(kh[4], kh[5]); o0.w = pk2(kh[6], kh[7]);
          o1.x = pk2(kh[8], kh[9]); o1.y = pk2(kh[10], kh[11]); o1.z = pk2(kh[12], kh[13]); o1.w = pk2(kh[14], kh[15]);
          *(LAS v4u*)(L + HG_KHT + sw64(ek, etq * 2)) = o0; *(LAS v4u*)(L + HG_KHT + sw64(ek, etq * 2 + 1)) = o1;
          o0.x = pk2(vv[0], vv[1]); o0.y = pk2(vv[2], vv[3]); o0.z = pk2(vv[4], vv[5]); o0.w = pk2(vv[6], vv[7]);
          o1.x = pk2(vv[8], vv[9]); o1.y = pk2(vv[10], vv[11]); o1.z = pk2(vv[12], vv[13]); o1.w = pk2(vv[14], vv[15]);
          *(LAS v4u*)(L + HG_VT + sw64(ek, etq * 2)) = o0; *(LAS v4u*)(L + HG_VT + sw64(ek, etq * 2 + 1)) = o1; }
        if (etq == 0) ((LAS float*)(L + HG_DEC))[ek] = __expf(bend);
        LDS_BARRIER();
        v2u gate_raw[4];
#pragma unroll
        for (int i = 0; i < 4; ++i) gate_raw[i] = *(const v2u*)(PROJ + (row0 + tt * 16 + fr) * LDP + 4608 + h * 128 + (4 * vh + i) * 16 + q4 * 4);
        if (c + 1 < c_hi) { const bf16* pq = PROJ + (row0 + 64 + etq * 16) * LDP + h * 128 + ek;
#pragma unroll
            for (int i = 0; i < 16; ++i) { rq[i] = pq[(size_t)i * LDP]; rf[i] = pq[(size_t)i * LDP + 1536]; rv[i] = pq[(size_t)i * LDP + 3072]; } }
#pragma unroll
        for (int u = 0; u < 2; ++u) { const int st = w >> 1, ttl = 2 * (w & 1) + u;
            f32x4 acc = (f32x4){0.f, 0.f, 0.f, 0.f};
            if (st <= ttl) {
#pragma unroll
                for (int ks = 0; ks < 4; ++ks) { const bf16x8 a = *(LAS bf16x8*)(L + HG_KT + sw128(st * 16 + fr, ks * 4 + q4)); const bf16x8 bq = *(LAS bf16x8*)(L + HG_QT + sw128(ttl * 16 + fr, ks * 4 + q4)); acc = MFMA16(a, bq, acc); } }
            const int t = ttl * 16 + fr, s0 = st * 16 + q4 * 4;
#pragma unroll
            for (int r = 0; r < 4; ++r) if (s0 + r > t) acc[r] = 0.f;
            *(LAS v2u*)(L + HG_ATT + sw64(t, s0 >> 3) + (s0 & 7) * 2) = pk4(acc); }
        f32x4 oT[4];
#pragma unroll
        for (int i = 0; i < 4; ++i) oT[i] = (f32x4){0.f, 0.f, 0.f, 0.f};
#pragma unroll
        for (int ks = 0; ks < 4; ++ks) { const bf16x8 bq = *(LAS bf16x8*)(L + HG_QH + sw128(tt * 16 + fr, ks * 4 + q4));
#pragma unroll
            for (int i = 0; i < 4; ++i) { const bf16x8 a = *(LAS bf16x8*)(L + HG_ST + sw128((4 * vh + i) * 16 + fr, ks * 4 + q4)); oT[i] = MFMA16(a, bq, oT[i]); } }
        { const f32x4 dec = *(LAS f32x4*)(L + HG_DEC + (16 * w + q4 * 4) * 4);
#pragma unroll
          for (int vt = 0; vt < 8; ++vt) Sacc[vt] = Sacc[vt] * dec;
#pragma unroll
          for (int ks = 0; ks < 2; ++ks) { const bf16x8 a = *(LAS bf16x8*)(L + HG_KHT + sw64(16 * w + fr, ks * 4 + q4));
#pragma unroll
              for (int vt = 0; vt < 8; ++vt) { const bf16x8 bv = *(LAS bf16x8*)(L + HG_VT + sw64(16 * vt + fr, ks * 4 + q4)); Sacc[vt] = MFMA16(a, bv, Sacc[vt]); } } }
        LDS_BARRIER();
        { const int k0 = 16 * w + q4 * 4;
#pragma unroll
          for (int vt = 0; vt < 8; ++vt) *(LAS v2u*)(L + HG_ST + sw128(16 * vt + fr, k0 >> 3) + (k0 & 7) * 2) = pk4(Sacc[vt]); }
#pragma unroll
        for (int ks = 0; ks < 2; ++ks) { const bf16x8 bq = *(LAS bf16x8*)(L + HG_ATT + sw64(tt * 16 + fr, ks * 4 + q4));
#pragma unroll
            for (int i = 0; i < 4; ++i) { const bf16x8 a = *(LAS bf16x8*)(L + HG_VT + sw64((4 * vh + i) * 16 + fr, ks * 4 + q4)); oT[i] = MFMA16(a, bq, oT[i]); } }
        float ss = 0.f;
#pragma unroll
        for (int i = 0; i < 4; ++i) ss += (oT[i].x * oT[i].x + oT[i].y * oT[i].y) + (oT[i].z * oT[i].z + oT[i].w * oT[i].w);
        ss += __shfl_xor(ss, 16); ss += __shfl_xor(ss, 32);
        if (q4 == 0) ((LAS float*)(L + HG_SS))[w * 16 + fr] = ss;
        LDS_BARRIER();
        const float tot = ((LAS float*)(L + HG_SS))[w * 16 + fr] + ((LAS float*)(L + HG_SS))[(w ^ 4) * 16 + fr];
        const float rstd = 1.f / sqrtf(tot * (1.f / 128.f) + RMS_EPS);
        const size_t row = row0 + tt * 16 + fr;
#pragma unroll
        for (int i = 0; i < 4; ++i) { const int ch = h * 128 + (4 * vh + i) * 16 + q4 * 4;
            const f32x4 gon = *(const f32x4*)(onorm_g + ch); const f32x4 gate = bf4(gate_raw[i]);
            f32x4 o = oT[i] * rstd * gon;
            o.x *= fsilu(gate.x); o.y *= fsilu(gate.y); o.z *= fsilu(gate.z); o.w *= fsilu(gate.w);
            *(v2u*)(MIXC + row * D + ch) = pk4(o); }
    }
    if (c_hi == SEQ / 64) {
#pragma unroll
        for (int vt = 0; vt < 8; ++vt)
#pragma unroll
            for (int r = 0; r < 4; ++r) state_out[(size_t)(16 * w + q4 * 4 + r) * 128 + 16 * vt + fr] = Sacc[vt][r]; }
    __syncthreads();
}

__device__ __forceinline__ void hgrn_sample_unit(int lane, const bf16* PROJ, bf16* MIXC, const float* lb_logits, const float* onorm_g, const float* S0, float* S1, int j, int b, int h) {
    const size_t row = MP + b; const int vq = lane & 31, kr = lane >> 5;
    float fg[2], kvv[2], sq[2];
#pragma unroll
    for (int u = 0; u < 2; ++u) { const int k = lane + 64 * u; const bf16* p = PROJ + row * LDP + h * 128 + k;
        const float q = bf2f(p[0]), f = bf2f(p[1536]); const float lbk = lower_bound(lb_logits, j, h * 128 + k);
        float sp, sn; sig2(f, sp, sn); fg[u] = fmaxf(lbk + (1.f - lbk) * sp, 1e-30f); kvv[u] = (1.f - lbk) * sn; sq[u] = fsilu(q); }
    const f32x4 v4 = bf4(*(const v2u*)(PROJ + row * LDP + 3072 + h * 128 + 4 * vq));
    f32x4 o = (f32x4){0.f, 0.f, 0.f, 0.f};
#pragma unroll 16
    for (int it = 0; it < 64; ++it) { const int k = 2 * it + kr; const int src = k & 63;
        const float fgk = __shfl(it < 32 ? fg[0] : fg[1], src), kvk = __shfl(it < 32 ? kvv[0] : kvv[1], src), sqk = __shfl(it < 32 ? sq[0] : sq[1], src);
        const f32x4 S = *(const f32x4*)(S0 + (size_t)k * 128 + 4 * vq);
        const f32x4 Sn = S * fgk + v4 * kvk;
        *(f32x4*)(S1 + (size_t)k * 128 + 4 * vq) = Sn;
        o = o + Sn * sqk; }
    o.x += __shfl_xor(o.x, 32); o.y += __shfl_xor(o.y, 32); o.z += __shfl_xor(o.z, 32); o.w += __shfl_xor(o.w, 32);
    float ss = (o.x * o.x + o.y * o.y) + (o.z * o.z + o.w * o.w);
#pragma unroll
    for (int m = 1; m < 32; m <<= 1) ss += __shfl_xor(ss, m);
    const float rstd = 1.f / sqrtf(ss * (1.f / 128.f) + RMS_EPS);
    if (lane < 32) { const int ch = h * 128 + 4 * vq;
        const f32x4 gon = *(const f32x4*)(onorm_g + ch); const f32x4 gate = bf4(*(const v2u*)(PROJ + row * LDP + 4608 + ch));
        f32x4 r = o * rstd * gon; r.x *= fsilu(gate.x); r.y *= fsilu(gate.y); r.z *= fsilu(gate.z); r.w *= fsilu(gate.w);
        *(v2u*)(MIXC + row * D + ch) = pk4(r); }
}

constexpr int XA_K = 0, XA_KLD = 272, XA_VT = 256 * 272, XA_VLD = 520;
__device__ __forceinline__ void xattn_prompt_unit(Frame& F, const bf16* PROJ, int xq_off, bf16* MIXC, const float* Kb, const float* Vb, int b, int head, int qpart) {
    const ldsp L = F.lds; const int tid = fresh_tid(), w = __builtin_amdgcn_readfirstlane(tid >> 6), lane = tid & 63, fr = lane & 15, q4 = lane >> 4;
    __syncthreads();
#pragma unroll 8
    for (int it = 0; it < 16; ++it) { const int idx = it * NTHR + tid, m = idx >> 5, e4 = idx & 31;
        const f32x4 kx = *(const f32x4*)(Kb + (size_t)m * XDIM + head * XD + 4 * e4);
        *(LAS v2u*)(L + XA_K + m * XA_KLD + e4 * 8) = pk4(kx);
        const f32x4 vx = *(const f32x4*)(Vb + (size_t)m * XDIM + head * XD + 4 * e4);
#pragma unroll
        for (int q = 0; q < 4; ++q) { const int e = 4 * e4 + q; *(LAS unsigned short*)(L + XA_VT + e * XA_VLD + m * 2) = (unsigned short)f2bf(vx[q]); } }
    __syncthreads();
    const float scale = 0.08838834764831845f;
    const ldsp kbase = L + XA_K + fr * XA_KLD + q4 * 16; const ldsp vbase = L + XA_VT + fr * XA_VLD + q4 * 8;
#pragma unroll 1
    for (int qt = 0; qt < 2; ++qt) {
        const size_t r = (size_t)b * SEQ + qpart * 256 + qt * 128 + w * 16 + fr;
        bf16x8 qf[4];
#pragma unroll
        for (int ks = 0; ks < 4; ++ks) qf[ks] = *(const bf16x8*)(PROJ + r * LDP + xq_off + head * XD + ks * 32 + q4 * 8);
        f32x4 sT[16];
#pragma unroll
        for (int mt = 0; mt < 16; ++mt) { f32x4 acc = (f32x4){0.f, 0.f, 0.f, 0.f};
#pragma unroll
            for (int ks = 0; ks < 4; ++ks) { const bf16x8 a = *(LAS bf16x8*)(kbase + mt * 16 * XA_KLD + ks * 64); acc = MFMA16(a, qf[ks], acc); }
            sT[mt] = acc; __builtin_amdgcn_sched_barrier(0); }
        float mx = -3.0e38f;
#pragma unroll
        for (int mt = 0; mt < 16; ++mt) mx = fmaxf(mx, fmaxf(fmaxf(sT[mt].x, sT[mt].y), fmaxf(sT[mt].z, sT[mt].w)));
        mx = fmaxf(mx, __shfl_xor(mx, 16)); mx = fmaxf(mx, __shfl_xor(mx, 32));
        float l = 0.f;
#pragma unroll
        for (int mt = 0; mt < 16; ++mt) {
#pragma unroll
            for (int q = 0; q < 4; ++q) { const float p = __expf((sT[mt][q] - mx) * scale); sT[mt][q] = p; l += p; } }
        l += __shfl_xor(l, 16); l += __shfl_xor(l, 32);
        const float inv = 1.f / l;
        f32x4 oT[8];
#pragma unroll
        for (int et = 0; et < 8; ++et) oT[et] = (f32x4){0.f, 0.f, 0.f, 0.f};
#pragma unroll
        for (int s = 0; s < 8; ++s) {
            v4u pw; pw.x = pk2(sT[2 * s].x, sT[2 * s].y); pw.y = pk2(sT[2 * s].z, sT[2 * s].w); pw.z = pk2(sT[2 * s + 1].x, sT[2 * s + 1].y); pw.w = pk2(sT[2 * s + 1].z, sT[2 * s + 1].w);
            const bf16x8 pf = __builtin_bit_cast(bf16x8, pw);
#pragma unroll
            for (int et = 0; et < 8; ++et) {
                const v2u a0 = *(LAS v2u*)(vbase + et * 16 * XA_VLD + s * 64);
                const v2u a1 = *(LAS v2u*)(vbase + et * 16 * XA_VLD + s * 64 + 32);
                v4u aw; aw.x = a0.x; aw.y = a0.y; aw.z = a1.x; aw.w = a1.y;
                oT[et] = MFMA16(__builtin_bit_cast(bf16x8, aw), pf, oT[et]); }
            __builtin_amdgcn_sched_barrier(0); }
#pragma unroll
        for (int et = 0; et < 8; ++et) *(v2u*)(MIXC + r * D + MIX + head * XD + et * 16 + q4 * 4) = pk4(oT[et] * inv);
    }
    __syncthreads();
}
__device__ __forceinline__ void xattn_sample_pair(Frame& F, const bf16* PROJ, int xq_off, bf16* MIXC, const float* Kall, const float* Vall, int unit0) {
    const ldsp L = F.lds; const int tid = fresh_tid(), w = __builtin_amdgcn_readfirstlane(tid >> 6), lane = tid & 63;
    const int unit = unit0 + (w >> 2), mp = w & 3, b = unit >> 2, head = unit & 3;
    const size_t row = MP + b; const int fr = lane & 15, q4 = lane >> 4, e4 = lane & 31, mr = lane >> 5;
    const float* Kb = Kall + (size_t)b * NMEM * XDIM; const float* Vb = Vall + (size_t)b * NMEM * XDIM;
    const float scale = 0.08838834764831845f;
    bf16x8 qf[4];
#pragma unroll
    for (int ks = 0; ks < 4; ++ks) { const v4u raw = *(const v4u*)(PROJ + row * LDP + xq_off + head * XD + ks * 32 + q4 * 8);
        v4u o; o.x = pk2_hw(bflo(raw.x) * scale, bfhi(raw.x) * scale); o.y = pk2_hw(bflo(raw.y) * scale, bfhi(raw.y) * scale); o.z = pk2_hw(bflo(raw.z) * scale, bfhi(raw.z) * scale); o.w = pk2_hw(bflo(raw.w) * scale, bfhi(raw.w) * scale);
        qf[ks] = __builtin_bit_cast(bf16x8, o); }
    f32x4 sT[4];
#pragma unroll
    for (int i = 0; i < 4; ++i) { f32x4 acc = (f32x4){0.f, 0.f, 0.f, 0.f};
        const float* kp = Kb + (size_t)(mp * 64 + i * 16 + fr) * XDIM + head * XD + q4 * 8;
        f32x4 x0[4], x1[4];
#pragma unroll
        for (int ks = 0; ks < 4; ++ks) { x0[ks] = *(const f32x4*)(kp + ks * 32); x1[ks] = *(const f32x4*)(kp + ks * 32 + 4); }
#pragma unroll
        for (int ks = 0; ks < 4; ++ks) { v4u aw; aw.x = pk2_hw(x0[ks].x, x0[ks].y); aw.y = pk2_hw(x0[ks].z, x0[ks].w); aw.z = pk2_hw(x1[ks].x, x1[ks].y); aw.w = pk2_hw(x1[ks].z, x1[ks].w);
            acc = MFMA16(__builtin_bit_cast(bf16x8, aw), qf[ks], acc); }
        sT[i] = acc; }
    float mx = -3.0e38f;
#pragma unroll
    for (int i = 0; i < 4; ++i) mx = fmaxf(mx, fmaxf(fmaxf(sT[i].x, sT[i].y), fmaxf(sT[i].z, sT[i].w)));
    mx = fmaxf(mx, __shfl_xor(mx, 16)); mx = fmaxf(mx, __shfl_xor(mx, 32));
    float l = 0.f;
#pragma unroll
    for (int i = 0; i < 4; ++i) {
#pragma unroll
        for (int q = 0; q < 4; ++q) { const float p = __expf(sT[i][q] - mx); sT[i][q] = p; l += p; } }
    l += __shfl_xor(l, 16); l += __shfl_xor(l, 32);
    f32x4 o = (f32x4){0.f, 0.f, 0.f, 0.f};
    const float* vp = Vb + head * XD + 4 * e4;
#pragma unroll
    for (int i = 0; i < 4; ++i) {
#pragma unroll
        for (int ii = 0; ii < 8; ++ii) { const int m0 = mp * 64 + i * 16 + 2 * ii; const int src = ((2 * ii) >> 2) * 16;
            const float pa = __shfl(sT[i][2 * (ii & 1)], src), pb = __shfl(sT[i][2 * (ii & 1) + 1], src);
            const f32x4 vx = *(const f32x4*)(vp + (size_t)(m0 + mr) * XDIM);
            o = o + vx * (mr ? pb : pa); } }
    o.x += __shfl_xor(o.x, 32); o.y += __shfl_xor(o.y, 32); o.z += __shfl_xor(o.z, 32); o.w += __shfl_xor(o.w, 32);
    LAS float* slot = (LAS float*)(L + w * 528);
    if (lane == 0) { slot[0] = mx; slot[1] = l; }
    if (lane < 32) *(LAS f32x4*)(slot + 4 + 4 * e4) = o;
    LDS_BARRIER();
    if (mp == 0 && lane < 32) { float M = -3.0e38f;
#pragma unroll
        for (int i = 0; i < 4; ++i) M = fmaxf(M, ((LAS float*)(L + (w + i) * 528))[0]);
        float Lsum = 0.f; f32x4 O = (f32x4){0.f, 0.f, 0.f, 0.f};
#pragma unroll
        for (int i = 0; i < 4; ++i) { const LAS float* s = (const LAS float*)(L + (w + i) * 528); const float f = __expf(s[0] - M); Lsum += s[1] * f; O = O + *(const LAS f32x4*)(s + 4 + 4 * e4) * f; }
        *(v2u*)(MIXC + row * D + MIX + head * XD + 4 * e4) = pk4(O * (1.f / Lsum)); }
    LDS_BARRIER();
}

__device__ __forceinline__ void xattn_sample_unit(int lane, const bf16* PROJ, int xq_off, bf16* MIXC, const float* Kb, const float* Vb, int b, int head) {
    const size_t row = MP + b; const int fr = lane & 15, q4 = lane >> 4, e4 = lane & 31, mr = lane >> 5;
    const float scale = 0.08838834764831845f;
    bf16x8 qf[4];
#pragma unroll
    for (int ks = 0; ks < 4; ++ks) { const v4u raw = *(const v4u*)(PROJ + row * LDP + xq_off + head * XD + ks * 32 + q4 * 8);
        v4u o; o.x = pk2_hw(bflo(raw.x) * scale, bfhi(raw.x) * scale); o.y = pk2_hw(bflo(raw.y) * scale, bfhi(raw.y) * scale); o.z = pk2_hw(bflo(raw.z) * scale, bfhi(raw.z) * scale); o.w = pk2_hw(bflo(raw.w) * scale, bfhi(raw.w) * scale);
        qf[ks] = __builtin_bit_cast(bf16x8, o); }
    f32x4 sT[16];
#pragma unroll
    for (int mt = 0; mt < 16; ++mt) { f32x4 acc = (f32x4){0.f, 0.f, 0.f, 0.f};
        const float* kp = Kb + (size_t)(mt * 16 + fr) * XDIM + head * XD + q4 * 8;
        f32x4 x0[4], x1[4];
#pragma unroll
        for (int ks = 0; ks < 4; ++ks) { x0[ks] = *(const f32x4*)(kp + ks * 32); x1[ks] = *(const f32x4*)(kp + ks * 32 + 4); }
#pragma unroll
        for (int ks = 0; ks < 4; ++ks) { v4u aw; aw.x = pk2_hw(x0[ks].x, x0[ks].y); aw.y = pk2_hw(x0[ks].z, x0[ks].w); aw.z = pk2_hw(x1[ks].x, x1[ks].y); aw.w = pk2_hw(x1[ks].z, x1[ks].w);
            acc = MFMA16(__builtin_bit_cast(bf16x8, aw), qf[ks], acc); }
        sT[mt] = acc; }
    float mx = -3.0e38f;
#pragma unroll
    for (int mt = 0; mt < 16; ++mt) mx = fmaxf(mx, fmaxf(fmaxf(sT[mt].x, sT[mt].y), fmaxf(sT[mt].z, sT[mt].w)));
    mx = fmaxf(mx, __shfl_xor(mx, 16)); mx = fmaxf(mx, __shfl_xor(mx, 32));
    float l = 0.f;
#pragma unroll
    for (int mt = 0; mt < 16; ++mt) {
#pragma unroll
        for (int q = 0; q < 4; ++q) { const float p = __expf(sT[mt][q] - mx); sT[mt][q] = p; l += p; } }
    l += __shfl_xor(l, 16); l += __shfl_xor(l, 32);
    f32x4 o = (f32x4){0.f, 0.f, 0.f, 0.f};
    const float* vp = Vb + head * XD + 4 * e4;
#pragma unroll
    for (int mt = 0; mt < 16; ++mt) {
#pragma unroll
        for (int i = 0; i < 8; ++i) { const int m0 = mt * 16 + 2 * i;
            const int src = ((2 * i) >> 2) * 16;
            const float pa = __shfl(sT[mt][2 * (i & 1)], src);
            const float pb = __shfl(sT[mt][2 * (i & 1) + 1], src);
            const f32x4 vx = *(const f32x4*)(vp + (size_t)(m0 + mr) * XDIM);
            o = o + vx * (mr ? pb : pa); } }
    o.x += __shfl_xor(o.x, 32); o.y += __shfl_xor(o.y, 32); o.z += __shfl_xor(o.z, 32); o.w += __shfl_xor(o.w, 32);
    if (lane < 32) *(v2u*)(MIXC + row * D + MIX + head * XD + 4 * e4) = pk4(o * (1.f / l));
}


__device__ __forceinline__ long rw_prev_row(int row) { return row < MP ? (((row & (SEQ - 1)) == 0) ? -1L : (long)row - 1) : (long)row + NSMP; }
__device__ __forceinline__ f32x4 ld_bf4(const bf16* p) { return bf4(*(const v2u*)p); }
__device__ __forceinline__ f32x4 ld_bf4_prev(const bf16* PROJ, long prow, int col) { return prow >= 0 ? bf4(*(const v2u*)(PROJ + (size_t)prow * LDP + col)) : (f32x4){0.f, 0.f, 0.f, 0.f}; }
__device__ __forceinline__ float ftanh(float x) { return 1.f - 2.f * __builtin_amdgcn_rcpf(1.f + __expf(2.f * x)); }
__device__ __forceinline__ float quad_sum(float x) {
    x += __builtin_bit_cast(float, __builtin_amdgcn_mov_dpp(__builtin_bit_cast(int, x), 0xB1, 0xF, 0xF, true));
    x += __builtin_bit_cast(float, __builtin_amdgcn_mov_dpp(__builtin_bit_cast(int, x), 0x4E, 0xF, 0xF, true));
    return x;
}

constexpr int RC_LI = 0, RC_RAW = 46080, RC_XCH = RC_RAW + 3 * 9216;
__device__ __forceinline__ void rwkv_prep_unit(Frame& F, const Args& A, int j, int r0, int h_lo, int h_hi) {
    const ldsp L = F.lds; const int tid = fresh_tid(), w = __builtin_amdgcn_readfirstlane(tid >> 6), lane = tid & 63, fr = lane & 15, q4 = lane >> 4;
    const int it = w >> 1, jh = w & 1;
    constexpr bool sample = true;
    const bf16* PROJ = (const bf16*)(F.ws + WS_PROJ);
    const float* mu = A.in[20] + (size_t)j * B_MIXC; const float* w0 = A.in[21] + (size_t)j * MIX; const float* a0 = A.in[23] + (size_t)j * MIX;
    const float* k_k = A.in[26] + (size_t)j * MIX; const float* k_a = A.in[27] + (size_t)j * MIX; const float* r_k = A.in[28] + (size_t)j * MIX;
    const bf16* LW = (const bf16*)(F.ws + WS_LW) + (size_t)j * MIX * LORA_K;
    float* RR = (float*)(F.ws + WS_RR); float* RK = (float*)(F.ws + WS_RK); float* RV = (float*)(F.ws + WS_RV); float* RKK = (float*)(F.ws + WS_RKK);
    float* RKA = (float*)(F.ws + WS_RKA); float* RWd = (float*)(F.ws + WS_RW); float* RG = (float*)(F.ws + WS_RG); float* BON = (float*)(F.ws + WS_BONUS);
    __syncthreads();
    for (int itr = 0; itr < 11; ++itr) { const int idx = itr * NTHR + tid;
        if (idx < 64 * 88) { const int t = idx / 88, c4 = idx - t * 88, col = 4 * c4; const int row = r0 + t; const long prow = rw_prev_row(row);
            const f32x4 P = ld_bf4(PROJ + (size_t)row * LDP + B_LORA_OFF + col), Pp = ld_bf4_prev(PROJ, prow, B_LORA_OFF + col);
            const f32x4 m4 = *(const f32x4*)(mu + 4608 + col);
            f32x4 xs = P + (Pp - P) * m4;
            if (col < 64) { xs.x = ftanh(xs.x); xs.y = ftanh(xs.y); xs.z = ftanh(xs.z); xs.w = ftanh(xs.w); }
            else if (col >= 128) { xs.x = fsigmoid(xs.x); xs.y = fsigmoid(xs.y); xs.z = fsigmoid(xs.z); xs.w = fsigmoid(xs.w); }
            *(LAS v2u*)(L + RC_LI + t * 720 + col * 2) = pk4(xs); } }
#pragma unroll 1
    for (int h = h_lo; h < h_hi; ++h) {
        __syncthreads();
        { const int row = tid >> 3, c8 = tid & 7;
#pragma unroll
          for (int x = 0; x < 3; ++x) { const v4u val = *(const v4u*)(PROJ + (size_t)(r0 + row) * LDP + x * 1536 + h * 64 + c8 * 8);
              *(LAS v4u*)(L + RC_RAW + x * 9216 + (row + 1) * 128 + c8 * 16) = val; }
          if (tid < 8) { const long prow = sample ? -1L : rw_prev_row(r0);
#pragma unroll
              for (int x = 0; x < 3; ++x) { v4u val = (v4u){0u, 0u, 0u, 0u}; if (prow >= 0) val = *(const v4u*)(PROJ + (size_t)prow * LDP + x * 1536 + h * 64 + tid * 8);
                  *(LAS v4u*)(L + RC_RAW + x * 9216 + tid * 16) = val; } } }
        f32x4 aw[2], aa[2], ag[2];
#pragma unroll
        for (int u = 0; u < 2; ++u) { aw[u] = (f32x4){0.f, 0.f, 0.f, 0.f}; aa[u] = aw[u]; ag[u] = aw[u]; }
        { const bf16* lw0 = LW + (size_t)(h * 64 + (2 * jh) * 16 + fr) * LORA_K + q4 * 8; const ldsp li = L + RC_LI + (it * 16 + fr) * 720 + q4 * 16;
#pragma unroll
          for (int ks = 0; ks < 11; ++ks) { const bf16x8 afr = *(LAS bf16x8*)(li + ks * 64);
#pragma unroll
              for (int u = 0; u < 2; ++u) { const bf16x8 bfr = *(const bf16x8*)(lw0 + (size_t)u * 16 * LORA_K + ks * 32);
                  if (ks < 2) aw[u] = MFMA16(afr, bfr, aw[u]); else if (ks < 4) aa[u] = MFMA16(afr, bfr, aa[u]); else ag[u] = MFMA16(afr, bfr, ag[u]); } } }
        __syncthreads();
        float xr[2][4], xk[2][4], xv[2][4], dw[2][4], av[2][4], kkr[2][4];
        float nrm[4] = {0.f, 0.f, 0.f, 0.f}, bon[4] = {0.f, 0.f, 0.f, 0.f};
#pragma unroll
        for (int u = 0; u < 2; ++u) { const int c = (2 * jh + u) * 16 + fr, ch = h * 64 + c;
            const float mur = mu[ch], muk = mu[1536 + ch], muv = mu[3072 + ch], w0c = w0[ch], a0c = a0[ch], kkc = k_k[ch], kac = k_a[ch], rkc = r_k[ch];
#pragma unroll
            for (int e = 0; e < 4; ++e) { const int t = it * 16 + 4 * q4 + e;
                const float cr = bf2f(*(LAS unsigned short*)(L + RC_RAW + (t + 1) * 128 + c * 2)), ck = bf2f(*(LAS unsigned short*)(L + RC_RAW + 9216 + (t + 1) * 128 + c * 2)),
                            cv = bf2f(*(LAS unsigned short*)(L + RC_RAW + 18432 + (t + 1) * 128 + c * 2));
                float pr, pk, pv;
                if (sample) { const bf16* pp = PROJ + (size_t)(r0 + t + NSMP) * LDP + ch; pr = bf2f(pp[0]); pk = bf2f(pp[1536]); pv = bf2f(pp[3072]); }
                else { pr = bf2f(*(LAS unsigned short*)(L + RC_RAW + t * 128 + c * 2)); pk = bf2f(*(LAS unsigned short*)(L + RC_RAW + 9216 + t * 128 + c * 2)); pv = bf2f(*(LAS unsigned short*)(L + RC_RAW + 18432 + t * 128 + c * 2)); }
                const float r_ = cr + (pr - cr) * mur, k_ = ck + (pk - ck) * muk, v_ = cv + (pv - cv) * muv;
                const float x = -(w0c + aw[u][e]);
                const float sp = fmaxf(x, 0.f) + __logf(1.f + __expf(-fabsf(x)));
                dw[u][e] = -__expf(-sp - 0.5f);
                const float a = fsigmoid(a0c + aa[u][e]);
                const float kr_ = k_ * kkc, kp = k_ * (1.f + (a - 1.f) * kac);
                xr[u][e] = r_; xk[u][e] = kp; xv[u][e] = v_; av[u][e] = a; kkr[u][e] = kr_;
                nrm[e] += kr_ * kr_; bon[e] += r_ * kp * rkc; } }
#pragma unroll
        for (int e = 0; e < 4; ++e) {
#pragma unroll
            for (int m = 1; m < 16; m <<= 1) { nrm[e] += __shfl_xor(nrm[e], m); bon[e] += __shfl_xor(bon[e], m); } }
        if (fr == 0) {
#pragma unroll
            for (int e = 0; e < 4; ++e) { ((LAS float*)(L + RC_XCH))[(w * 2 + 0) * 16 + 4 * q4 + e] = nrm[e]; ((LAS float*)(L + RC_XCH))[(w * 2 + 1) * 16 + 4 * q4 + e] = bon[e]; } }
        __syncthreads();
#pragma unroll
        for (int e = 0; e < 4; ++e) { nrm[e] += ((LAS float*)(L + RC_XCH))[((w ^ 1) * 2 + 0) * 16 + 4 * q4 + e]; bon[e] += ((LAS float*)(L + RC_XCH))[((w ^ 1) * 2 + 1) * 16 + 4 * q4 + e];
            nrm[e] = 1.f / fmaxf(sqrtf(nrm[e]), 1e-12f); }
#pragma unroll
        for (int u = 0; u < 2; ++u) { const int c = (2 * jh + u) * 16 + fr, ch = h * 64 + c;
#pragma unroll
            for (int e = 0; e < 4; ++e) { const size_t o = (size_t)(r0 + it * 16 + 4 * q4 + e) * MIX + ch;
                const float kk = kkr[u][e] * nrm[e];
                RR[o] = xr[u][e]; RK[o] = xk[u][e]; RV[o] = xv[u][e]; RKK[o] = kk; RKA[o] = kk * av[u][e]; RWd[o] = __expf(dw[u][e]); RG[o] = ag[u][e]; } }
        if (fr == 0 && jh == 0) {
#pragma unroll
            for (int e = 0; e < 4; ++e) BON[(size_t)(r0 + it * 16 + 4 * q4 + e) * BH + h] = bon[e]; }
    }
    __syncthreads();
}

__device__ __forceinline__ void rwkv_sample_unit(Frame& F, const Args& A, int lane, int j, int b, int h) {
    const float* RWd = (const float*)(F.ws + WS_RW); const float* RKK = (const float*)(F.ws + WS_RKK); const float* RKA = (const float*)(F.ws + WS_RKA);
    const float* RK = (const float*)(F.ws + WS_RK); const float* RR = (const float*)(F.ws + WS_RR); const float* RV = (const float*)(F.ws + WS_RV);
    const float* RG = (const float*)(F.ws + WS_RG); const float* BON = (const float*)(F.ws + WS_BONUS); bf16* MIXC = (bf16*)(F.ws + WS_MIXC);
    const float* lnx_g = A.in[29] + (size_t)j * MIX; const float* lnx_b = A.in[30] + (size_t)j * MIX;
    const size_t row = MP + b; const int chan = h * BHD; const int vr = lane >> 4, kc = lane & 15;
    const size_t vo = row * MIX + chan + 4 * kc;
    const f32x4 w4 = *(const f32x4*)(RWd + vo), kk4 = *(const f32x4*)(RKK + vo), ka4 = *(const f32x4*)(RKA + vo), k4 = *(const f32x4*)(RK + vo), r4 = *(const f32x4*)(RR + vo);
    const float* S0 = A.in[5] + ((size_t)(j * NSMP + b) * BH + h) * (BHD * BHD);
    float* S1 = F.out + O_SRS + ((size_t)(j * NSMP + b) * BH + h) * (BHD * BHD);
    float myo = 0.f, osum = 0.f, osq = 0.f;
#pragma unroll
    for (int vb = 0; vb < 16; ++vb) { const int v = 4 * vb + vr;
        f32x4 S = *(const f32x4*)(S0 + (size_t)v * BHD + 4 * kc);
        float sa = (S.x * kk4.x + S.y * kk4.y) + (S.z * kk4.z + S.w * kk4.w);
#pragma unroll
        for (int m = 1; m < 16; m <<= 1) sa += __shfl_xor(sa, m);
        sa = -sa;
        const float vv = RV[row * MIX + chan + v];
        S = S * w4 + ka4 * sa + k4 * vv;
        *(f32x4*)(S1 + (size_t)v * BHD + 4 * kc) = S;
        float o = (S.x * r4.x + S.y * r4.y) + (S.z * r4.z + S.w * r4.w);
#pragma unroll
        for (int m = 1; m < 16; m <<= 1) o += __shfl_xor(o, m);
        osum += o; osq += o * o;
        myo = (kc == vb) ? o : myo; }
    osum += __shfl_xor(osum, 16); osum += __shfl_xor(osum, 32); osq += __shfl_xor(osq, 16); osq += __shfl_xor(osq, 32);
    const float mean = osum * (1.f / 64.f); const float var = fmaxf(osq * (1.f / 64.f) - mean * mean, 0.f);
    const float rstd = 1.f / sqrtf(var + GN_EPS);
    const int ch = chan + 4 * kc + vr;
    const float on = (myo - mean) * rstd * lnx_g[ch] + lnx_b[ch];
    const float bonus = BON[row * BH + h] * RV[row * MIX + ch];
    MIXC[row * D + ch] = (bf16)f2bf((on + bonus) * RG[row * MIX + ch]);
}


#ifndef PROBE_SUB
#define PROBE_SUB 0
#endif
constexpr int RK_LI = 0, RK_XCH = 46080, RK_TOT = 47104, RK_LD = 51200, RK_WC = 55296, RK_TILE = 55552, TBYTES = 9216;
#define TBUF(p) (L + RK_TILE + (p) * TBYTES)
__device__ __forceinline__ f32x4 mm_tile(ldsp Ab, ldsp Bb, int ia, int jb, int fr, int q4) {
    f32x4 acc = (f32x4){0.f, 0.f, 0.f, 0.f};
#pragma unroll
    for (int ks = 0; ks < 2; ++ks) { const bf16x8 a = *(LAS bf16x8*)(Ab + (ia * 16 + fr) * 144 + ks * 64 + q4 * 16); const bf16x8 b = *(LAS bf16x8*)(Bb + (jb * 16 + fr) * 144 + ks * 64 + q4 * 16); acc = MFMA16(a, b, acc); }
    return acc;
}
__device__ __forceinline__ void st_tileT(ldsp buf, int ia, int jb, int fr, int q4, f32x4 v) { *(LAS v2u*)(buf + (jb * 16 + fr) * 144 + (ia * 16 + 4 * q4) * 2) = pk4(v); }

__device__ __forceinline__ void rwkv_chunk_unit(Frame& F, const Args& A, int j, int b, int cidx, int h_lo, int h_hi) {
    const ldsp L = F.lds; const int tid = fresh_tid(), w = __builtin_amdgcn_readfirstlane(tid >> 6), lane = tid & 63, fr = lane & 15, q4 = lane >> 4;
    const int it = w >> 1, jh = w & 1, grp = it * 4 + q4, i0 = it * 16 + 4 * q4;
    const int r0 = b * SEQ + cidx * 64;
    const bf16* PROJ = (const bf16*)(F.ws + WS_PROJ);
    const float* mu = A.in[20] + (size_t)j * B_MIXC; const float* w0 = A.in[21] + (size_t)j * MIX; const float* a0 = A.in[23] + (size_t)j * MIX;
    const float* k_k = A.in[26] + (size_t)j * MIX; const float* k_a = A.in[27] + (size_t)j * MIX; const float* r_k = A.in[28] + (size_t)j * MIX;
    const float* lnx_b = A.in[30] + (size_t)j * MIX;
    const bf16* LW = (const bf16*)(F.ws + WS_LW) + (size_t)j * MIX * LORA_K;
    __syncthreads();
#pragma unroll 2
    for (int itr = 0; itr < 11; ++itr) { const int idx = itr * NTHR + tid;
        if (idx < 64 * 88) { const int t = idx / 88, c4 = idx - t * 88, col = 4 * c4; const int row = r0 + t; const long prow = rw_prev_row(row);
            const f32x4 P = ld_bf4(PROJ + (size_t)row * LDP + B_LORA_OFF + col), Pp = ld_bf4_prev(PROJ, prow, B_LORA_OFF + col);
            const f32x4 m4 = *(const f32x4*)(mu + 4608 + col);
            f32x4 xs = P + (Pp - P) * m4;
            if (col < 64) { xs.x = ftanh(xs.x); xs.y = ftanh(xs.y); xs.z = ftanh(xs.z); xs.w = ftanh(xs.w); }
            else if (col >= 128) { xs.x = fsigmoid(xs.x); xs.y = fsigmoid(xs.y); xs.z = fsigmoid(xs.z); xs.w = fsigmoid(xs.w); }
            *(LAS v2u*)(L + RK_LI + t * 720 + col * 2) = pk4(xs); } }
    for (int i = tid; i < TBYTES / 16; i += NTHR) *(LAS v4u*)(TBUF(7) + i * 16) = (v4u){0u, 0u, 0u, 0u};
#pragma unroll 1
    for (int h = h_lo; h < h_hi; ++h) {
        unsigned char* rec = F.ws + WS_REC + ((size_t)(b * BH + h) * 32 + cidx) * REC_BYTES;
        LDS_BARRIER();
        { const int row = tid >> 3, c8 = tid & 7;
#pragma unroll
          for (int x = 0; x < 3; ++x) { const v4u val = *(const v4u*)(PROJ + (size_t)(r0 + row) * LDP + x * 1536 + h * 64 + c8 * 8);
              *(LAS v4u*)(TBUF(8 + x) + (row + 1) * 128 + c8 * 16) = val; }
          if (tid < 8) { const long prow = rw_prev_row(r0);
#pragma unroll
              for (int x = 0; x < 3; ++x) { v4u val = (v4u){0u, 0u, 0u, 0u}; if (prow >= 0) val = *(const v4u*)(PROJ + (size_t)prow * LDP + x * 1536 + h * 64 + tid * 8);
                  *(LAS v4u*)(TBUF(8 + x) + tid * 16) = val; } } }
        f32x4 aw[2], aa[2], ag[2];
#pragma unroll
        for (int u = 0; u < 2; ++u) { aw[u] = (f32x4){0.f, 0.f, 0.f, 0.f}; aa[u] = aw[u]; ag[u] = aw[u]; }
        { const bf16* lw0 = LW + (size_t)(h * 64 + (2 * jh) * 16 + fr) * LORA_K + q4 * 8; const ldsp li = L + RK_LI + (it * 16 + fr) * 720 + q4 * 16;
#pragma unroll
          for (int ks = 0; ks < 11; ++ks) { const bf16x8 afr = *(LAS bf16x8*)(li + ks * 64);
#pragma unroll
              for (int u = 0; u < 2; ++u) { const bf16x8 bfr = *(const bf16x8*)(lw0 + (size_t)u * 16 * LORA_K + ks * 32);
                  if (ks < 2) aw[u] = MFMA16(afr, bfr, aw[u]); else if (ks < 4) aa[u] = MFMA16(afr, bfr, aa[u]); else ag[u] = MFMA16(afr, bfr, ag[u]); }
          } }
        LDS_BARRIER();
        float xr[2][4], kp[2][4], xv[2][4], dw[2][4], av[2][4], kkr[2][4];
        float nrm[4] = {0.f, 0.f, 0.f, 0.f}, bon[4] = {0.f, 0.f, 0.f, 0.f};
#pragma unroll
        for (int u = 0; u < 2; ++u) { const int c = (2 * jh + u) * 16 + fr, ch = h * 64 + c;
            const float mur = mu[ch], muk = mu[1536 + ch], muv = mu[3072 + ch], w0c = w0[ch], a0c = a0[ch], kkc = k_k[ch], kac = k_a[ch], rkc = r_k[ch];
            float run = 0.f;
#pragma unroll
            for (int e = 0; e < 4; ++e) { const int t = i0 + e;
                const float cr = bf2f(*(LAS unsigned short*)(TBUF(8) + (t + 1) * 128 + c * 2)), ck = bf2f(*(LAS unsigned short*)(TBUF(9) + (t + 1) * 128 + c * 2)), cv = bf2f(*(LAS unsigned short*)(TBUF(10) + (t + 1) * 128 + c * 2));
                const float pr = bf2f(*(LAS unsigned short*)(TBUF(8) + t * 128 + c * 2)), pk = bf2f(*(LAS unsigned short*)(TBUF(9) + t * 128 + c * 2)), pv = bf2f(*(LAS unsigned short*)(TBUF(10) + t * 128 + c * 2));
                const float r_ = cr + (pr - cr) * mur, k_ = ck + (pk - ck) * muk, v_ = cv + (pv - cv) * muv;
                const float x = -(w0c + aw[u][e]);
                const float sp = fmaxf(x, 0.f) + __logf(1.f + __expf(-fabsf(x)));
                const float lw = -__expf(-sp - 0.5f);
                run += lw; dw[u][e] = lw;
                const float a = fsigmoid(a0c + aa[u][e]);
                const float kr_ = k_ * kkc, kp_ = k_ * (1.f + (a - 1.f) * kac);
                xr[u][e] = r_; kp[u][e] = kp_; xv[u][e] = v_; av[u][e] = a; kkr[u][e] = kr_;
                nrm[e] += kr_ * kr_; bon[e] += r_ * kp_ * rkc; }
            ((LAS float*)(L + RK_TOT))[grp * 64 + c] = run; __builtin_amdgcn_sched_barrier(0); }
#pragma unroll
        for (int e = 0; e < 4; ++e) {
#pragma unroll
            for (int m = 1; m < 16; m <<= 1) { nrm[e] += __shfl_xor(nrm[e], m); bon[e] += __shfl_xor(bon[e], m); } }
        if (fr == 0) {
#pragma unroll
            for (int e = 0; e < 4; ++e) { ((LAS float*)(L + RK_XCH))[(w * 2 + 0) * 16 + 4 * q4 + e] = nrm[e]; ((LAS float*)(L + RK_XCH))[(w * 2 + 1) * 16 + 4 * q4 + e] = bon[e]; } }
        LDS_BARRIER();
#pragma unroll
        for (int e = 0; e < 4; ++e) { nrm[e] += ((LAS float*)(L + RK_XCH))[((w ^ 1) * 2 + 0) * 16 + 4 * q4 + e]; bon[e] += ((LAS float*)(L + RK_XCH))[((w ^ 1) * 2 + 1) * 16 + 4 * q4 + e];
            nrm[e] = 1.f / fmaxf(sqrtf(nrm[e]), 1e-12f); }
        f32x4 gbar[2];
#pragma unroll
        for (int u = 0; u < 2; ++u) { const int jt = 2 * jh + u, c = jt * 16 + fr, ch = h * 64 + c;
            float off = 0.f, tot = 0.f;
#pragma unroll
            for (int gp = 0; gp < 16; ++gp) { const float tv = ((LAS float*)(L + RK_TOT))[gp * 64 + c]; tot += tv; off += (gp < grp) ? tv : 0.f; }
            const float lnb = lnx_b[ch];
            f32x4 al, bb, vv4, gv, bv; float cum = off;
#pragma unroll
            for (int e = 0; e < 4; ++e) { const int t = i0 + e;
                cum += dw[u][e];
                const float eW = __expf(cum), eWm = __expf(cum - dw[u][e]), eInv = __expf(-cum), eBar = __expf(tot - cum);
                const float kk = kkr[u][e] * nrm[e], bq = kk * av[u][e];
                const float alpha = kk * eWm, rho = xr[u][e] * eW, beta = bq * eInv, gamma = kp[u][e] * eInv;
                *(LAS unsigned short*)(TBUF(0) + t * 144 + c * 2) = (unsigned short)f2bf(alpha);
                *(LAS unsigned short*)(TBUF(1) + t * 144 + c * 2) = (unsigned short)f2bf(beta);
                *(LAS unsigned short*)(TBUF(2) + t * 144 + c * 2) = (unsigned short)f2bf(gamma);
                *(LAS unsigned short*)(TBUF(3) + t * 144 + c * 2) = (unsigned short)f2bf(rho);
                al[e] = alpha; bb[e] = bq * eBar; gbar[u][e] = kp[u][e] * eBar; vv4[e] = xv[u][e];
                gv[e] = ag[u][e]; bv[e] = (lnb + bon[e] * xv[u][e]) * ag[u][e]; }
            *(LAS v2u*)(TBUF(4) + c * 144 + i0 * 2) = pk4(al);
            *(LAS v2u*)(TBUF(5) + c * 144 + i0 * 2) = pk4(bb);
            *(LAS v2u*)(TBUF(6) + c * 144 + i0 * 2) = pk4(vv4);
            if (grp == 0) ((LAS float*)(L + RK_WC))[c] = __expf(tot);
            const int ti = it * 4 + jt;
            *(v2u*)(rec + 4 * 8192 + (size_t)(ti * 64 + lane) * 8) = pk4(gv);
            *(v2u*)(rec + 5 * 8192 + (size_t)(ti * 64 + lane) * 8) = pk4(bv);
            __builtin_amdgcn_sched_barrier(0); }
        LDS_BARRIER();
        f32x4 n2r[2], etr[2], e2tr[2];
        { int tl_ = lane; asm volatile("" : "+v"(tl_)); const int fr = tl_ & 15, q4 = tl_ >> 4, i0 = it * 16 + 4 * q4; (void)i0;
        { bf16x8 aB[2], aA[2], aG[2];
#pragma unroll
          for (int ks = 0; ks < 2; ++ks) { const int o = (it * 16 + fr) * 144 + ks * 64 + q4 * 16; aA[ks] = *(LAS bf16x8*)(TBUF(0) + o); aB[ks] = *(LAS bf16x8*)(TBUF(1) + o); aG[ks] = *(LAS bf16x8*)(TBUF(2) + o); }
#pragma unroll
          for (int u = 0; u < 2; ++u) { const int jt = 2 * jh + u, jx = jt * 16 + fr;
              f32x4 m1 = (f32x4){0.f, 0.f, 0.f, 0.f}, m2 = m1, n1 = m1, n2 = m1;
#pragma unroll
              for (int ks = 0; ks < 2; ++ks) { const int o = (jt * 16 + fr) * 144 + ks * 64 + q4 * 16;
                  const bf16x8 bA = *(LAS bf16x8*)(TBUF(0) + o), bG = *(LAS bf16x8*)(TBUF(2) + o), bR = *(LAS bf16x8*)(TBUF(3) + o);
                  m1 = MFMA16(aB[ks], bA, m1); m2 = MFMA16(aA[ks], bG, m2); n1 = MFMA16(aB[ks], bR, n1); n2 = MFMA16(aG[ks], bR, n2); }
#pragma unroll
              for (int r = 0; r < 4; ++r) { const int ix = i0 + r; m1[r] = (ix < jx) ? m1[r] : 0.f; m2[r] = (jx < ix) ? m2[r] : 0.f; n1[r] = (ix <= jx) ? n1[r] : 0.f; n2[r] = (ix <= jx) ? n2[r] : 0.f; }
              if (it == jt) {
#pragma unroll
                  for (int r = 0; r < 4; ++r) ((LAS float*)(L + RK_LD))[(it * 16 + 4 * q4 + r) * 16 + fr] = m1[r];
                  m1 = (f32x4){0.f, 0.f, 0.f, 0.f}; }
              st_tileT(TBUF(8), it, jt, fr, q4, m1); st_tileT(TBUF(9), it, jt, fr, q4, m2); st_tileT(TBUF(10), it, jt, fr, q4, n1);
              n2r[u] = n2; } }
        LDS_BARRIER();
        for (int idx = tid; idx < 576; idx += NTHR) { const int row = idx / 9, chn = idx - row * 9; if ((chn >> 1) != (row >> 4)) *(LAS v4u*)(TBUF(2) + row * 144 + chn * 16) = (v4u){0u, 0u, 0u, 0u}; }
        if (w == 0) { const int bI = lane >> 4, cc = lane & 15; const LAS float* Ld = (const LAS float*)(L + RK_LD) + bI * 256;
            float x[16];
#pragma unroll
            for (int s = 15; s >= 0; --s) { float acc = (s == cc) ? 1.f : 0.f;
#pragma unroll
                for (int m = s + 1; m < 16; ++m) acc -= Ld[s * 16 + m] * x[m];
                x[s] = acc; __builtin_amdgcn_sched_barrier(0); }
            v4u o0, o1; o0.x = pk2(x[0], x[1]); o0.y = pk2(x[2], x[3]); o0.z = pk2(x[4], x[5]); o0.w = pk2(x[6], x[7]); o1.x = pk2(x[8], x[9]); o1.y = pk2(x[10], x[11]); o1.z = pk2(x[12], x[13]); o1.w = pk2(x[14], x[15]);
            *(LAS v4u*)(TBUF(7) + (bI * 16 + cc) * 144 + bI * 32) = o0; *(LAS v4u*)(TBUF(7) + (bI * 16 + cc) * 144 + bI * 32 + 16) = o1;
#pragma unroll
            for (int s = 0; s < 16; ++s) *(LAS unsigned short*)(TBUF(2) + (bI * 16 + s) * 144 + (bI * 16 + cc) * 2) = (unsigned short)f2bf(x[s]); }
        LDS_BARRIER();
        }
        { int tl_ = lane; asm volatile("" : "+v"(tl_)); const int fr = tl_ & 15, q4 = tl_ >> 4, i0 = it * 16 + 4 * q4; (void)i0;
#pragma unroll
        for (int u = 0; u < 2; ++u) { const int jt = 2 * jh + u;
            const f32x4 e1 = mm_tile(TBUF(2), TBUF(8), it, jt, fr, q4); st_tileT(TBUF(0), it, jt, fr, q4, e1);
            const f32x4 e2 = mm_tile(TBUF(8), TBUF(2), it, jt, fr, q4); st_tileT(TBUF(1), it, jt, fr, q4, e2); etr[u] = e2; }
        LDS_BARRIER();
#pragma unroll
        for (int u = 0; u < 2; ++u) { const int jt = 2 * jh + u; e2tr[u] = mm_tile(TBUF(0), TBUF(1), it, jt, fr, q4); st_tileT(TBUF(2), it, jt, fr, q4, e2tr[u]); }
        LDS_BARRIER();
#pragma unroll
        for (int u = 0; u < 2; ++u) { const int jt = 2 * jh + u; const f32x4 e3 = mm_tile(TBUF(0), TBUF(2), it, jt, fr, q4);
            f32x4 f = e2tr[u] - etr[u] - e3;
            if (it == jt) {
#pragma unroll
                for (int r = 0; r < 4; ++r) f[r] += (4 * q4 + r == fr) ? 1.f : 0.f; }
            st_tileT(TBUF(8), it, jt, fr, q4, f); }
        LDS_BARRIER();
#pragma unroll
        for (int u = 0; u < 2; ++u) { const int jt = 2 * jh + u; st_tileT(TBUF(2), it, jt, fr, q4, mm_tile(TBUF(8), TBUF(7), it, jt, fr, q4)); }
        LDS_BARRIER();
        }
        { int tl_ = lane; asm volatile("" : "+v"(tl_)); const int fr = tl_ & 15, q4 = tl_ >> 4, i0 = it * 16 + 4 * q4; (void)i0;
#pragma unroll
        for (int u = 0; u < 2; ++u) { const int jt = 2 * jh + u;
            st_tileT(TBUF(0), it, jt, fr, q4, mm_tile(TBUF(2), TBUF(4), it, jt, fr, q4));
            st_tileT(TBUF(1), it, jt, fr, q4, mm_tile(TBUF(2), TBUF(9), it, jt, fr, q4)); }
        LDS_BARRIER();
#pragma unroll
        for (int u = 0; u < 2; ++u) { const int jt = 2 * jh + u;
            const f32x4 g1n = mm_tile(TBUF(0), TBUF(10), it, jt, fr, q4), g2n = mm_tile(TBUF(1), TBUF(10), it, jt, fr, q4);
            const f32x4 g1b = mm_tile(TBUF(0), TBUF(5), it, jt, fr, q4), g2b = mm_tile(TBUF(1), TBUF(5), it, jt, fr, q4);
            const f32x4 rterm = bf4(*(LAS v2u*)(TBUF(3) + (jt * 16 + fr) * 144 + i0 * 2));
            f32x4 q1 = -g1b;
            if (it == jt) { const float wc = ((LAS float*)(L + RK_WC))[jt * 16 + fr];
#pragma unroll
                for (int r = 0; r < 4; ++r) q1[r] += (4 * q4 + r == fr) ? wc : 0.f; }
            st_tileT(TBUF(8), it, jt, fr, q4, rterm - g1n);
            st_tileT(TBUF(9), it, jt, fr, q4, q1);
            st_tileT(TBUF(2), it, jt, fr, q4, n2r[u] - g2n);
            st_tileT(TBUF(4), it, jt, fr, q4, gbar[u] - g2b); }
        LDS_BARRIER();
#pragma unroll
        for (int u = 0; u < 2; ++u) { const int jt = 2 * jh + u, ti = it * 4 + jt;
            *(v2u*)(rec + 2 * 8192 + (size_t)(ti * 64 + lane) * 8) = pk4(mm_tile(TBUF(4), TBUF(6), it, jt, fr, q4));
            *(v2u*)(rec + 3 * 8192 + (size_t)(ti * 64 + lane) * 8) = pk4(mm_tile(TBUF(2), TBUF(6), it, jt, fr, q4)); }
        { const int row = tid >> 3, c8 = tid & 7;
          *(v4u*)(rec + row * 128 + c8 * 16) = *(LAS v4u*)(TBUF(8) + row * 144 + c8 * 16);
          *(v4u*)(rec + 8192 + row * 128 + c8 * 16) = *(LAS v4u*)(TBUF(9) + row * 144 + c8 * 16); }
        }
    }
    __syncthreads();
}

constexpr int CH_S = 0, CH_Q = 9216;
__device__ __forceinline__ void rwkv_chain_unit(Frame& F, int b, int h, float* state_out) {
    const ldsp L = F.lds; const int tid = fresh_tid(), w = __builtin_amdgcn_readfirstlane(tid >> 6), lane = tid & 63, fr = lane & 15, q4 = lane >> 4;
    const int it = w >> 1, jh = w & 1;
    unsigned char* recb = F.ws + WS_REC + ((size_t)(b * BH + h) * 32) * REC_BYTES;
    const int row = tid >> 3, c8 = tid & 7;
    const size_t qoff = 8192 + row * 128 + c8 * 16, uoff0 = 2 * 8192 + (size_t)((it * 4 + 2 * jh) * 64 + lane) * 8, uoff1 = uoff0 + 512, soff = 6 * 8192 + row * 128 + c8 * 16;
    __syncthreads();
    for (int i = tid; i < TBYTES / 16; i += NTHR) *(LAS v4u*)(L + CH_S + i * 16) = (v4u){0u, 0u, 0u, 0u};
    v4u qreg[4]; v2u ureg[4][2];
#pragma unroll
    for (int i = 0; i < 3; ++i) { const unsigned char* rc = recb + (size_t)i * REC_BYTES; qreg[i] = *(const v4u*)(rc + qoff); ureg[i][0] = *(const v2u*)(rc + uoff0); ureg[i][1] = *(const v2u*)(rc + uoff1); }
    f32x4 acc[2];
#pragma unroll 1
    for (int cc = 0; cc < 8; ++cc) {
#pragma unroll
        for (int i = 0; i < 4; ++i) { const int c = 4 * cc + i;
            unsigned char* rec = recb + (size_t)c * REC_BYTES;
            *(LAS v4u*)(L + CH_Q + row * 144 + c8 * 16) = qreg[i];
            const f32x4 uu0 = bf4(ureg[i][0]), uu1 = bf4(ureg[i][1]);
            if (c + 3 < 32) { const unsigned char* rn = rec + 3 * REC_BYTES; const int s3 = (i + 3) & 3;
                qreg[s3] = *(const v4u*)(rn + qoff); ureg[s3][0] = *(const v2u*)(rn + uoff0); ureg[s3][1] = *(const v2u*)(rn + uoff1); }
            LDS_BARRIER();
            *(v4u*)(rec + soff) = *(LAS v4u*)(L + CH_S + row * 144 + c8 * 16);
            acc[0] = uu0 + mm_tile(L + CH_Q, L + CH_S, it, 2 * jh, fr, q4);
            acc[1] = uu1 + mm_tile(L + CH_Q, L + CH_S, it, 2 * jh + 1, fr, q4);
            LDS_BARRIER();
            st_tileT(L + CH_S, it, 2 * jh, fr, q4, acc[0]); st_tileT(L + CH_S, it, 2 * jh + 1, fr, q4, acc[1]); }
    }
#pragma unroll
    for (int u = 0; u < 2; ++u) *(f32x4*)(state_out + (size_t)((2 * jh + u) * 16 + fr) * BHD + it * 16 + 4 * q4) = acc[u];
    __syncthreads();
}

constexpr int RO_STG = 0, RO_LD = 1552;
__device__ __forceinline__ void rwkv_out_unit(Frame& F, const Args& A, int j, int b, int cidx, int h_lo) {
    const ldsp L = F.lds; const int tid = fresh_tid(), w = __builtin_amdgcn_readfirstlane(tid >> 6), lane = tid & 63, fr = lane & 15, q4 = lane >> 4;
    const int it = w & 3, hsel = w >> 2;
    const float* lnx_g = A.in[29] + (size_t)j * MIX;
    bf16* MIXC = (bf16*)(F.ws + WS_MIXC);
    const int r0 = b * SEQ + cidx * 64;
    __syncthreads();
#pragma unroll 1
    for (int hp = 0; hp < 6; ++hp) { const int hl = 2 * hp + hsel, h = h_lo + hl;
        const unsigned char* rec = F.ws + WS_REC + ((size_t)(b * BH + h) * 32 + cidx) * REC_BYTES;
        bf16x8 pa[2];
#pragma unroll
        for (int ks = 0; ks < 2; ++ks) pa[ks] = *(const bf16x8*)(rec + (it * 16 + fr) * 128 + ks * 64 + q4 * 16);
        f32x4 o[4]; float s1[4] = {0.f, 0.f, 0.f, 0.f}, s2[4] = {0.f, 0.f, 0.f, 0.f};
#pragma unroll
        for (int jt = 0; jt < 4; ++jt) { f32x4 acc = bf4(*(const v2u*)(rec + 3 * 8192 + (size_t)((it * 4 + jt) * 64 + lane) * 8));
#pragma unroll
            for (int ks = 0; ks < 2; ++ks) { const bf16x8 sb = *(const bf16x8*)(rec + 6 * 8192 + (jt * 16 + fr) * 128 + ks * 64 + q4 * 16); acc = MFMA16(pa[ks], sb, acc); }
            o[jt] = acc;
#pragma unroll
            for (int r = 0; r < 4; ++r) { s1[r] += acc[r]; s2[r] += acc[r] * acc[r]; } }
#pragma unroll
        for (int r = 0; r < 4; ++r) {
#pragma unroll
            for (int m = 1; m < 16; m <<= 1) { s1[r] += __shfl_xor(s1[r], m); s2[r] += __shfl_xor(s2[r], m); } }
        float mean[4], rstd[4];
#pragma unroll
        for (int r = 0; r < 4; ++r) { mean[r] = s1[r] * (1.f / 64.f); const float var = fmaxf(s2[r] * (1.f / 64.f) - mean[r] * mean[r], 0.f); rstd[r] = 1.f / sqrtf(var + GN_EPS); }
#pragma unroll
        for (int jt = 0; jt < 4; ++jt) { const int vch = jt * 16 + fr; const float lg = lnx_g[h * 64 + vch];
            const f32x4 gv = bf4(*(const v2u*)(rec + 4 * 8192 + (size_t)((it * 4 + jt) * 64 + lane) * 8)), bv = bf4(*(const v2u*)(rec + 5 * 8192 + (size_t)((it * 4 + jt) * 64 + lane) * 8));
#pragma unroll
            for (int r = 0; r < 4; ++r) { const float val = (o[jt][r] - mean[r]) * rstd[r] * lg * gv[r] + bv[r];
                *(LAS unsigned short*)(L + RO_STG + (it * 16 + 4 * q4 + r) * RO_LD + (hl * 64 + vch) * 2) = (unsigned short)f2bf(val); } }
    }
    __syncthreads();
    for (int i = tid; i < 64 * 96; i += NTHR) { const int t = i / 96, c16 = i - t * 96;
        *(v4u*)(MIXC + (size_t)(r0 + t) * D + h_lo * 64 + c16 * 8) = *(LAS v4u*)(L + RO_STG + t * RO_LD + c16 * 16); }
    __syncthreads();
}


constexpr int PH_PER_PAIR = 12, N_PHASES = 1 + 2 * PH_PER_PAIR + 1;
#ifndef MK_N_LAUNCHES
#define MK_N_LAUNCHES 1


#endif
#ifndef PROBE_K
#define PROBE_K 0
#endif
#ifndef PROBE_P0
#define PROBE_P0 0
#endif
#ifndef PROBE_SUB
#define PROBE_SUB 0
#endif

__global__ void __launch_bounds__(NTHR, 2) fwd_kernel(Args args) {
    extern __shared__ __attribute__((aligned(16))) unsigned char lds_raw[];
    Frame F;
    F.lds = (ldsp)lds_raw;
    F.tid = threadIdx.x; F.lane = F.tid & 63; F.wave = __builtin_amdgcn_readfirstlane(F.tid >> 6);
    F.G = gridDim.x; { const int bx = blockIdx.x; F.vcu = (F.G % 8 == 0) ? (bx % 8) * (F.G / 8) + bx / 8 : bx; }
    F.ws = args.ws; F.out = args.out;
    volatile LAS unsigned* MISC = (volatile LAS unsigned*)(F.lds + MISC_OFF);
    for (int u = F.tid; u < (LDS_BYTES - LDSCTL_OFF) / 4; u += NTHR) ((LAS unsigned*)(F.lds + LDSCTL_OFF))[u] = 0u;
    __syncthreads();
    const int lo = args.ph_lo, hi = args.ph_hi;
    const bool multi = (hi - lo) > 1;
    XcdBarrier bar; bar.bar = (unsigned*)(F.ws + WS_CTL) + CW_BAR; bar.x = 0; bar.st = nullptr;
    if (multi) bar = xcd_barrier_post((unsigned*)(F.ws + WS_CTL) + CW_BAR, MISC + 8);
#define IN(k) (lo <= (k) && (k) < hi)
#define SEAM(k) do { if (IN((k) + 1)) xcd_barrier(bar); } while (0)

    bf16* const H = (bf16*)(F.ws + WS_H); bf16* const PROJ = (bf16*)(F.ws + WS_PROJ); bf16* const MIXC = (bf16*)(F.ws + WS_MIXC); bf16* const ACT = (bf16*)(F.ws + WS_ACT);
    float* const X = (float*)(F.ws + WS_X); const float* const Xs = X + (size_t)MP * D;
    const int blk = blockIdx.x;

#define PH(k, ...) if (IN(base + (k))) { __VA_ARGS__ if constexpr (((PROBE_K) >> (k)) & 1) { __VA_ARGS__ } SEAM(base + (k)); }
    if (IN(0)) { p0_prologue(F, args); if constexpr (PROBE_P0) { p0_prologue(F, args); } SEAM(0); }

    for (int j = 0; j < 2; ++j) {
        const int base = 1 + j * PH_PER_PAIR;
        const int la = 2 * j, lb = 2 * j + 1;
        const bf16* const WinA = (const bf16*)(F.ws + WS_WINA + (size_t)j * SZ_WINA); const bf16* const WoutA = (const bf16*)(F.ws + WS_WOUTA + (size_t)j * SZ_WSQ);
        const bf16* const WinB = (const bf16*)(F.ws + WS_WINB + (size_t)j * SZ_WINB); const bf16* const WoutB = (const bf16*)(F.ws + WS_WOUTB + (size_t)j * SZ_WSQ);
        PH(0,
            { unsigned* sflag = (unsigned*)(F.ws + WS_CTL) + CW_SFLAG + 64 * la;
              if (blk >= 256 - SN_BLOCKS) { const int ftw = fresh_tid(); sample_rows_prepare(F, nullptr, nullptr, ss_slot(F.ws, 2 * la), sflag, (blk - (256 - SN_BLOCKS)) * NWAVES + __builtin_amdgcn_readfirstlane(ftw >> 6)); }
              run_gemm_sample(F, H, WinA, A_IN, D, EpiBf<0>{PROJ, LDP, ss_slot(F.ws, 2 * la)}, sflag); }
            if (j == 0) run_gemm(F, (const bf16*)(F.ws + WS_MEMN), (const bf16*)(F.ws + WS_WKV), 1024, 4096, D, EpiMemKV{F.out}, 128);
        )
        PH(1,
            { const float* Kp = F.out + O_MK + (size_t)la * (1024 * 512); const float* Vp = F.out + O_MV + (size_t)la * (1024 * 512);
            if (blk < 96) { const int bh = blk < 48 ? blk : blk - 48, b = bh / AH, h = bh % AH;
                hgrn_prompt_unit(F, PROJ, MIXC, args.in[16], args.in[17] + (size_t)j * MIX, F.out + O_SHP + ((size_t)(j * NB + b) * AH + h) * (AHD * AHD), j, b, h, blk < 48 ? HG_SPLIT : 0, blk < 48 ? SEQ / 64 : HG_SPLIT);
                if (PROBE_SUB == 10) hgrn_prompt_unit(F, PROJ, MIXC, args.in[16], args.in[17] + (size_t)j * MIX, F.out + O_SHP + ((size_t)(j * NB + b) * AH + h) * (AHD * AHD), j, b, h, blk < 48 ? HG_SPLIT : 0, blk < 48 ? SEQ / 64 : HG_SPLIT); }
            else { if (blk < 224) { const int u = blk - 96, b = u >> 5, head = (u >> 3) & 3, qp = u & 7;
                    xattn_prompt_unit(F, PROJ, A_XQ_OFF, MIXC, Kp + (size_t)b * NMEM * XDIM, Vp + (size_t)b * NMEM * XDIM, b, head, qp); }
                const int nw = (F.G - 96) * NWAVES; const int ft = fresh_tid(); F.lane = ft & 63; F.wave = __builtin_amdgcn_readfirstlane(ft >> 6);
                const int prio = blk >= 224 ? blk - 224 : blk - 96 + 32;
                for (int rep14 = 0; rep14 < (PROBE_SUB == 14 ? 2 : 1); ++rep14)
                for (int u = prio * NWAVES + F.wave; u < NSMP * AH + NSMP * XH; u += nw) {
                    if (u < NSMP * AH) { const int b = u / AH, h = u % AH;
                        hgrn_sample_unit(F.lane, PROJ, MIXC, args.in[16], args.in[17] + (size_t)j * MIX, args.in[4] + ((size_t)(j * NSMP + b) * AH + h) * (AHD * AHD),
                                         F.out + O_SHS + ((size_t)(j * NSMP + b) * AH + h) * (AHD * AHD), j, b, h); }
                    else { const int q = u - NSMP * AH, b = q >> 2, head = q & 3;
                        xattn_sample_unit(F.lane, PROJ, A_XQ_OFF, MIXC, args.in[2] + ((size_t)(la * NSMP + b) * NMEM) * XDIM, args.in[3] + ((size_t)(la * NSMP + b) * NMEM) * XDIM, b, head); } } }
            { __syncthreads();
                convert_items_dyn(F, args, args.git[2 + 2 * j], args.git[3 + 2 * j], (unsigned*)(F.ws + WS_CTL) + CW_CQ + 512 * j + 64 * (blk & 7), blk & 7); __syncthreads(); } }
        )
        if (IN(base + 2)) { run_gemm(F, MIXC, WoutA, MP, D, D, EpiResid<false>{X, D, H, ss_slot(F.ws, 2 * la + 1), nullptr}, 0);
              skinny_gemm<0, 2>(F, MIXC + (size_t)MP * D, D, nullptr, WoutA, D, 64 * (blk & 31), (blk >> 5) & 1, 512 * (blk >> 6), 512, X, D, MP); SEAM(base + 2); }
        if (PROBE_SUB == 12 && IN(base + 3)) { run_gemm(F, H, WoutA, MP, D, D, EpiDummy{(float*)PROJ, D}, 0); }
        if (PROBE_SUB == 13 && IN(base + 3)) { run_gemm(F, H, (const bf16*)(F.ws + WS_W1 + (size_t)la * SZ_WFF), MP, 4096, D, EpiDummy{(float*)PROJ, 4096}, 0); }
        PH(3, if (blk & 1) skinny_gemm<1, 1>(F, Xs, D, nullptr, (const bf16*)(F.ws + WS_W1 + (size_t)la * SZ_WFF), D, 64 * (blk >> 1), blk & 1, 0, D, ACT, DFF, MP);
              run_gemm(F, H, (const bf16*)(F.ws + WS_W1 + (size_t)la * SZ_WFF), MP, DFF, D, EpiBf<2>{ACT, DFF, nullptr}, 0);
              if (!(blk & 1)) skinny_gemm<1, 1>(F, Xs, D, nullptr, (const bf16*)(F.ws + WS_W1 + (size_t)la * SZ_WFF), D, 64 * (blk >> 1), blk & 1, 0, D, ACT, DFF, MP);
              if (PROBE_SUB == 5) skinny_gemm<1, 1>(F, Xs, D, nullptr, (const bf16*)(F.ws + WS_W1 + (size_t)la * SZ_WFF), D, 64 * (blk >> 1), blk & 1, 0, D, ACT, DFF, MP); )
        if (IN(base + 4)) { if (PROBE_SUB == 9) run_gemm(F, ACT, (const bf16*)(F.ws + WS_W2 + (size_t)la * SZ_WFF), MP, D, DFF, EpiDummy{(float*)PROJ, D}, 0);
              run_gemm(F, ACT, (const bf16*)(F.ws + WS_W2 + (size_t)la * SZ_WFF), MP, D, DFF, EpiResid<true>{X, D, H, ss_slot(F.ws, 2 * lb), ss_slot(F.ws, 2 * la + 1)}, 0);
              skinny_gemm<0, 2>(F, ACT + (size_t)MP * DFF, DFF, nullptr, (const bf16*)(F.ws + WS_W2 + (size_t)la * SZ_WFF), DFF, 64 * (blk & 31), (blk >> 5) & 1, 2048 * (blk >> 6), 2048, X, D, MP); SEAM(base + 4); }
        PH(5, { unsigned* sflag = (unsigned*)(F.ws + WS_CTL) + CW_SFLAG + 64 * lb;
              if (blk >= 256 - SN_BLOCKS) { const int ftw = fresh_tid(); sample_rows_prepare(F, args.in[6] + (size_t)j * NSMP * D, args.in[8] + (size_t)lb * D, ss_slot(F.ws, 2 * lb), sflag, (blk - (256 - SN_BLOCKS)) * NWAVES + __builtin_amdgcn_readfirstlane(ftw >> 6)); }
              run_gemm_sample_early(F, H, WinB, B_INP, D, EpiBf<0>{PROJ, LDP, ss_slot(F.ws, 2 * lb)}, sflag, (unsigned*)(F.ws + WS_CTL) + CW_PDONE + 64 * j); }
              if (blk >= 192) {
                  const int ft = fresh_tid(); const int ln = ft & 63, gwv = (blk - 192) * NWAVES + __builtin_amdgcn_readfirstlane(ft >> 6);
                  for (int r = gwv; r < NB + NSMP; r += 64 * NWAVES) { const int row = r < NB ? r * SEQ + SEQ - 1 : MP + (r - NB);
                      float* dst = r < NB ? F.out + O_SSP + (size_t)(j * NB + r) * D : F.out + O_SSS + (size_t)(j * NSMP + (r - NB)) * D;
                      norm_row(X + (size_t)row * D, args.in[8] + (size_t)lb * D, ln, nullptr, dst, nullptr, nullptr); } }
              if (blk >= 214) { wait_counter((const unsigned*)(F.ws + WS_CTL) + CW_PDONE + 64 * j, B_INP / 256);
                  const int idx = blk - 214, h0 = idx < 36 ? idx : 36 + 2 * (idx - 36), nh = idx < 36 ? 1 : 2;
                  rwkv_prep_unit(F, args, j, (128 + h0 / 24) * 64, h0 % 24, h0 % 24 + nh); } )
        PH(6,
            rwkv_chunk_unit(F, args, j, blk >> 6, (blk >> 1) & 31, (blk & 1) * 12, (blk & 1) * 12 + 12);
        )
        PH(7,
            { const float* Kp = F.out + O_MK + (size_t)lb * (1024 * 512); const float* Vp = F.out + O_MV + (size_t)lb * (1024 * 512);
            if (blk < 96) { const int b = blk / BH, h = blk % BH; rwkv_chain_unit(F, b, h, F.out + O_SRP + ((size_t)(j * NB + b) * BH + h) * (BHD * BHD));
                if (PROBE_SUB == 7) rwkv_chain_unit(F, b, h, F.out + O_SRP + ((size_t)(j * NB + b) * BH + h) * (BHD * BHD)); }
            else if (blk < 224) { const int u = blk - 96, b = u >> 5, head = (u >> 3) & 3, qp = u & 7;
                    xattn_prompt_unit(F, PROJ, B_XQ_OFF, MIXC, Kp + (size_t)b * NMEM * XDIM, Vp + (size_t)b * NMEM * XDIM, b, head, qp);
                    if (PROBE_SUB == 17) xattn_prompt_unit(F, PROJ, B_XQ_OFF, MIXC, Kp + (size_t)b * NMEM * XDIM, Vp + (size_t)b * NMEM * XDIM, b, head, qp); }
            __syncthreads();
            xattn_sample_pair(F, PROJ, B_XQ_OFF, MIXC, args.in[2] + (size_t)lb * NSMP * NMEM * XDIM, args.in[3] + (size_t)lb * NSMP * NMEM * XDIM, 2 * blk);
            { const int nw = F.G * NWAVES; const int ft = fresh_tid(); F.lane = ft & 63; F.wave = __builtin_amdgcn_readfirstlane(ft >> 6);
              const int prio = blk >= 224 ? blk - 224 : (blk >= 96 ? blk - 96 + 128 : blk + 32);
              for (int u = prio * NWAVES + F.wave; u < NSMP * BH; u += nw) rwkv_sample_unit(F, args, F.lane, j, u / BH, u % BH); } }
        )
        PH(8, rwkv_out_unit(F, args, j, blk >> 6, (blk >> 1) & 31, (blk & 1) * 12); )
        if (IN(base + 9)) { run_gemm(F, MIXC, WoutB, MP, D, D, EpiResid<false>{X, D, H, ss_slot(F.ws, 2 * lb + 1), nullptr}, 0);
               skinny_gemm<0, 2>(F, MIXC + (size_t)MP * D, D, nullptr, WoutB, D, 64 * (blk & 31), (blk >> 5) & 1, 512 * (blk >> 6), 512, X, D, MP); SEAM(base + 9); }
        PH(10, if (blk & 1) skinny_gemm<1, 1>(F, Xs, D, nullptr, (const bf16*)(F.ws + WS_W1 + (size_t)lb * SZ_WFF), D, 64 * (blk >> 1), blk & 1, 0, D, ACT, DFF, MP);
              run_gemm(F, H, (const bf16*)(F.ws + WS_W1 + (size_t)lb * SZ_WFF), MP, DFF, D, EpiBf<2>{ACT, DFF, nullptr}, 0);
              if (!(blk & 1)) skinny_gemm<1, 1>(F, Xs, D, nullptr, (const bf16*)(F.ws + WS_W1 + (size_t)lb * SZ_WFF), D, 64 * (blk >> 1), blk & 1, 0, D, ACT, DFF, MP);
               if (PROBE_SUB == 5) skinny_gemm<1, 1>(F, Xs, D, nullptr, (const bf16*)(F.ws + WS_W1 + (size_t)lb * SZ_WFF), D, 64 * (blk >> 1), blk & 1, 0, D, ACT, DFF, MP); )
        if (IN(base + 11)) { if (PROBE_SUB == 9) run_gemm(F, ACT, (const bf16*)(F.ws + WS_W2 + (size_t)lb * SZ_WFF), MP, D, DFF, EpiDummy{(float*)PROJ, D}, 0);
              run_gemm(F, ACT, (const bf16*)(F.ws + WS_W2 + (size_t)lb * SZ_WFF), MP, D, DFF, EpiResid<true>{X, D, H, ss_slot(F.ws, 2 * lb + 2), ss_slot(F.ws, 2 * lb + 1)}, 0);
               skinny_gemm<0, 2>(F, ACT + (size_t)MP * DFF, DFF, nullptr, (const bf16*)(F.ws + WS_W2 + (size_t)lb * SZ_WFF), DFF, 64 * (blk & 31), (blk >> 5) & 1, 2048 * (blk >> 6), 2048, X, D, MP); SEAM(base + 11); }
    }
    if (IN(N_PHASES - 1)) { norm_phase(F, args, args.in[10], false, true, -1); }
#undef PH
#undef IN
#undef SEAM
}

static int add_job(Job* jobs, int& n, int& items, const float* src, bf16* dst, int ldw, int K, int ncols, int ldt, int koff, int row_off, const float* gain = nullptr) {
    Job J{}; J.src = src; J.dst = dst; J.gain = gain; J.ldw = ldw; J.K = K; J.ncols = ncols; J.ldt = ldt; J.koff = koff; J.row_off = row_off; J.item0 = items; J.pad = 0;
    jobs[n++] = J; items += ((K + 63) / 64) * ((ncols + 63) / 64); return n;
}

extern "C" void kernel_launch(void* const* d_in, const int* in_sizes, int n_in, void* d_out, int out_size, void* d_ws, size_t ws_size, hipStream_t stream) {
    static int ready = 0;
    if (ready == 0) {
        if (n_in != 33 || (size_t)out_size != O_END || ws_size < WS_END) { fprintf(stderr, "kernel_launch: unexpected shapes: n_in %d out %d ws %zu (need %zu)\n", n_in, out_size, ws_size, (size_t)WS_END); ready = -1; return; }
        if (hipFuncSetAttribute((const void*)fwd_kernel, hipFuncAttributeMaxDynamicSharedMemorySize, LDS_BYTES) != hipSuccess) { fprintf(stderr, "kernel_launch: hipFuncSetAttribute failed\n"); ready = -1; return; }
        int per_cu = 0;
        if (hipOccupancyMaxActiveBlocksPerMultiprocessor(&per_cu, (const void*)fwd_kernel, NTHR, LDS_BYTES) != hipSuccess || per_cu < 1) fprintf(stderr, "kernel_launch: occupancy query says %d\n", per_cu);
        (void)hipGetLastError();
        ready = 1;
    }
    if (ready < 0) return;
    unsigned char* ws = (unsigned char*)d_ws;
    (void)hipMemsetAsync(ws + WS_CTL, 0, CTL_BYTES, stream);
    Args a{};
    for (int i = 0; i < 33; ++i) a.in[i] = (const float*)d_in[i];
    a.out = (float*)d_out; a.ws = ws;
    int n = 0, items = 0;
    const float* a_w_in = a.in[14]; const float* a_w_out = a.in[15]; const float* b_w_in = a.in[18]; const float* b_w_out = a.in[19];
    const float* w1 = a.in[31]; const float* w2 = a.in[32]; const float* wk = a.in[12]; const float* wv = a.in[13];
    auto job_a_in = [&](int j) { add_job(a.jobs, n, items, a_w_in + (size_t)j * D * A_IN, (bf16*)(ws + WS_WINA + j * SZ_WINA), A_IN, D, A_IN, D, 0, 0, a.in[8] + (size_t)(2 * j) * D); };
    auto job_a_out = [&](int j) { add_job(a.jobs, n, items, a_w_out + (size_t)j * D * D, (bf16*)(ws + WS_WOUTA + j * SZ_WSQ), D, D, D, D, 0, 0); };
    auto job_b = [&](int j) {
        const float* bw = b_w_in + (size_t)j * D * B_IN; bf16* bd = (bf16*)(ws + WS_WINB + j * SZ_WINB); const float* gB = a.in[8] + (size_t)(2 * j + 1) * D;
        add_job(a.jobs, n, items, bw, bd, B_IN, D, 4608, D, 0, 0, gB);
        add_job(a.jobs, n, items, bw + B_MIXC, bd, B_IN, D, XDIM, D, 0, B_XQ_OFF, gB);
        add_job(a.jobs, n, items, bw + 4608, bd, B_IN, D, LORA_K, D, 0, B_LORA_OFF, gB);
        add_job(a.jobs, n, items, b_w_out + (size_t)j * D * D, (bf16*)(ws + WS_WOUTB + j * SZ_WSQ), D, D, D, D, 0, 0);
        bf16* lw = (bf16*)(ws + WS_LW + j * SZ_LW);
        add_job(a.jobs, n, items, a.in[22] + (size_t)j * 64 * MIX, lw, MIX, 64, MIX, LORA_K, 0, 0);
        add_job(a.jobs, n, items, a.in[24] + (size_t)j * 64 * MIX, lw, MIX, 64, MIX, LORA_K, 64, 0);
        add_job(a.jobs, n, items, a.in[25] + (size_t)j * 224 * MIX, lw, MIX, 224, MIX, LORA_K, 128, 0); };
    auto job_mlp = [&](int l) {
        add_job(a.jobs, n, items, w1 + (size_t)l * D * DFF, (bf16*)(ws + WS_W1 + l * SZ_WFF), DFF, D, DFF, D, 0, 0, a.in[9] + (size_t)l * D);
        add_job(a.jobs, n, items, w2 + (size_t)l * DFF * D, (bf16*)(ws + WS_W2 + l * SZ_WFF), D, DFF, D, DFF, 0, 0); };
    a.git[0] = 0;
    job_a_in(0);
    for (int l = 0; l < 4; ++l) {
        add_job(a.jobs, n, items, wk + (size_t)l * D * XDIM, (bf16*)(ws + WS_WKV + l * SZ_WKV), XDIM, D, XDIM, D, 0, 0);
        add_job(a.jobs, n, items, wv + (size_t)l * D * XDIM, (bf16*)(ws + WS_WKV + l * SZ_WKV), XDIM, D, XDIM, D, 0, XDIM); }
    a.git[1] = items;
    job_a_out(0); job_mlp(0); job_b(0); job_mlp(1); job_a_in(1);
    a.git[3] = items; a.git[2] = a.git[1] + (int)((a.git[3] - a.git[1]) * 0.0f);
    job_a_out(1); job_mlp(2); job_b(1); job_mlp(3);
    a.git[5] = items; a.git[4] = a.git[3] + (int)((a.git[5] - a.git[3]) * 0.0f);
    a.njobs = n; a.nitems = items;
    const int grid = 256;
#if MK_N_LAUNCHES == 1
    a.ph_lo = 0; a.ph_hi = N_PHASES;
    hipLaunchKernelGGL(fwd_kernel, dim3(grid), dim3(NTHR), LDS_BYTES, stream, a);
#else
    for (int p = 0; p < N_PHASES; ++p) { a.ph_lo = p; a.ph_hi = p + 1; hipLaunchKernelGGL(fwd_kernel, dim3(grid), dim3(NTHR), LDS_BYTES, stream, a); }
#endif
    const hipError_t le = hipPeekAtLastError();
    if (le != hipSuccess) fprintf(stderr, "kernel_launch: launch failed: %s\n", hipGetErrorName(le));
}
```

```cpp
#include <hip/hip_runtime.h>
#include <cstdio>
#include <cstdint>
#define MK_N_LAUNCHES 1
#define PROBE_K 0
#define PROBE_P0 0
#define PROBE_SUB 0
namespace pg8 {
#define PG8_LAS __attribute__((address_space(3)))
typedef unsigned short bf16_t;
typedef short bf16x8 __attribute__((ext_vector_type(8)));
typedef float f32x4 __attribute__((ext_vector_type(4)));
typedef unsigned u32x4 __attribute__((ext_vector_type(4)));
constexpr int BM = 256, BK = 64, HALF = 128, HTB = HALF * BK * 2  , STAGE_BYTES = 8 * HTB, NXCD = 8, WGM = 4;

__host__ __device__ __forceinline__ int lds_byte(int r, int c) { const int st = (r >> 4) * 2 + (c >> 5), rr = r & 15, cc = c & 31, ob = rr * 64 + cc * 2; return st * 1024 + (ob ^ (((ob >> 9) & 1) << 5)); }
__host__ __device__ __forceinline__ void stage_rc(int b, int& R, int& C) { const int st = b / 1024, sb = b % 1024, swz = sb ^ (((sb >> 9) & 1) << 5); R = (st >> 1) * 16 + swz / 64; C = (st & 1) * 32 + (swz % 64) / 2; }
__host__ __device__ __forceinline__ int perm32(int rho) { const int n = rho >> 4, i = rho & 15; return 8 * (i >> 2) + 4 * n + (i & 3); }

struct Unit { int pm, pn; };
struct Gemm { const bf16_t* A; const bf16_t* Bt; int M, N, K; };

struct StaticOrder {
    int nM, nN, nwg, G, c;
    __host__ __device__ void init(int M, int N, int G_, int c_) { nM = M / BM; nN = N / BM; nwg = nM * nN; G = G_; c = c_; }
    __host__ __device__ bool next(int i, Unit& u) const {
        const long L = (long)i * G + c; if (L >= nwg) return false;
        int wgid = (int)L; { const int q = nwg / NXCD, r = nwg % NXCD, xcd = wgid % NXCD, off = wgid / NXCD; wgid = (xcd < r ? xcd * (q + 1) : r * (q + 1) + (xcd - r) * q) + off; }
        const int nig = WGM * nN, gid = wgid / nig, fm = gid * WGM, gsz = (nM - fm) < WGM ? (nM - fm) : WGM;
        u.pm = fm + ((wgid % nig) % gsz); u.pn = (wgid % nig) / gsz; return true;
    }
    __device__ __forceinline__ void a_ready(const Unit&) const {}
    __device__ __forceinline__ void done(const Unit&) const {}
};

__device__ __forceinline__ unsigned cvt_pk_bf16(float lo, float hi) { unsigned r; asm volatile("v_cvt_pk_bf16_f32 %0, %1, %2" : "=v"(r) : "v"(lo), "v"(hi)); return r; }
typedef float f32x2 __attribute__((ext_vector_type(2)));
template <class Epi, class Sched, bool ALIGN_EPI = false, bool SP2 = false>
__device__ __forceinline__ void gemm_phase(PG8_LAS unsigned char* lds, const Gemm g, const Sched& S, const Epi& E) {
    int tid_ = threadIdx.x; asm volatile("" : "+v"(tid_));
    const int tid = tid_, wid = __builtin_amdgcn_readfirstlane(tid >> 6), lane = tid & 63, wr = wid >> 2, wc = wid & 3, fr = lane & 15, fq = lane >> 4;
    const int K = g.K, nt = K / BK;
    unsigned voffA[2], voffB[2];
#pragma unroll
    for (int i = 0; i < 2; ++i) { int R, C; stage_rc(tid * 16 + i * 8192, R, C); const int Rb = Epi::PERM ? ((R & ~31) + perm32(R & 31)) : R;
        voffA[i] = (unsigned)(R * K + C) * 2u; voffB[i] = (unsigned)(Rb * K + C) * 2u; }
    const size_t kstep = (size_t)(BK * 2);
    const size_t hstep = (size_t)HALF * K * 2;
    const size_t tstep = 2 * hstep;
    const unsigned ldsw = (unsigned)wid * 1024u;
    const int aoff = lds_byte(wr * 64 + fr, fq * 8), boff = lds_byte(wc * 32 + fr, fq * 8);
#define PG8_SA(b, h) (((b) * 2 + (h)) * HTB)
#define PG8_SB(b, h) ((4 + (b) * 2 + (h)) * HTB)
#define PG8_STAGE(bufoff, gbase, voff) do { _Pragma("unroll") for (int _i = 0; _i < 2; ++_i) \
        __builtin_amdgcn_global_load_lds((const unsigned*)((const char*)(gbase) + (voff)[_i]), (PG8_LAS unsigned*)(lds + (bufoff) + ldsw + _i * 8192), 16, 0, 0); } while (0)
#define PG8_LDA(dst, b, h) do { _Pragma("unroll") for (int m = 0; m < 4; ++m) _Pragma("unroll") for (int k = 0; k < 2; ++k) dst[m][k] = *(const PG8_LAS bf16x8*)(lds + PG8_SA(b, h) + aoff + m * 2048 + k * 1024); } while (0)
#define PG8_LDB(dst, b, h) do { _Pragma("unroll") for (int n = 0; n < 2; ++n) _Pragma("unroll") for (int k = 0; k < 2; ++k) dst[n][k] = *(const PG8_LAS bf16x8*)(lds + PG8_SB(b, h) + boff + n * 2048 + k * 1024); } while (0)
#define PG8_MMA(ai, bj, At, Bt) do { __builtin_amdgcn_s_setprio(1); _Pragma("unroll") for (int m = 0; m < 4; ++m) _Pragma("unroll") for (int n = 0; n < 2; ++n) _Pragma("unroll") for (int k = 0; k < 2; ++k) \
        acc[ai][bj][m][n] = __builtin_amdgcn_mfma_f32_16x16x32_bf16(Bt[n][k], At[m][k], acc[ai][bj][m][n], 0, 0, 0); __builtin_amdgcn_s_setprio(0); } while (0)
#define PG8_WAIT_V(n) asm volatile("s_waitcnt vmcnt(" #n ")" ::: "memory")
#define PG8_WAIT_L(n) asm volatile("s_waitcnt lgkmcnt(" #n ")" ::: "memory")
#define PG8_BAR __builtin_amdgcn_s_barrier()
#define PG8_SCHED __builtin_amdgcn_sched_barrier(0)
    Unit cur, nxt; int ui = 0;
    if (!S.next(0, cur)) return;
    f32x4 acc[2][2][4][2];
#pragma unroll
    for (int a = 0; a < 2; ++a)
#pragma unroll
        for (int b = 0; b < 2; ++b)
#pragma unroll
            for (int m = 0; m < 4; ++m)
#pragma unroll
                for (int n = 0; n < 2; ++n) acc[a][b][m][n] = (f32x4){0.f, 0.f, 0.f, 0.f};
    bf16x8 At[4][2], B0[2][2], B1[2][2];
    const char* cA = (const char*)g.A + (size_t)cur.pm * tstep; const char* cB = (const char*)g.Bt + (size_t)cur.pn * tstep;
    S.a_ready(cur);
    if constexpr (SP2) {
        PG8_STAGE(PG8_SB(0, 0), cB, voffB); PG8_STAGE(PG8_SB(0, 1), cB + hstep, voffB); PG8_STAGE(PG8_SA(0, 0), cA, voffA); PG8_STAGE(PG8_SA(0, 1), cA + hstep, voffA);
        if (wr == 1) PG8_BAR;
        PG8_WAIT_V(2); PG8_BAR;
        PG8_STAGE(PG8_SB(1, 0), cB + kstep, voffB); PG8_STAGE(PG8_SA(1, 0), cA + kstep, voffA); PG8_STAGE(PG8_SB(1, 1), cB + hstep + kstep, voffB);
        PG8_WAIT_V(6); PG8_BAR;
    } else {
        PG8_STAGE(PG8_SB(0, 0), cB, voffB); PG8_STAGE(PG8_SA(0, 0), cA, voffA); PG8_STAGE(PG8_SB(0, 1), cB + hstep, voffB); PG8_STAGE(PG8_SA(0, 1), cA + hstep, voffA);
        if (wr == 1) PG8_BAR;
        PG8_WAIT_V(4); PG8_BAR;
        PG8_STAGE(PG8_SB(1, 0), cB + kstep, voffB); PG8_STAGE(PG8_SA(1, 0), cA + kstep, voffA); PG8_STAGE(PG8_SB(1, 1), cB + hstep + kstep, voffB);
        PG8_WAIT_V(6); PG8_BAR;
    }
    for (;;) {
        const bool has_next = S.next(ui + 1, nxt);
        const char* nA = has_next ? (const char*)g.A + (size_t)nxt.pm * tstep : cA; const char* nB = has_next ? (const char*)g.Bt + (size_t)nxt.pn * tstep : cB;
        for (int t = 0; t < nt; t += 2) {
            const bool last = (t == nt - 2);
            const char* a1 = cA + (size_t)(t + 1) * kstep;
            const char* a2 = last ? nA : cA + (size_t)(t + 2) * kstep; const char* b2 = last ? nB : cB + (size_t)(t + 2) * kstep;
            const char* a3 = a2 + kstep; const char* b3 = b2 + kstep;
            if (last && has_next) S.a_ready(nxt);
            if constexpr (SP2) {
            PG8_LDB(B0, 0, 0); PG8_LDB(B1, 0, 1); PG8_SCHED; PG8_LDA(At, 0, 0); PG8_STAGE(PG8_SA(1, 1), a1 + hstep, voffA);
            PG8_WAIT_V(8); PG8_WAIT_L(0); PG8_BAR; PG8_MMA(0, 0, At, B0); PG8_MMA(0, 1, At, B1); PG8_BAR; PG8_SCHED;
            PG8_LDA(At, 0, 1); PG8_STAGE(PG8_SB(0, 0), b2, voffB); PG8_STAGE(PG8_SB(0, 1), b2 + hstep, voffB); PG8_STAGE(PG8_SA(0, 0), a2, voffA);
            PG8_WAIT_V(8); PG8_WAIT_L(0); PG8_BAR; PG8_MMA(1, 0, At, B0); PG8_MMA(1, 1, At, B1); PG8_BAR; PG8_SCHED;
            PG8_LDB(B0, 1, 0); PG8_LDB(B1, 1, 1); PG8_SCHED; PG8_LDA(At, 1, 0); PG8_STAGE(PG8_SA(0, 1), a2 + hstep, voffA);
            PG8_WAIT_V(8); PG8_WAIT_L(0); PG8_BAR; PG8_MMA(0, 0, At, B0); PG8_MMA(0, 1, At, B1); PG8_BAR; PG8_SCHED;
            PG8_LDA(At, 1, 1); PG8_STAGE(PG8_SB(1, 0), b3, voffB); PG8_STAGE(PG8_SB(1, 1), b3 + hstep, voffB); PG8_STAGE(PG8_SA(1, 0), a3, voffA);
            PG8_WAIT_V(8); PG8_WAIT_L(0); PG8_BAR; PG8_MMA(1, 0, At, B0); PG8_MMA(1, 1, At, B1); PG8_BAR; PG8_SCHED;
            } else {
            PG8_LDB(B0, 0, 0); PG8_SCHED; PG8_LDA(At, 0, 0); PG8_STAGE(PG8_SA(1, 1), a1 + hstep, voffA);
            PG8_WAIT_L(8); PG8_BAR; PG8_WAIT_L(0); PG8_MMA(0, 0, At, B0); PG8_BAR; PG8_SCHED;
            PG8_LDB(B1, 0, 1); PG8_STAGE(PG8_SB(0, 0), b2, voffB);
            PG8_BAR; PG8_WAIT_L(0); PG8_MMA(0, 1, At, B1); PG8_BAR;
            PG8_LDA(At, 0, 1); PG8_STAGE(PG8_SA(0, 0), a2, voffA);
            PG8_BAR; PG8_WAIT_L(0); PG8_MMA(1, 0, At, B0); PG8_BAR; PG8_SCHED;
            PG8_STAGE(PG8_SB(0, 1), b2 + hstep, voffB);
            PG8_WAIT_V(6); PG8_BAR; PG8_MMA(1, 1, At, B1); PG8_BAR;
            PG8_LDB(B0, 1, 0); PG8_SCHED; PG8_LDA(At, 1, 0); PG8_STAGE(PG8_SA(0, 1), a2 + hstep, voffA);
            PG8_WAIT_L(8); PG8_BAR; PG8_WAIT_L(0); PG8_MMA(0, 0, At, B0); PG8_BAR; PG8_SCHED;
            PG8_LDB(B1, 1, 1); PG8_STAGE(PG8_SB(1, 0), b3, voffB);
            PG8_BAR; PG8_WAIT_L(0); PG8_MMA(0, 1, At, B1); PG8_BAR;
            PG8_LDA(At, 1, 1); PG8_STAGE(PG8_SA(1, 0), a3, voffA);
            PG8_BAR; PG8_WAIT_L(0); PG8_MMA(1, 0, At, B0); PG8_BAR; PG8_SCHED;
            PG8_STAGE(PG8_SB(1, 1), b3 + hstep, voffB);
            PG8_WAIT_V(6); PG8_BAR; PG8_MMA(1, 1, At, B1); PG8_BAR;
            }
        }
        if constexpr (ALIGN_EPI) { if (wr == 0) PG8_BAR; }
        if constexpr (!Epi::AFTER_DRAIN) { E(acc, cur, wr, wc, fr, fq); S.done(cur); }
        if (!has_next) break;
#pragma unroll
        for (int a = 0; a < 2; ++a)
#pragma unroll
            for (int b = 0; b < 2; ++b)
#pragma unroll
                for (int m = 0; m < 4; ++m)
#pragma unroll
                    for (int n = 0; n < 2; ++n) acc[a][b][m][n] = (f32x4){0.f, 0.f, 0.f, 0.f};
        cur = nxt; cA = nA; cB = nB; ++ui;
        if constexpr (ALIGN_EPI) { if (wr == 1) PG8_BAR; }
    }
    PG8_WAIT_V(0);
    if constexpr (!ALIGN_EPI) { if (wr == 0) PG8_BAR; }
    PG8_BAR;
    if constexpr (Epi::AFTER_DRAIN) { E.fused(acc, cur, wr, wc, fr, fq, lds, wid, lane); S.done(cur); }
#undef PG8_SA
#undef PG8_SB
#undef PG8_STAGE
#undef PG8_LDA
#undef PG8_LDB
#undef PG8_MMA
#undef PG8_WAIT_V
#undef PG8_WAIT_L
#undef PG8_BAR
#undef PG8_SCHED
}
}


#define GAS __attribute__((address_space(1)))
#define LAS __attribute__((address_space(3)))
typedef unsigned short bf16;
typedef unsigned v4u __attribute__((ext_vector_type(4)));
typedef unsigned v2u __attribute__((ext_vector_type(2)));
typedef float f32x4 __attribute__((ext_vector_type(4)));
typedef float f32x2 __attribute__((ext_vector_type(2)));
typedef short bf16x8 __attribute__((ext_vector_type(8)));
typedef LAS unsigned char* ldsp;

constexpr int NWAVES = 8, NTHR = 512;
constexpr int D = 2048, SEQ = 2048, NB = 4, MP = 8192, NSMP = 128, MR = 8320, MT = 8448;
constexpr int NMEM = 256, XH = 4, XD = 128, XDIM = 512, MIX = 1536;
constexpr int AH = 12, AHD = 128, A_IN = 6656, LDP = 6656;
constexpr int BH = 24, BHD = 64, B_IN = 5472, B_INP = 5632, B_MIXC = 4960;
constexpr int DFF = 8192;
constexpr int LORA_K = 352;
constexpr int A_XQ_OFF = 6144;
constexpr int B_XQ_OFF = 4608;
constexpr int B_LORA_OFF = 5120;
constexpr float RMS_EPS = 1e-6f, GN_EPS = 64e-5f;

constexpr size_t O_YP = 0, O_YS = 16777216, O_MK = 17039360, O_MV = 19136512, O_SHP = 21233664, O_SRP = 22806528,
                 O_SSP = 23592960, O_SHS = 23609344, O_SRS = 73940992, O_SSS = 99106816, O_END = 99631104;

constexpr size_t al256(size_t x) { return (x + 255) & ~(size_t)255; }
constexpr size_t WS_CTL = 0, CTL_BYTES = 1u << 20;
constexpr size_t SZ_WINA = (size_t)A_IN * D * 2, SZ_WSQ = (size_t)D * D * 2, SZ_WINB = (size_t)B_INP * D * 2, SZ_WFF = (size_t)DFF * D * 2,
                 SZ_WKV = (size_t)1024 * D * 2, SZ_LW = (size_t)MIX * LORA_K * 2;
constexpr size_t WS_WINA = WS_CTL + CTL_BYTES;
constexpr size_t WS_WOUTA = WS_WINA + 2 * SZ_WINA;
constexpr size_t WS_WINB = WS_WOUTA + 2 * SZ_WSQ;
constexpr size_t WS_WOUTB = WS_WINB + 2 * SZ_WINB;
constexpr size_t WS_W1 = WS_WOUTB + 2 * SZ_WSQ;
constexpr size_t WS_W2 = WS_W1 + 4 * SZ_WFF;
constexpr size_t WS_WKV = WS_W2 + 4 * SZ_WFF;
constexpr size_t WS_LW = WS_WKV + 4 * SZ_WKV;
constexpr size_t WS_X = al256(WS_LW + 2 * SZ_LW);
constexpr size_t WS_H = WS_X + (size_t)MT * D * 4;
constexpr size_t WS_PROJ = WS_H + (size_t)MT * D * 2;
constexpr size_t WS_MIXC = WS_PROJ + (size_t)MT * LDP * 2;
constexpr size_t WS_ACT = WS_MIXC + (size_t)MT * D * 2;
constexpr size_t WS_MEMN = WS_ACT + (size_t)MT * DFF * 2;
constexpr size_t SZ_RW = (size_t)MT * MIX * 4;
constexpr size_t WS_RR = WS_MEMN + (size_t)1024 * D * 2;
constexpr size_t WS_RK = WS_RR + SZ_RW, WS_RV = WS_RK + SZ_RW, WS_RKK = WS_RV + SZ_RW, WS_RKA = WS_RKK + SZ_RW, WS_RW = WS_RKA + SZ_RW,
                 WS_RG = WS_RW + SZ_RW, WS_RO = WS_RG + SZ_RW;
constexpr size_t WS_BONUS = WS_RO + SZ_RW;
constexpr size_t WS_REC = al256(WS_BONUS + (size_t)MT * BH * 4);
constexpr size_t REC_BYTES = 7 * 8192;
constexpr size_t WS_END = al256(WS_REC + (size_t)NB * BH * 32 * REC_BYTES);

constexpr int CW_BAR = 4096;
constexpr int CW_CQ = 3072;
constexpr int CW_PDONE = 2560;
#ifndef HG_SPLIT
#define HG_SPLIT 16
#endif
constexpr int CW_SFLAG = 2048;
constexpr size_t CTL_SS = 65536;
typedef unsigned long long u64;
constexpr float SS_FIX = 1048576.f, SS_UNFIX = 1.f / 1048576.f;
__device__ __forceinline__ u64* ss_slot(unsigned char* ws, int s) { return (u64*)(ws + WS_CTL + CTL_SS) + (size_t)s * MT; }

constexpr int RING_BYTES = 159744, LDSCTL_OFF = RING_BYTES, MISC_OFF = LDSCTL_OFF + 320, LDS_BYTES = RING_BYTES + 1024;

#define LDS_WAIT() asm volatile("s_waitcnt lgkmcnt(0)" ::: "memory")
#define LDS_BARRIER() do { asm volatile("s_waitcnt lgkmcnt(0)" ::: "memory"); __builtin_amdgcn_s_barrier(); asm volatile("" ::: "memory"); } while (0)
#define VM_WAIT() asm volatile("s_waitcnt vmcnt(0)" ::: "memory")
typedef __bf16 bf16x2_t __attribute__((ext_vector_type(2)));
__device__ __forceinline__ unsigned pk2_hw(float lo, float hi) { f32x2 v = {lo, hi}; const bf16x2_t b = __builtin_convertvector(v, bf16x2_t); return __builtin_bit_cast(unsigned, b); }
__device__ __forceinline__ unsigned f2bf(float f) { return (__builtin_bit_cast(unsigned, f) + 0x8000u) >> 16; }
__device__ __forceinline__ unsigned pk2(float lo, float hi) { return __builtin_amdgcn_perm(__builtin_bit_cast(unsigned, hi) + 0x8000u, __builtin_bit_cast(unsigned, lo) + 0x8000u, 0x07060302u); }
__device__ __forceinline__ float bf2f(unsigned short b) { return __builtin_bit_cast(float, ((unsigned)b) << 16); }
__device__ __forceinline__ float bflo(unsigned w) { return __builtin_bit_cast(float, w << 16); }
__device__ __forceinline__ float bfhi(unsigned w) { return __builtin_bit_cast(float, w & 0xffff0000u); }
__device__ __forceinline__ f32x4 bf4(v2u w) { return (f32x4){bflo(w.x), bfhi(w.x), bflo(w.y), bfhi(w.y)}; }
__device__ __forceinline__ v2u pk4(f32x4 v) { v2u r; r.x = pk2(v.x, v.y); r.y = pk2(v.z, v.w); return r; }
__device__ __forceinline__ float wave_sum(float v) {
#pragma unroll
    for (int o = 1; o < 64; o <<= 1) v += __shfl_xor(v, o);
    return v;
}
__device__ __forceinline__ float wave_max(float v) {
#pragma unroll
    for (int o = 1; o < 64; o <<= 1) v = fmaxf(v, __shfl_xor(v, o));
    return v;
}
__device__ __forceinline__ float fsigmoid(float x) { return __builtin_amdgcn_rcpf(1.f + __expf(-x)); }
__device__ __forceinline__ int sw128(int r, int c) { return r * 256 + ((c ^ (r & 15)) << 4); }
__device__ __forceinline__ int sw64(int r, int c) { return r * 128 + ((c ^ ((r >> 1) & 7)) << 4); }
__device__ __forceinline__ int sw256(int r, int c) { return r * 512 + ((c ^ (r & 15)) << 4); }
#define MFMA16(a, b, c) __builtin_amdgcn_mfma_f32_16x16x32_bf16((a), (b), (c), 0, 0, 0)

#define XB_TMO      128
#define XB_XCNT(j)  (256  + 64 * (j))
#define XB_XSUB(j)  (1280 + 64 * (j))
#define XB_XGEN(j)  (2304 + 64 * (j))
#define XB_TOP      3328
#define XB_TOPGEN   3392
#define XCD_BAR_WORDS 3456
#define XB_SPIN_CAP (1u << 18)
__device__ __forceinline__ unsigned xb_ld(unsigned* p)              { return __hip_atomic_load(p, __ATOMIC_RELAXED, __HIP_MEMORY_SCOPE_AGENT); }
__device__ __forceinline__ unsigned xb_add(unsigned* p, unsigned v) { return __hip_atomic_fetch_add(p, v, __ATOMIC_RELAXED, __HIP_MEMORY_SCOPE_AGENT); }
__device__ __forceinline__ unsigned xb_xcc_id() { return (unsigned)__builtin_amdgcn_s_getreg((3 << 11) | 20) & 0xFu; }
#define XB_SPIN(cond, bar) do { unsigned _sp = 0; while (cond) { __builtin_amdgcn_s_sleep(1); \
    if ((++_sp & 255u) == 0u) { if (xb_ld(&(bar)[XB_TMO])) break; if (_sp > XB_SPIN_CAP) { atomicAdd(&(bar)[XB_TMO], 1u); break; } } } } while (0)
struct XcdBarrier { unsigned* bar; unsigned x; volatile LAS unsigned* st; };
__device__ __forceinline__ XcdBarrier xcd_barrier_post(unsigned* bar, volatile LAS unsigned* st) {
    XcdBarrier b; b.bar = bar; b.x = xb_xcc_id(); b.st = st;
    if (threadIdx.x == 0) (void)xb_add(&bar[XB_XCNT(b.x)], 1u);
    return b;
}
__device__ __forceinline__ void xcd_barrier_complete(unsigned* bar, unsigned x, unsigned& nloc, unsigned& nx) {
    const unsigned G = gridDim.x * gridDim.y * gridDim.z;
    unsigned sum, cnt, mine, sp = 0u;
    for (;;) {
        sum = 0u; cnt = 0u; mine = 0u;
#pragma unroll
        for (unsigned j = 0; j < 16; ++j) { const unsigned c = xb_ld(&bar[XB_XCNT(j)]); sum += c; cnt += (c > 0u) ? 1u : 0u; mine = (j == x) ? c : mine; }
        if (sum == G) break;
        __builtin_amdgcn_s_sleep(1);
        if ((++sp & 255u) == 0u) { if (xb_ld(&bar[XB_TMO])) break; if (sp > XB_SPIN_CAP) { atomicAdd(&bar[XB_TMO], 1u); break; } }
    }
    nloc = mine > 0u ? mine : 1u; nx = cnt > 0u ? cnt : 1u;
}
__device__ __forceinline__ void xcd_barrier(const XcdBarrier& b) {
    asm volatile("s_waitcnt vmcnt(0)" ::: "memory");
    __syncthreads();
    if (threadIdx.x == 0) {
        unsigned* bar = b.bar;
        __builtin_amdgcn_s_waitcnt(0);
        unsigned nloc = b.st[0], nx = b.st[1];
        if (nloc == 0u) { xcd_barrier_complete(bar, b.x, nloc, nx); b.st[0] = nloc; b.st[1] = nx; }
        const unsigned old = xb_add(&bar[XB_XSUB(b.x)], 1u);
        const unsigned gen = old / nloc;
        if (old + 1u == (gen + 1u) * nloc) {
            __builtin_amdgcn_fence(__ATOMIC_RELEASE, "agent");
            asm volatile("s_waitcnt vmcnt(0)" ::: "memory");
            const unsigned og = xb_add(&bar[XB_TOP], 1u);
            const unsigned tg = og / nx;
            if (og + 1u == (tg + 1u) * nx) xb_add(&bar[XB_TOPGEN], 1u);
            else XB_SPIN(xb_ld(&bar[XB_TOPGEN]) == tg, bar);
            __builtin_amdgcn_fence(__ATOMIC_ACQUIRE, "agent");
            xb_add(&bar[XB_XGEN(b.x)], 1u);
            asm volatile("s_waitcnt vmcnt(0)" ::: "memory");
        } else {
            XB_SPIN(xb_ld(&bar[XB_XGEN(b.x)]) == gen, bar);
            __builtin_amdgcn_fence(__ATOMIC_ACQUIRE, "agent");
            asm volatile("s_waitcnt vmcnt(0)" ::: "memory");
        }
    }
    __syncthreads();
}

__device__ __forceinline__ float atomic_add_agent(float* p, float v) { return __hip_atomic_fetch_add(p, v, __ATOMIC_RELAXED, __HIP_MEMORY_SCOPE_AGENT); }
template <int ACT> struct EpiBf {
    static constexpr bool PERM = true, AFTER_DRAIN = false;
    bf16* O; int ldc; const u64* ss;
    __device__ __forceinline__ void operator()(const pg8::f32x4 (&acc)[2][2][4][2], const pg8::Unit& u, int wr, int wc, int fr, int fq) const {
        const int row0 = u.pm * 256 + wr * 64 + fr, col0 = u.pn * 256 + wc * 32 + 8 * fq;
#pragma unroll
        for (int ai = 0; ai < 2; ++ai)
#pragma unroll
            for (int m = 0; m < 4; ++m) { const int row = row0 + ai * 128 + m * 16; bf16* rowp = O + (size_t)row * ldc + col0;
                const float rs = (ACT == 2) ? 1.f : __builtin_amdgcn_rsqf((float)ss[row] * (SS_UNFIX / D) + RMS_EPS);
#pragma unroll
                for (int bj = 0; bj < 2; ++bj) { pg8::f32x4 v0 = acc[ai][bj][m][0] * rs, v1 = acc[ai][bj][m][1] * rs;
                    if (ACT >= 1) {
#pragma unroll
                        for (int q = 0; q < 4; ++q) { const float a = fmaxf(v0[q], 0.f), b = fmaxf(v1[q], 0.f); v0[q] = a * a; v1[q] = b * b; } }
                    pg8::u32x4 w; w.x = pg8::cvt_pk_bf16(v0[0], v0[1]); w.y = pg8::cvt_pk_bf16(v0[2], v0[3]); w.z = pg8::cvt_pk_bf16(v1[0], v1[1]); w.w = pg8::cvt_pk_bf16(v1[2], v1[3]);
                    *(pg8::u32x4*)(rowp + bj * 128) = w; }
                __builtin_amdgcn_sched_barrier(0); }
    }
};
template <bool SCL> struct EpiResid {
    static constexpr bool PERM = false, AFTER_DRAIN = false;
    float* X; int ldc; bf16* Hb; u64* ssq; const u64* scl;
    __device__ __forceinline__ void operator()(const pg8::f32x4 (&acc)[2][2][4][2], const pg8::Unit& u, int wr, int wc, int fr, int fq) const {
        const int row0 = u.pm * 256 + wr * 64 + fr, col0 = u.pn * 256 + wc * 32 + 4 * fq; u64 rets[8];
#pragma unroll
        for (int ai = 0; ai < 2; ++ai) {
            pg8::f32x4 xin[4][4]; float r2v[4];
#pragma unroll
            for (int m = 0; m < 4; ++m) { const int row = row0 + ai * 128 + m * 16; const float* rowp = X + (size_t)row * ldc + col0;
                r2v[m] = SCL ? (float)scl[row] : 0.f;
#pragma unroll
                for (int q = 0; q < 4; ++q) xin[m][q] = *(const pg8::f32x4*)(rowp + (q >> 1) * 128 + (q & 1) * 16); }
            __builtin_amdgcn_sched_barrier(0);
#pragma unroll
            for (int m = 0; m < 4; ++m) { const int row = row0 + ai * 128 + m * 16; float* rowp = X + (size_t)row * ldc + col0; bf16* hp = Hb + (size_t)row * ldc + col0;
                const float r2 = SCL ? __builtin_amdgcn_rcpf(r2v[m] * (SS_UNFIX / D) + RMS_EPS) : 1.f;
                float s = 0.f;
#pragma unroll
                for (int bj = 0; bj < 2; ++bj)
#pragma unroll
                    for (int n = 0; n < 2; ++n) { const pg8::f32x4 x = xin[m][bj * 2 + n] + acc[ai][bj][m][n] * r2; *(pg8::f32x4*)(rowp + bj * 128 + n * 16) = x;
                        v2u hw; hw.x = pg8::cvt_pk_bf16(x[0], x[1]); hw.y = pg8::cvt_pk_bf16(x[2], x[3]); *(v2u*)(hp + bj * 128 + n * 16) = hw;
                        s += (x[0] * x[0] + x[1] * x[1]) + (x[2] * x[2] + x[3] * x[3]); }
                s += __shfl_xor(s, 16); s += __shfl_xor(s, 32);
                rets[ai * 4 + m] = 0;
                if (fq == 0) rets[ai * 4 + m] = __hip_atomic_fetch_add(ssq + row, (u64)(s * SS_FIX + 0.5f), __ATOMIC_RELAXED, __HIP_MEMORY_SCOPE_AGENT); }
            __builtin_amdgcn_sched_barrier(0); }
#pragma unroll
        for (int g = 0; g < 8; ++g) asm volatile("" :: "v"(rets[g]));
    }
};
struct EpiMemKV {
    static constexpr bool PERM = false, AFTER_DRAIN = false;
    float* out;
    __device__ __forceinline__ void operator()(const pg8::f32x4 (&acc)[2][2][4][2], const pg8::Unit& u, int wr, int wc, int fr, int fq) const {
        const int layer = u.pn >> 2, kv = (u.pn >> 1) & 1, c0 = (u.pn & 1) * 256 + wc * 32 + 4 * fq;
        float* base = out + (kv ? O_MV : O_MK) + (size_t)layer * (1024 * 512);
        const int row0 = u.pm * 256 + wr * 64 + fr;
#pragma unroll
        for (int ai = 0; ai < 2; ++ai)
#pragma unroll
            for (int m = 0; m < 4; ++m) { float* rowp = base + (size_t)(row0 + ai * 128 + m * 16) * 512 + c0;
#pragma unroll
                for (int bj = 0; bj < 2; ++bj)
#pragma unroll
                    for (int n = 0; n < 2; ++n) *(pg8::f32x4*)(rowp + bj * 128 + n * 16) = acc[ai][bj][m][n]; }
    }
};
struct EpiDummy {
    static constexpr bool PERM = false, AFTER_DRAIN = false;
    float* C; int ldc;
    __device__ __forceinline__ void operator()(const pg8::f32x4 (&acc)[2][2][4][2], const pg8::Unit& u, int wr, int wc, int fr, int fq) const {
        const int row0 = u.pm * 256 + wr * 64 + fr, col0 = u.pn * 256 + wc * 32 + 4 * fq;
#pragma unroll
        for (int ai = 0; ai < 2; ++ai)
#pragma unroll
            for (int m = 0; m < 4; ++m) { float* rowp = C + (size_t)(row0 + ai * 128 + m * 16) * ldc + col0;
#pragma unroll
                for (int bj = 0; bj < 2; ++bj)
#pragma unroll
                    for (int n = 0; n < 2; ++n) *(pg8::f32x4*)(rowp + bj * 128 + n * 16) = acc[ai][bj][m][n]; }
    }
};
struct RotOrder : pg8::StaticOrder {};

struct Job { const float* src; bf16* dst; const float* gain; int ldw, K, ncols, ldt, koff, row_off, item0, pad; };
constexpr int NJOBS = 34;
struct Args { const float* in[33]; float* out; unsigned char* ws; Job jobs[NJOBS]; int git[6]; int njobs, nitems, ph_lo, ph_hi, pad2[2]; };

__device__ __forceinline__ int fresh_tid() { int t = threadIdx.x; asm volatile("" : "+v"(t)); return t; }
struct Frame {
    ldsp lds;
    int tid, lane, wave, G, vcu;
    unsigned char* ws; float* out;
};


__device__ __forceinline__ void norm_row(const float* src, const float* g, int lane, bf16* hdst, float* fdst, float* xcopy, float* f2) {
    const f32x4* xr = (const f32x4*)src + lane; const f32x4* gr = (const f32x4*)g + lane;
    f32x4 v[8]; float s = 0.f;
#pragma unroll
    for (int j = 0; j < 8; ++j) { v[j] = xr[64 * j]; s += (v[j].x * v[j].x + v[j].y * v[j].y) + (v[j].z * v[j].z + v[j].w * v[j].w); }
    s = wave_sum(s);
    const float rstd = 1.f / sqrtf(s * (1.f / D) + RMS_EPS);
    f32x4 gv[8];
#pragma unroll
    for (int j = 0; j < 8; ++j) gv[j] = gr[64 * j];
    if (xcopy) {
#pragma unroll
        for (int j = 0; j < 8; ++j) ((f32x4*)xcopy + lane)[64 * j] = v[j]; }
#pragma unroll
    for (int j = 0; j < 8; ++j) { const f32x4 y = v[j] * rstd * gv[j];
        if (hdst) ((v2u*)hdst + lane)[64 * j] = pk4(y);
        if (fdst) ((f32x4*)fdst + lane)[64 * j] = y;
        if (f2) ((f32x4*)f2 + lane)[64 * j] = y; }
}

__device__ __forceinline__ void norm_phase(Frame& F0, const Args& A, const float* g, bool first, bool final, int shift_j) {
    Frame F = F0; F.tid = fresh_tid(); F.lane = F.tid & 63; F.wave = __builtin_amdgcn_readfirstlane(F.tid >> 6);
    const int gw = F.vcu * NWAVES + F.wave, NGW = F.G * NWAVES;
    float* X = (float*)(F.ws + WS_X); bf16* H = (bf16*)(F.ws + WS_H);
    for (int row = gw; row < MR; row += NGW) {
        const float* src = first ? (row < MP ? A.in[0] + (size_t)row * D : A.in[1] + (size_t)(row - MP) * D) : X + (size_t)row * D;
        float* f2 = nullptr;
        if (shift_j >= 0) {
            if (row < MP) { if ((row & (SEQ - 1)) == SEQ - 1) f2 = F.out + O_SSP + (size_t)(shift_j * NB + (row >> 11)) * D; }
            else f2 = F.out + O_SSS + (size_t)(shift_j * NSMP + (row - MP)) * D;
        }
        norm_row(src, g, F.lane, final ? nullptr : H + (size_t)row * D, final ? F.out + O_YP + (size_t)row * D : nullptr, first ? X + (size_t)row * D : nullptr, f2);
    }
    if (shift_j >= 0) {
        const float* sh = A.in[6] + (size_t)shift_j * NSMP * D;
        for (int r = gw; r < NSMP; r += NGW) { const f32x4* xr = (const f32x4*)(sh + (size_t)r * D) + F.lane; v2u* o = (v2u*)(H + (size_t)(MR + r) * D) + F.lane;
#pragma unroll
            for (int j = 0; j < 8; ++j) o[64 * j] = pk4(xr[64 * j]); }
    }
}

struct CvtMeta { int j, k0, n0, hg; };
__device__ __forceinline__ CvtMeta cvt_load(const Args& A, int it, int lane, f32x4 (&v0)[8], f32x4 (&v1)[8], float (&g0)[8], float (&g1)[8]) {
    int j = 0;
    for (int q = 1; q < A.njobs; ++q) if (it >= A.jobs[q].item0) j = q;
    const Job& J = A.jobs[j]; const int item = it - J.item0;
    const int nblk = (J.ncols + 63) / 64, kb = item / nblk, nb = item - kb * nblk, k0 = 64 * kb, n0 = 64 * nb;
    const int n4 = 4 * (lane & 15), kp = lane >> 4; const float* gp = J.gain ? J.gain : J.src;
    const int nc = min(n0 + n4, J.ncols - 4);
#pragma unroll
    for (int i = 0; i < 8; ++i) { const int k = min(k0 + 8 * i + 2 * kp, J.K - 2);
        v0[i] = *(const f32x4*)(J.src + (size_t)k * J.ldw + nc);
        v1[i] = *(const f32x4*)(J.src + (size_t)(k + 1) * J.ldw + nc);
        g0[i] = gp[k]; g1[i] = gp[k + 1]; }
    return CvtMeta{j, k0, n0, J.gain != nullptr ? 1 : 0};
}
__device__ __forceinline__ void convert_items(Frame& F, const Args& A, int it_lo, int it_hi, int wk, int nworkers) {
    const int tid = fresh_tid(), lane = tid & 63, w = __builtin_amdgcn_readfirstlane(tid >> 6);
    LAS unsigned* scr = (LAS unsigned*)(F.lds + w * 8448);
    const int n4 = 4 * (lane & 15), kp = lane >> 4, c = lane & 7;
    f32x4 v0[8], v1[8]; float g0[8], g1[8]; CvtMeta m{0, 0, 0, 0};
    int it = it_lo + wk;
    if (it < it_hi) m = cvt_load(A, it, lane, v0, v1, g0, g1);
    while (it < it_hi) {
#pragma unroll
        for (int i = 0; i < 8; ++i) { LAS unsigned* s = scr + n4 * 33 + 4 * i + kp; const f32x4 x0 = v0[i] * (m.hg ? g0[i] : 1.f), x1 = v1[i] * (m.hg ? g1[i] : 1.f);
            s[0] = pk2(x0.x, x1.x); s[33] = pk2(x0.y, x1.y); s[66] = pk2(x0.z, x1.z); s[99] = pk2(x0.w, x1.w); }
        const CvtMeta cur = m; const int nxt = it + nworkers;
        if (nxt < it_hi) m = cvt_load(A, nxt, lane, v0, v1, g0, g1);
        LDS_WAIT(); asm volatile("" ::: "memory");
        const Job& J = A.jobs[cur.j];
        if (cur.k0 + 8 * c < J.K) {
#pragma unroll
            for (int jn = 0; jn < 8; ++jn) { const int n = jn * 8 + (lane >> 3); const LAS unsigned* s = scr + n * 33 + 4 * c;
                v4u o; o.x = s[0]; o.y = s[1]; o.z = s[2]; o.w = s[3];
                if (cur.n0 + n < J.ncols) *(v4u*)(J.dst + (size_t)(J.row_off + cur.n0 + n) * J.ldt + J.koff + cur.k0 + 8 * c) = o; } }
        LDS_WAIT(); asm volatile("" ::: "memory");
        it = nxt;
    }
}
__device__ __forceinline__ void cvt_store(const Args& A, const CvtMeta cur, LAS unsigned* scr, int lane, int c) {
    const Job& J = A.jobs[cur.j];
    if (cur.k0 + 8 * c < J.K) {
#pragma unroll
        for (int jn = 0; jn < 8; ++jn) { const int n = jn * 8 + (lane >> 3); const LAS unsigned* s = scr + n * 33 + 4 * c;
            v4u o; o.x = s[0]; o.y = s[1]; o.z = s[2]; o.w = s[3];
            if (cur.n0 + n < J.ncols) *(v4u*)(J.dst + (size_t)(J.row_off + cur.n0 + n) * J.ldt + J.koff + cur.k0 + 8 * c) = o; } }
}
__device__ __forceinline__ void convert_items_dyn(Frame& F, const Args& A, int it_lo, int it_hi, unsigned* ctr, int q) {
    const int tid = fresh_tid(), lane = tid & 63, w = __builtin_amdgcn_readfirstlane(tid >> 6);
    LAS unsigned* scr = (LAS unsigned*)(F.lds + w * 8448);
    const int n4 = 4 * (lane & 15), kp = lane >> 4, c = lane & 7;
    f32x4 v0[8], v1[8]; float g0[8], g1[8]; CvtMeta m{0, 0, 0, 0};
    unsigned av = 0u;
    if (lane == 0) av = __hip_atomic_fetch_add(ctr, 2u, __ATOMIC_RELAXED, __HIP_MEMORY_SCOPE_AGENT);
    const int first = (int)__builtin_amdgcn_readfirstlane(av);
    int it = it_lo + 2 * (8 * first + q), tnext = first + 1;
    if (lane == 0) av = __hip_atomic_fetch_add(ctr, 1u, __ATOMIC_RELAXED, __HIP_MEMORY_SCOPE_AGENT);
    if (it < it_hi) m = cvt_load(A, it, lane, v0, v1, g0, g1);
    while (it < it_hi) {
#pragma unroll
        for (int i = 0; i < 8; ++i) { LAS unsigned* s = scr + n4 * 33 + 4 * i + kp; const f32x4 x0 = v0[i] * (m.hg ? g0[i] : 1.f), x1 = v1[i] * (m.hg ? g1[i] : 1.f);
            s[0] = pk2(x0.x, x1.x); s[33] = pk2(x0.y, x1.y); s[66] = pk2(x0.z, x1.z); s[99] = pk2(x0.w, x1.w); }
        const CvtMeta cur = m;
        int nxt;
        if (((it - it_lo) & 1) == 0) nxt = it + 1;
        else { nxt = it_lo + 2 * (8 * tnext + q);
            tnext = (int)__builtin_amdgcn_readfirstlane(av);
            if (lane == 0) av = __hip_atomic_fetch_add(ctr, 1u, __ATOMIC_RELAXED, __HIP_MEMORY_SCOPE_AGENT); }
        if (nxt < it_hi) m = cvt_load(A, nxt, lane, v0, v1, g0, g1);
        LDS_WAIT(); asm volatile("" ::: "memory");
        cvt_store(A, cur, scr, lane, c);
        LDS_WAIT(); asm volatile("" ::: "memory");
        it = nxt;
    }
}
__device__ __forceinline__ void p0_prologue(Frame& F0, const Args& A) {
    Frame F = F0; F.tid = fresh_tid(); F.lane = F.tid & 63; F.wave = __builtin_amdgcn_readfirstlane(F.tid >> 6);
    const int gw = F.vcu * NWAVES + F.wave, NGW = F.G * NWAVES;
    convert_items(F, A, 0, A.git[1], gw, NGW);
    for (int jj = 0; jj < 2; ++jj) { v4u* z = (v4u*)(F.ws + WS_WINB + jj * SZ_WINB + (size_t)B_IN * D * 2); const int n16 = (B_INP - B_IN) * D * 2 / 16;
        for (int i = gw * 64 + F.lane; i < n16; i += NGW * 64) z[i] = (v4u){0u, 0u, 0u, 0u}; }
    bf16* MEMN = (bf16*)(F.ws + WS_MEMN);
    for (int row = gw; row < NB * NMEM; row += NGW) norm_row(A.in[7] + (size_t)row * D, A.in[11], F.lane, MEMN + (size_t)row * D, nullptr, nullptr, nullptr);
    { float* X = (float*)(F.ws + WS_X); bf16* H = (bf16*)(F.ws + WS_H); u64* ss0 = ss_slot(F.ws, 0);
      for (int row = gw; row < MR; row += NGW) {
          const float* src = row < MP ? A.in[0] + (size_t)row * D : A.in[1] + (size_t)(row - MP) * D;
          const f32x4* xr = (const f32x4*)src + F.lane; float s = 0.f;
          f32x4 vr[8];
#pragma unroll
          for (int jj = 0; jj < 8; ++jj) vr[jj] = xr[64 * jj];
#pragma unroll
          for (int jj = 0; jj < 8; ++jj) { const f32x4 v = vr[jj]; s += (v.x * v.x + v.y * v.y) + (v.z * v.z + v.w * v.w);
              ((f32x4*)(X + (size_t)row * D) + F.lane)[64 * jj] = v; ((v2u*)(H + (size_t)row * D) + F.lane)[64 * jj] = pk4(v); }
          s = wave_sum(s); if (F.lane == 0) ss0[row] = (u64)(s * SS_FIX + 0.5f); } }
}

#ifndef GEMM_ALIGN
#define GEMM_ALIGN true
#endif
#ifndef GEMM_SP2
#define GEMM_SP2 true
#endif
template <class Epi> __device__ __forceinline__ void run_gemm(Frame& F, const bf16* Am, const bf16* Bt, int M, int N, int K, const Epi& E, int rot) {
    pg8::Gemm g{Am, Bt, M, N, K}; pg8::StaticOrder S; S.init(M, N, F.G, (int)((blockIdx.x + rot) % F.G));
    pg8::gemm_phase<Epi, pg8::StaticOrder, GEMM_ALIGN, GEMM_SP2>(F.lds, g, S, E);
}

constexpr int SK_RED = 0, SK_SSQ = 131072;
template <int AMODE, int EMODE> __device__ __forceinline__ void skinny_gemm(Frame& F, const void* Aptr, int lda, const float* gain, const bf16* Bt, int ldb, int n0, int rh, int k0, int klen, void* outp, int ldc, int orow0) {
    const ldsp L = F.lds; const int tid = fresh_tid(), w = __builtin_amdgcn_readfirstlane(tid >> 6), lane = tid & 63, fr = lane & 15, q4 = lane >> 4;
    const int kw = klen >> 3, kb = k0 + w * kw, nks = kw >> 5;
    f32x4 acc[4][4]; float ssq[4];
#pragma unroll
    for (int rt = 0; rt < 4; ++rt) { ssq[rt] = 0.f;
#pragma unroll
        for (int ct = 0; ct < 4; ++ct) acc[rt][ct] = (f32x4){0.f, 0.f, 0.f, 0.f}; }
    const bf16* bp = Bt + (size_t)(n0 + fr) * ldb + kb + q4 * 8;
    __syncthreads();
#pragma unroll 2
    for (int ks = 0; ks < nks; ++ks) {
        bf16x8 bq[4];
#pragma unroll
        for (int ct = 0; ct < 4; ++ct) bq[ct] = *(const bf16x8*)(bp + (size_t)ct * 16 * ldb + ks * 32);
        bf16x8 a[4];
        if (AMODE == 0) { const bf16* ap = (const bf16*)Aptr + (size_t)(rh * 64 + fr) * lda + kb + q4 * 8 + ks * 32;
#pragma unroll
            for (int rt = 0; rt < 4; ++rt) a[rt] = *(const bf16x8*)(ap + (size_t)rt * 16 * lda); }
        else { const float* ap = (const float*)Aptr + (size_t)(rh * 64 + fr) * lda + kb + q4 * 8 + ks * 32;
            f32x4 g0 = (f32x4){1.f, 1.f, 1.f, 1.f}, g1 = g0;
            if (AMODE == 2) { const f32x4 t0 = *(const f32x4*)(gain + kb + q4 * 8 + ks * 32), t1 = *(const f32x4*)(gain + kb + q4 * 8 + ks * 32 + 4);
                g0 = (f32x4){__builtin_amdgcn_rcpf(t0.x), __builtin_amdgcn_rcpf(t0.y), __builtin_amdgcn_rcpf(t0.z), __builtin_amdgcn_rcpf(t0.w)};
                g1 = (f32x4){__builtin_amdgcn_rcpf(t1.x), __builtin_amdgcn_rcpf(t1.y), __builtin_amdgcn_rcpf(t1.z), __builtin_amdgcn_rcpf(t1.w)}; }
            f32x4 x0[4], x1[4];
#pragma unroll
            for (int rt = 0; rt < 4; ++rt) { x0[rt] = *(const f32x4*)(ap + (size_t)rt * 16 * lda); x1[rt] = *(const f32x4*)(ap + (size_t)rt * 16 * lda + 4); }
#pragma unroll
            for (int rt = 0; rt < 4; ++rt) { f32x4 y0 = x0[rt], y1 = x1[rt];
                if (AMODE == 2) { y0 = y0 * g0; y1 = y1 * g1; }
                if (AMODE == 1) ssq[rt] += (y0.x * y0.x + y0.y * y0.y) + (y0.z * y0.z + y0.w * y0.w) + (y1.x * y1.x + y1.y * y1.y) + (y1.z * y1.z + y1.w * y1.w);
                v4u aw; aw.x = pk2(y0.x, y0.y); aw.y = pk2(y0.z, y0.w); aw.z = pk2(y1.x, y1.y); aw.w = pk2(y1.z, y1.w);
                a[rt] = __builtin_bit_cast(bf16x8, aw); } }
#pragma unroll
        for (int rt = 0; rt < 4; ++rt)
#pragma unroll
            for (int ct = 0; ct < 4; ++ct) acc[rt][ct] = MFMA16(bq[ct], a[rt], acc[rt][ct]);
    }
#pragma unroll
    for (int rt = 0; rt < 4; ++rt)
#pragma unroll
        for (int ct = 0; ct < 4; ++ct) *(LAS f32x4*)(L + SK_RED + ((w * 16 + rt * 4 + ct) * 64 + lane) * 16) = acc[rt][ct];
    if (AMODE == 1) {
#pragma unroll
        for (int rt = 0; rt < 4; ++rt) { float s = ssq[rt]; s += __shfl_xor(s, 16); s += __shfl_xor(s, 32); if (q4 == 0) ((LAS float*)(L + SK_SSQ))[(w * 4 + rt) * 16 + fr] = s; } }
    __syncthreads();
    const int rto = w >> 1, cto = 2 * (w & 1);
    f32x4 r0 = (f32x4){0.f, 0.f, 0.f, 0.f}, r1 = r0; float st = 0.f;
#pragma unroll
    for (int sw = 0; sw < 8; ++sw) { r0 = r0 + *(LAS f32x4*)(L + SK_RED + ((sw * 16 + rto * 4 + cto) * 64 + lane) * 16); r1 = r1 + *(LAS f32x4*)(L + SK_RED + ((sw * 16 + rto * 4 + cto + 1) * 64 + lane) * 16);
        if (AMODE == 1) st += ((LAS float*)(L + SK_SSQ))[(sw * 4 + rto) * 16 + fr]; }
    if (AMODE == 1) { const float rs = __builtin_amdgcn_rsqf(st * (1.f / D) + RMS_EPS); r0 = r0 * rs; r1 = r1 * rs; }
    const int m = orow0 + rh * 64 + 16 * rto + fr, c0 = n0 + cto * 16 + q4 * 4;
    if (EMODE == 2) { float* o = (float*)outp + (size_t)m * ldc + c0; float ret = 0.f;
#pragma unroll
        for (int r = 0; r < 4; ++r) { ret += atomic_add_agent(o + r, r0[r]); ret += atomic_add_agent(o + 16 + r, r1[r]); }
        asm volatile("" :: "v"(ret)); }
    else { if (EMODE == 1) {
#pragma unroll
            for (int r = 0; r < 4; ++r) { const float x0 = fmaxf(r0[r], 0.f), x1 = fmaxf(r1[r], 0.f); r0[r] = x0 * x0; r1[r] = x1 * x1; } }
        bf16* o = (bf16*)outp + (size_t)m * ldc + c0; *(v2u*)o = pk4(r0); *(v2u*)(o + 16) = pk4(r1); }
    __syncthreads();
}

constexpr int SN_BLOCKS = 16;
__device__ __forceinline__ void sample_rows_prepare(Frame& F, const float* shift, const float* gain, u64* ssq, unsigned* flag, int wv) {
    const int tid = fresh_tid(), lane = tid & 63;
    const float* X = (const float*)(F.ws + WS_X); bf16* H = (bf16*)(F.ws + WS_H);
    { const int row = MP + wv; const f32x4* xr = (const f32x4*)(X + (size_t)row * D) + lane; float s = 0.f;
      f32x4 vr[8];
#pragma unroll
      for (int jj = 0; jj < 8; ++jj) vr[jj] = xr[64 * jj];
#pragma unroll
      for (int jj = 0; jj < 8; ++jj) { const f32x4 v = vr[jj]; s += (v.x * v.x + v.y * v.y) + (v.z * v.z + v.w * v.w); ((v2u*)(H + (size_t)row * D) + lane)[64 * jj] = pk4(v); }
      s = wave_sum(s); if (lane == 0) ssq[row] = (u64)(s * SS_FIX + 0.5f); }
    if (shift) { const int row = MR + wv; const f32x4* xr = (const f32x4*)(shift + (size_t)wv * D) + lane; const f32x4* gr = (const f32x4*)gain + lane;
        f32x4 vr[8], gq[8];
#pragma unroll
        for (int jj = 0; jj < 8; ++jj) { vr[jj] = xr[64 * jj]; gq[jj] = gr[64 * jj]; }
#pragma unroll
        for (int jj = 0; jj < 8; ++jj) { const f32x4 v = vr[jj], g = gq[jj];
            ((v2u*)(H + (size_t)row * D) + lane)[64 * jj] = pk4((f32x4){v.x * __builtin_amdgcn_rcpf(g.x), v.y * __builtin_amdgcn_rcpf(g.y), v.z * __builtin_amdgcn_rcpf(g.z), v.w * __builtin_amdgcn_rcpf(g.w)}); }
        if (lane == 0) { u64 one = (u64)((double)D * (1.0 - (double)RMS_EPS) * (double)SS_FIX + 0.5); asm volatile("" : "+s"(one)); ssq[row] = one; } }
    asm volatile("s_waitcnt vmcnt(0)" ::: "memory");
    __syncthreads();
    if (tid == 0) { __builtin_amdgcn_fence(__ATOMIC_RELEASE, "agent"); asm volatile("s_waitcnt vmcnt(0)" ::: "memory");
        (void)__hip_atomic_fetch_add(flag, 1u, __ATOMIC_RELAXED, __HIP_MEMORY_SCOPE_AGENT); }
}
struct SampleOrder : pg8::StaticOrder {
    const unsigned* flag;
    __device__ __forceinline__ void a_ready(const pg8::Unit& u) const {
        if (u.pm == MP / 256) {
            if (__builtin_amdgcn_readfirstlane(threadIdx.x >> 6) == 0) {
                int polls = 0;
                while ((unsigned)__builtin_amdgcn_readfirstlane(__hip_atomic_load(flag, __ATOMIC_RELAXED, __HIP_MEMORY_SCOPE_AGENT)) < (unsigned)SN_BLOCKS) { polls = __builtin_amdgcn_readfirstlane(polls + 1); if (polls > (1 << 18)) break; __builtin_amdgcn_s_sleep(2); }
                __builtin_amdgcn_fence(__ATOMIC_ACQUIRE, "agent");
                asm volatile("s_waitcnt vmcnt(0)" ::: "memory"); }
            asm volatile("" ::: "memory"); __builtin_amdgcn_s_barrier(); asm volatile("" ::: "memory");
        }
    }
};
struct SampleOrderEarly : SampleOrder {
    unsigned* donectr;
    __device__ bool next(int i, pg8::Unit& u) const {
        long Lq = (long)i * G + c; if (Lq >= nwg) return false;
        if (Lq >= 214 && Lq < 214 + nN) { u.pm = nM - 1; u.pn = (int)Lq - 214; return true; }
        if (Lq >= 551 && ((Lq - 551) & 7) == 0 && (Lq - 551) / 8 < nN) Lq = 214 + (Lq - 551) / 8;
        int wgid = (int)Lq; { const int q = nwg / pg8::NXCD, r = nwg % pg8::NXCD, xcd = wgid % pg8::NXCD, off = wgid / pg8::NXCD; wgid = (xcd < r ? xcd * (q + 1) : r * (q + 1) + (xcd - r) * q) + off; }
        const int nig = pg8::WGM * nN, gid = wgid / nig, fm = gid * pg8::WGM, gsz = (nM - fm) < pg8::WGM ? (nM - fm) : pg8::WGM;
        u.pm = fm + ((wgid % nig) % gsz); u.pn = (wgid % nig) / gsz; return true;
    }
    __device__ __forceinline__ void done(const pg8::Unit& u) const {
        if (u.pm == MP / 256) {
            asm volatile("s_waitcnt vmcnt(0)" ::: "memory"); __builtin_amdgcn_s_barrier(); asm volatile("" ::: "memory");
            if (threadIdx.x == 0) { __builtin_amdgcn_fence(__ATOMIC_RELEASE, "agent"); asm volatile("s_waitcnt vmcnt(0)" ::: "memory");
                (void)__hip_atomic_fetch_add(donectr, 1u, __ATOMIC_RELAXED, __HIP_MEMORY_SCOPE_AGENT); }
        }
    }
};
template <class Epi> __device__ __forceinline__ void run_gemm_sample_early(Frame& F, const bf16* Am, const bf16* Bt, int N, int K, const Epi& E, const unsigned* flag, unsigned* donectr) {
    pg8::Gemm g{Am, Bt, MT, N, K}; SampleOrderEarly S; S.init(MT, N, F.G, (int)blockIdx.x); S.flag = flag; S.donectr = donectr;
    pg8::gemm_phase<Epi, SampleOrderEarly, GEMM_ALIGN, GEMM_SP2>(F.lds, g, S, E);
}
__device__ __forceinline__ void wait_counter(const unsigned* ctr, unsigned target) {
    if (__builtin_amdgcn_readfirstlane(threadIdx.x >> 6) == 0) { int polls = 0;
        while ((unsigned)__builtin_amdgcn_readfirstlane(__hip_atomic_load(ctr, __ATOMIC_RELAXED, __HIP_MEMORY_SCOPE_AGENT)) < target) { polls = __builtin_amdgcn_readfirstlane(polls + 1); if (polls > (1 << 18)) break; __builtin_amdgcn_s_sleep(2); }
        __builtin_amdgcn_fence(__ATOMIC_ACQUIRE, "agent"); asm volatile("s_waitcnt vmcnt(0)" ::: "memory"); }
    __syncthreads();
    __builtin_amdgcn_fence(__ATOMIC_ACQUIRE, "agent"); asm volatile("s_waitcnt vmcnt(0)" ::: "memory");
}
template <class Epi> __device__ __forceinline__ void run_gemm_sample(Frame& F, const bf16* Am, const bf16* Bt, int N, int K, const Epi& E, const unsigned* flag) {
    pg8::Gemm g{Am, Bt, MT, N, K}; SampleOrder S; S.init(MT, N, F.G, (int)blockIdx.x); S.flag = flag;
    pg8::gemm_phase<Epi, SampleOrder, GEMM_ALIGN, GEMM_SP2>(F.lds, g, S, E);
}

constexpr int HG_QT = 0, HG_KT = 16384, HG_QH = 32768, HG_KHT = 49152, HG_VT = 65536, HG_ATT = 81920, HG_ST = 90112, HG_TOT = 122880, HG_DEC = 124928, HG_SS = 125440, HG_DEC2 = 126976;

__device__ __forceinline__ float lower_bound(const float* lb_logits, int j, int ch) {
    if (j == 0) return 0.f;
    const float l0 = lb_logits[ch], l1 = lb_logits[MIX + ch];
    return 1.f / (1.f + __expf(l0 - l1));
}
__device__ __forceinline__ void sig2(float x, float& sp, float& sn) { const float e = __expf(-fabsf(x)), r = __builtin_amdgcn_rcpf(1.f + e); const float big = r, small = e * r; sp = x >= 0.f ? big : small; sn = x >= 0.f ? small : big; }
__device__ __forceinline__ float fsilu(float x) { float sp, sn; sig2(x, sp, sn); return x * sp; }

__device__ __forceinline__ void hgrn_prompt_unit(Frame& F, const bf16* PROJ, bf16* MIXC, const float* lb_logits, const float* onorm_g, float* state_out, int j, int b, int h, int c_lo, int c_hi) {
    const ldsp L = F.lds; const int tid = fresh_tid(), w = __builtin_amdgcn_readfirstlane(tid >> 6), lane = tid & 63, fr = lane & 15, q4 = lane >> 4;
    const int ek = tid & 127, etq = tid >> 7;
    const float lbk = lower_bound(lb_logits, j, h * 128 + ek), oml = 1.f - lbk;
    f32x4 Sacc[8];
#pragma unroll
    for (int i = 0; i < 8; ++i) Sacc[i] = (f32x4){0.f, 0.f, 0.f, 0.f};
    for (int i = tid; i < 32768 / 16; i += NTHR) *(LAS v4u*)(L + HG_ST + i * 16) = (v4u){0u, 0u, 0u, 0u};
    __syncthreads();
    const int tt = w & 3, vh = w >> 2;
    unsigned short rq[16], rf[16], rv[16];
    if (c_lo > 0) {
        { const bf16* pq = PROJ + ((size_t)b * SEQ + etq * 16) * LDP + h * 128 + ek;
#pragma unroll
          for (int i = 0; i < 16; ++i) { rf[i] = pq[(size_t)i * LDP + 1536]; rv[i] = pq[(size_t)i * LDP + 3072]; } }
#pragma unroll 1
        for (int c = 0; c < c_lo; ++c) {
            int tl_ = tid; asm volatile("" : "+v"(tl_));
            const int lane = tl_ & 63, fr = lane & 15, q4 = lane >> 4, ek = tl_ & 127, etq = tl_ >> 7;
            const int kbuf = (c & 1) ? HG_QT : HG_KHT, vbuf = (c & 1) ? HG_KT : HG_VT, dbuf = (c & 1) ? HG_DEC2 : HG_DEC;
            float fv[16], vv[16];
#pragma unroll
            for (int i = 0; i < 16; ++i) { fv[i] = bf2f(rf[i]); vv[i] = bf2f(rv[i]); }
            float bl[16], kv[16]; float run = 0.f;
#pragma unroll
            for (int i = 0; i < 16; ++i) { float sp, sn; sig2(fv[i], sp, sn); const float fg = lbk + oml * sp; run += __logf(fmaxf(fg, 1e-30f)); bl[i] = run; kv[i] = oml * sn; }
            ((LAS float*)(L + HG_TOT))[etq * 128 + ek] = run;
            LDS_BARRIER();
            const float t0 = ((LAS float*)(L + HG_TOT))[ek], t1 = ((LAS float*)(L + HG_TOT))[128 + ek], t2 = ((LAS float*)(L + HG_TOT))[256 + ek], t3 = ((LAS float*)(L + HG_TOT))[384 + ek];
            const float bend = (t0 + t1) + (t2 + t3);
            const float rem = bend - ((etq > 0 ? t0 : 0.f) + (etq > 1 ? t1 : 0.f) + (etq > 2 ? t2 : 0.f));
            float kh[16];
#pragma unroll
            for (int i = 0; i < 16; ++i) kh[i] = kv[i] * __expf(fminf(rem - bl[i], 0.f));
            { v4u o0, o1;
              o0.x = pk2(kh[0], kh[1]); o0.y = pk2(kh[2], kh[3]); o0.z = pk2(kh[4], kh[5]); o0.w = pk2(kh[6], kh[7]);
              o1.x = pk2(kh[8], kh[9]); o1.y = pk2(kh[10], kh[11]); o1.z = pk2(kh[12], kh[13]); o1.w = pk2(kh[14], kh[15]);
              *(LAS v4u*)(L + kbuf + sw64(ek, etq * 2)) = o0; *(LAS v4u*)(L + kbuf + sw64(ek, etq * 2 + 1)) = o1;
              o0.x = pk2(vv[0], vv[1]); o0.y = pk2(vv[2], vv[3]); o0.z = pk2(vv[4], vv[5]); o0.w = pk2(vv[6], vv[7]);
              o1.x = pk2(vv[8], vv[9]); o1.y = pk2(vv[10], vv[11]); o1.z = pk2(vv[12], vv[13]); o1.w = pk2(vv[14], vv[15]);
              *(LAS v4u*)(L + vbuf + sw64(ek, etq * 2)) = o0; *(LAS v4u*)(L + vbuf + sw64(ek, etq * 2 + 1)) = o1; }
            if (etq == 0) ((LAS float*)(L + dbuf))[ek] = __expf(bend);
            LDS_BARRIER();
            if (c + 1 < c_lo) { const bf16* pq = PROJ + ((size_t)b * SEQ + (c + 1) * 64 + etq * 16) * LDP + h * 128 + ek;
#pragma unroll
                for (int i = 0; i < 16; ++i) { rf[i] = pq[(size_t)i * LDP + 1536]; rv[i] = pq[(size_t)i * LDP + 3072]; } }
            { const f32x4 dec = *(LAS f32x4*)(L + dbuf + (16 * w + q4 * 4) * 4);
#pragma unroll
              for (int vt = 0; vt < 8; ++vt) Sacc[vt] = Sacc[vt] * dec;
#pragma unroll
              for (int ks = 0; ks < 2; ++ks) { const bf16x8 a = *(LAS bf16x8*)(L + kbuf + sw64(16 * w + fr, ks * 4 + q4));
#pragma unroll
                  for (int vt = 0; vt < 8; ++vt) { const bf16x8 bv = *(LAS bf16x8*)(L + vbuf + sw64(16 * vt + fr, ks * 4 + q4)); Sacc[vt] = MFMA16(a, bv, Sacc[vt]); } } }
            __builtin_amdgcn_sched_barrier(0);
        }
        { int tl_ = tid; asm volatile("" : "+v"(tl_)); const int lane = tl_ & 63, fr = lane & 15, q4 = lane >> 4; const int k0 = 16 * w + q4 * 4;
#pragma unroll
          for (int vt = 0; vt < 8; ++vt) *(LAS v2u*)(L + HG_ST + sw128(16 * vt + fr, k0 >> 3) + (k0 & 7) * 2) = pk4(Sacc[vt]); }
    }
    { const bf16* pq = PROJ + ((size_t)b * SEQ + c_lo * 64 + etq * 16) * LDP + h * 128 + ek;
#pragma unroll
      for (int i = 0; i < 16; ++i) { rq[i] = pq[(size_t)i * LDP]; rf[i] = pq[(size_t)i * LDP + 1536]; rv[i] = pq[(size_t)i * LDP + 3072]; } }
#pragma unroll 1
    for (int c = c_lo; c < c_hi; ++c) {
        int tl_ = tid; asm volatile("" : "+v"(tl_));
        const int lane = tl_ & 63, fr = lane & 15, q4 = lane >> 4, ek = tl_ & 127, etq = tl_ >> 7;
        const size_t row0 = (size_t)b * SEQ + c * 64;
        float qv[16], fv[16], vv[16];
#pragma unroll
        for (int i = 0; i < 16; ++i) { qv[i] = bf2f(rq[i]); fv[i] = bf2f(rf[i]); vv[i] = bf2f(rv[i]); }
        float bl[16], kv[16]; float run = 0.f;
#pragma unroll
        for (int i = 0; i < 16; ++i) { float sp, sn; sig2(fv[i], sp, sn); const float fg = lbk + oml * sp; run += __logf(fmaxf(fg, 1e-30f)); bl[i] = run; kv[i] = oml * sn; }
        ((LAS float*)(L + HG_TOT))[etq * 128 + ek] = run;
        LDS_BARRIER();
        const float t0 = ((LAS float*)(L + HG_TOT))[ek], t1 = ((LAS float*)(L + HG_TOT))[128 + ek], t2 = ((LAS float*)(L + HG_TOT))[256 + ek], t3 = ((LAS float*)(L + HG_TOT))[384 + ek];
        const float off = (etq > 0 ? t0 : 0.f) + (etq > 1 ? t1 : 0.f) + (etq > 2 ? t2 : 0.f);
        const float mref = t0 + t1, bend = mref + t2 + t3, ebm = __expf(t2 + t3);
        float kh[16];
#pragma unroll
        for (int i = 0; i < 16; ++i) { const int t = etq * 16 + i; const float bt = off + bl[i];
            const float d = fminf(fmaxf(bt - mref, -60.f), 60.f), e1 = __expf(d), e2 = __builtin_amdgcn_rcpf(e1);
            const float sq = fsilu(qv[i]);
            const int a = sw128(t, ek >> 3) + (ek & 7) * 2;
            *(LAS unsigned short*)(L + HG_QT + a) = (unsigned short)f2bf(sq * e1);
            *(LAS unsigned short*)(L + HG_KT + a) = (unsigned short)f2bf(kv[i] * e2);
            *(LAS unsigned short*)(L + HG_QH + a) = (unsigned short)f2bf(sq * __expf(bt));
            kh[i] = kv[i] * (ebm * e2); }
        { v4u o0, o1;
          o0.x = pk2(kh[0], kh[1]); o0.y = pk2(kh[2], kh[3]); o0.z = pk2(kh[4], kh[5]); o0.w = pk2(kh[6], kh[7]);
          o1.x = pk2(kh[8], kh[9]); o1.y = pk2(kh[10], kh[11]); o1.z = pk2(kh[12], kh[13]); o1.w = pk2(kh[14], kh[15]);
          *(LAS v4u*)(L + HG_KHT + sw64(ek, etq * 2)) = o0; *(LAS v4u*)(L + HG_KHT + sw64(ek, etq * 2 + 1)) = o1;
          o0.x = pk2(vv[0], vv[1]); o0.y = pk2(vv[2], vv[3]); o0.z = pk2(vv[4], vv[5]); o0.w = pk2(vv[6], vv[7]);
          o1.x = pk2(vv[8], vv[9]); o1.y = pk2(vv[10], vv[11]); o1.z = pk2(vv[12], vv[13]); o1.w = pk2(vv[14], vv[15]);
          *(LAS v4u*)(L + HG_VT + sw64(ek, etq * 2)) = o0; *(LAS v4u*)(L + HG_VT + sw64(ek, etq * 2 + 1)) = o1; }
        if (etq == 0) ((LAS float*)(L + HG_DEC))[ek] = __expf(bend);
        LDS_BARRIER();
        v2u gate_raw[4];
#pragma unroll
        for (int i = 0; i < 4; ++i) gate_raw[i] = *(const v2u*)(PROJ + (row0 + tt * 16 + fr) * LDP + 4608 + h * 128 + (4 * vh + i) * 16 + q4 * 4);
        if (c + 1 < c_hi) { const bf16* pq = PROJ + (row0 + 64 + etq * 16) * LDP + h * 128 + ek;
#pragma unroll
            for (int i = 0; i < 16; ++i) { rq[i] = pq[(size_t)i * LDP]; rf[i] = pq[(size_t)i * LDP + 1536]; rv[i] = pq[(size_t)i * LDP + 3072]; } }
#pragma unroll
        for (int u = 0; u < 2; ++u) { const int st = w >> 1, ttl = 2 * (w & 1) + u;
            f32x4 acc = (f32x4){0.f, 0.f, 0.f, 0.f};
            if (st <= ttl) {
#pragma unroll
                for (int ks = 0; ks < 4; ++ks) { const bf16x8 a = *(LAS bf16x8*)(L + HG_KT + sw128(st * 16 + fr, ks * 4 + q4)); const bf16x8 bq = *(LAS bf16x8*)(L + HG_QT + sw128(ttl * 16 + fr, ks * 4 + q4)); acc = MFMA16(a, bq, acc); } }
            const int t = ttl * 16 + fr, s0 = st * 16 + q4 * 4;
#pragma unroll
            for (int r = 0; r < 4; ++r) if (s0 + r > t) acc[r] = 0.f;
            *(LAS v2u*)(L + HG_ATT + sw64(t, s0 >> 3) + (s0 & 7) * 2) = pk4(acc); }
        f32x4 oT[4];
#pragma unroll
        for (int i = 0; i < 4; ++i) oT[i] = (f32x4){0.f, 0.f, 0.f, 0.f};
#pragma unroll
        for (int ks = 0; ks < 4; ++ks) { const bf16x8 bq = *(LAS bf16x8*)(L + HG_QH + sw128(tt * 16 + fr, ks * 4 + q4));
#pragma unroll
            for (int i = 0; i < 4; ++i) { const bf16x8 a = *(LAS bf16x8*)(L + HG_ST + sw128((4 * vh + i) * 16 + fr, ks * 4 + q4)); oT[i] = MFMA16(a, bq, oT[i]); } }
        { const f32x4 dec = *(LAS f32x4*)(L + HG_DEC + (16 * w + q4 * 4) * 4);
#pragma unroll
          for (int vt = 0; vt < 8; ++vt) Sacc[vt] = Sacc[vt] * dec;
#pragma unroll
          for (int ks = 0; ks < 2; ++ks) { const bf16x8 a = *(LAS bf16x8*)(L + HG_KHT + sw64(16 * w + fr, ks * 4 + q4));
#pragma unroll
              for (int vt = 0; vt < 8; ++vt) { const bf16x8 bv = *(LAS bf16x8*)(L + HG_VT + sw64(16 * vt + fr, ks * 4 + q4)); Sacc[vt] = MFMA16(a, bv, Sacc[vt]); } } }
        LDS_BARRIER();
        { const int k0 = 16 * w + q4 * 4;
#pragma unroll
          for (int vt = 0; vt < 8; ++vt) *(LAS v2u*)(L + HG_ST + sw128(16 * vt + fr, k0 >> 3) + (k0 & 7) * 2) = pk4(Sacc[vt]); }
#pragma unroll
        for (int ks = 0; ks < 2; ++ks) { const bf16x8 bq = *(LAS bf16x8*)(L + HG_ATT + sw64(tt * 16 + fr, ks * 4 + q4));
#pragma unroll
            for (int i = 0; i < 4; ++i) { const bf16x8 a = *(LAS bf16x8*)(L + HG_VT + sw64((4 * vh + i) * 16 + fr, ks * 4 + q4)); oT[i] = MFMA16(a, bq, oT[i]); } }
        float ss = 0.f;
#pragma unroll
        for (int i = 0; i < 4; ++i) ss += (oT[i].x * oT[i].x + oT[i].y * oT[i].y) + (oT[i].z * oT[i].z + oT[i].w * oT[i].w);
        ss += __shfl_xor(ss, 16); ss += __shfl_xor(ss, 32);
        if (q4 == 0) ((LAS float*)(L + HG_SS))[w * 16 + fr] = ss;
        LDS_BARRIER();
        const float tot = ((LAS float*)(L + HG_SS))[w * 16 + fr] + ((LAS float*)(L + HG_SS))[(w ^ 4) * 16 + fr];
        const float rstd = 1.f / sqrtf(tot * (1.f / 128.f) + RMS_EPS);
        const size_t row = row0 + tt * 16 + fr;
#pragma unroll
        for (int i = 0; i < 4; ++i) { const int ch = h * 128 + (4 * vh + i) * 16 + q4 * 4;
            const f32x4 gon = *(const f32x4*)(onorm_g + ch); const f32x4 gate = bf4(gate_raw[i]);
            f32x4 o = oT[i] * rstd * gon;
            o.x *= fsilu(gate.x); o.y *= fsilu(gate.y); o.z *= fsilu(gate.z); o.w *= fsilu(gate.w);
            *(v2u*)(MIXC + row * D + ch) = pk4(o); }
    }
    if (c_hi == SEQ / 64) {
#pragma unroll
        for (int vt = 0; vt < 8; ++vt)
#pragma unroll
            for (int r = 0; r < 4; ++r) state_out[(size_t)(16 * w + q4 * 4 + r) * 128 + 16 * vt + fr] = Sacc[vt][r]; }
    __syncthreads();
}

__device__ __forceinline__ void hgrn_sample_unit(int lane, const bf16* PROJ, bf16* MIXC, const float* lb_logits, const float* onorm_g, const float* S0, float* S1, int j, int b, int h) {
    const size_t row = MP + b; const int vq = lane & 31, kr = lane >> 5;
    float fg[2], kvv[2], sq[2];
#pragma unroll
    for (int u = 0; u < 2; ++u) { const int k = lane + 64 * u; const bf16* p = PROJ + row * LDP + h * 128 + k;
        const float q = bf2f(p[0]), f = bf2f(p[1536]); const float lbk = lower_bound(lb_logits, j, h * 128 + k);
        float sp, sn; sig2(f, sp, sn); fg[u] = fmaxf(lbk + (1.f - lbk) * sp, 1e-30f); kvv[u] = (1.f - lbk) * sn; sq[u] = fsilu(q); }
    const f32x4 v4 = bf4(*(const v2u*)(PROJ + row * LDP + 3072 + h * 128 + 4 * vq));
    f32x4 o = (f32x4){0.f, 0.f, 0.f, 0.f};
#pragma unroll 1
    for (int ib = 0; ib < 8; ++ib) {
        f32x4 Sv[8];
#pragma unroll
        for (int i = 0; i < 8; ++i) Sv[i] = *(const f32x4*)(S0 + (size_t)(2 * (ib * 8 + i) + kr) * 128 + 4 * vq);
        __builtin_amdgcn_sched_barrier(0);
        const bool lowh = ib < 4;
#pragma unroll
        for (int i = 0; i < 8; ++i) { const int it = ib * 8 + i, k = 2 * it + kr; const int src = k & 63;
            const float fgk = __shfl(lowh ? fg[0] : fg[1], src), kvk = __shfl(lowh ? kvv[0] : kvv[1], src), sqk = __shfl(lowh ? sq[0] : sq[1], src);
            const f32x4 Sn = Sv[i] * fgk + v4 * kvk;
            *(f32x4*)(S1 + (size_t)k * 128 + 4 * vq) = Sn;
            o = o + Sn * sqk; } }
    o.x += __shfl_xor(o.x, 32); o.y += __shfl_xor(o.y, 32); o.z += __shfl_xor(o.z, 32); o.w += __shfl_xor(o.w, 32);
    float ss = (o.x * o.x + o.y * o.y) + (o.z * o.z + o.w * o.w);
#pragma unroll
    for (int m = 1; m < 32; m <<= 1) ss += __shfl_xor(ss, m);
    const float rstd = 1.f / sqrtf(ss * (1.f / 128.f) + RMS_EPS);
    if (lane < 32) { const int ch = h * 128 + 4 * vq;
        const f32x4 gon = *(const f32x4*)(onorm_g + ch); const f32x4 gate = bf4(*(const v2u*)(PROJ + row * LDP + 4608 + ch));
        f32x4 r = o * rstd * gon; r.x *= fsilu(gate.x); r.y *= fsilu(gate.y); r.z *= fsilu(gate.z); r.w *= fsilu(gate.w);
        *(v2u*)(MIXC + row * D + ch) = pk4(r); }
}

constexpr int XA_K = 0, XA_KLD = 272, XA_VT = 256 * 272, XA_VLD = 520;
__device__ __forceinline__ void xattn_prompt_unit(Frame& F, const bf16* PROJ, int xq_off, bf16* MIXC, const float* Kb, const float* Vb, int b, int head, int qpart) {
    const ldsp L = F.lds; const int tid = fresh_tid(), w = __builtin_amdgcn_readfirstlane(tid >> 6), lane = tid & 63, fr = lane & 15, q4 = lane >> 4;
    __syncthreads();
#pragma unroll 1
    for (int hb = 0; hb < 2; ++hb) {
        f32x4 kx[8], vx[8];
#pragma unroll
        for (int i = 0; i < 8; ++i) { const int idx = (hb * 8 + i) * NTHR + tid, m = idx >> 5, e4 = idx & 31;
            kx[i] = *(const f32x4*)(Kb + (size_t)m * XDIM + head * XD + 4 * e4); vx[i] = *(const f32x4*)(Vb + (size_t)m * XDIM + head * XD + 4 * e4); }
        __builtin_amdgcn_sched_barrier(0);
#pragma unroll
        for (int i = 0; i < 8; ++i) { const int idx = (hb * 8 + i) * NTHR + tid, m = idx >> 5, e4 = idx & 31;
            *(LAS v2u*)(L + XA_K + m * XA_KLD + e4 * 8) = pk4(kx[i]);
#pragma unroll
            for (int q = 0; q < 4; ++q) { const int e = 4 * e4 + q; *(LAS unsigned short*)(L + XA_VT + e * XA_VLD + m * 2) = (unsigned short)f2bf(vx[i][q]); } }
        __builtin_amdgcn_sched_barrier(0); }
    __syncthreads();
    const float scale = 0.08838834764831845f;
    const ldsp kbase = L + XA_K + fr * XA_KLD + q4 * 16; const ldsp vbase = L + XA_VT + fr * XA_VLD + q4 * 8;
#pragma unroll 1
    for (int qt = 0; qt < 2; ++qt) {
        const size_t r = (size_t)b * SEQ + qpart * 256 + qt * 128 + w * 16 + fr;
        bf16x8 qf[4];
#pragma unroll
        for (int ks = 0; ks < 4; ++ks) qf[ks] = *(const bf16x8*)(PROJ + r * LDP + xq_off + head * XD + ks * 32 + q4 * 8);
        f32x4 sT[16];
#pragma unroll
        for (int mt = 0; mt < 16; ++mt) { f32x4 acc = (f32x4){0.f, 0.f, 0.f, 0.f};
#pragma unroll
            for (int ks = 0; ks < 4; ++ks) { const bf16x8 a = *(LAS bf16x8*)(kbase + mt * 16 * XA_KLD + ks * 64); acc = MFMA16(a, qf[ks], acc); }
            sT[mt] = acc; __builtin_amdgcn_sched_barrier(0); }
        float mx = -3.0e38f;
#pragma unroll
        for (int mt = 0; mt < 16; ++mt) mx = fmaxf(mx, fmaxf(fmaxf(sT[mt].x, sT[mt].y), fmaxf(sT[mt].z, sT[mt].w)));
        mx = fmaxf(mx, __shfl_xor(mx, 16)); mx = fmaxf(mx, __shfl_xor(mx, 32));
        float l = 0.f;
#pragma unroll
        for (int mt = 0; mt < 16; ++mt) {
#pragma unroll
            for (int q = 0; q < 4; ++q) { const float p = __expf((sT[mt][q] - mx) * scale); sT[mt][q] = p; l += p; } }
        l += __shfl_xor(l, 16); l += __shfl_xor(l, 32);
        const float inv = 1.f / l;
        f32x4 oT[8];
#pragma unroll
        for (int et = 0; et < 8; ++et) oT[et] = (f32x4){0.f, 0.f, 0.f, 0.f};
#pragma unroll
        for (int s = 0; s < 8; ++s) {
            v4u pw; pw.x = pk2(sT[2 * s].x, sT[2 * s].y); pw.y = pk2(sT[2 * s].z, sT[2 * s].w); pw.z = pk2(sT[2 * s + 1].x, sT[2 * s + 1].y); pw.w = pk2(sT[2 * s + 1].z, sT[2 * s + 1].w);
            const bf16x8 pf = __builtin_bit_cast(bf16x8, pw);
#pragma unroll
            for (int et = 0; et < 8; ++et) {
                const v2u a0 = *(LAS v2u*)(vbase + et * 16 * XA_VLD + s * 64);
                const v2u a1 = *(LAS v2u*)(vbase + et * 16 * XA_VLD + s * 64 + 32);
                v4u aw; aw.x = a0.x; aw.y = a0.y; aw.z = a1.x; aw.w = a1.y;
                oT[et] = MFMA16(__builtin_bit_cast(bf16x8, aw), pf, oT[et]); }
            __builtin_amdgcn_sched_barrier(0); }
#pragma unroll
        for (int et = 0; et < 8; ++et) *(v2u*)(MIXC + r * D + MIX + head * XD + et * 16 + q4 * 4) = pk4(oT[et] * inv);
    }
    __syncthreads();
}
__device__ __forceinline__ void xattn_sample_pair(Frame& F, const bf16* PROJ, int xq_off, bf16* MIXC, const float* Kall, const float* Vall, int unit0) {
    const ldsp L = F.lds; const int tid = fresh_tid(), w = __builtin_amdgcn_readfirstlane(tid >> 6), lane = tid & 63;
    const int unit = unit0 + (w >> 2), mp = w & 3, b = unit >> 2, head = unit & 3;
    const size_t row = MP + b; const int fr = lane & 15, q4 = lane >> 4, e4 = lane & 31, mr = lane >> 5;
    const float* Kb = Kall + (size_t)b * NMEM * XDIM; const float* Vb = Vall + (size_t)b * NMEM * XDIM;
    const float scale = 0.08838834764831845f;
    bf16x8 qf[4];
#pragma unroll
    for (int ks = 0; ks < 4; ++ks) { const v4u raw = *(const v4u*)(PROJ + row * LDP + xq_off + head * XD + ks * 32 + q4 * 8);
        v4u o; o.x = pk2_hw(bflo(raw.x) * scale, bfhi(raw.x) * scale); o.y = pk2_hw(bflo(raw.y) * scale, bfhi(raw.y) * scale); o.z = pk2_hw(bflo(raw.z) * scale, bfhi(raw.z) * scale); o.w = pk2_hw(bflo(raw.w) * scale, bfhi(raw.w) * scale);
        qf[ks] = __builtin_bit_cast(bf16x8, o); }
    f32x4 sT[4];
#pragma unroll
    for (int i = 0; i < 4; ++i) { f32x4 acc = (f32x4){0.f, 0.f, 0.f, 0.f};
        const float* kp = Kb + (size_t)(mp * 64 + i * 16 + fr) * XDIM + head * XD + q4 * 8;
        f32x4 x0[4], x1[4];
#pragma unroll
        for (int ks = 0; ks < 4; ++ks) { x0[ks] = *(const f32x4*)(kp + ks * 32); x1[ks] = *(const f32x4*)(kp + ks * 32 + 4); }
#pragma unroll
        for (int ks = 0; ks < 4; ++ks) { v4u aw; aw.x = pk2_hw(x0[ks].x, x0[ks].y); aw.y = pk2_hw(x0[ks].z, x0[ks].w); aw.z = pk2_hw(x1[ks].x, x1[ks].y); aw.w = pk2_hw(x1[ks].z, x1[ks].w);
            acc = MFMA16(__builtin_bit_cast(bf16x8, aw), qf[ks], acc); }
        sT[i] = acc; }
    float mx = -3.0e38f;
#pragma unroll
    for (int i = 0; i < 4; ++i) mx = fmaxf(mx, fmaxf(fmaxf(sT[i].x, sT[i].y), fmaxf(sT[i].z, sT[i].w)));
    mx = fmaxf(mx, __shfl_xor(mx, 16)); mx = fmaxf(mx, __shfl_xor(mx, 32));
    float l = 0.f;
#pragma unroll
    for (int i = 0; i < 4; ++i) {
#pragma unroll
        for (int q = 0; q < 4; ++q) { const float p = __expf(sT[i][q] - mx); sT[i][q] = p; l += p; } }
    l += __shfl_xor(l, 16); l += __shfl_xor(l, 32);
    f32x4 o = (f32x4){0.f, 0.f, 0.f, 0.f};
    const float* vp = Vb + head * XD + 4 * e4;
#pragma unroll
    for (int i = 0; i < 4; ++i) {
#pragma unroll
        for (int ii = 0; ii < 8; ++ii) { const int m0 = mp * 64 + i * 16 + 2 * ii; const int src = ((2 * ii) >> 2) * 16;
            const float pa = __shfl(sT[i][2 * (ii & 1)], src), pb = __shfl(sT[i][2 * (ii & 1) + 1], src);
            const f32x4 vx = *(const f32x4*)(vp + (size_t)(m0 + mr) * XDIM);
            o = o + vx * (mr ? pb : pa); } }
    o.x += __shfl_xor(o.x, 32); o.y += __shfl_xor(o.y, 32); o.z += __shfl_xor(o.z, 32); o.w += __shfl_xor(o.w, 32);
    LAS float* slot = (LAS float*)(L + w * 528);
    if (lane == 0) { slot[0] = mx; slot[1] = l; }
    if (lane < 32) *(LAS f32x4*)(slot + 4 + 4 * e4) = o;
    LDS_BARRIER();
    if (mp == 0 && lane < 32) { float M = -3.0e38f;
#pragma unroll
        for (int i = 0; i < 4; ++i) M = fmaxf(M, ((LAS float*)(L + (w + i) * 528))[0]);
        float Lsum = 0.f; f32x4 O = (f32x4){0.f, 0.f, 0.f, 0.f};
#pragma unroll
        for (int i = 0; i < 4; ++i) { const LAS float* s = (const LAS float*)(L + (w + i) * 528); const float f = __expf(s[0] - M); Lsum += s[1] * f; O = O + *(const LAS f32x4*)(s + 4 + 4 * e4) * f; }
        *(v2u*)(MIXC + row * D + MIX + head * XD + 4 * e4) = pk4(O * (1.f / Lsum)); }
    LDS_BARRIER();
}

__device__ __forceinline__ void xattn_sample_unit(int lane, const bf16* PROJ, int xq_off, bf16* MIXC, const float* Kb, const float* Vb, int b, int head) {
    const size_t row = MP + b; const int fr = lane & 15, q4 = lane >> 4, e4 = lane & 31, mr = lane >> 5;
    const float scale = 0.08838834764831845f;
    bf16x8 qf[4];
#pragma unroll
    for (int ks = 0; ks < 4; ++ks) { const v4u raw = *(const v4u*)(PROJ + row * LDP + xq_off + head * XD + ks * 32 + q4 * 8);
        v4u o; o.x = pk2_hw(bflo(raw.x) * scale, bfhi(raw.x) * scale); o.y = pk2_hw(bflo(raw.y) * scale, bfhi(raw.y) * scale); o.z = pk2_hw(bflo(raw.z) * scale, bfhi(raw.z) * scale); o.w = pk2_hw(bflo(raw.w) * scale, bfhi(raw.w) * scale);
        qf[ks] = __builtin_bit_cast(bf16x8, o); }
    f32x4 sT[16];
#pragma unroll
    for (int mt = 0; mt < 16; ++mt) { f32x4 acc = (f32x4){0.f, 0.f, 0.f, 0.f};
        const float* kp = Kb + (size_t)(mt * 16 + fr) * XDIM + head * XD + q4 * 8;
        f32x4 x0[4], x1[4];
#pragma unroll
        for (int ks = 0; ks < 4; ++ks) { x0[ks] = *(const f32x4*)(kp + ks * 32); x1[ks] = *(const f32x4*)(kp + ks * 32 + 4); }
#pragma unroll
        for (int ks = 0; ks < 4; ++ks) { v4u aw; aw.x = pk2_hw(x0[ks].x, x0[ks].y); aw.y = pk2_hw(x0[ks].z, x0[ks].w); aw.z = pk2_hw(x1[ks].x, x1[ks].y); aw.w = pk2_hw(x1[ks].z, x1[ks].w);
            acc = MFMA16(__builtin_bit_cast(bf16x8, aw), qf[ks], acc); }
        sT[mt] = acc; }
    float mx = -3.0e38f;
#pragma unroll
    for (int mt = 0; mt < 16; ++mt) mx = fmaxf(mx, fmaxf(fmaxf(sT[mt].x, sT[mt].y), fmaxf(sT[mt].z, sT[mt].w)));
    mx = fmaxf(mx, __shfl_xor(mx, 16)); mx = fmaxf(mx, __shfl_xor(mx, 32));
    float l = 0.f;
#pragma unroll
    for (int mt = 0; mt < 16; ++mt) {
#pragma unroll
        for (int q = 0; q < 4; ++q) { const float p = __expf(sT[mt][q] - mx); sT[mt][q] = p; l += p; } }
    l += __shfl_xor(l, 16); l += __shfl_xor(l, 32);
    f32x4 o = (f32x4){0.f, 0.f, 0.f, 0.f};
    const float* vp = Vb + head * XD + 4 * e4;
#pragma unroll
    for (int mt = 0; mt < 16; ++mt) {
#pragma unroll
        for (int i = 0; i < 8; ++i) { const int m0 = mt * 16 + 2 * i;
            const int src = ((2 * i) >> 2) * 16;
            const float pa = __shfl(sT[mt][2 * (i & 1)], src);
            const float pb = __shfl(sT[mt][2 * (i & 1) + 1], src);
            const f32x4 vx = *(const f32x4*)(vp + (size_t)(m0 + mr) * XDIM);
            o = o + vx * (mr ? pb : pa); } }
    o.x += __shfl_xor(o.x, 32); o.y += __shfl_xor(o.y, 32); o.z += __shfl_xor(o.z, 32); o.w += __shfl_xor(o.w, 32);
    if (lane < 32) *(v2u*)(MIXC + row * D + MIX + head * XD + 4 * e4) = pk4(o * (1.f / l));
}


__device__ __forceinline__ long rw_prev_row(int row) { return row < MP ? (((row & (SEQ - 1)) == 0) ? -1L : (long)row - 1) : (long)row + NSMP; }
__device__ __forceinline__ f32x4 ld_bf4(const bf16* p) { return bf4(*(const v2u*)p); }
__device__ __forceinline__ f32x4 ld_bf4_prev(const bf16* PROJ, long prow, int col) { return prow >= 0 ? bf4(*(const v2u*)(PROJ + (size_t)prow * LDP + col)) : (f32x4){0.f, 0.f, 0.f, 0.f}; }
__device__ __forceinline__ float ftanh(float x) { return 1.f - 2.f * __builtin_amdgcn_rcpf(1.f + __expf(2.f * x)); }
__device__ __forceinline__ float quad_sum(float x) {
    x += __builtin_bit_cast(float, __builtin_amdgcn_mov_dpp(__builtin_bit_cast(int, x), 0xB1, 0xF, 0xF, true));
    x += __builtin_bit_cast(float, __builtin_amdgcn_mov_dpp(__builtin_bit_cast(int, x), 0x4E, 0xF, 0xF, true));
    return x;
}

constexpr int RC_LI = 0, RC_RAW = 46080, RC_XCH = RC_RAW + 3 * 9216;
__device__ __forceinline__ void rwkv_prep_unit(Frame& F, const Args& A, int j, int r0, int h_lo, int h_hi) {
    const ldsp L = F.lds; const int tid = fresh_tid(), w = __builtin_amdgcn_readfirstlane(tid >> 6), lane = tid & 63, fr = lane & 15, q4 = lane >> 4;
    const int it = w >> 1, jh = w & 1;
    constexpr bool sample = true;
    const bf16* PROJ = (const bf16*)(F.ws + WS_PROJ);
    const float* mu = A.in[20] + (size_t)j * B_MIXC; const float* w0 = A.in[21] + (size_t)j * MIX; const float* a0 = A.in[23] + (size_t)j * MIX;
    const float* k_k = A.in[26] + (size_t)j * MIX; const float* k_a = A.in[27] + (size_t)j * MIX; const float* r_k = A.in[28] + (size_t)j * MIX;
    const bf16* LW = (const bf16*)(F.ws + WS_LW) + (size_t)j * MIX * LORA_K;
    float* RR = (float*)(F.ws + WS_RR); float* RK = (float*)(F.ws + WS_RK); float* RV = (float*)(F.ws + WS_RV); float* RKK = (float*)(F.ws + WS_RKK);
    float* RKA = (float*)(F.ws + WS_RKA); float* RWd = (float*)(F.ws + WS_RW); float* RG = (float*)(F.ws + WS_RG); float* BON = (float*)(F.ws + WS_BONUS);
    __syncthreads();
    for (int itr = 0; itr < 11; ++itr) { const int idx = itr * NTHR + tid;
        if (idx < 64 * 88) { const int t = idx / 88, c4 = idx - t * 88, col = 4 * c4; const int row = r0 + t; const long prow = rw_prev_row(row);
            const f32x4 P = ld_bf4(PROJ + (size_t)row * LDP + B_LORA_OFF + col), Pp = ld_bf4_prev(PROJ, prow, B_LORA_OFF + col);
            const f32x4 m4 = *(const f32x4*)(mu + 4608 + col);
            f32x4 xs = P + (Pp - P) * m4;
            if (col < 64) { xs.x = ftanh(xs.x); xs.y = ftanh(xs.y); xs.z = ftanh(xs.z); xs.w = ftanh(xs.w); }
            else if (col >= 128) { xs.x = fsigmoid(xs.x); xs.y = fsigmoid(xs.y); xs.z = fsigmoid(xs.z); xs.w = fsigmoid(xs.w); }
            *(LAS v2u*)(L + RC_LI + t * 720 + col * 2) = pk4(xs); } }
#pragma unroll 1
    for (int h = h_lo; h < h_hi; ++h) {
        __syncthreads();
        { const int row = tid >> 3, c8 = tid & 7;
#pragma unroll
          for (int x = 0; x < 3; ++x) { const v4u val = *(const v4u*)(PROJ + (size_t)(r0 + row) * LDP + x * 1536 + h * 64 + c8 * 8);
              *(LAS v4u*)(L + RC_RAW + x * 9216 + (row + 1) * 128 + c8 * 16) = val; }
          if (tid < 8) { const long prow = sample ? -1L : rw_prev_row(r0);
#pragma unroll
              for (int x = 0; x < 3; ++x) { v4u val = (v4u){0u, 0u, 0u, 0u}; if (prow >= 0) val = *(const v4u*)(PROJ + (size_t)prow * LDP + x * 1536 + h * 64 + tid * 8);
                  *(LAS v4u*)(L + RC_RAW + x * 9216 + tid * 16) = val; } } }
        f32x4 aw[2], aa[2], ag[2];
#pragma unroll
        for (int u = 0; u < 2; ++u) { aw[u] = (f32x4){0.f, 0.f, 0.f, 0.f}; aa[u] = aw[u]; ag[u] = aw[u]; }
        { const bf16* lw0 = LW + (size_t)(h * 64 + (2 * jh) * 16 + fr) * LORA_K + q4 * 8; const ldsp li = L + RC_LI + (it * 16 + fr) * 720 + q4 * 16;
#pragma unroll
          for (int ks = 0; ks < 11; ++ks) { const bf16x8 afr = *(LAS bf16x8*)(li + ks * 64);
#pragma unroll
              for (int u = 0; u < 2; ++u) { const bf16x8 bfr = *(const bf16x8*)(lw0 + (size_t)u * 16 * LORA_K + ks * 32);
                  if (ks < 2) aw[u] = MFMA16(afr, bfr, aw[u]); else if (ks < 4) aa[u] = MFMA16(afr, bfr, aa[u]); else ag[u] = MFMA16(afr, bfr, ag[u]); } } }
        __syncthreads();
        float xr[2][4], xk[2][4], xv[2][4], dw[2][4], av[2][4], kkr[2][4];
        float nrm[4] = {0.f, 0.f, 0.f, 0.f}, bon[4] = {0.f, 0.f, 0.f, 0.f};
#pragma unroll
        for (int u = 0; u < 2; ++u) { const int c = (2 * jh + u) * 16 + fr, ch = h * 64 + c;
            const float mur = mu[ch], muk = mu[1536 + ch], muv = mu[3072 + ch], w0c = w0[ch], a0c = a0[ch], kkc = k_k[ch], kac = k_a[ch], rkc = r_k[ch];
#pragma unroll
            for (int e = 0; e < 4; ++e) { const int t = it * 16 + 4 * q4 + e;
                const float cr = bf2f(*(LAS unsigned short*)(L + RC_RAW + (t + 1) * 128 + c * 2)), ck = bf2f(*(LAS unsigned short*)(L + RC_RAW + 9216 + (t + 1) * 128 + c * 2)),
                            cv = bf2f(*(LAS unsigned short*)(L + RC_RAW + 18432 + (t + 1) * 128 + c * 2));
                float pr, pk, pv;
                if (sample) { const bf16* pp = PROJ + (size_t)(r0 + t + NSMP) * LDP + ch; pr = bf2f(pp[0]); pk = bf2f(pp[1536]); pv = bf2f(pp[3072]); }
                else { pr = bf2f(*(LAS unsigned short*)(L + RC_RAW + t * 128 + c * 2)); pk = bf2f(*(LAS unsigned short*)(L + RC_RAW + 9216 + t * 128 + c * 2)); pv = bf2f(*(LAS unsigned short*)(L + RC_RAW + 18432 + t * 128 + c * 2)); }
                const float r_ = cr + (pr - cr) * mur, k_ = ck + (pk - ck) * muk, v_ = cv + (pv - cv) * muv;
                const float x = -(w0c + aw[u][e]);
                const float sp = fmaxf(x, 0.f) + __logf(1.f + __expf(-fabsf(x)));
                dw[u][e] = -__expf(-sp - 0.5f);
                const float a = fsigmoid(a0c + aa[u][e]);
                const float kr_ = k_ * kkc, kp = k_ * (1.f + (a - 1.f) * kac);
                xr[u][e] = r_; xk[u][e] = kp; xv[u][e] = v_; av[u][e] = a; kkr[u][e] = kr_;
                nrm[e] += kr_ * kr_; bon[e] += r_ * kp * rkc; } }
#pragma unroll
        for (int e = 0; e < 4; ++e) {
#pragma unroll
            for (int m = 1; m < 16; m <<= 1) { nrm[e] += __shfl_xor(nrm[e], m); bon[e] += __shfl_xor(bon[e], m); } }
        if (fr == 0) {
#pragma unroll
            for (int e = 0; e < 4; ++e) { ((LAS float*)(L + RC_XCH))[(w * 2 + 0) * 16 + 4 * q4 + e] = nrm[e]; ((LAS float*)(L + RC_XCH))[(w * 2 + 1) * 16 + 4 * q4 + e] = bon[e]; } }
        __syncthreads();
#pragma unroll
        for (int e = 0; e < 4; ++e) { nrm[e] += ((LAS float*)(L + RC_XCH))[((w ^ 1) * 2 + 0) * 16 + 4 * q4 + e]; bon[e] += ((LAS float*)(L + RC_XCH))[((w ^ 1) * 2 + 1) * 16 + 4 * q4 + e];
            nrm[e] = 1.f / fmaxf(sqrtf(nrm[e]), 1e-12f); }
#pragma unroll
        for (int u = 0; u < 2; ++u) { const int c = (2 * jh + u) * 16 + fr, ch = h * 64 + c;
#pragma unroll
            for (int e = 0; e < 4; ++e) { const size_t o = (size_t)(r0 + it * 16 + 4 * q4 + e) * MIX + ch;
                const float kk = kkr[u][e] * nrm[e];
                RR[o] = xr[u][e]; RK[o] = xk[u][e]; RV[o] = xv[u][e]; RKK[o] = kk; RKA[o] = kk * av[u][e]; RWd[o] = __expf(dw[u][e]); RG[o] = ag[u][e]; } }
        if (fr == 0 && jh == 0) {
#pragma unroll
            for (int e = 0; e < 4; ++e) BON[(size_t)(r0 + it * 16 + 4 * q4 + e) * BH + h] = bon[e]; }
    }
    __syncthreads();
}

__device__ __forceinline__ void rwkv_sample_unit(Frame& F, const Args& A, int lane, int j, int b, int h) {
    const float* RWd = (const float*)(F.ws + WS_RW); const float* RKK = (const float*)(F.ws + WS_RKK); const float* RKA = (const float*)(F.ws + WS_RKA);
    const float* RK = (const float*)(F.ws + WS_RK); const float* RR = (const float*)(F.ws + WS_RR); const float* RV = (const float*)(F.ws + WS_RV);
    const float* RG = (const float*)(F.ws + WS_RG); const float* BON = (const float*)(F.ws + WS_BONUS); bf16* MIXC = (bf16*)(F.ws + WS_MIXC);
    const float* lnx_g = A.in[29] + (size_t)j * MIX; const float* lnx_b = A.in[30] + (size_t)j * MIX;
    const size_t row = MP + b; const int chan = h * BHD; const int vr = lane >> 4, kc = lane & 15;
    const size_t vo = row * MIX + chan + 4 * kc;
    const f32x4 w4 = *(const f32x4*)(RWd + vo), kk4 = *(const f32x4*)(RKK + vo), ka4 = *(const f32x4*)(RKA + vo), k4 = *(const f32x4*)(RK + vo), r4 = *(const f32x4*)(RR + vo);
    const float* S0 = A.in[5] + ((size_t)(j * NSMP + b) * BH + h) * (BHD * BHD);
    float* S1 = F.out + O_SRS + ((size_t)(j * NSMP + b) * BH + h) * (BHD * BHD);
    float myo = 0.f, osum = 0.f, osq = 0.f;
#pragma unroll
    for (int vb = 0; vb < 16; ++vb) { const int v = 4 * vb + vr;
        f32x4 S = *(const f32x4*)(S0 + (size_t)v * BHD + 4 * kc);
        float sa = (S.x * kk4.x + S.y * kk4.y) + (S.z * kk4.z + S.w * kk4.w);
#pragma unroll
        for (int m = 1; m < 16; m <<= 1) sa += __shfl_xor(sa, m);
        sa = -sa;
        const float vv = RV[row * MIX + chan + v];
        S = S * w4 + ka4 * sa + k4 * vv;
        *(f32x4*)(S1 + (size_t)v * BHD + 4 * kc) = S;
        float o = (S.x * r4.x + S.y * r4.y) + (S.z * r4.z + S.w * r4.w);
#pragma unroll
        for (int m = 1; m < 16; m <<= 1) o += __shfl_xor(o, m);
        osum += o; osq += o * o;
        myo = (kc == vb) ? o : myo; }
    osum += __shfl_xor(osum, 16); osum += __shfl_xor(osum, 32); osq += __shfl_xor(osq, 16); osq += __shfl_xor(osq, 32);
    const float mean = osum * (1.f / 64.f); const float var = fmaxf(osq * (1.f / 64.f) - mean * mean, 0.f);
    const float rstd = 1.f / sqrtf(var + GN_EPS);
    const int ch = chan + 4 * kc + vr;
    const float on = (myo - mean) * rstd * lnx_g[ch] + lnx_b[ch];
    const float bonus = BON[row * BH + h] * RV[row * MIX + ch];
    MIXC[row * D + ch] = (bf16)f2bf((on + bonus) * RG[row * MIX + ch]);
}


#ifndef PROBE_SUB
#define PROBE_SUB 0
#endif
constexpr int RK_LI = 0, RK_XCH = 46080, RK_TOT = 47104, RK_LD = 51200, RK_WC = 55296, RK_TILE = 55552, TBYTES = 9216;
#define TBUF(p) (L + RK_TILE + (p) * TBYTES)
__device__ __forceinline__ f32x4 mm_tile(ldsp Ab, ldsp Bb, int ia, int jb, int fr, int q4) {
    f32x4 acc = (f32x4){0.f, 0.f, 0.f, 0.f};
#pragma unroll
    for (int ks = 0; ks < 2; ++ks) { const bf16x8 a = *(LAS bf16x8*)(Ab + (ia * 16 + fr) * 144 + ks * 64 + q4 * 16); const bf16x8 b = *(LAS bf16x8*)(Bb + (jb * 16 + fr) * 144 + ks * 64 + q4 * 16); acc = MFMA16(a, b, acc); }
    return acc;
}
__device__ __forceinline__ void st_tileT(ldsp buf, int ia, int jb, int fr, int q4, f32x4 v) { *(LAS v2u*)(buf + (jb * 16 + fr) * 144 + (ia * 16 + 4 * q4) * 2) = pk4(v); }

__device__ __forceinline__ void rwkv_chunk_unit(Frame& F, const Args& A, int j, int b, int cidx, int h_lo, int h_hi) {
    const ldsp L = F.lds; const int tid = fresh_tid(), w = __builtin_amdgcn_readfirstlane(tid >> 6), lane = tid & 63, fr = lane & 15, q4 = lane >> 4;
    const int it = w >> 1, jh = w & 1, grp = it * 4 + q4, i0 = it * 16 + 4 * q4;
    const int r0 = b * SEQ + cidx * 64;
    const bf16* PROJ = (const bf16*)(F.ws + WS_PROJ);
    const float* mu = A.in[20] + (size_t)j * B_MIXC; const float* w0 = A.in[21] + (size_t)j * MIX; const float* a0 = A.in[23] + (size_t)j * MIX;
    const float* k_k = A.in[26] + (size_t)j * MIX; const float* k_a = A.in[27] + (size_t)j * MIX; const float* r_k = A.in[28] + (size_t)j * MIX;
    const float* lnx_b = A.in[30] + (size_t)j * MIX;
    const bf16* LW = (const bf16*)(F.ws + WS_LW) + (size_t)j * MIX * LORA_K;
    __syncthreads();
#pragma unroll 2
    for (int itr = 0; itr < 11; ++itr) { const int idx = itr * NTHR + tid;
        if (idx < 64 * 88) { const int t = idx / 88, c4 = idx - t * 88, col = 4 * c4; const int row = r0 + t; const long prow = rw_prev_row(row);
            const f32x4 P = ld_bf4(PROJ + (size_t)row * LDP + B_LORA_OFF + col), Pp = ld_bf4_prev(PROJ, prow, B_LORA_OFF + col);
            const f32x4 m4 = *(const f32x4*)(mu + 4608 + col);
            f32x4 xs = P + (Pp - P) * m4;
            if (col < 64) { xs.x = ftanh(xs.x); xs.y = ftanh(xs.y); xs.z = ftanh(xs.z); xs.w = ftanh(xs.w); }
            else if (col >= 128) { xs.x = fsigmoid(xs.x); xs.y = fsigmoid(xs.y); xs.z = fsigmoid(xs.z); xs.w = fsigmoid(xs.w); }
            *(LAS v2u*)(L + RK_LI + t * 720 + col * 2) = pk4(xs); } }
    for (int i = tid; i < TBYTES / 16; i += NTHR) *(LAS v4u*)(TBUF(7) + i * 16) = (v4u){0u, 0u, 0u, 0u};
#pragma unroll 1
    for (int h = h_lo; h < h_hi; ++h) {
        unsigned char* rec = F.ws + WS_REC + ((size_t)(b * BH + h) * 32 + cidx) * REC_BYTES;
        LDS_BARRIER();
        { const int row = tid >> 3, c8 = tid & 7;
#pragma unroll
          for (int x = 0; x < 3; ++x) { const v4u val = *(const v4u*)(PROJ + (size_t)(r0 + row) * LDP + x * 1536 + h * 64 + c8 * 8);
              *(LAS v4u*)(TBUF(8 + x) + (row + 1) * 128 + c8 * 16) = val; }
          if (tid < 8) { const long prow = rw_prev_row(r0);
#pragma unroll
              for (int x = 0; x < 3; ++x) { v4u val = (v4u){0u, 0u, 0u, 0u}; if (prow >= 0) val = *(const v4u*)(PROJ + (size_t)prow * LDP + x * 1536 + h * 64 + tid * 8);
                  *(LAS v4u*)(TBUF(8 + x) + tid * 16) = val; } } }
        f32x4 aw[2], aa[2], ag[2];
#pragma unroll
        for (int u = 0; u < 2; ++u) { aw[u] = (f32x4){0.f, 0.f, 0.f, 0.f}; aa[u] = aw[u]; ag[u] = aw[u]; }
        { const bf16* lw0 = LW + (size_t)(h * 64 + (2 * jh) * 16 + fr) * LORA_K + q4 * 8; const ldsp li = L + RK_LI + (it * 16 + fr) * 720 + q4 * 16;
#pragma unroll
          for (int ks = 0; ks < 11; ++ks) { const bf16x8 afr = *(LAS bf16x8*)(li + ks * 64);
#pragma unroll
              for (int u = 0; u < 2; ++u) { const bf16x8 bfr = *(const bf16x8*)(lw0 + (size_t)u * 16 * LORA_K + ks * 32);
                  if (ks < 2) aw[u] = MFMA16(afr, bfr, aw[u]); else if (ks < 4) aa[u] = MFMA16(afr, bfr, aa[u]); else ag[u] = MFMA16(afr, bfr, ag[u]); }
          } }
        LDS_BARRIER();
        float xr[2][4], kp[2][4], xv[2][4], dw[2][4], av[2][4], kkr[2][4];
        float nrm[4] = {0.f, 0.f, 0.f, 0.f}, bon[4] = {0.f, 0.f, 0.f, 0.f};
#pragma unroll
        for (int u = 0; u < 2; ++u) { const int c = (2 * jh + u) * 16 + fr, ch = h * 64 + c;
            const float mur = mu[ch], muk = mu[1536 + ch], muv = mu[3072 + ch], w0c = w0[ch], a0c = a0[ch], kkc = k_k[ch], kac = k_a[ch], rkc = r_k[ch];
            float run = 0.f;
#pragma unroll
            for (int e = 0; e < 4; ++e) { const int t = i0 + e;
                const float cr = bf2f(*(LAS unsigned short*)(TBUF(8) + (t + 1) * 128 + c * 2)), ck = bf2f(*(LAS unsigned short*)(TBUF(9) + (t + 1) * 128 + c * 2)), cv = bf2f(*(LAS unsigned short*)(TBUF(10) + (t + 1) * 128 + c * 2));
                const float pr = bf2f(*(LAS unsigned short*)(TBUF(8) + t * 128 + c * 2)), pk = bf2f(*(LAS unsigned short*)(TBUF(9) + t * 128 + c * 2)), pv = bf2f(*(LAS unsigned short*)(TBUF(10) + t * 128 + c * 2));
                const float r_ = cr + (pr - cr) * mur, k_ = ck + (pk - ck) * muk, v_ = cv + (pv - cv) * muv;
                const float x = -(w0c + aw[u][e]);
                const float sp = fmaxf(x, 0.f) + __logf(1.f + __expf(-fabsf(x)));
                const float lw = -__expf(-sp - 0.5f);
                run += lw; dw[u][e] = lw;
                const float a = fsigmoid(a0c + aa[u][e]);
                const float kr_ = k_ * kkc, kp_ = k_ * (1.f + (a - 1.f) * kac);
                xr[u][e] = r_; kp[u][e] = kp_; xv[u][e] = v_; av[u][e] = a; kkr[u][e] = kr_;
                nrm[e] += kr_ * kr_; bon[e] += r_ * kp_ * rkc; }
            ((LAS float*)(L + RK_TOT))[grp * 64 + c] = run; __builtin_amdgcn_sched_barrier(0); }
#pragma unroll
        for (int e = 0; e < 4; ++e) {
#pragma unroll
            for (int m = 1; m < 16; m <<= 1) { nrm[e] += __shfl_xor(nrm[e], m); bon[e] += __shfl_xor(bon[e], m); } }
        if (fr == 0) {
#pragma unroll
            for (int e = 0; e < 4; ++e) { ((LAS float*)(L + RK_XCH))[(w * 2 + 0) * 16 + 4 * q4 + e] = nrm[e]; ((LAS float*)(L + RK_XCH))[(w * 2 + 1) * 16 + 4 * q4 + e] = bon[e]; } }
        LDS_BARRIER();
#pragma unroll
        for (int e = 0; e < 4; ++e) { nrm[e] += ((LAS float*)(L + RK_XCH))[((w ^ 1) * 2 + 0) * 16 + 4 * q4 + e]; bon[e] += ((LAS float*)(L + RK_XCH))[((w ^ 1) * 2 + 1) * 16 + 4 * q4 + e];
            nrm[e] = 1.f / fmaxf(sqrtf(nrm[e]), 1e-12f); }
        f32x4 gbar[2];
#pragma unroll
        for (int u = 0; u < 2; ++u) { const int jt = 2 * jh + u, c = jt * 16 + fr, ch = h * 64 + c;
            float off = 0.f, tot = 0.f;
#pragma unroll
            for (int gp = 0; gp < 16; ++gp) { const float tv = ((LAS float*)(L + RK_TOT))[gp * 64 + c]; tot += tv; off += (gp < grp) ? tv : 0.f; }
            const float lnb = lnx_b[ch];
            f32x4 al, bb, vv4, gv, bv; float cum = off;
#pragma unroll
            for (int e = 0; e < 4; ++e) { const int t = i0 + e;
                cum += dw[u][e];
                const float eW = __expf(cum), eWm = __expf(cum - dw[u][e]), eInv = __expf(-cum), eBar = __expf(tot - cum);
                const float kk = kkr[u][e] * nrm[e], bq = kk * av[u][e];
                const float alpha = kk * eWm, rho = xr[u][e] * eW, beta = bq * eInv, gamma = kp[u][e] * eInv;
                *(LAS unsigned short*)(TBUF(0) + t * 144 + c * 2) = (unsigned short)f2bf(alpha);
                *(LAS unsigned short*)(TBUF(1) + t * 144 + c * 2) = (unsigned short)f2bf(beta);
                *(LAS unsigned short*)(TBUF(2) + t * 144 + c * 2) = (unsigned short)f2bf(gamma);
                *(LAS unsigned short*)(TBUF(3) + t * 144 + c * 2) = (unsigned short)f2bf(rho);
                al[e] = alpha; bb[e] = bq * eBar; gbar[u][e] = kp[u][e] * eBar; vv4[e] = xv[u][e];
                gv[e] = ag[u][e]; bv[e] = (lnb + bon[e] * xv[u][e]) * ag[u][e]; }
            *(LAS v2u*)(TBUF(4) + c * 144 + i0 * 2) = pk4(al);
            *(LAS v2u*)(TBUF(5) + c * 144 + i0 * 2) = pk4(bb);
            *(LAS v2u*)(TBUF(6) + c * 144 + i0 * 2) = pk4(vv4);
            if (grp == 0) ((LAS float*)(L + RK_WC))[c] = __expf(tot);
            const int ti = it * 4 + jt;
            *(v2u*)(rec + 4 * 8192 + (size_t)(ti * 64 + lane) * 8) = pk4(gv);
            *(v2u*)(rec + 5 * 8192 + (size_t)(ti * 64 + lane) * 8) = pk4(bv);
            __builtin_amdgcn_sched_barrier(0); }
        LDS_BARRIER();
        f32x4 n2r[2], etr[2], e2tr[2];
        { int tl_ = lane; asm volatile("" : "+v"(tl_)); const int fr = tl_ & 15, q4 = tl_ >> 4, i0 = it * 16 + 4 * q4; (void)i0;
        { bf16x8 aB[2], aA[2], aG[2];
#pragma unroll
          for (int ks = 0; ks < 2; ++ks) { const int o = (it * 16 + fr) * 144 + ks * 64 + q4 * 16; aA[ks] = *(LAS bf16x8*)(TBUF(0) + o); aB[ks] = *(LAS bf16x8*)(TBUF(1) + o); aG[ks] = *(LAS bf16x8*)(TBUF(2) + o); }
#pragma unroll
          for (int u = 0; u < 2; ++u) { const int jt = 2 * jh + u, jx = jt * 16 + fr;
              f32x4 m1 = (f32x4){0.f, 0.f, 0.f, 0.f}, m2 = m1, n1 = m1, n2 = m1;
#pragma unroll
              for (int ks = 0; ks < 2; ++ks) { const int o = (jt * 16 + fr) * 144 + ks * 64 + q4 * 16;
                  const bf16x8 bA = *(LAS bf16x8*)(TBUF(0) + o), bG = *(LAS bf16x8*)(TBUF(2) + o), bR = *(LAS bf16x8*)(TBUF(3) + o);
                  m1 = MFMA16(aB[ks], bA, m1); m2 = MFMA16(aA[ks], bG, m2); n1 = MFMA16(aB[ks], bR, n1); n2 = MFMA16(aG[ks], bR, n2); }
#pragma unroll
              for (int r = 0; r < 4; ++r) { const int ix = i0 + r; m1[r] = (ix < jx) ? m1[r] : 0.f; m2[r] = (jx < ix) ? m2[r] : 0.f; n1[r] = (ix <= jx) ? n1[r] : 0.f; n2[r] = (ix <= jx) ? n2[r] : 0.f; }
              if (it == jt) {
#pragma unroll
                  for (int r = 0; r < 4; ++r) ((LAS float*)(L + RK_LD))[(it * 16 + 4 * q4 + r) * 16 + fr] = m1[r];
                  m1 = (f32x4){0.f, 0.f, 0.f, 0.f}; }
              st_tileT(TBUF(8), it, jt, fr, q4, m1); st_tileT(TBUF(9), it, jt, fr, q4, m2); st_tileT(TBUF(10), it, jt, fr, q4, n1);
              n2r[u] = n2; } }
        LDS_BARRIER();
        for (int idx = tid; idx < 576; idx += NTHR) { const int row = idx / 9, chn = idx - row * 9; if ((chn >> 1) != (row >> 4)) *(LAS v4u*)(TBUF(2) + row * 144 + chn * 16) = (v4u){0u, 0u, 0u, 0u}; }
        if (w == 0) { const int bI = lane >> 4, cc = lane & 15; const LAS float* Ld = (const LAS float*)(L + RK_LD) + bI * 256;
            float x[16];
#pragma unroll
            for (int s = 15; s >= 0; --s) { float acc = (s == cc) ? 1.f : 0.f;
#pragma unroll
                for (int m = s + 1; m < 16; ++m) acc -= Ld[s * 16 + m] * x[m];
                x[s] = acc; __builtin_amdgcn_sched_barrier(0); }
            v4u o0, o1; o0.x = pk2(x[0], x[1]); o0.y = pk2(x[2], x[3]); o0.z = pk2(x[4], x[5]); o0.w = pk2(x[6], x[7]); o1.x = pk2(x[8], x[9]); o1.y = pk2(x[10], x[11]); o1.z = pk2(x[12], x[13]); o1.w = pk2(x[14], x[15]);
            *(LAS v4u*)(TBUF(7) + (bI * 16 + cc) * 144 + bI * 32) = o0; *(LAS v4u*)(TBUF(7) + (bI * 16 + cc) * 144 + bI * 32 + 16) = o1;
#pragma unroll
            for (int s = 0; s < 16; ++s) *(LAS unsigned short*)(TBUF(2) + (bI * 16 + s) * 144 + (bI * 16 + cc) * 2) = (unsigned short)f2bf(x[s]); }
        LDS_BARRIER();
        }
        { int tl_ = lane; asm volatile("" : "+v"(tl_)); const int fr = tl_ & 15, q4 = tl_ >> 4, i0 = it * 16 + 4 * q4; (void)i0;
#pragma unroll
        for (int u = 0; u < 2; ++u) { const int jt = 2 * jh + u;
            const f32x4 e1 = mm_tile(TBUF(2), TBUF(8), it, jt, fr, q4); st_tileT(TBUF(0), it, jt, fr, q4, e1);
            const f32x4 e2 = mm_tile(TBUF(8), TBUF(2), it, jt, fr, q4); st_tileT(TBUF(1), it, jt, fr, q4, e2); etr[u] = e2; }
        LDS_BARRIER();
#pragma unroll
        for (int u = 0; u < 2; ++u) { const int jt = 2 * jh + u; e2tr[u] = mm_tile(TBUF(0), TBUF(1), it, jt, fr, q4); st_tileT(TBUF(2), it, jt, fr, q4, e2tr[u]); }
        LDS_BARRIER();
#pragma unroll
        for (int u = 0; u < 2; ++u) { const int jt = 2 * jh + u; const f32x4 e3 = mm_tile(TBUF(0), TBUF(2), it, jt, fr, q4);
            f32x4 f = e2tr[u] - etr[u] - e3;
            if (it == jt) {
#pragma unroll
                for (int r = 0; r < 4; ++r) f[r] += (4 * q4 + r == fr) ? 1.f : 0.f; }
            st_tileT(TBUF(8), it, jt, fr, q4, f); }
        LDS_BARRIER();
#pragma unroll
        for (int u = 0; u < 2; ++u) { const int jt = 2 * jh + u; st_tileT(TBUF(2), it, jt, fr, q4, mm_tile(TBUF(8), TBUF(7), it, jt, fr, q4)); }
        LDS_BARRIER();
        }
        { int tl_ = lane; asm volatile("" : "+v"(tl_)); const int fr = tl_ & 15, q4 = tl_ >> 4, i0 = it * 16 + 4 * q4; (void)i0;
#pragma unroll
        for (int u = 0; u < 2; ++u) { const int jt = 2 * jh + u;
            st_tileT(TBUF(0), it, jt, fr, q4, mm_tile(TBUF(2), TBUF(4), it, jt, fr, q4));
            st_tileT(TBUF(1), it, jt, fr, q4, mm_tile(TBUF(2), TBUF(9), it, jt, fr, q4)); }
        LDS_BARRIER();
#pragma unroll
        for (int u = 0; u < 2; ++u) { const int jt = 2 * jh + u;
            const f32x4 g1n = mm_tile(TBUF(0), TBUF(10), it, jt, fr, q4), g2n = mm_tile(TBUF(1), TBUF(10), it, jt, fr, q4);
            const f32x4 g1b = mm_tile(TBUF(0), TBUF(5), it, jt, fr, q4), g2b = mm_tile(TBUF(1), TBUF(5), it, jt, fr, q4);
            const f32x4 rterm = bf4(*(LAS v2u*)(TBUF(3) + (jt * 16 + fr) * 144 + i0 * 2));
            f32x4 q1 = -g1b;
            if (it == jt) { const float wc = ((LAS float*)(L + RK_WC))[jt * 16 + fr];
#pragma unroll
                for (int r = 0; r < 4; ++r) q1[r] += (4 * q4 + r == fr) ? wc : 0.f; }
            st_tileT(TBUF(8), it, jt, fr, q4, rterm - g1n);
            st_tileT(TBUF(9), it, jt, fr, q4, q1);
            st_tileT(TBUF(2), it, jt, fr, q4, n2r[u] - g2n);
            st_tileT(TBUF(4), it, jt, fr, q4, gbar[u] - g2b); }
        LDS_BARRIER();
#pragma unroll
        for (int u = 0; u < 2; ++u) { const int jt = 2 * jh + u, ti = it * 4 + jt;
            *(v2u*)(rec + 2 * 8192 + (size_t)(ti * 64 + lane) * 8) = pk4(mm_tile(TBUF(4), TBUF(6), it, jt, fr, q4));
            *(v2u*)(rec + 3 * 8192 + (size_t)(ti * 64 + lane) * 8) = pk4(mm_tile(TBUF(2), TBUF(6), it, jt, fr, q4)); }
        { const int row = tid >> 3, c8 = tid & 7;
          *(v4u*)(rec + row * 128 + c8 * 16) = *(LAS v4u*)(TBUF(8) + row * 144 + c8 * 16);
          *(v4u*)(rec + 8192 + row * 128 + c8 * 16) = *(LAS v4u*)(TBUF(9) + row * 144 + c8 * 16); }
        }
    }
    __syncthreads();
}

constexpr int CH_S = 0, CH_Q = 9216;
__device__ __forceinline__ void rwkv_chain_unit(Frame& F, int b, int h, float* state_out) {
    const ldsp L = F.lds; const int tid = fresh_tid(), w = __builtin_amdgcn_readfirstlane(tid >> 6), lane = tid & 63, fr = lane & 15, q4 = lane >> 4;
    const int it = w >> 1, jh = w & 1;
    unsigned char* recb = F.ws + WS_REC + ((size_t)(b * BH + h) * 32) * REC_BYTES;
    const int row = tid >> 3, c8 = tid & 7;
    const size_t qoff = 8192 + row * 128 + c8 * 16, uoff0 = 2 * 8192 + (size_t)((it * 4 + 2 * jh) * 64 + lane) * 8, uoff1 = uoff0 + 512, soff = 6 * 8192 + row * 128 + c8 * 16;
    __syncthreads();
    for (int i = tid; i < TBYTES / 16; i += NTHR) *(LAS v4u*)(L + CH_S + i * 16) = (v4u){0u, 0u, 0u, 0u};
    v4u qreg[4]; v2u ureg[4][2];
#pragma unroll
    for (int i = 0; i < 3; ++i) { const unsigned char* rc = recb + (size_t)i * REC_BYTES; qreg[i] = *(const v4u*)(rc + qoff); ureg[i][0] = *(const v2u*)(rc + uoff0); ureg[i][1] = *(const v2u*)(rc + uoff1); }
    f32x4 acc[2];
#pragma unroll 1
    for (int cc = 0; cc < 8; ++cc) {
#pragma unroll
        for (int i = 0; i < 4; ++i) { const int c = 4 * cc + i;
            unsigned char* rec = recb + (size_t)c * REC_BYTES;
            *(LAS v4u*)(L + CH_Q + row * 144 + c8 * 16) = qreg[i];
            const f32x4 uu0 = bf4(ureg[i][0]), uu1 = bf4(ureg[i][1]);
            if (c + 3 < 32) { const unsigned char* rn = rec + 3 * REC_BYTES; const int s3 = (i + 3) & 3;
                qreg[s3] = *(const v4u*)(rn + qoff); ureg[s3][0] = *(const v2u*)(rn + uoff0); ureg[s3][1] = *(const v2u*)(rn + uoff1); }
            LDS_BARRIER();
            *(v4u*)(rec + soff) = *(LAS v4u*)(L + CH_S + row * 144 + c8 * 16);
            acc[0] = uu0 + mm_tile(L + CH_Q, L + CH_S, it, 2 * jh, fr, q4);
            acc[1] = uu1 + mm_tile(L + CH_Q, L + CH_S, it, 2 * jh + 1, fr, q4);
            LDS_BARRIER();
            st_tileT(L + CH_S, it, 2 * jh, fr, q4, acc[0]); st_tileT(L + CH_S, it, 2 * jh + 1, fr, q4, acc[1]); }
    }
#pragma unroll
    for (int u = 0; u < 2; ++u) *(f32x4*)(state_out + (size_t)((2 * jh + u) * 16 + fr) * BHD + it * 16 + 4 * q4) = acc[u];
    __syncthreads();
}

constexpr int RO_STG = 0, RO_LD = 1552;
__device__ __forceinline__ void rwkv_out_unit(Frame& F, const Args& A, int j, int b, int cidx, int h_lo) {
    const ldsp L = F.lds; const int tid = fresh_tid(), w = __builtin_amdgcn_readfirstlane(tid >> 6), lane = tid & 63, fr = lane & 15, q4 = lane >> 4;
    const int it = w & 3, hsel = w >> 2;
    const float* lnx_g = A.in[29] + (size_t)j * MIX;
    bf16* MIXC = (bf16*)(F.ws + WS_MIXC);
    const int r0 = b * SEQ + cidx * 64;
    __syncthreads();
#pragma unroll 1
    for (int hp = 0; hp < 6; ++hp) { const int hl = 2 * hp + hsel, h = h_lo + hl;
        const unsigned char* rec = F.ws + WS_REC + ((size_t)(b * BH + h) * 32 + cidx) * REC_BYTES;
        bf16x8 pa[2];
#pragma unroll
        for (int ks = 0; ks < 2; ++ks) pa[ks] = *(const bf16x8*)(rec + (it * 16 + fr) * 128 + ks * 64 + q4 * 16);
        f32x4 o[4]; float s1[4] = {0.f, 0.f, 0.f, 0.f}, s2[4] = {0.f, 0.f, 0.f, 0.f};
#pragma unroll
        for (int jt = 0; jt < 4; ++jt) { f32x4 acc = bf4(*(const v2u*)(rec + 3 * 8192 + (size_t)((it * 4 + jt) * 64 + lane) * 8));
#pragma unroll
            for (int ks = 0; ks < 2; ++ks) { const bf16x8 sb = *(const bf16x8*)(rec + 6 * 8192 + (jt * 16 + fr) * 128 + ks * 64 + q4 * 16); acc = MFMA16(pa[ks], sb, acc); }
            o[jt] = acc;
#pragma unroll
            for (int r = 0; r < 4; ++r) { s1[r] += acc[r]; s2[r] += acc[r] * acc[r]; } }
#pragma unroll
        for (int r = 0; r < 4; ++r) {
#pragma unroll
            for (int m = 1; m < 16; m <<= 1) { s1[r] += __shfl_xor(s1[r], m); s2[r] += __shfl_xor(s2[r], m); } }
        float mean[4], rstd[4];
#pragma unroll
        for (int r = 0; r < 4; ++r) { mean[r] = s1[r] * (1.f / 64.f); const float var = fmaxf(s2[r] * (1.f / 64.f) - mean[r] * mean[r], 0.f); rstd[r] = 1.f / sqrtf(var + GN_EPS); }
#pragma unroll
        for (int jt = 0; jt < 4; ++jt) { const int vch = jt * 16 + fr; const float lg = lnx_g[h * 64 + vch];
            const f32x4 gv = bf4(*(const v2u*)(rec + 4 * 8192 + (size_t)((it * 4 + jt) * 64 + lane) * 8)), bv = bf4(*(const v2u*)(rec + 5 * 8192 + (size_t)((it * 4 + jt) * 64 + lane) * 8));
#pragma unroll
            for (int r = 0; r < 4; ++r) { const float val = (o[jt][r] - mean[r]) * rstd[r] * lg * gv[r] + bv[r];
                *(LAS unsigned short*)(L + RO_STG + (it * 16 + 4 * q4 + r) * RO_LD + (hl * 64 + vch) * 2) = (unsigned short)f2bf(val); } }
    }
    __syncthreads();
    for (int i = tid; i < 64 * 96; i += NTHR) { const int t = i / 96, c16 = i - t * 96;
        *(v4u*)(MIXC + (size_t)(r0 + t) * D + h_lo * 64 + c16 * 8) = *(LAS v4u*)(L + RO_STG + t * RO_LD + c16 * 16); }
    __syncthreads();
}


constexpr int PH_PER_PAIR = 12, N_PHASES = 1 + 2 * PH_PER_PAIR + 1;
#ifndef MK_N_LAUNCHES
#define MK_N_LAUNCHES 1


#endif
#ifndef PROBE_K
#define PROBE_K 0
#endif
#ifndef PROBE_P0
#define PROBE_P0 0
#endif
#ifndef PROBE_SUB
#define PROBE_SUB 0
#endif

__global__ void __launch_bounds__(NTHR, 2) fwd_kernel(Args args) {
    extern __shared__ __attribute__((aligned(16))) unsigned char lds_raw[];
    Frame F;
    F.lds = (ldsp)lds_raw;
    F.tid = threadIdx.x; F.lane = F.tid & 63; F.wave = __builtin_amdgcn_readfirstlane(F.tid >> 6);
    F.G = gridDim.x; { const int bx = blockIdx.x; F.vcu = (F.G % 8 == 0) ? (bx % 8) * (F.G / 8) + bx / 8 : bx; }
    F.ws = args.ws; F.out = args.out;
    volatile LAS unsigned* MISC = (volatile LAS unsigned*)(F.lds + MISC_OFF);
    for (int u = F.tid; u < (LDS_BYTES - LDSCTL_OFF) / 4; u += NTHR) ((LAS unsigned*)(F.lds + LDSCTL_OFF))[u] = 0u;
    __syncthreads();
    const int lo = args.ph_lo, hi = args.ph_hi;
    const bool multi = (hi - lo) > 1;
    XcdBarrier bar; bar.bar = (unsigned*)(F.ws + WS_CTL) + CW_BAR; bar.x = 0; bar.st = nullptr;
    if (multi) bar = xcd_barrier_post((unsigned*)(F.ws + WS_CTL) + CW_BAR, MISC + 8);
#define IN(k) (lo <= (k) && (k) < hi)
#define SEAM(k) do { if (IN((k) + 1)) xcd_barrier(bar); } while (0)

    bf16* const H = (bf16*)(F.ws + WS_H); bf16* const PROJ = (bf16*)(F.ws + WS_PROJ); bf16* const MIXC = (bf16*)(F.ws + WS_MIXC); bf16* const ACT = (bf16*)(F.ws + WS_ACT);
    float* const X = (float*)(F.ws + WS_X); const float* const Xs = X + (size_t)MP * D;
    const int blk = blockIdx.x;

#define PH(k, ...) if (IN(base + (k))) { __VA_ARGS__ if constexpr (((PROBE_K) >> (k)) & 1) { __VA_ARGS__ } SEAM(base + (k)); }
    if (IN(0)) { p0_prologue(F, args); if constexpr (PROBE_P0) { p0_prologue(F, args); } SEAM(0); }

    for (int j = 0; j < 2; ++j) {
        const int base = 1 + j * PH_PER_PAIR;
        const int la = 2 * j, lb = 2 * j + 1;
        const bf16* const WinA = (const bf16*)(F.ws + WS_WINA + (size_t)j * SZ_WINA); const bf16* const WoutA = (const bf16*)(F.ws + WS_WOUTA + (size_t)j * SZ_WSQ);
        const bf16* const WinB = (const bf16*)(F.ws + WS_WINB + (size_t)j * SZ_WINB); const bf16* const WoutB = (const bf16*)(F.ws + WS_WOUTB + (size_t)j * SZ_WSQ);
        PH(0,
            { unsigned* sflag = (unsigned*)(F.ws + WS_CTL) + CW_SFLAG + 64 * la;
              if (blk >= 256 - SN_BLOCKS) { const int ftw = fresh_tid(); sample_rows_prepare(F, nullptr, nullptr, ss_slot(F.ws, 2 * la), sflag, (blk - (256 - SN_BLOCKS)) * NWAVES + __builtin_amdgcn_readfirstlane(ftw >> 6)); }
              run_gemm_sample(F, H, WinA, A_IN, D, EpiBf<0>{PROJ, LDP, ss_slot(F.ws, 2 * la)}, sflag); }
            if (j == 0) run_gemm(F, (const bf16*)(F.ws + WS_MEMN), (const bf16*)(F.ws + WS_WKV), 1024, 4096, D, EpiMemKV{F.out}, 128);
        )
        PH(1,
            { const float* Kp = F.out + O_MK + (size_t)la * (1024 * 512); const float* Vp = F.out + O_MV + (size_t)la * (1024 * 512);
            if (blk < 96) { const int bh = blk < 48 ? blk : blk - 48, b = bh / AH, h = bh % AH;
                hgrn_prompt_unit(F, PROJ, MIXC, args.in[16], args.in[17] + (size_t)j * MIX, F.out + O_SHP + ((size_t)(j * NB + b) * AH + h) * (AHD * AHD), j, b, h, blk < 48 ? HG_SPLIT : 0, blk < 48 ? SEQ / 64 : HG_SPLIT);
                if (PROBE_SUB == 10) hgrn_prompt_unit(F, PROJ, MIXC, args.in[16], args.in[17] + (size_t)j * MIX, F.out + O_SHP + ((size_t)(j * NB + b) * AH + h) * (AHD * AHD), j, b, h, blk < 48 ? HG_SPLIT : 0, blk < 48 ? SEQ / 64 : HG_SPLIT); }
            else { if (blk < 224) { const int u = blk - 96, b = u >> 5, head = (u >> 3) & 3, qp = u & 7;
                    xattn_prompt_unit(F, PROJ, A_XQ_OFF, MIXC, Kp + (size_t)b * NMEM * XDIM, Vp + (size_t)b * NMEM * XDIM, b, head, qp); }
                const int nw = (F.G - 96) * NWAVES; const int ft = fresh_tid(); F.lane = ft & 63; F.wave = __builtin_amdgcn_readfirstlane(ft >> 6);
                const int prio = blk >= 224 ? blk - 224 : blk - 96 + 32;
                for (int rep14 = 0; rep14 < (PROBE_SUB == 14 ? 2 : 1); ++rep14)
                for (int u = prio * NWAVES + F.wave; u < NSMP * AH + NSMP * XH; u += nw) {
                    if (u < NSMP * AH) { const int b = u / AH, h = u % AH;
                        hgrn_sample_unit(F.lane, PROJ, MIXC, args.in[16], args.in[17] + (size_t)j * MIX, args.in[4] + ((size_t)(j * NSMP + b) * AH + h) * (AHD * AHD),
                                         F.out + O_SHS + ((size_t)(j * NSMP + b) * AH + h) * (AHD * AHD), j, b, h); }
                    else { const int q = u - NSMP * AH, b = q >> 2, head = q & 3;
                        xattn_sample_unit(F.lane, PROJ, A_XQ_OFF, MIXC, args.in[2] + ((size_t)(la * NSMP + b) * NMEM) * XDIM, args.in[3] + ((size_t)(la * NSMP + b) * NMEM) * XDIM, b, head); } } }
            { __syncthreads();
                convert_items_dyn(F, args, args.git[2 + 2 * j], args.git[3 + 2 * j], (unsigned*)(F.ws + WS_CTL) + CW_CQ + 512 * j + 64 * (blk & 7), blk & 7); __syncthreads(); } }
        )
        if (IN(base + 2)) { run_gemm(F, MIXC, WoutA, MP, D, D, EpiResid<false>{X, D, H, ss_slot(F.ws, 2 * la + 1), nullptr}, 0);
              skinny_gemm<0, 2>(F, MIXC + (size_t)MP * D, D, nullptr, WoutA, D, 64 * (blk & 31), (blk >> 5) & 1, 512 * (blk >> 6), 512, X, D, MP); SEAM(base + 2); }
        if (PROBE_SUB == 12 && IN(base + 3)) { run_gemm(F, H, WoutA, MP, D, D, EpiDummy{(float*)PROJ, D}, 0); }
        if (PROBE_SUB == 13 && IN(base + 3)) { run_gemm(F, H, (const bf16*)(F.ws + WS_W1 + (size_t)la * SZ_WFF), MP, 4096, D, EpiDummy{(float*)PROJ, 4096}, 0); }
        PH(3, if (blk & 1) skinny_gemm<1, 1>(F, Xs, D, nullptr, (const bf16*)(F.ws + WS_W1 + (size_t)la * SZ_WFF), D, 64 * (blk >> 1), blk & 1, 0, D, ACT, DFF, MP);
              run_gemm(F, H, (const bf16*)(F.ws + WS_W1 + (size_t)la * SZ_WFF), MP, DFF, D, EpiBf<2>{ACT, DFF, nullptr}, 0);
              if (!(blk & 1)) skinny_gemm<1, 1>(F, Xs, D, nullptr, (const bf16*)(F.ws + WS_W1 + (size_t)la * SZ_WFF), D, 64 * (blk >> 1), blk & 1, 0, D, ACT, DFF, MP);
              if (PROBE_SUB == 5) skinny_gemm<1, 1>(F, Xs, D, nullptr, (const bf16*)(F.ws + WS_W1 + (size_t)la * SZ_WFF), D, 64 * (blk >> 1), blk & 1, 0, D, ACT, DFF, MP); )
        if (IN(base + 4)) { if (PROBE_SUB == 9) run_gemm(F, ACT, (const bf16*)(F.ws + WS_W2 + (size_t)la * SZ_WFF), MP, D, DFF, EpiDummy{(float*)PROJ, D}, 0);
              run_gemm(F, ACT, (const bf16*)(F.ws + WS_W2 + (size_t)la * SZ_WFF), MP, D, DFF, EpiResid<true>{X, D, H, ss_slot(F.ws, 2 * lb), ss_slot(F.ws, 2 * la + 1)}, 0);
              skinny_gemm<0, 2>(F, ACT + (size_t)MP * DFF, DFF, nullptr, (const bf16*)(F.ws + WS_W2 + (size_t)la * SZ_WFF), DFF, 64 * (blk & 31), (blk >> 5) & 1, 2048 * (blk >> 6), 2048, X, D, MP); SEAM(base + 4); }
        PH(5, { unsigned* sflag = (unsigned*)(F.ws + WS_CTL) + CW_SFLAG + 64 * lb;
              if (blk >= 256 - SN_BLOCKS) { const int ftw = fresh_tid(); sample_rows_prepare(F, args.in[6] + (size_t)j * NSMP * D, args.in[8] + (size_t)lb * D, ss_slot(F.ws, 2 * lb), sflag, (blk - (256 - SN_BLOCKS)) * NWAVES + __builtin_amdgcn_readfirstlane(ftw >> 6)); }
              run_gemm_sample_early(F, H, WinB, B_INP, D, EpiBf<0>{PROJ, LDP, ss_slot(F.ws, 2 * lb)}, sflag, (unsigned*)(F.ws + WS_CTL) + CW_PDONE + 64 * j); }
              if (blk >= 192) {
                  const int ft = fresh_tid(); const int ln = ft & 63, gwv = (blk - 192) * NWAVES + __builtin_amdgcn_readfirstlane(ft >> 6);
                  for (int r = gwv; r < NB + NSMP; r += 64 * NWAVES) { const int row = r < NB ? r * SEQ + SEQ - 1 : MP + (r - NB);
                      float* dst = r < NB ? F.out + O_SSP + (size_t)(j * NB + r) * D : F.out + O_SSS + (size_t)(j * NSMP + (r - NB)) * D;
                      norm_row(X + (size_t)row * D, args.in[8] + (size_t)lb * D, ln, nullptr, dst, nullptr, nullptr); } }
              if (blk >= 214) { wait_counter((const unsigned*)(F.ws + WS_CTL) + CW_PDONE + 64 * j, B_INP / 256);
                  const int idx = blk - 214, h0 = idx < 36 ? idx : 36 + 2 * (idx - 36), nh = idx < 36 ? 1 : 2;
                  rwkv_prep_unit(F, args, j, (128 + h0 / 24) * 64, h0 % 24, h0 % 24 + nh); } )
        PH(6,
            rwkv_chunk_unit(F, args, j, blk >> 6, (blk >> 1) & 31, (blk & 1) * 12, (blk & 1) * 12 + 12);
        )
        PH(7,
            { const float* Kp = F.out + O_MK + (size_t)lb * (1024 * 512); const float* Vp = F.out + O_MV + (size_t)lb * (1024 * 512);
            if (blk < 96) { const int b = blk / BH, h = blk % BH; rwkv_chain_unit(F, b, h, F.out + O_SRP + ((size_t)(j * NB + b) * BH + h) * (BHD * BHD));
                if (PROBE_SUB == 7) rwkv_chain_unit(F, b, h, F.out + O_SRP + ((size_t)(j * NB + b) * BH + h) * (BHD * BHD)); }
            else if (blk < 224) { const int u = blk - 96, b = u >> 5, head = (u >> 3) & 3, qp = u & 7;
                    xattn_prompt_unit(F, PROJ, B_XQ_OFF, MIXC, Kp + (size_t)b * NMEM * XDIM, Vp + (size_t)b * NMEM * XDIM, b, head, qp);
                    if (PROBE_SUB == 17) xattn_prompt_unit(F, PROJ, B_XQ_OFF, MIXC, Kp + (size_t)b * NMEM * XDIM, Vp + (size_t)b * NMEM * XDIM, b, head, qp); }
            __syncthreads();
            xattn_sample_pair(F, PROJ, B_XQ_OFF, MIXC, args.in[2] + (size_t)lb * NSMP * NMEM * XDIM, args.in[3] + (size_t)lb * NSMP * NMEM * XDIM, 2 * blk);
            { const int nw = F.G * NWAVES; const int ft = fresh_tid(); F.lane = ft & 63; F.wave = __builtin_amdgcn_readfirstlane(ft >> 6);
              const int prio = blk >= 224 ? blk - 224 : (blk >= 96 ? blk - 96 + 128 : blk + 32);
              for (int u = prio * NWAVES + F.wave; u < NSMP * BH; u += nw) rwkv_sample_unit(F, args, F.lane, j, u / BH, u % BH); } }
        )
        PH(8, rwkv_out_unit(F, args, j, blk >> 6, (blk >> 1) & 31, (blk & 1) * 12); )
        if (IN(base + 9)) { run_gemm(F, MIXC, WoutB, MP, D, D, EpiResid<false>{X, D, H, ss_slot(F.ws, 2 * lb + 1), nullptr}, 0);
               skinny_gemm<0, 2>(F, MIXC + (size_t)MP * D, D, nullptr, WoutB, D, 64 * (blk & 31), (blk >> 5) & 1, 512 * (blk >> 6), 512, X, D, MP); SEAM(base + 9); }
        PH(10, if (blk & 1) skinny_gemm<1, 1>(F, Xs, D, nullptr, (const bf16*)(F.ws + WS_W1 + (size_t)lb * SZ_WFF), D, 64 * (blk >> 1), blk & 1, 0, D, ACT, DFF, MP);
              run_gemm(F, H, (const bf16*)(F.ws + WS_W1 + (size_t)lb * SZ_WFF), MP, DFF, D, EpiBf<2>{ACT, DFF, nullptr}, 0);
              if (!(blk & 1)) skinny_gemm<1, 1>(F, Xs, D, nullptr, (const bf16*)(F.ws + WS_W1 + (size_t)lb * SZ_WFF), D, 64 * (blk >> 1), blk & 1, 0, D, ACT, DFF, MP);
               if (PROBE_SUB == 5) skinny_gemm<1, 1>(F, Xs, D, nullptr, (const bf16*)(F.ws + WS_W1 + (size_t)lb * SZ_WFF), D, 64 * (blk >> 1), blk & 1, 0, D, ACT, DFF, MP); )
        if (IN(base + 11)) { if (PROBE_SUB == 9) run_gemm(F, ACT, (const bf16*)(F.ws + WS_W2 + (size_t)lb * SZ_WFF), MP, D, DFF, EpiDummy{(float*)PROJ, D}, 0);
              run_gemm(F, ACT, (const bf16*)(F.ws + WS_W2 + (size_t)lb * SZ_WFF), MP, D, DFF, EpiResid<true>{X, D, H, ss_slot(F.ws, 2 * lb + 2), ss_slot(F.ws, 2 * lb + 1)}, 0);
               skinny_gemm<0, 2>(F, ACT + (size_t)MP * DFF, DFF, nullptr, (const bf16*)(F.ws + WS_W2 + (size_t)lb * SZ_WFF), DFF, 64 * (blk & 31), (blk >> 5) & 1, 2048 * (blk >> 6), 2048, X, D, MP); SEAM(base + 11); }
    }
    if (IN(N_PHASES - 1)) { norm_phase(F, args, args.in[10], false, true, -1); }
#undef PH
#undef IN
#undef SEAM
}

static int add_job(Job* jobs, int& n, int& items, const float* src, bf16* dst, int ldw, int K, int ncols, int ldt, int koff, int row_off, const float* gain = nullptr) {
    Job J{}; J.src = src; J.dst = dst; J.gain = gain; J.ldw = ldw; J.K = K; J.ncols = ncols; J.ldt = ldt; J.koff = koff; J.row_off = row_off; J.item0 = items; J.pad = 0;
    jobs[n++] = J; items += ((K + 63) / 64) * ((ncols + 63) / 64); return n;
}

extern "C" void kernel_launch(void* const* d_in, const int* in_sizes, int n_in, void* d_out, int out_size, void* d_ws, size_t ws_size, hipStream_t stream) {
    static int ready = 0;
    if (ready == 0) {
        if (n_in != 33 || (size_t)out_size != O_END || ws_size < WS_END) { fprintf(stderr, "kernel_launch: unexpected shapes: n_in %d out %d ws %zu (need %zu)\n", n_in, out_size, ws_size, (size_t)WS_END); ready = -1; return; }
        if (hipFuncSetAttribute((const void*)fwd_kernel, hipFuncAttributeMaxDynamicSharedMemorySize, LDS_BYTES) != hipSuccess) { fprintf(stderr, "kernel_launch: hipFuncSetAttribute failed\n"); ready = -1; return; }
        int per_cu = 0;
        if (hipOccupancyMaxActiveBlocksPerMultiprocessor(&per_cu, (const void*)fwd_kernel, NTHR, LDS_BYTES) != hipSuccess || per_cu < 1) fprintf(stderr, "kernel_launch: occupancy query says %d\n", per_cu);
        (void)hipGetLastError();
        ready = 1;
    }
    if (ready < 0) return;
    unsigned char* ws = (unsigned char*)d_ws;
    (void)hipMemsetAsync(ws + WS_CTL, 0, CTL_BYTES, stream);
    Args a{};
    for (int i = 0; i < 33; ++i) a.in[i] = (const float*)d_in[i];
    a.out = (float*)d_out; a.ws = ws;
    int n = 0, items = 0;
    const float* a_w_in = a.in[14]; const float* a_w_out = a.in[15]; const float* b_w_in = a.in[18]; const float* b_w_out = a.in[19];
    const float* w1 = a.in[31]; const float* w2 = a.in[32]; const float* wk = a.in[12]; const float* wv = a.in[13];
    auto job_a_in = [&](int j) { add_job(a.jobs, n, items, a_w_in + (size_t)j * D * A_IN, (bf16*)(ws + WS_WINA + j * SZ_WINA), A_IN, D, A_IN, D, 0, 0, a.in[8] + (size_t)(2 * j) * D); };
    auto job_a_out = [&](int j) { add_job(a.jobs, n, items, a_w_out + (size_t)j * D * D, (bf16*)(ws + WS_WOUTA + j * SZ_WSQ), D, D, D, D, 0, 0); };
    auto job_b = [&](int j) {
        const float* bw = b_w_in + (size_t)j * D * B_IN; bf16* bd = (bf16*)(ws + WS_WINB + j * SZ_WINB); const float* gB = a.in[8] + (size_t)(2 * j + 1) * D;
        add_job(a.jobs, n, items, bw, bd, B_IN, D, 4608, D, 0, 0, gB);
        add_job(a.jobs, n, items, bw + B_MIXC, bd, B_IN, D, XDIM, D, 0, B_XQ_OFF, gB);
        add_job(a.jobs, n, items, bw + 4608, bd, B_IN, D, LORA_K, D, 0, B_LORA_OFF, gB);
        add_job(a.jobs, n, items, b_w_out + (size_t)j * D * D, (bf16*)(ws + WS_WOUTB + j * SZ_WSQ), D, D, D, D, 0, 0);
        bf16* lw = (bf16*)(ws + WS_LW + j * SZ_LW);
        add_job(a.jobs, n, items, a.in[22] + (size_t)j * 64 * MIX, lw, MIX, 64, MIX, LORA_K, 0, 0);
        add_job(a.jobs, n, items, a.in[24] + (size_t)j * 64 * MIX, lw, MIX, 64, MIX, LORA_K, 64, 0);
        add_job(a.jobs, n, items, a.in[25] + (size_t)j * 224 * MIX, lw, MIX, 224, MIX, LORA_K, 128, 0); };
    auto job_mlp = [&](int l) {
        add_job(a.jobs, n, items, w1 + (size_t)l * D * DFF, (bf16*)(ws + WS_W1 + l * SZ_WFF), DFF, D, DFF, D, 0, 0, a.in[9] + (size_t)l * D);
        add_job(a.jobs, n, items, w2 + (size_t)l * DFF * D, (bf16*)(ws + WS_W2 + l * SZ_WFF), D, DFF, D, DFF, 0, 0); };
    a.git[0] = 0;
    job_a_in(0);
    for (int l = 0; l < 4; ++l) {
        add_job(a.jobs, n, items, wk + (size_t)l * D * XDIM, (bf16*)(ws + WS_WKV + l * SZ_WKV), XDIM, D, XDIM, D, 0, 0);
        add_job(a.jobs, n, items, wv + (size_t)l * D * XDIM, (bf16*)(ws + WS_WKV + l * SZ_WKV), XDIM, D, XDIM, D, 0, XDIM); }
    a.git[1] = items;
    job_a_out(0); job_mlp(0); job_b(0); job_mlp(1); job_a_in(1);
    a.git[3] = items; a.git[2] = a.git[1] + (int)((a.git[3] - a.git[1]) * 0.0f);
    job_a_out(1); job_mlp(2); job_b(1); job_mlp(3);
    a.git[5] = items; a.git[4] = a.git[3] + (int)((a.git[5] - a.git[3]) * 0.0f);
    a.njobs = n; a.nitems = items;
    const int grid = 256;
#if MK_N_LAUNCHES == 1
    a.ph_lo = 0; a.ph_hi = N_PHASES;
    hipLaunchKernelGGL(fwd_kernel, dim3(grid), dim3(NTHR), LDS_BYTES, stream, a);
#else
    for (int p = 0; p < N_PHASES; ++p) { a.ph_lo = p; a.ph_hi = p + 1; hipLaunchKernelGGL(fwd_kernel, dim3(grid), dim3(NTHR), LDS_BYTES, stream, a); }
#endif
    const hipError_t le = hipPeekAtLastError();
    if (le != hipSuccess) fprintf(stderr, "kernel_launch: launch failed: %s\n", hipGetErrorName(le));
}
```

```cpp
#include <hip/hip_runtime.h>
#include <cstdio>
#include <cstdint>
#define MK_N_LAUNCHES 1
#define PROBE_K 0
#define PROBE_P0 0
#define PROBE_SUB 0
namespace pg8 {
#define PG8_LAS __attribute__((address_space(3)))
typedef unsigned short bf16_t;
typedef short bf16x8 __attribute__((ext_vector_type(8)));
typedef float f32x4 __attribute__((ext_vector_type(4)));
typedef unsigned u32x4 __attribute__((ext_vector_type(4)));
constexpr int BM = 256, BK = 64, HALF = 128, HTB = HALF * BK * 2  , STAGE_BYTES = 8 * HTB, NXCD = 8, WGM = 4;

__host__ __device__ __forceinline__ int lds_byte(int r, int c) { const int st = (r >> 4) * 2 + (c >> 5), rr = r & 15, cc = c & 31, ob = rr * 64 + cc * 2; return st * 1024 + (ob ^ (((ob >> 9) & 1) << 5)); }
__host__ __device__ __forceinline__ void stage_rc(int b, int& R, int& C) { const int st = b / 1024, sb = b % 1024, swz = sb ^ (((sb >> 9) & 1) << 5); R = (st >> 1) * 16 + swz / 64; C = (st & 1) * 32 + (swz % 64) / 2; }
__host__ __device__ __forceinline__ int perm32(int rho) { const int n = rho >> 4, i = rho & 15; return 8 * (i >> 2) + 4 * n + (i & 3); }

struct Unit { int pm, pn; };
struct Gemm { const bf16_t* A; const bf16_t* Bt; int M, N, K; };

struct StaticOrder {
    int nM, nN, nwg, G, c;
    __host__ __device__ void init(int M, int N, int G_, int c_) { nM = M / BM; nN = N / BM; nwg = nM * nN; G = G_; c = c_; }
    __host__ __device__ bool next(int i, Unit& u) const {
        const long L = (long)i * G + c; if (L >= nwg) return false;
        int wgid = (int)L; { const int q = nwg / NXCD, r = nwg % NXCD, xcd = wgid % NXCD, off = wgid / NXCD; wgid = (xcd < r ? xcd * (q + 1) : r * (q + 1) + (xcd - r) * q) + off; }
        const int nig = WGM * nN, gid = wgid / nig, fm = gid * WGM, gsz = (nM - fm) < WGM ? (nM - fm) : WGM;
        u.pm = fm + ((wgid % nig) % gsz); u.pn = (wgid % nig) / gsz; return true;
    }
    __device__ __forceinline__ void a_ready(const Unit&) const {}
    __device__ __forceinline__ void done(const Unit&) const {}
};

__device__ __forceinline__ unsigned cvt_pk_bf16(float lo, float hi) { unsigned r; asm volatile("v_cvt_pk_bf16_f32 %0, %1, %2" : "=v"(r) : "v"(lo), "v"(hi)); return r; }
typedef float f32x2 __attribute__((ext_vector_type(2)));
template <class Epi, class Sched, bool ALIGN_EPI = false, bool SP2 = false>
__device__ __forceinline__ void gemm_phase(PG8_LAS unsigned char* lds, const Gemm g, const Sched& S, const Epi& E) {
    int tid_ = threadIdx.x; asm volatile("" : "+v"(tid_));
    const int tid = tid_, wid = __builtin_amdgcn_readfirstlane(tid >> 6), lane = tid & 63, wr = wid >> 2, wc = wid & 3, fr = lane & 15, fq = lane >> 4;
    const int K = g.K, nt = K / BK;
    unsigned voffA[2], voffB[2];
#pragma unroll
    for (int i = 0; i < 2; ++i) { int R, C; stage_rc(tid * 16 + i * 8192, R, C); const int Rb = Epi::PERM ? ((R & ~31) + perm32(R & 31)) : R;
        voffA[i] = (unsigned)(R * K + C) * 2u; voffB[i] = (unsigned)(Rb * K + C) * 2u; }
    const size_t kstep = (size_t)(BK * 2);
    const size_t hstep = (size_t)HALF * K * 2;
    const size_t tstep = 2 * hstep;
    const unsigned ldsw = (unsigned)wid * 1024u;
    const int aoff = lds_byte(wr * 64 + fr, fq * 8), boff = lds_byte(wc * 32 + fr, fq * 8);
#define PG8_SA(b, h) (((b) * 2 + (h)) * HTB)
#define PG8_SB(b, h) ((4 + (b) * 2 + (h)) * HTB)
#define PG8_STAGE(bufoff, gbase, voff) do { _Pragma("unroll") for (int _i = 0; _i < 2; ++_i) \
        __builtin_amdgcn_global_load_lds((const unsigned*)((const char*)(gbase) + (voff)[_i]), (PG8_LAS unsigned*)(lds + (bufoff) + ldsw + _i * 8192), 16, 0, 0); } while (0)
#define PG8_LDA(dst, b, h) do { _Pragma("unroll") for (int m = 0; m < 4; ++m) _Pragma("unroll") for (int k = 0; k < 2; ++k) dst[m][k] = *(const PG8_LAS bf16x8*)(lds + PG8_SA(b, h) + aoff + m * 2048 + k * 1024); } while (0)
#define PG8_LDB(dst, b, h) do { _Pragma("unroll") for (int n = 0; n < 2; ++n) _Pragma("unroll") for (int k = 0; k < 2; ++k) dst[n][k] = *(const PG8_LAS bf16x8*)(lds + PG8_SB(b, h) + boff + n * 2048 + k * 1024); } while (0)
#define PG8_MMA(ai, bj, At, Bt) do { __builtin_amdgcn_s_setprio(1); _Pragma("unroll") for (int m = 0; m < 4; ++m) _Pragma("unroll") for (int n = 0; n < 2; ++n) _Pragma("unroll") for (int k = 0; k < 2; ++k) \
        acc[ai][bj][m][n] = __builtin_amdgcn_mfma_f32_16x16x32_bf16(Bt[n][k], At[m][k], acc[ai][bj][m][n], 0, 0, 0); __builtin_amdgcn_s_setprio(0); } while (0)
#define PG8_WAIT_V(n) asm volatile("s_waitcnt vmcnt(" #n ")" ::: "memory")
#define PG8_WAIT_L(n) asm volatile("s_waitcnt lgkmcnt(" #n ")" ::: "memory")
#define PG8_BAR __builtin_amdgcn_s_barrier()
#define PG8_SCHED __builtin_amdgcn_sched_barrier(0)
    Unit cur, nxt; int ui = 0;
    if (!S.next(0, cur)) return;
    f32x4 acc[2][2][4][2];
#pragma unroll
    for (int a = 0; a < 2; ++a)
#pragma unroll
        for (int b = 0; b < 2; ++b)
#pragma unroll
            for (int m = 0; m < 4; ++m)
#pragma unroll
                for (int n = 0; n < 2; ++n) acc[a][b][m][n] = (f32x4){0.f, 0.f, 0.f, 0.f};
    bf16x8 At[4][2], B0[2][2], B1[2][2];
    const char* cA = (const char*)g.A + (size_t)cur.pm * tstep; const char* cB = (const char*)g.Bt + (size_t)cur.pn * tstep;
    S.a_ready(cur);
    if constexpr (SP2) {
        PG8_STAGE(PG8_SB(0, 0), cB, voffB); PG8_STAGE(PG8_SB(0, 1), cB + hstep, voffB); PG8_STAGE(PG8_SA(0, 0), cA, voffA); PG8_STAGE(PG8_SA(0, 1), cA + hstep, voffA);
        if (wr == 1) PG8_BAR;
        PG8_WAIT_V(2); PG8_BAR;
        PG8_STAGE(PG8_SB(1, 0), cB + kstep, voffB); PG8_STAGE(PG8_SA(1, 0), cA + kstep, voffA); PG8_STAGE(PG8_SB(1, 1), cB + hstep + kstep, voffB);
        PG8_WAIT_V(6); PG8_BAR;
    } else {
        PG8_STAGE(PG8_SB(0, 0), cB, voffB); PG8_STAGE(PG8_SA(0, 0), cA, voffA); PG8_STAGE(PG8_SB(0, 1), cB + hstep, voffB); PG8_STAGE(PG8_SA(0, 1), cA + hstep, voffA);
        if (wr == 1) PG8_BAR;
        PG8_WAIT_V(4); PG8_BAR;
        PG8_STAGE(PG8_SB(1, 0), cB + kstep, voffB); PG8_STAGE(PG8_SA(1, 0), cA + kstep, voffA); PG8_STAGE(PG8_SB(1, 1), cB + hstep + kstep, voffB);
        PG8_WAIT_V(6); PG8_BAR;
    }
    for (;;) {
        const bool has_next = S.next(ui + 1, nxt);
        const char* nA = has_next ? (const char*)g.A + (size_t)nxt.pm * tstep : cA; const char* nB = has_next ? (const char*)g.Bt + (size_t)nxt.pn * tstep : cB;
        for (int t = 0; t < nt; t += 2) {
            const bool last = (t == nt - 2);
            const char* a1 = cA + (size_t)(t + 1) * kstep;
            const char* a2 = last ? nA : cA + (size_t)(t + 2) * kstep; const char* b2 = last ? nB : cB + (size_t)(t + 2) * kstep;
            const char* a3 = a2 + kstep; const char* b3 = b2 + kstep;
            if (last && has_next) S.a_ready(nxt);
            if constexpr (SP2) {
            PG8_LDB(B0, 0, 0); PG8_LDB(B1, 0, 1); PG8_SCHED; PG8_LDA(At, 0, 0); PG8_STAGE(PG8_SA(1, 1), a1 + hstep, voffA);
            PG8_WAIT_V(8); PG8_WAIT_L(0); PG8_BAR; PG8_MMA(0, 0, At, B0); PG8_MMA(0, 1, At, B1); PG8_BAR; PG8_SCHED;
            PG8_LDA(At, 0, 1); PG8_STAGE(PG8_SB(0, 0), b2, voffB); PG8_STAGE(PG8_SB(0, 1), b2 + hstep, voffB); PG8_STAGE(PG8_SA(0, 0), a2, voffA);
            PG8_WAIT_V(8); PG8_WAIT_L(0); PG8_BAR; PG8_MMA(1, 0, At, B0); PG8_MMA(1, 1, At, B1); PG8_BAR; PG8_SCHED;
            PG8_LDB(B0, 1, 0); PG8_LDB(B1, 1, 1); PG8_SCHED; PG8_LDA(At, 1, 0); PG8_STAGE(PG8_SA(0, 1), a2 + hstep, voffA);
            PG8_WAIT_V(8); PG8_WAIT_L(0); PG8_BAR; PG8_MMA(0, 0, At, B0); PG8_MMA(0, 1, At, B1); PG8_BAR; PG8_SCHED;
            PG8_LDA(At, 1, 1); PG8_STAGE(PG8_SB(1, 0), b3, voffB); PG8_STAGE(PG8_SB(1, 1), b3 + hstep, voffB); PG8_STAGE(PG8_SA(1, 0), a3, voffA);
            PG8_WAIT_V(8); PG8_WAIT_L(0); PG8_BAR; PG8_MMA(1, 0, At, B0); PG8_MMA(1, 1, At, B1); PG8_BAR; PG8_SCHED;
            } else {
            PG8_LDB(B0, 0, 0); PG8_SCHED; PG8_LDA(At, 0, 0); PG8_STAGE(PG8_SA(1, 1), a1 + hstep, voffA);
            PG8_WAIT_L(8); PG8_BAR; PG8_WAIT_L(0); PG8_MMA(0, 0, At, B0); PG8_BAR; PG8_SCHED;
            PG8_LDB(B1, 0, 1); PG8_STAGE(PG8_SB(0, 0), b2, voffB);
            PG8_BAR; PG8_WAIT_L(0); PG8_MMA(0, 1, At, B1); PG8_BAR;
            PG8_LDA(At, 0, 1); PG8_STAGE(PG8_SA(0, 0), a2, voffA);
            PG8_BAR; PG8_WAIT_L(0); PG8_MMA(1, 0, At, B0); PG8_BAR; PG8_SCHED;
            PG8_STAGE(PG8_SB(0, 1), b2 + hstep, voffB);
            PG8_WAIT_V(6); PG8_BAR; PG8_MMA(1, 1, At, B1); PG8_BAR;
            PG8_LDB(B0, 1, 0); PG8_SCHED; PG8_LDA(At, 1, 0); PG8_STAGE(PG8_SA(0, 1), a2 + hstep, voffA);
            PG8_WAIT_L(8); PG8_BAR; PG8_WAIT_L(0); PG8_MMA(0, 0, At, B0); PG8_BAR; PG8_SCHED;
            PG8_LDB(B1, 1, 1); PG8_STAGE(PG8_SB(1, 0), b3, voffB);
            PG8_BAR; PG8_WAIT_L(0); PG8_MMA(0, 1, At, B1); PG8_BAR;
            PG8_LDA(At, 1, 1); PG8_STAGE(PG8_SA(1, 0), a3, voffA);
            PG8_BAR; PG8_WAIT_L(0); PG8_MMA(1, 0, At, B0); PG8_BAR; PG8_SCHED;
            PG8_STAGE(PG8_SB(1, 1), b3 + hstep, voffB);
            PG8_WAIT_V(6); PG8_BAR; PG8_MMA(1, 1, At, B1); PG8_BAR;
            }
        }
        if constexpr (ALIGN_EPI) { if (wr == 0) PG8_BAR; }
        if constexpr (!Epi::AFTER_DRAIN) { E(acc, cur, wr, wc, fr, fq); S.done(cur); }
        if (!has_next) break;
#pragma unroll
        for (int a = 0; a < 2; ++a)
#pragma unroll
            for (int b = 0; b < 2; ++b)
#pragma unroll
                for (int m = 0; m < 4; ++m)
#pragma unroll
                    for (int n = 0; n < 2; ++n) acc[a][b][m][n] = (f32x4){0.f, 0.f, 0.f, 0.f};
        cur = nxt; cA = nA; cB = nB; ++ui;
        if constexpr (ALIGN_EPI) { if (wr == 1) PG8_BAR; }
    }
    PG8_WAIT_V(0);
    if constexpr (!ALIGN_EPI) { if (wr == 0) PG8_BAR; }
    PG8_BAR;
    if constexpr (Epi::AFTER_DRAIN) { E.fused(acc, cur, wr, wc, fr, fq, lds, wid, lane); S.done(cur); }
#undef PG8_SA
#undef PG8_SB
#undef PG8_STAGE
#undef PG8_LDA
#undef PG8_LDB
#undef PG8_MMA
#undef PG8_WAIT_V
#undef PG8_WAIT_L
#undef PG8_BAR
#undef PG8_SCHED
}
}


#define GAS __attribute__((address_space(1)))
#define LAS __attribute__((address_space(3)))
typedef unsigned short bf16;
typedef unsigned v4u __attribute__((ext_vector_type(4)));
typedef unsigned v2u __attribute__((ext_vector_type(2)));
typedef float f32x4 __attribute__((ext_vector_type(4)));
typedef float f32x2 __attribute__((ext_vector_type(2)));
typedef short bf16x8 __attribute__((ext_vector_type(8)));
typedef LAS unsigned char* ldsp;

constexpr int NWAVES = 8, NTHR = 512;
constexpr int D = 2048, SEQ = 2048, NB = 4, MP = 8192, NSMP = 128, MR = 8320, MT = 8448;
constexpr int NMEM = 256, XH = 4, XD = 128, XDIM = 512, MIX = 1536;
constexpr int AH = 12, AHD = 128, A_IN = 6656, LDP = 6656;
constexpr int BH = 24, BHD = 64, B_IN = 5472, B_INP = 5632, B_MIXC = 4960;
constexpr int DFF = 8192;
constexpr int LORA_K = 352;
constexpr int A_XQ_OFF = 6144;
constexpr int B_XQ_OFF = 4608;
constexpr int B_LORA_OFF = 5120;
constexpr float RMS_EPS = 1e-6f, GN_EPS = 64e-5f;

constexpr size_t O_YP = 0, O_YS = 16777216, O_MK = 17039360, O_MV = 19136512, O_SHP = 21233664, O_SRP = 22806528,
                 O_SSP = 23592960, O_SHS = 23609344, O_SRS = 73940992, O_SSS = 99106816, O_END = 99631104;

constexpr size_t al256(size_t x) { return (x + 255) & ~(size_t)255; }
constexpr size_t WS_CTL = 0, CTL_BYTES = 1u << 20;
constexpr size_t SZ_WINA = (size_t)A_IN * D * 2, SZ_WSQ = (size_t)D * D * 2, SZ_WINB = (size_t)B_INP * D * 2, SZ_WFF = (size_t)DFF * D * 2,
                 SZ_WKV = (size_t)1024 * D * 2, SZ_LW = (size_t)MIX * LORA_K * 2;
constexpr size_t WS_WINA = WS_CTL + CTL_BYTES;
constexpr size_t WS_WOUTA = WS_WINA + 2 * SZ_WINA;
constexpr size_t WS_WINB = WS_WOUTA + 2 * SZ_WSQ;
constexpr size_t WS_WOUTB = WS_WINB + 2 * SZ_WINB;
constexpr size_t WS_W1 = WS_WOUTB + 2 * SZ_WSQ;
constexpr size_t WS_W2 = WS_W1 + 4 * SZ_WFF;
constexpr size_t WS_WKV = WS_W2 + 4 * SZ_WFF;
constexpr size_t WS_LW = WS_WKV + 4 * SZ_WKV;
constexpr size_t WS_X = al256(WS_LW + 2 * SZ_LW);
constexpr size_t WS_H = WS_X + (size_t)MT * D * 4;
constexpr size_t WS_PROJ = WS_H + (size_t)MT * D * 2;
constexpr size_t WS_MIXC = WS_PROJ + (size_t)MT * LDP * 2;
constexpr size_t WS_ACT = WS_MIXC + (size_t)MT * D * 2;
constexpr size_t WS_MEMN = WS_ACT + (size_t)MT * DFF * 2;
constexpr size_t SZ_RW = (size_t)MT * MIX * 4;
constexpr size_t WS_RR = WS_MEMN + (size_t)1024 * D * 2;
constexpr size_t WS_RK = WS_RR + SZ_RW, WS_RV = WS_RK + SZ_RW, WS_RKK = WS_RV + SZ_RW, WS_RKA = WS_RKK + SZ_RW, WS_RW = WS_RKA + SZ_RW,
                 WS_RG = WS_RW + SZ_RW, WS_RO = WS_RG + SZ_RW;
constexpr size_t WS_BONUS = WS_RO + SZ_RW;
constexpr size_t WS_REC = al256(WS_BONUS + (size_t)MT * BH * 4);
constexpr size_t REC_BYTES = 7 * 8192;
constexpr size_t WS_END = al256(WS_REC + (size_t)NB * BH * 32 * REC_BYTES);

constexpr int CW_BAR = 4096;
constexpr int CW_CQ = 3072;
constexpr int CW_PDONE = 2560;
#ifndef HG_SPLIT
#define HG_SPLIT 16
#endif
constexpr int CW_SFLAG = 2048;
constexpr size_t CTL_SS = 65536;
typedef unsigned long long u64;
constexpr float SS_FIX = 1048576.f, SS_UNFIX = 1.f / 1048576.f;
__device__ __forceinline__ u64* ss_slot(unsigned char* ws, int s) { return (u64*)(ws + WS_CTL + CTL_SS) + (size_t)s * MT; }

constexpr int RING_BYTES = 159744, LDSCTL_OFF = RING_BYTES, MISC_OFF = LDSCTL_OFF + 320, LDS_BYTES = RING_BYTES + 1024;

#define LDS_WAIT() asm volatile("s_waitcnt lgkmcnt(0)" ::: "memory")
#define LDS_BARRIER() do { asm volatile("s_waitcnt lgkmcnt(0)" ::: "memory"); __builtin_amdgcn_s_barrier(); asm volatile("" ::: "memory"); } while (0)
#define VM_WAIT() asm volatile("s_waitcnt vmcnt(0)" ::: "memory")
typedef __bf16 bf16x2_t __attribute__((ext_vector_type(2)));
__device__ __forceinline__ unsigned pk2_hw(float lo, float hi) { f32x2 v = {lo, hi}; const bf16x2_t b = __builtin_convertvector(v, bf16x2_t); return __builtin_bit_cast(unsigned, b); }
__device__ __forceinline__ unsigned f2bf(float f) { return (__builtin_bit_cast(unsigned, f) + 0x8000u) >> 16; }
__device__ __forceinline__ unsigned pk2(float lo, float hi) { return __builtin_amdgcn_perm(__builtin_bit_cast(unsigned, hi) + 0x8000u, __builtin_bit_cast(unsigned, lo) + 0x8000u, 0x07060302u); }
__device__ __forceinline__ float bf2f(unsigned short b) { return __builtin_bit_cast(float, ((unsigned)b) << 16); }
__device__ __forceinline__ float bflo(unsigned w) { return __builtin_bit_cast(float, w << 16); }
__device__ __forceinline__ float bfhi(unsigned w) { return __builtin_bit_cast(float, w & 0xffff0000u); }
__device__ __forceinline__ f32x4 bf4(v2u w) { return (f32x4){bflo(w.x), bfhi(w.x), bflo(w.y), bfhi(w.y)}; }
__device__ __forceinline__ v2u pk4(f32x4 v) { v2u r; r.x = pk2(v.x, v.y); r.y = pk2(v.z, v.w); return r; }
__device__ __forceinline__ float wave_sum(float v) {
#pragma unroll
    for (int o = 1; o < 64; o <<= 1) v += __shfl_xor(v, o);
    return v;
}
__device__ __forceinline__ float wave_max(float v) {
#pragma unroll
    for (int o = 1; o < 64; o <<= 1) v = fmaxf(v, __shfl_xor(v, o));
    return v;
}
__device__ __forceinline__ float fsigmoid(float x) { return __builtin_amdgcn_rcpf(1.f + __expf(-x)); }
__device__ __forceinline__ int sw128(int r, int c) { return r * 256 + ((c ^ (r & 15)) << 4); }
__device__ __forceinline__ int sw64(int r, int c) { return r * 128 + ((c ^ ((r >> 1) & 7)) << 4); }
__device__ __forceinline__ int sw256(int r, int c) { return r * 512 + ((c ^ (r & 15)) << 4); }
#define MFMA16(a, b, c) __builtin_amdgcn_mfma_f32_16x16x32_bf16((a), (b), (c), 0, 0, 0)

#define XB_TMO      128
#define XB_XCNT(j)  (256  + 64 * (j))
#define XB_XSUB(j)  (1280 + 64 * (j))
#define XB_XGEN(j)  (2304 + 64 * (j))
#define XB_TOP      3328
#define XB_TOPGEN   3392
#define XCD_BAR_WORDS 3456
#define XB_SPIN_CAP (1u << 18)
__device__ __forceinline__ unsigned xb_ld(unsigned* p)              { return __hip_atomic_load(p, __ATOMIC_RELAXED, __HIP_MEMORY_SCOPE_AGENT); }
__device__ __forceinline__ unsigned xb_add(unsigned* p, unsigned v) { return __hip_atomic_fetch_add(p, v, __ATOMIC_RELAXED, __HIP_MEMORY_SCOPE_AGENT); }
__device__ __forceinline__ unsigned xb_xcc_id() { return (unsigned)__builtin_amdgcn_s_getreg((3 << 11) | 20) & 0xFu; }
#define XB_SPIN(cond, bar) do { unsigned _sp = 0; while (cond) { __builtin_amdgcn_s_sleep(1); \
    if ((++_sp & 255u) == 0u) { if (xb_ld(&(bar)[XB_TMO])) break; if (_sp > XB_SPIN_CAP) { atomicAdd(&(bar)[XB_TMO], 1u); break; } } } } while (0)
struct XcdBarrier { unsigned* bar; unsigned x; volatile LAS unsigned* st; };
__device__ __forceinline__ XcdBarrier xcd_barrier_post(unsigned* bar, volatile LAS unsigned* st) {
    XcdBarrier b; b.bar = bar; b.x = xb_xcc_id(); b.st = st;
    if (threadIdx.x == 0) (void)xb_add(&bar[XB_XCNT(b.x)], 1u);
    return b;
}
__device__ __forceinline__ void xcd_barrier_complete(unsigned* bar, unsigned x, unsigned& nloc, unsigned& nx) {
    const unsigned G = gridDim.x * gridDim.y * gridDim.z;
    unsigned sum, cnt, mine, sp = 0u;
    for (;;) {
        sum = 0u; cnt = 0u; mine = 0u;
#pragma unroll
        for (unsigned j = 0; j < 16; ++j) { const unsigned c = xb_ld(&bar[XB_XCNT(j)]); sum += c; cnt += (c > 0u) ? 1u : 0u; mine = (j == x) ? c : mine; }
        if (sum == G) break;
        __builtin_amdgcn_s_sleep(1);
        if ((++sp & 255u) == 0u) { if (xb_ld(&bar[XB_TMO])) break; if (sp > XB_SPIN_CAP) { atomicAdd(&bar[XB_TMO], 1u); break; } }
    }
    nloc = mine > 0u ? mine : 1u; nx = cnt > 0u ? cnt : 1u;
}
__device__ __forceinline__ void xcd_barrier(const XcdBarrier& b) {
    asm volatile("s_waitcnt vmcnt(0)" ::: "memory");
    __syncthreads();
    if (threadIdx.x == 0) {
        unsigned* bar = b.bar;
        __builtin_amdgcn_s_waitcnt(0);
        unsigned nloc = b.st[0], nx = b.st[1];
        if (nloc == 0u) { xcd_barrier_complete(bar, b.x, nloc, nx); b.st[0] = nloc; b.st[1] = nx; }
        const unsigned old = xb_add(&bar[XB_XSUB(b.x)], 1u);
        const unsigned gen = old / nloc;
        if (old + 1u == (gen + 1u) * nloc) {
            __builtin_amdgcn_fence(__ATOMIC_RELEASE, "agent");
            asm volatile("s_waitcnt vmcnt(0)" ::: "memory");
            const unsigned og = xb_add(&bar[XB_TOP], 1u);
            const unsigned tg = og / nx;
            if (og + 1u == (tg + 1u) * nx) xb_add(&bar[XB_TOPGEN], 1u);
            else XB_SPIN(xb_ld(&bar[XB_TOPGEN]) == tg, bar);
            __builtin_amdgcn_fence(__ATOMIC_ACQUIRE, "agent");
            xb_add(&bar[XB_XGEN(b.x)], 1u);
            asm volatile("s_waitcnt vmcnt(0)" ::: "memory");
        } else {
            XB_SPIN(xb_ld(&bar[XB_XGEN(b.x)]) == gen, bar);
            __builtin_amdgcn_fence(__ATOMIC_ACQUIRE, "agent");
            asm volatile("s_waitcnt vmcnt(0)" ::: "memory");
        }
    }
    __syncthreads();
}

__device__ __forceinline__ float atomic_add_agent(float* p, float v) { return __hip_atomic_fetch_add(p, v, __ATOMIC_RELAXED, __HIP_MEMORY_SCOPE_AGENT); }
template <int ACT> struct EpiBf {
    static constexpr bool PERM = true, AFTER_DRAIN = false;
    bf16* O; int ldc; const u64* ss;
    __device__ __forceinline__ void operator()(const pg8::f32x4 (&acc)[2][2][4][2], const pg8::Unit& u, int wr, int wc, int fr, int fq) const {
        const int row0 = u.pm * 256 + wr * 64 + fr, col0 = u.pn * 256 + wc * 32 + 8 * fq;
#pragma unroll
        for (int ai = 0; ai < 2; ++ai)
#pragma unroll
            for (int m = 0; m < 4; ++m) { const int row = row0 + ai * 128 + m * 16; bf16* rowp = O + (size_t)row * ldc + col0;
                const float rs = (ACT == 2) ? 1.f : __builtin_amdgcn_rsqf((float)ss[row] * (SS_UNFIX / D) + RMS_EPS);
#pragma unroll
                for (int bj = 0; bj < 2; ++bj) { pg8::f32x4 v0 = acc[ai][bj][m][0] * rs, v1 = acc[ai][bj][m][1] * rs;
                    if (ACT >= 1) {
#pragma unroll
                        for (int q = 0; q < 4; ++q) { const float a = fmaxf(v0[q], 0.f), b = fmaxf(v1[q], 0.f); v0[q] = a * a; v1[q] = b * b; } }
                    pg8::u32x4 w; w.x = pg8::cvt_pk_bf16(v0[0], v0[1]); w.y = pg8::cvt_pk_bf16(v0[2], v0[3]); w.z = pg8::cvt_pk_bf16(v1[0], v1[1]); w.w = pg8::cvt_pk_bf16(v1[2], v1[3]);
                    *(pg8::u32x4*)(rowp + bj * 128) = w; }
                __builtin_amdgcn_sched_barrier(0); }
    }
};
template <bool SCL> struct EpiResid {
    static constexpr bool PERM = false, AFTER_DRAIN = false;
    float* X; int ldc; bf16* Hb; u64* ssq; const u64* scl;
    __device__ __forceinline__ void operator()(const pg8::f32x4 (&acc)[2][2][4][2], const pg8::Unit& u, int wr, int wc, int fr, int fq) const {
        const int row0 = u.pm * 256 + wr * 64 + fr, col0 = u.pn * 256 + wc * 32 + 4 * fq; u64 rets[8];
#pragma unroll
        for (int ai = 0; ai < 2; ++ai) {
            pg8::f32x4 xin[4][4]; float r2v[4];
#pragma unroll
            for (int m = 0; m < 4; ++m) { const int row = row0 + ai * 128 + m * 16; const float* rowp = X + (size_t)row * ldc + col0;
                r2v[m] = SCL ? (float)scl[row] : 0.f;
#pragma unroll
                for (int q = 0; q < 4; ++q) xin[m][q] = *(const pg8::f32x4*)(rowp + (q >> 1) * 128 + (q & 1) * 16); }
            __builtin_amdgcn_sched_barrier(0);
#pragma unroll
            for (int m = 0; m < 4; ++m) { const int row = row0 + ai * 128 + m * 16; float* rowp = X + (size_t)row * ldc + col0; bf16* hp = Hb + (size_t)row * ldc + col0;
                const float r2 = SCL ? __builtin_amdgcn_rcpf(r2v[m] * (SS_UNFIX / D) + RMS_EPS) : 1.f;
                float s = 0.f;
#pragma unroll
                for (int bj = 0; bj < 2; ++bj)
#pragma unroll
                    for (int n = 0; n < 2; ++n) { const pg8::f32x4 x = xin[m][bj * 2 + n] + acc[ai][bj][m][n] * r2; *(pg8::f32x4*)(rowp + bj * 128 + n * 16) = x;
                        v2u hw; hw.x = pg8::cvt_pk_bf16(x[0], x[1]); hw.y = pg8::cvt_pk_bf16(x[2], x[3]); *(v2u*)(hp + bj * 128 + n * 16) = hw;
                        s += (x[0] * x[0] + x[1] * x[1]) + (x[2] * x[2] + x[3] * x[3]); }
                s += __shfl_xor(s, 16); s += __shfl_xor(s, 32);
                rets[ai * 4 + m] = 0;
                if (fq == 0) rets[ai * 4 + m] = __hip_atomic_fetch_add(ssq + row, (u64)(s * SS_FIX + 0.5f), __ATOMIC_RELAXED, __HIP_MEMORY_SCOPE_AGENT); }
            __builtin_amdgcn_sched_barrier(0); }
#pragma unroll
        for (int g = 0; g < 8; ++g) asm volatile("" :: "v"(rets[g]));
    }
};
struct EpiMemKV {
    static constexpr bool PERM = false, AFTER_DRAIN = false;
    float* out;
    __device__ __forceinline__ void operator()(const pg8::f32x4 (&acc)[2][2][4][2], const pg8::Unit& u, int wr, int wc, int fr, int fq) const {
        const int layer = u.pn >> 2, kv = (u.pn >> 1) & 1, c0 = (u.pn & 1) * 256 + wc * 32 + 4 * fq;
        float* base = out + (kv ? O_MV : O_MK) + (size_t)layer * (1024 * 512);
        const int row0 = u.pm * 256 + wr * 64 + fr;
#pragma unroll
        for (int ai = 0; ai < 2; ++ai)
#pragma unroll
            for (int m = 0; m < 4; ++m) { float* rowp = base + (size_t)(row0 + ai * 128 + m * 16) * 512 + c0;
#pragma unroll
                for (int bj = 0; bj < 2; ++bj)
#pragma unroll
                    for (int n = 0; n < 2; ++n) *(pg8::f32x4*)(rowp + bj * 128 + n * 16) = acc[ai][bj][m][n]; }
    }
};
struct EpiDummy {
    static constexpr bool PERM = false, AFTER_DRAIN = false;
    float* C; int ldc;
    __device__ __forceinline__ void operator()(const pg8::f32x4 (&acc)[2][2][4][2], const pg8::Unit& u, int wr, int wc, int fr, int fq) const {
        const int row0 = u.pm * 256 + wr * 64 + fr, col0 = u.pn * 256 + wc * 32 + 4 * fq;
#pragma unroll
        for (int ai = 0; ai < 2; ++ai)
#pragma unroll
            for (int m = 0; m < 4; ++m) { float* rowp = C + (size_t)(row0 + ai * 128 + m * 16) * ldc + col0;
#pragma unroll
                for (int bj = 0; bj < 2; ++bj)
#pragma unroll
                    for (int n = 0; n < 2; ++n) *(pg8::f32x4*)(rowp + bj * 128 + n * 16) = acc[ai][bj][m][n]; }
    }
};
struct RotOrder : pg8::StaticOrder {};

struct Job { const float* src; bf16* dst; const float* gain; int ldw, K, ncols, ldt, koff, row_off, item0, pad; };
constexpr int NJOBS = 34;
struct Args { const float* in[33]; float* out; unsigned char* ws; Job jobs[NJOBS]; int git[6]; int njobs, nitems, ph_lo, ph_hi, pad2[2]; };

__device__ __forceinline__ int fresh_tid() { int t = threadIdx.x; asm volatile("" : "+v"(t)); return t; }
struct Frame {
    ldsp lds;
    int tid, lane, wave, G, vcu;
    unsigned char* ws; float* out;
};


__device__ __forceinline__ void norm_row(const float* src, const float* g, int lane, bf16* hdst, float* fdst, float* xcopy, float* f2) {
    const f32x4* xr = (const f32x4*)src + lane; const f32x4* gr = (const f32x4*)g + lane;
    f32x4 v[8]; float s = 0.f;
#pragma unroll
    for (int j = 0; j < 8; ++j) { v[j] = xr[64 * j]; s += (v[j].x * v[j].x + v[j].y * v[j].y) + (v[j].z * v[j].z + v[j].w * v[j].w); }
    s = wave_sum(s);
    const float rstd = 1.f / sqrtf(s * (1.f / D) + RMS_EPS);
    f32x4 gv[8];
#pragma unroll
    for (int j = 0; j < 8; ++j) gv[j] = gr[64 * j];
    if (xcopy) {
#pragma unroll
        for (int j = 0; j < 8; ++j) ((f32x4*)xcopy + lane)[64 * j] = v[j]; }
#pragma unroll
    for (int j = 0; j < 8; ++j) { const f32x4 y = v[j] * rstd * gv[j];
        if (hdst) ((v2u*)hdst + lane)[64 * j] = pk4(y);
        if (fdst) ((f32x4*)fdst + lane)[64 * j] = y;
        if (f2) ((f32x4*)f2 + lane)[64 * j] = y; }
}

__device__ __forceinline__ void norm_phase(Frame& F0, const Args& A, const float* g, bool first, bool final, int shift_j) {
    Frame F = F0; F.tid = fresh_tid(); F.lane = F.tid & 63; F.wave = __builtin_amdgcn_readfirstlane(F.tid >> 6);
    const int gw = F.vcu * NWAVES + F.wave, NGW = F.G * NWAVES;
    float* X = (float*)(F.ws + WS_X); bf16* H = (bf16*)(F.ws + WS_H);
    for (int row = gw; row < MR; row += NGW) {
        const float* src = first ? (row < MP ? A.in[0] + (size_t)row * D : A.in[1] + (size_t)(row - MP) * D) : X + (size_t)row * D;
        float* f2 = nullptr;
        if (shift_j >= 0) {
            if (row < MP) { if ((row & (SEQ - 1)) == SEQ - 1) f2 = F.out + O_SSP + (size_t)(shift_j * NB + (row >> 11)) * D; }
            else f2 = F.out + O_SSS + (size_t)(shift_j * NSMP + (row - MP)) * D;
        }
        norm_row(src, g, F.lane, final ? nullptr : H + (size_t)row * D, final ? F.out + O_YP + (size_t)row * D : nullptr, first ? X + (size_t)row * D : nullptr, f2);
    }
    if (shift_j >= 0) {
        const float* sh = A.in[6] + (size_t)shift_j * NSMP * D;
        for (int r = gw; r < NSMP; r += NGW) { const f32x4* xr = (const f32x4*)(sh + (size_t)r * D) + F.lane; v2u* o = (v2u*)(H + (size_t)(MR + r) * D) + F.lane;
#pragma unroll
            for (int j = 0; j < 8; ++j) o[64 * j] = pk4(xr[64 * j]); }
    }
}

struct CvtMeta { int j, k0, n0, hg; };
__device__ __forceinline__ CvtMeta cvt_load(const Args& A, int it, int lane, f32x4 (&v0)[8], f32x4 (&v1)[8], float (&g0)[8], float (&g1)[8]) {
    int j = 0;
    for (int q = 1; q < A.njobs; ++q) if (it >= A.jobs[q].item0) j = q;
    const Job& J = A.jobs[j]; const int item = it - J.item0;
    const int nblk = (J.ncols + 63) / 64, kb = item / nblk, nb = item - kb * nblk, k0 = 64 * kb, n0 = 64 * nb;
    const int n4 = 4 * (lane & 15), kp = lane >> 4; const float* gp = J.gain ? J.gain : J.src;
    const int nc = min(n0 + n4, J.ncols - 4);
#pragma unroll
    for (int i = 0; i < 8; ++i) { const int k = min(k0 + 8 * i + 2 * kp, J.K - 2);
        v0[i] = *(const f32x4*)(J.src + (size_t)k * J.ldw + nc);
        v1[i] = *(const f32x4*)(J.src + (size_t)(k + 1) * J.ldw + nc);
        g0[i] = gp[k]; g1[i] = gp[k + 1]; }
    return CvtMeta{j, k0, n0, J.gain != nullptr ? 1 : 0};
}
__device__ __forceinline__ void convert_items(Frame& F, const Args& A, int it_lo, int it_hi, int wk, int nworkers) {
    const int tid = fresh_tid(), lane = tid & 63, w = __builtin_amdgcn_readfirstlane(tid >> 6);
    LAS unsigned* scr = (LAS unsigned*)(F.lds + w * 8448);
    const int n4 = 4 * (lane & 15), kp = lane >> 4, c = lane & 7;
    f32x4 v0[8], v1[8]; float g0[8], g1[8]; CvtMeta m{0, 0, 0, 0};
    int it = it_lo + wk;
    if (it < it_hi) m = cvt_load(A, it, lane, v0, v1, g0, g1);
    while (it < it_hi) {
#pragma unroll
        for (int i = 0; i < 8; ++i) { LAS unsigned* s = scr + n4 * 33 + 4 * i + kp; const f32x4 x0 = v0[i] * (m.hg ? g0[i] : 1.f), x1 = v1[i] * (m.hg ? g1[i] : 1.f);
            s[0] = pk2(x0.x, x1.x); s[33] = pk2(x0.y, x1.y); s[66] = pk2(x0.z, x1.z); s[99] = pk2(x0.w, x1.w); }
        const CvtMeta cur = m; const int nxt = it + nworkers;
        if (nxt < it_hi) m = cvt_load(A, nxt, lane, v0, v1, g0, g1);
        LDS_WAIT(); asm volatile("" ::: "memory");
        const Job& J = A.jobs[cur.j];
        if (cur.k0 + 8 * c < J.K) {
#pragma unroll
            for (int jn = 0; jn < 8; ++jn) { const int n = jn * 8 + (lane >> 3); const LAS unsigned* s = scr + n * 33 + 4 * c;
                v4u o; o.x = s[0]; o.y = s[1]; o.z = s[2]; o.w = s[3];
                if (cur.n0 + n < J.ncols) *(v4u*)(J.dst + (size_t)(J.row_off + cur.n0 + n) * J.ldt + J.koff + cur.k0 + 8 * c) = o; } }
        LDS_WAIT(); asm volatile("" ::: "memory");
        it = nxt;
    }
}
__device__ __forceinline__ void cvt_store(const Args& A, const CvtMeta cur, LAS unsigned* scr, int lane, int c) {
    const Job& J = A.jobs[cur.j];
    if (cur.k0 + 8 * c < J.K) {
#pragma unroll
        for (int jn = 0; jn < 8; ++jn) { const int n = jn * 8 + (lane >> 3); const LAS unsigned* s = scr + n * 33 + 4 * c;
            v4u o; o.x = s[0]; o.y = s[1]; o.z = s[2]; o.w = s[3];
            if (cur.n0 + n < J.ncols) *(v4u*)(J.dst + (size_t)(J.row_off + cur.n0 + n) * J.ldt + J.koff + cur.k0 + 8 * c) = o; } }
}
__device__ __forceinline__ void convert_items_dyn(Frame& F, const Args& A, int it_lo, int it_hi, unsigned* ctr, int q) {
    const int tid = fresh_tid(), lane = tid & 63, w = __builtin_amdgcn_readfirstlane(tid >> 6);
    LAS unsigned* scr = (LAS unsigned*)(F.lds + w * 8448);
    const int n4 = 4 * (lane & 15), kp = lane >> 4, c = lane & 7;
    f32x4 v0[8], v1[8]; float g0[8], g1[8]; CvtMeta m{0, 0, 0, 0};
    unsigned av = 0u;
    if (lane == 0) av = __hip_atomic_fetch_add(ctr, 2u, __ATOMIC_RELAXED, __HIP_MEMORY_SCOPE_AGENT);
    const int first = (int)__builtin_amdgcn_readfirstlane(av);
    int it = it_lo + 2 * (8 * first + q), tnext = first + 1;
    if (lane == 0) av = __hip_atomic_fetch_add(ctr, 1u, __ATOMIC_RELAXED, __HIP_MEMORY_SCOPE_AGENT);
    if (it < it_hi) m = cvt_load(A, it, lane, v0, v1, g0, g1);
    while (it < it_hi) {
#pragma unroll
        for (int i = 0; i < 8; ++i) { LAS unsigned* s = scr + n4 * 33 + 4 * i + kp; const f32x4 x0 = v0[i] * (m.hg ? g0[i] : 1.f), x1 = v1[i] * (m.hg ? g1[i] : 1.f);
            s[0] = pk2(x0.x, x1.x); s[33] = pk2(x0.y, x1.y); s[66] = pk2(x0.z, x1.z); s[99] = pk2(x0.w, x1.w); }
        const CvtMeta cur = m;
        int nxt;
        if (((it - it_lo) & 1) == 0) nxt = it + 1;
        else { nxt = it_lo + 2 * (8 * tnext + q);
            tnext = (int)__builtin_amdgcn_readfirstlane(av);
            if (lane == 0) av = __hip_atomic_fetch_add(ctr, 1u, __ATOMIC_RELAXED, __HIP_MEMORY_SCOPE_AGENT); }
        if (nxt < it_hi) m = cvt_load(A, nxt, lane, v0, v1, g0, g1);
        LDS_WAIT(); asm volatile("" ::: "memory");
        cvt_store(A, cur, scr, lane, c);
        LDS_WAIT(); asm volatile("" ::: "memory");
        it = nxt;
    }
}
__device__ __forceinline__ void p0_prologue(Frame& F0, const Args& A) {
    Frame F = F0; F.tid = fresh_tid(); F.lane = F.tid & 63; F.wave = __builtin_amdgcn_readfirstlane(F.tid >> 6);
    const int gw = F.vcu * NWAVES + F.wave, NGW = F.G * NWAVES;
    convert_items(F, A, 0, A.git[1], gw, NGW);
    for (int jj = 0; jj < 2; ++jj) { v4u* z = (v4u*)(F.ws + WS_WINB + jj * SZ_WINB + (size_t)B_IN * D * 2); const int n16 = (B_INP - B_IN) * D * 2 / 16;
        for (int i = gw * 64 + F.lane; i < n16; i += NGW * 64) z[i] = (v4u){0u, 0u, 0u, 0u}; }
    bf16* MEMN = (bf16*)(F.ws + WS_MEMN);
    for (int row = gw; row < NB * NMEM; row += NGW) norm_row(A.in[7] + (size_t)row * D, A.in[11], F.lane, MEMN + (size_t)row * D, nullptr, nullptr, nullptr);
    { float* X = (float*)(F.ws + WS_X); bf16* H = (bf16*)(F.ws + WS_H); u64* ss0 = ss_slot(F.ws, 0);
      for (int row = gw; row < MR; row += NGW) {
          const float* src = row < MP ? A.in[0] + (size_t)row * D : A.in[1] + (size_t)(row - MP) * D;
          const f32x4* xr = (const f32x4*)src + F.lane; float s = 0.f;
          f32x4 vr[8];
#pragma unroll
          for (int jj = 0; jj < 8; ++jj) vr[jj] = xr[64 * jj];
#pragma unroll
          for (int jj = 0; jj < 8; ++jj) { const f32x4 v = vr[jj]; s += (v.x * v.x + v.y * v.y) + (v.z * v.z + v.w * v.w);
              ((f32x4*)(X + (size_t)row * D) + F.lane)[64 * jj] = v; ((v2u*)(H + (size_t)row * D) + F.lane)[64 * jj] = pk4(v); }
          s = wave_sum(s); if (F.lane == 0) ss0[row] = (u64)(s * SS_FIX + 0.5f); } }
}

#ifndef GEMM_ALIGN
#define GEMM_ALIGN true
#endif
#ifndef GEMM_SP2
#define GEMM_SP2 true
#endif
template <class Epi> __device__ __forceinline__ void run_gemm(Frame& F, const bf16* Am, const bf16* Bt, int M, int N, int K, const Epi& E, int rot) {
    pg8::Gemm g{Am, Bt, M, N, K}; pg8::StaticOrder S; S.init(M, N, F.G, (int)((blockIdx.x + rot) % F.G));
    pg8::gemm_phase<Epi, pg8::StaticOrder, GEMM_ALIGN, GEMM_SP2>(F.lds, g, S, E);
}

constexpr int SK_RED = 0, SK_SSQ = 131072;
template <int AMODE, int EMODE> __device__ __forceinline__ void skinny_gemm(Frame& F, const void* Aptr, int lda, const float* gain, const bf16* Bt, int ldb, int n0, int rh, int k0, int klen, void* outp, int ldc, int orow0) {
    const ldsp L = F.lds; const int tid = fresh_tid(), w = __builtin_amdgcn_readfirstlane(tid >> 6), lane = tid & 63, fr = lane & 15, q4 = lane >> 4;
    const int kw = klen >> 3, kb = k0 + w * kw, nks = kw >> 5;
    f32x4 acc[4][4]; float ssq[4];
#pragma unroll
    for (int rt = 0; rt < 4; ++rt) { ssq[rt] = 0.f;
#pragma unroll
        for (int ct = 0; ct < 4; ++ct) acc[rt][ct] = (f32x4){0.f, 0.f, 0.f, 0.f}; }
    const bf16* bp = Bt + (size_t)(n0 + fr) * ldb + kb + q4 * 8;
    __syncthreads();
#pragma unroll 2
    for (int ks = 0; ks < nks; ++ks) {
        bf16x8 bq[4];
#pragma unroll
        for (int ct = 0; ct < 4; ++ct) bq[ct] = *(const bf16x8*)(bp + (size_t)ct * 16 * ldb + ks * 32);
        bf16x8 a[4];
        if (AMODE == 0) { const bf16* ap = (const bf16*)Aptr + (size_t)(rh * 64 + fr) * lda + kb + q4 * 8 + ks * 32;
#pragma unroll
            for (int rt = 0; rt < 4; ++rt) a[rt] = *(const bf16x8*)(ap + (size_t)rt * 16 * lda); }
        else { const float* ap = (const float*)Aptr + (size_t)(rh * 64 + fr) * lda + kb + q4 * 8 + ks * 32;
            f32x4 g0 = (f32x4){1.f, 1.f, 1.f, 1.f}, g1 = g0;
            if (AMODE == 2) { const f32x4 t0 = *(const f32x4*)(gain + kb + q4 * 8 + ks * 32), t1 = *(const f32x4*)(gain + kb + q4 * 8 + ks * 32 + 4);
                g0 = (f32x4){__builtin_amdgcn_rcpf(t0.x), __builtin_amdgcn_rcpf(t0.y), __builtin_amdgcn_rcpf(t0.z), __builtin_amdgcn_rcpf(t0.w)};
                g1 = (f32x4){__builtin_amdgcn_rcpf(t1.x), __builtin_amdgcn_rcpf(t1.y), __builtin_amdgcn_rcpf(t1.z), __builtin_amdgcn_rcpf(t1.w)}; }
            f32x4 x0[4], x1[4];
#pragma unroll
            for (int rt = 0; rt < 4; ++rt) { x0[rt] = *(const f32x4*)(ap + (size_t)rt * 16 * lda); x1[rt] = *(const f32x4*)(ap + (size_t)rt * 16 * lda + 4); }
#pragma unroll
            for (int rt = 0; rt < 4; ++rt) { f32x4 y0 = x0[rt], y1 = x1[rt];
                if (AMODE == 2) { y0 = y0 * g0; y1 = y1 * g1; }
                if (AMODE == 1) ssq[rt] += (y0.x * y0.x + y0.y * y0.y) + (y0.z * y0.z + y0.w * y0.w) + (y1.x * y1.x + y1.y * y1.y) + (y1.z * y1.z + y1.w * y1.w);
                v4u aw; aw.x = pk2(y0.x, y0.y); aw.y = pk2(y0.z, y0.w); aw.z = pk2(y1.x, y1.y); aw.w = pk2(y1.z, y1.w);
                a[rt] = __builtin_bit_cast(bf16x8, aw); } }
#pragma unroll
        for (int rt = 0; rt < 4; ++rt)
#pragma unroll
            for (int ct = 0; ct < 4; ++ct) acc[rt][ct] = MFMA16(bq[ct], a[rt], acc[rt][ct]);
    }
#pragma unroll
    for (int rt = 0; rt < 4; ++rt)
#pragma unroll
        for (int ct = 0; ct < 4; ++ct) *(LAS f32x4*)(L + SK_RED + ((w * 16 + rt * 4 + ct) * 64 + lane) * 16) = acc[rt][ct];
    if (AMODE == 1) {
#pragma unroll
        for (int rt = 0; rt < 4; ++rt) { float s = ssq[rt]; s += __shfl_xor(s, 16); s += __shfl_xor(s, 32); if (q4 == 0) ((LAS float*)(L + SK_SSQ))[(w * 4 + rt) * 16 + fr] = s; } }
    __syncthreads();
    const int rto = w >> 1, cto = 2 * (w & 1);
    f32x4 r0 = (f32x4){0.f, 0.f, 0.f, 0.f}, r1 = r0; float st = 0.f;
#pragma unroll
    for (int sw = 0; sw < 8; ++sw) { r0 = r0 + *(LAS f32x4*)(L + SK_RED + ((sw * 16 + rto * 4 + cto) * 64 + lane) * 16); r1 = r1 + *(LAS f32x4*)(L + SK_RED + ((sw * 16 + rto * 4 + cto + 1) * 64 + lane) * 16);
        if (AMODE == 1) st += ((LAS float*)(L + SK_SSQ))[(sw * 4 + rto) * 16 + fr]; }
    if (AMODE == 1) { const float rs = __builtin_amdgcn_rsqf(st * (1.f / D) + RMS_EPS); r0 = r0 * rs; r1 = r1 * rs; }
    const int m = orow0 + rh * 64 + 16 * rto + fr, c0 = n0 + cto * 16 + q4 * 4;
    if (EMODE == 2) { float* o = (float*)outp + (size_t)m * ldc + c0; float ret = 0.f;
#pragma unroll
        for (int r = 0; r < 4; ++r) { ret += atomic_add_agent(o + r, r0[r]); ret += atomic_add_agent(o + 16 + r, r1[r]); }
        asm volatile("" :: "v"(ret)); }
    else { if (EMODE == 1) {
#pragma unroll
            for (int r = 0; r < 4; ++r) { const float x0 = fmaxf(r0[r], 0.f), x1 = fmaxf(r1[r], 0.f); r0[r] = x0 * x0; r1[r] = x1 * x1; } }
        bf16* o = (bf16*)outp + (size_t)m * ldc + c0; *(v2u*)o = pk4(r0); *(v2u*)(o + 16) = pk4(r1); }
    __syncthreads();
}

constexpr int SN_BLOCKS = 16;
__device__ __forceinline__ void sample_rows_prepare(Frame& F, const float* shift, const float* gain, u64* ssq, unsigned* flag, int wv) {
    const int tid = fresh_tid(), lane = tid & 63;
    const float* X = (const float*)(F.ws + WS_X); bf16* H = (bf16*)(F.ws + WS_H);
    { const int row = MP + wv; const f32x4* xr = (const f32x4*)(X + (size_t)row * D) + lane; float s = 0.f;
      f32x4 vr[8];
#pragma unroll
      for (int jj = 0; jj < 8; ++jj) vr[jj] = xr[64 * jj];
#pragma unroll
      for (int jj = 0; jj < 8; ++jj) { const f32x4 v = vr[jj]; s += (v.x * v.x + v.y * v.y) + (v.z * v.z + v.w * v.w); ((v2u*)(H + (size_t)row * D) + lane)[64 * jj] = pk4(v); }
      s = wave_sum(s); if (lane == 0) ssq[row] = (u64)(s * SS_FIX + 0.5f); }
    if (shift) { const int row = MR + wv; const f32x4* xr = (const f32x4*)(shift + (size_t)wv * D) + lane; const f32x4* gr = (const f32x4*)gain + lane;
        f32x4 vr[8], gq[8];
#pragma unroll
        for (int jj = 0; jj < 8; ++jj) { vr[jj] = xr[64 * jj]; gq[jj] = gr[64 * jj]; }
#pragma unroll
        for (int jj = 0; jj < 8; ++jj) { const f32x4 v = vr[jj], g = gq[jj];
            ((v2u*)(H + (size_t)row * D) + lane)[64 * jj] = pk4((f32x4){v.x * __builtin_amdgcn_rcpf(g.x), v.y * __builtin_amdgcn_rcpf(g.y), v.z * __builtin_amdgcn_rcpf(g.z), v.w * __builtin_amdgcn_rcpf(g.w)}); }
        if (lane == 0) { u64 one = (u64)((double)D * (1.0 - (double)RMS_EPS) * (double)SS_FIX + 0.5); asm volatile("" : "+s"(one)); ssq[row] = one; } }
    asm volatile("s_waitcnt vmcnt(0)" ::: "memory");
    __syncthreads();
    if (tid == 0) { __builtin_amdgcn_fence(__ATOMIC_RELEASE, "agent"); asm volatile("s_waitcnt vmcnt(0)" ::: "memory");
        (void)__hip_atomic_fetch_add(flag, 1u, __ATOMIC_RELAXED, __HIP_MEMORY_SCOPE_AGENT); }
}
struct SampleOrder : pg8::StaticOrder {
    const unsigned* flag;
    __device__ __forceinline__ void a_ready(const pg8::Unit& u) const {
        if (u.pm == MP / 256) {
            if (__builtin_amdgcn_readfirstlane(threadIdx.x >> 6) == 0) {
                int polls = 0;
                while ((unsigned)__builtin_amdgcn_readfirstlane(__hip_atomic_load(flag, __ATOMIC_RELAXED, __HIP_MEMORY_SCOPE_AGENT)) < (unsigned)SN_BLOCKS) { polls = __builtin_amdgcn_readfirstlane(polls + 1); if (polls > (1 << 18)) break; __builtin_amdgcn_s_sleep(2); }
                __builtin_amdgcn_fence(__ATOMIC_ACQUIRE, "agent");
                asm volatile("s_waitcnt vmcnt(0)" ::: "memory"); }
            asm volatile("" ::: "memory"); __builtin_amdgcn_s_barrier(); asm volatile("" ::: "memory");
        }
    }
};
struct SampleOrderEarly : SampleOrder {
    unsigned* donectr;
    __device__ bool next(int i, pg8::Unit& u) const {
        long Lq = (long)i * G + c; if (Lq >= nwg) return false;
        if (Lq >= 214 && Lq < 214 + nN) { u.pm = nM - 1; u.pn = (int)Lq - 214; return true; }
        if (Lq >= 551 && ((Lq - 551) & 7) == 0 && (Lq - 551) / 8 < nN) Lq = 214 + (Lq - 551) / 8;
        int wgid = (int)Lq; { const int q = nwg / pg8::NXCD, r = nwg % pg8::NXCD, xcd = wgid % pg8::NXCD, off = wgid / pg8::NXCD; wgid = (xcd < r ? xcd * (q + 1) : r * (q + 1) + (xcd - r) * q) + off; }
        const int nig = pg8::WGM * nN, gid = wgid / nig, fm = gid * pg8::WGM, gsz = (nM - fm) < pg8::WGM ? (nM - fm) : pg8::WGM;
        u.pm = fm + ((wgid % nig) % gsz); u.pn = (wgid % nig) / gsz; return true;
    }
    __device__ __forceinline__ void done(const pg8::Unit& u) const {
        if (u.pm == MP / 256) {
            asm volatile("s_waitcnt vmcnt(0)" ::: "memory"); __builtin_amdgcn_s_barrier(); asm volatile("" ::: "memory");
            if (threadIdx.x == 0) { __builtin_amdgcn_fence(__ATOMIC_RELEASE, "agent"); asm volatile("s_waitcnt vmcnt(0)" ::: "memory");
                (void)__hip_atomic_fetch_add(donectr, 1u, __ATOMIC_RELAXED, __HIP_MEMORY_SCOPE_AGENT); }
        }
    }
};
template <class Epi> __device__ __forceinline__ void run_gemm_sample_early(Frame& F, const bf16* Am, const bf16* Bt, int N, int K, const Epi& E, const unsigned* flag, unsigned* donectr) {
    pg8::Gemm g{Am, Bt, MT, N, K}; SampleOrderEarly S; S.init(MT, N, F.G, (int)blockIdx.x); S.flag = flag; S.donectr = donectr;
    pg8::gemm_phase<Epi, SampleOrderEarly, GEMM_ALIGN, GEMM_SP2>(F.lds, g, S, E);
}
__device__ __forceinline__ void wait_counter(const unsigned* ctr, unsigned target) {
    if (__builtin_amdgcn_readfirstlane(threadIdx.x >> 6) == 0) { int polls = 0;
        while ((unsigned)__builtin_amdgcn_readfirstlane(__hip_atomic_load(ctr, __ATOMIC_RELAXED, __HIP_MEMORY_SCOPE_AGENT)) < target) { polls = __builtin_amdgcn_readfirstlane(polls + 1); if (polls > (1 << 18)) break; __builtin_amdgcn_s_sleep(2); }
        __builtin_amdgcn_fence(__ATOMIC_ACQUIRE, "agent"); asm volatile("s_waitcnt vmcnt(0)" ::: "memory"); }
    __syncthreads();
    __builtin_amdgcn_fence(__ATOMIC_ACQUIRE, "agent"); asm volatile("s_waitcnt vmcnt(0)" ::: "memory");
}
template <class Epi> __device__ __forceinline__ void run_gemm_sample(Frame& F, const bf16* Am, const bf16* Bt, int N, int K, const Epi& E, const unsigned* flag) {
    pg8::Gemm g{Am, Bt, MT, N, K}; SampleOrder S; S.init(MT, N, F.G, (int)blockIdx.x); S.flag = flag;
    pg8::gemm_phase<Epi, SampleOrder, GEMM_ALIGN, GEMM_SP2>(F.lds, g, S, E);
}

constexpr int HG_QT = 0, HG_KT = 16384, HG_QH = 32768, HG_KHT = 49152, HG_VT = 65536, HG_ATT = 81920, HG_ST = 90112, HG_TOT = 122880, HG_DEC = 124928, HG_SS = 125440, HG_DEC2 = 126976;

__device__ __forceinline__ float lower_bound(const float* lb_logits, int j, int ch) {
    if (j == 0) return 0.f;
    const float l0 = lb_logits[ch], l1 = lb_logits[MIX + ch];
    return 1.f / (1.f + __expf(l0 - l1));
}
__device__ __forceinline__ void sig2(float x, float& sp, float& sn) { const float e = __expf(-fabsf(x)), r = __builtin_amdgcn_rcpf(1.f + e); const float big = r, small = e * r; sp = x >= 0.f ? big : small; sn = x >= 0.f ? small : big; }
__device__ __forceinline__ float fsilu(float x) { float sp, sn; sig2(x, sp, sn); return x * sp; }

__device__ __forceinline__ void hgrn_prompt_unit(Frame& F, const bf16* PROJ, bf16* MIXC, const float* lb_logits, const float* onorm_g, float* state_out, int j, int b, int h, int c_lo, int c_hi) {
    const ldsp L = F.lds; const int tid = fresh_tid(), w = __builtin_amdgcn_readfirstlane(tid >> 6), lane = tid & 63, fr = lane & 15, q4 = lane >> 4;
    const int ek = tid & 127, etq = tid >> 7;
    const float lbk = lower_bound(lb_logits, j, h * 128 + ek), oml = 1.f - lbk;
    f32x4 Sacc[8];
#pragma unroll
    for (int i = 0; i < 8; ++i) Sacc[i] = (f32x4){0.f, 0.f, 0.f, 0.f};
    for (int i = tid; i < 32768 / 16; i += NTHR) *(LAS v4u*)(L + HG_ST + i * 16) = (v4u){0u, 0u, 0u, 0u};
    __syncthreads();
    const int tt = w & 3, vh = w >> 2;
    unsigned short rq[16], rf[16], rv[16];
    if (c_lo > 0) {
        { const bf16* pq = PROJ + ((size_t)b * SEQ + etq * 16) * LDP + h * 128 + ek;
#pragma unroll
          for (int i = 0; i < 16; ++i) { rf[i] = pq[(size_t)i * LDP + 1536]; rv[i] = pq[(size_t)i * LDP + 3072]; } }
#pragma unroll 1
        for (int c = 0; c < c_lo; ++c) {
            int tl_ = tid; asm volatile("" : "+v"(tl_));
            const int lane = tl_ & 63, fr = lane & 15, q4 = lane >> 4, ek = tl_ & 127, etq = tl_ >> 7;
            const int kbuf = (c & 1) ? HG_QT : HG_KHT, vbuf = (c & 1) ? HG_KT : HG_VT, dbuf = (c & 1) ? HG_DEC2 : HG_DEC;
            float fv[16], vv[16];
#pragma unroll
            for (int i = 0; i < 16; ++i) { fv[i] = bf2f(rf[i]); vv[i] = bf2f(rv[i]); }
            float bl[16], kv[16]; float run = 0.f;
#pragma unroll
            for (int i = 0; i < 16; ++i) { float sp, sn; sig2(fv[i], sp, sn); const float fg = lbk + oml * sp; run += __logf(fmaxf(fg, 1e-30f)); bl[i] = run; kv[i] = oml * sn; }
            ((LAS float*)(L + HG_TOT))[etq * 128 + ek] = run;
            LDS_BARRIER();
            const float t0 = ((LAS float*)(L + HG_TOT))[ek], t1 = ((LAS float*)(L + HG_TOT))[128 + ek], t2 = ((LAS float*)(L + HG_TOT))[256 + ek], t3 = ((LAS float*)(L + HG_TOT))[384 + ek];
            const float bend = (t0 + t1) + (t2 + t3);
            const float rem = bend - ((etq > 0 ? t0 : 0.f) + (etq > 1 ? t1 : 0.f) + (etq > 2 ? t2 : 0.f));
            float kh[16];
#pragma unroll
            for (int i = 0; i < 16; ++i) kh[i] = kv[i] * __expf(fminf(rem - bl[i], 0.f));
            { v4u o0, o1;
              o0.x = pk2(kh[0], kh[1]); o0.y = pk2(kh[2], kh[3]); o0.z = pk2(kh[4], kh[5]); o0.w = pk2(kh[6], kh[7]);
              o1.x = pk2(kh[8], kh[9]); o1.y = pk2(kh[10], kh[11]); o1.z = pk2(kh[12], kh[13]); o1.w = pk2(kh[14], kh[15]);
              *(LAS v4u*)(L + kbuf + sw64(ek, etq * 2)) = o0; *(LAS v4u*)(L + kbuf + sw64(ek, etq * 2 + 1)) = o1;
              o0.x = pk2(vv[0], vv[1]); o0.y = pk2(vv[2], vv[3]); o0.z = pk2(vv[4], vv[5]); o0.w = pk2(vv[6], vv[7]);
              o1.x = pk2(vv[8], vv[9]); o1.y = pk2(vv[10], vv[11]); o1.z = pk2(vv[12], vv[13]); o1.w = pk2(vv[14], vv[15]);
              *(LAS v4u*)(L + vbuf + sw64(ek, etq * 2)) = o0; *(LAS v4u*)(L + vbuf + sw64(ek, etq * 2 + 1)) = o1; }
            if (etq == 0) ((LAS float*)(L + dbuf))[ek] = __expf(bend);
            LDS_BARRIER();
            if (c + 1 < c_lo) { const bf16* pq = PROJ + ((size_t)b * SEQ + (c + 1) * 64 + etq * 16) * LDP + h * 128 + ek;
#pragma unroll
                for (int i = 0; i < 16; ++i) { rf[i] = pq[(size_t)i * LDP + 1536]; rv[i] = pq[(size_t)i * LDP + 3072]; } }
            { const f32x4 dec = *(LAS f32x4*)(L + dbuf + (16 * w + q4 * 4) * 4);
#pragma unroll
              for (int vt = 0; vt < 8; ++vt) Sacc[vt] = Sacc[vt] * dec;
#pragma unroll
              for (int ks = 0; ks < 2; ++ks) { const bf16x8 a = *(LAS bf16x8*)(L + kbuf + sw64(16 * w + fr, ks * 4 + q4));
#pragma unroll
                  for (int vt = 0; vt < 8; ++vt) { const bf16x8 bv = *(LAS bf16x8*)(L + vbuf + sw64(16 * vt + fr, ks * 4 + q4)); Sacc[vt] = MFMA16(a, bv, Sacc[vt]); } } }
            __builtin_amdgcn_sched_barrier(0);
        }
        { int tl_ = tid; asm volatile("" : "+v"(tl_)); const int lane = tl_ & 63, fr = lane & 15, q4 = lane >> 4; const int k0 = 16 * w + q4 * 4;
#pragma unroll
          for (int vt = 0; vt < 8; ++vt) *(LAS v2u*)(L + HG_ST + sw128(16 * vt + fr, k0 >> 3) + (k0 & 7) * 2) = pk4(Sacc[vt]); }
    }
    { const bf16* pq = PROJ + ((size_t)b * SEQ + c_lo * 64 + etq * 16) * LDP + h * 128 + ek;
#pragma unroll
      for (int i = 0; i < 16; ++i) { rq[i] = pq[(size_t)i * LDP]; rf[i] = pq[(size_t)i * LDP + 1536]; rv[i] = pq[(size_t)i * LDP + 3072]; } }
#pragma unroll 1
    for (int c = c_lo; c < c_hi; ++c) {
        int tl_ = tid; asm volatile("" : "+v"(tl_));
        const int lane = tl_ & 63, fr = lane & 15, q4 = lane >> 4, ek = tl_ & 127, etq = tl_ >> 7;
        const size_t row0 = (size_t)b * SEQ + c * 64;
        float qv[16], fv[16], vv[16];
#pragma unroll
        for (int i = 0; i < 16; ++i) { qv[i] = bf2f(rq[i]); fv[i] = bf2f(rf[i]); vv[i] = bf2f(rv[i]); }
        float bl[16], kv[16]; float run = 0.f;
#pragma unroll
        for (int i = 0; i < 16; ++i) { float sp, sn; sig2(fv[i], sp, sn); const float fg = lbk + oml * sp; run += __logf(fmaxf(fg, 1e-30f)); bl[i] = run; kv[i] = oml * sn; }
        ((LAS float*)(L + HG_TOT))[etq * 128 + ek] = run;
        LDS_BARRIER();
        const float t0 = ((LAS float*)(L + HG_TOT))[ek], t1 = ((LAS float*)(L + HG_TOT))[128 + ek], t2 = ((LAS float*)(L + HG_TOT))[256 + ek], t3 = ((LAS float*)(L + HG_TOT))[384 + ek];
        const float off = (etq > 0 ? t0 : 0.f) + (etq > 1 ? t1 : 0.f) + (etq > 2 ? t2 : 0.f);
        const float mref = t0 + t1, bend = mref + t2 + t3, ebm = __expf(t2 + t3);
        float kh[16];
#pragma unroll
        for (int i = 0; i < 16; ++i) { const int t = etq * 16 + i; const float bt = off + bl[i];
            const float d = fminf(fmaxf(bt - mref, -60.f), 60.f), e1 = __expf(d), e2 = __builtin_amdgcn_rcpf(e1);
            const float sq = fsilu(qv[i]);
            const int a = sw128(t, ek >> 3) + (ek & 7) * 2;
            *(LAS unsigned short*)(L + HG_QT + a) = (unsigned short)f2bf(sq * e1);
            *(LAS unsigned short*)(L + HG_KT + a) = (unsigned short)f2bf(kv[i] * e2);
            *(LAS unsigned short*)(L + HG_QH + a) = (unsigned short)f2bf(sq * __expf(bt));
            kh[i] = kv[i] * (ebm * e2); }
        { v4u o0, o1;
          o0.x = pk2(kh[0], kh[1]); o0.y = pk2(kh[2], kh[3]); o0.z = pk2(kh[4], kh[5]); o0.w = pk2(kh[6], kh[7]);
          o1.x = pk2(kh[8], kh[9]); o1.y = pk2(kh[10], kh[11]); o1.z = pk2(kh[12], kh[13]); o1.w = pk2(kh[14], kh[15]);
          *(LAS v4u*)(L + HG_KHT + sw64(ek, etq * 2)) = o0; *(LAS v4u*)(L + HG_KHT + sw64(ek, etq * 2 + 1)) = o1;
          o0.x = pk2(vv[0], vv[1]); o0.y = pk2(vv[2], vv[3]); o0.z = pk2(vv[4], vv[5]); o0.w = pk2(vv[6], vv[7]);
          o1.x = pk2(vv[8], vv[9]); o1.y = pk2(vv[10], vv[11]); o1.z = pk2(vv[12], vv[13]); o1.w = pk2(vv[14], vv[15]);
          *(LAS v4u*)(L + HG_VT + sw64(ek, etq * 2)) = o0; *(LAS v4u*)(L + HG_VT + sw64(ek, etq * 2 + 1)) = o1; }
        if (etq == 0) ((LAS float*)(L + HG_DEC))[ek] = __expf(bend);
        LDS_BARRIER();
        v2u gate_raw[4];
#pragma unroll
        for (int i = 0; i < 4; ++i) gate_raw[i] = *(const v2u*)(PROJ + (row0 + tt * 16 + fr) * LDP + 4608 + h * 128 + (4 * vh + i) * 16 + q4 * 4);
        if (c + 1 < c_hi) { const bf16* pq = PROJ + (row0 + 64 + etq * 16) * LDP + h * 128 + ek;
#pragma unroll
            for (int i = 0; i < 16; ++i) { rq[i] = pq[(size_t)i * LDP]; rf[i] = pq[(size_t)i * LDP + 1536]; rv[i] = pq[(size_t)i * LDP + 3072]; } }
#pragma unroll
        for (int u = 0; u < 2; ++u) { const int st = w >> 1, ttl = 2 * (w & 1) + u;
            f32x4 acc = (f32x4){0.f, 0.f, 0.f, 0.f};
            if (st <= ttl) {
#pragma unroll
                for (int ks = 0; ks < 4; ++ks) { const bf16x8 a = *(LAS bf16x8*)(L + HG_KT + sw128(st * 16 + fr, ks * 4 + q4)); const bf16x8 bq = *(LAS bf16x8*)(L + HG_QT + sw128(ttl * 16 + fr, ks * 4 + q4)); acc = MFMA16(a, bq, acc); } }
            const int t = ttl * 16 + fr, s0 = st * 16 + q4 * 4;
#pragma unroll
            for (int r = 0; r < 4; ++r) if (s0 + r > t) acc[r] = 0.f;
            *(LAS v2u*)(L + HG_ATT + sw64(t, s0 >> 3) + (s0 & 7) * 2) = pk4(acc); }
        f32x4 oT[4];
#pragma unroll
        for (int i = 0; i < 4; ++i) oT[i] = (f32x4){0.f, 0.f, 0.f, 0.f};
#pragma unroll
        for (int ks = 0; ks < 4; ++ks) { const bf16x8 bq = *(LAS bf16x8*)(L + HG_QH + sw128(tt * 16 + fr, ks * 4 + q4));
#pragma unroll
            for (int i = 0; i < 4; ++i) { const bf16x8 a = *(LAS bf16x8*)(L + HG_ST + sw128((4 * vh + i) * 16 + fr, ks * 4 + q4)); oT[i] = MFMA16(a, bq, oT[i]); } }
        { const f32x4 dec = *(LAS f32x4*)(L + HG_DEC + (16 * w + q4 * 4) * 4);
#pragma unroll
          for (int vt = 0; vt < 8; ++vt) Sacc[vt] = Sacc[vt] * dec;
#pragma unroll
          for (int ks = 0; ks < 2; ++ks) { const bf16x8 a = *(LAS bf16x8*)(L + HG_KHT + sw64(16 * w + fr, ks * 4 + q4));
#pragma unroll
              for (int vt = 0; vt < 8; ++vt) { const bf16x8 bv = *(LAS bf16x8*)(L + HG_VT + sw64(16 * vt + fr, ks * 4 + q4)); Sacc[vt] = MFMA16(a, bv, Sacc[vt]); } } }
        LDS_BARRIER();
        { const int k0 = 16 * w + q4 * 4;
#pragma unroll
          for (int vt = 0; vt < 8; ++vt) *(LAS v2u*)(L + HG_ST + sw128(16 * vt + fr, k0 >> 3) + (k0 & 7) * 2) = pk4(Sacc[vt]); }
#pragma unroll
        for (int ks = 0; ks < 2; ++ks) { const bf16x8 bq = *(LAS bf16x8*)(L + HG_ATT + sw64(tt * 16 + fr, ks * 4 + q4));
#pragma unroll
            for (int i = 0; i < 4; ++i) { const bf16x8 a = *(LAS bf16x8*)(L + HG_VT + sw64((4 * vh + i) * 16 + fr, ks * 4 + q4)); oT[i] = MFMA16(a, bq, oT[i]); } }
        float ss = 0.f;
#pragma unroll
        for (int i = 0; i < 4; ++i) ss += (oT[i].x * oT[i].x + oT[i].y * oT[i].y) + (oT[i].z * oT[i].z + oT[i].w * oT[i].w);
        ss += __shfl_xor(ss, 16); ss += __shfl_xor(ss, 32);
        if (q4 == 0) ((LAS float*)(L + HG_SS))[w * 16 + fr] = ss;
        LDS_BARRIER();
        const float tot = ((LAS float*)(L + HG_SS))[w * 16 + fr] + ((LAS float*)(L + HG_SS))[(w ^ 4) * 16 + fr];
        const float rstd = 1.f / sqrtf(tot * (1.f / 128.f) + RMS_EPS);
        const size_t row = row0 + tt * 16 + fr;
#pragma unroll
        for (int i = 0; i < 4; ++i) { const int ch = h * 128 + (4 * vh + i) * 16 + q4 * 4;
            const f32x4 gon = *(const f32x4*)(onorm_g + ch); const f32x4 gate = bf4(gate_raw[i]);
            f32x4 o = oT[i] * rstd * gon;
            o.x *= fsilu(gate.x); o.y *= fsilu(gate.y); o.z *= fsilu(gate.z); o.w *= fsilu(gate.w);
            *(v2u*)(MIXC + row * D + ch) = pk4(o); }
    }
    if (c_hi == SEQ / 64) {
#pragma unroll
        for (int vt = 0; vt < 8; ++vt)
#pragma unroll
            for (int r = 0; r < 4; ++r) state_out[(size_t)(16 * w + q4 * 4 + r) * 128 + 16 * vt + fr] = Sacc[vt][r]; }
    __syncthreads();
}

__device__ __forceinline__ void hgrn_sample_unit(int lane, const bf16* PROJ, bf16* MIXC, const float* lb_logits, const float* onorm_g, const float* S0, float* S1, int j, int b, int h) {
    const size_t row = MP + b; const int vq = lane & 31, kr = lane >> 5;
    float fg[2], kvv[2], sq[2];
#pragma unroll
    for (int u = 0; u < 2; ++u) { const int k = lane + 64 * u; const bf16* p = PROJ + row * LDP + h * 128 + k;
        const float q = bf2f(p[0]), f = bf2f(p[1536]); const float lbk = lower_bound(lb_logits, j, h * 128 + k);
        float sp, sn; sig2(f, sp, sn); fg[u] = fmaxf(lbk + (1.f - lbk) * sp, 1e-30f); kvv[u] = (1.f - lbk) * sn; sq[u] = fsilu(q); }
    const f32x4 v4 = bf4(*(const v2u*)(PROJ + row * LDP + 3072 + h * 128 + 4 * vq));
    f32x4 o = (f32x4){0.f, 0.f, 0.f, 0.f};
#pragma unroll 1
    for (int ib = 0; ib < 8; ++ib) {
        f32x4 Sv[8];
#pragma unroll
        for (int i = 0; i < 8; ++i) Sv[i] = *(const f32x4*)(S0 + (size_t)(2 * (ib * 8 + i) + kr) * 128 + 4 * vq);
        __builtin_amdgcn_sched_barrier(0);
        const bool lowh = ib < 4;
#pragma unroll
        for (int i = 0; i < 8; ++i) { const int it = ib * 8 + i, k = 2 * it + kr; const int src = k & 63;
            const float fgk = __shfl(lowh ? fg[0] : fg[1], src), kvk = __shfl(lowh ? kvv[0] : kvv[1], src), sqk = __shfl(lowh ? sq[0] : sq[1], src);
            const f32x4 Sn = Sv[i] * fgk + v4 * kvk;
            *(f32x4*)(S1 + (size_t)k * 128 + 4 * vq) = Sn;
            o = o + Sn * sqk; } }
    o.x += __shfl_xor(o.x, 32); o.y += __shfl_xor(o.y, 32); o.z += __shfl_xor(o.z, 32); o.w += __shfl_xor(o.w, 32);
    float ss = (o.x * o.x + o.y * o.y) + (o.z * o.z + o.w * o.w);
#pragma unroll
    for (int m = 1; m < 32; m <<= 1) ss += __shfl_xor(ss, m);
    const float rstd = 1.f / sqrtf(ss * (1.f / 128.f) + RMS_EPS);
    if (lane < 32) { const int ch = h * 128 + 4 * vq;
        const f32x4 gon = *(const f32x4*)(onorm_g + ch); const f32x4 gate = bf4(*(const v2u*)(PROJ + row * LDP + 4608 + ch));
        f32x4 r = o * rstd * gon; r.x *= fsilu(gate.x); r.y *= fsilu(gate.y); r.z *= fsilu(gate.z); r.w *= fsilu(gate.w);
        *(v2u*)(MIXC + row * D + ch) = pk4(r); }
}

constexpr int XA_K = 0, XA_KLD = 272, XA_VT = 256 * 272, XA_VLD = 520;
__device__ __forceinline__ void xattn_prompt_unit(Frame& F, const bf16* PROJ, int xq_off, bf16* MIXC, const float* Kb, const float* Vb, int b, int head, int qpart) {
    const ldsp L = F.lds; const int tid = fresh_tid(), w = __builtin_amdgcn_readfirstlane(tid >> 6), lane = tid & 63, fr = lane & 15, q4 = lane >> 4;
    __syncthreads();
#pragma unroll 1
    for (int hb = 0; hb < 2; ++hb) {
        f32x4 kx[8], vx[8];
#pragma unroll
        for (int i = 0; i < 8; ++i) { const int idx = (hb * 8 + i) * NTHR + tid, m = idx >> 5, e4 = idx & 31;
            kx[i] = *(const f32x4*)(Kb + (size_t)m * XDIM + head * XD + 4 * e4); vx[i] = *(const f32x4*)(Vb + (size_t)m * XDIM + head * XD + 4 * e4); }
        __builtin_amdgcn_sched_barrier(0);
#pragma unroll
        for (int i = 0; i < 8; ++i) { const int idx = (hb * 8 + i) * NTHR + tid, m = idx >> 5, e4 = idx & 31;
            *(LAS v2u*)(L + XA_K + m * XA_KLD + e4 * 8) = pk4(kx[i]);
#pragma unroll
            for (int q = 0; q < 4; ++q) { const int e = 4 * e4 + q; *(LAS unsigned short*)(L + XA_VT + e * XA_VLD + m * 2) = (unsigned short)f2bf(vx[i][q]); } }
        __builtin_amdgcn_sched_barrier(0); }
    __syncthreads();
    const float scale = 0.08838834764831845f;
    const ldsp kbase = L + XA_K + fr * XA_KLD + q4 * 16; const ldsp vbase = L + XA_VT + fr * XA_VLD + q4 * 8;
#pragma unroll 1
    for (int qt = 0; qt < 2; ++qt) {
        const size_t r = (size_t)b * SEQ + qpart * 256 + qt * 128 + w * 16 + fr;
        bf16x8 qf[4];
#pragma unroll
        for (int ks = 0; ks < 4; ++ks) qf[ks] = *(const bf16x8*)(PROJ + r * LDP + xq_off + head * XD + ks * 32 + q4 * 8);
        f32x4 sT[16];
#pragma unroll
        for (int mt = 0; mt < 16; ++mt) { f32x4 acc = (f32x4){0.f, 0.f, 0.f, 0.f};
#pragma unroll
            for (int ks = 0; ks < 4; ++ks) { const bf16x8 a = *(LAS bf16x8*)(kbase + mt * 16 * XA_KLD + ks * 64); acc = MFMA16(a, qf[ks], acc); }
            sT[mt] = acc; __builtin_amdgcn_sched_barrier(0); }
        float mx = -3.0e38f;
#pragma unroll
        for (int mt = 0; mt < 16; ++mt) mx = fmaxf(mx, fmaxf(fmaxf(sT[mt].x, sT[mt].y), fmaxf(sT[mt].z, sT[mt].w)));
        mx = fmaxf(mx, __shfl_xor(mx, 16)); mx = fmaxf(mx, __shfl_xor(mx, 32));
        float l = 0.f;
#pragma unroll
        for (int mt = 0; mt < 16; ++mt) {
#pragma unroll
            for (int q = 0; q < 4; ++q) { const float p = __expf((sT[mt][q] - mx) * scale); sT[mt][q] = p; l += p; } }
        l += __shfl_xor(l, 16); l += __shfl_xor(l, 32);
        const float inv = 1.f / l;
        f32x4 oT[8];
#pragma unroll
        for (int et = 0; et < 8; ++et) oT[et] = (f32x4){0.f, 0.f, 0.f, 0.f};
#pragma unroll
        for (int s = 0; s < 8; ++s) {
            v4u pw; pw.x = pk2(sT[2 * s].x, sT[2 * s].y); pw.y = pk2(sT[2 * s].z, sT[2 * s].w); pw.z = pk2(sT[2 * s + 1].x, sT[2 * s + 1].y); pw.w = pk2(sT[2 * s + 1].z, sT[2 * s + 1].w);
            const bf16x8 pf = __builtin_bit_cast(bf16x8, pw);
#pragma unroll
            for (int et = 0; et < 8; ++et) {
                const v2u a0 = *(LAS v2u*)(vbase + et * 16 * XA_VLD + s * 64);
                const v2u a1 = *(LAS v2u*)(vbase + et * 16 * XA_VLD + s * 64 + 32);
                v4u aw; aw.x = a0.x; aw.y = a0.y; aw.z = a1.x; aw.w = a1.y;
                oT[et] = MFMA16(__builtin_bit_cast(bf16x8, aw), pf, oT[et]); }
            __builtin_amdgcn_sched_barrier(0); }
#pragma unroll
        for (int et = 0; et < 8; ++et) *(v2u*)(MIXC + r * D + MIX + head * XD + et * 16 + q4 * 4) = pk4(oT[et] * inv);
    }
    __syncthreads();
}
__device__ __forceinline__ void xattn_sample_pair(Frame& F, const bf16* PROJ, int xq_off, bf16* MIXC, const float* Kall, const float* Vall, int unit0) {
    const ldsp L = F.lds; const int tid = fresh_tid(), w = __builtin_amdgcn_readfirstlane(tid >> 6), lane = tid & 63;
    const int unit = unit0 + (w >> 2), mp = w & 3, b = unit >> 2, head = unit & 3;
    const size_t row = MP + b; const int fr = lane & 15, q4 = lane >> 4, e4 = lane & 31, mr = lane >> 5;
    const float* Kb = Kall + (size_t)b * NMEM * XDIM; const float* Vb = Vall + (size_t)b * NMEM * XDIM;
    const float scale = 0.08838834764831845f;
    bf16x8 qf[4];
#pragma unroll
    for (int ks = 0; ks < 4; ++ks) { const v4u raw = *(const v4u*)(PROJ + row * LDP + xq_off + head * XD + ks * 32 + q4 * 8);
        v4u o; o.x = pk2_hw(bflo(raw.x) * scale, bfhi(raw.x) * scale); o.y = pk2_hw(bflo(raw.y) * scale, bfhi(raw.y) * scale); o.z = pk2_hw(bflo(raw.z) * scale, bfhi(raw.z) * scale); o.w = pk2_hw(bflo(raw.w) * scale, bfhi(raw.w) * scale);
        qf[ks] = __builtin_bit_cast(bf16x8, o); }
    f32x4 sT[4];
#pragma unroll
    for (int i = 0; i < 4; ++i) { f32x4 acc = (f32x4){0.f, 0.f, 0.f, 0.f};
        const float* kp = Kb + (size_t)(mp * 64 + i * 16 + fr) * XDIM + head * XD + q4 * 8;
        f32x4 x0[4], x1[4];
#pragma unroll
        for (int ks = 0; ks < 4; ++ks) { x0[ks] = *(const f32x4*)(kp + ks * 32); x1[ks] = *(const f32x4*)(kp + ks * 32 + 4); }
#pragma unroll
        for (int ks = 0; ks < 4; ++ks) { v4u aw; aw.x = pk2_hw(x0[ks].x, x0[ks].y); aw.y = pk2_hw(x0[ks].z, x0[ks].w); aw.z = pk2_hw(x1[ks].x, x1[ks].y); aw.w = pk2_hw(x1[ks].z, x1[ks].w);
            acc = MFMA16(__builtin_bit_cast(bf16x8, aw), qf[ks], acc); }
        sT[i] = acc; }
    float mx = -3.0e38f;
#pragma unroll
    for (int i = 0; i < 4; ++i) mx = fmaxf(mx, fmaxf(fmaxf(sT[i].x, sT[i].y), fmaxf(sT[i].z, sT[i].w)));
    mx = fmaxf(mx, __shfl_xor(mx, 16)); mx = fmaxf(mx, __shfl_xor(mx, 32));
    float l = 0.f;
#pragma unroll
    for (int i = 0; i < 4; ++i) {
#pragma unroll
        for (int q = 0; q < 4; ++q) { const float p = __expf(sT[i][q] - mx); sT[i][q] = p; l += p; } }
    l += __shfl_xor(l, 16); l += __shfl_xor(l, 32);
    f32x4 o = (f32x4){0.f, 0.f, 0.f, 0.f};
    const float* vp = Vb + head * XD + 4 * e4;
#pragma unroll
    for (int i = 0; i < 4; ++i) {
#pragma unroll
        for (int ii = 0; ii < 8; ++ii) { const int m0 = mp * 64 + i * 16 + 2 * ii; const int src = ((2 * ii) >> 2) * 16;
            const float pa = __shfl(sT[i][2 * (ii & 1)], src), pb = __shfl(sT[i][2 * (ii & 1) + 1], src);
            const f32x4 vx = *(const f32x4*)(vp + (size_t)(m0 + mr) * XDIM);
            o = o + vx * (mr ? pb : pa); } }
    o.x += __shfl_xor(o.x, 32); o.y += __shfl_xor(o.y, 32); o.z += __shfl_xor(o.z, 32); o.w += __shfl_xor(o.w, 32);
    LAS float* slot = (LAS float*)(L + w * 528);
    if (lane == 0) { slot[0] = mx; slot[1] = l; }
    if (lane < 32) *(LAS f32x4*)(slot + 4 + 4 * e4) = o;
    LDS_BARRIER();
    if (mp == 0 && lane < 32) { float M = -3.0e38f;
#pragma unroll
        for (int i = 0; i < 4; ++i) M = fmaxf(M, ((LAS float*)(L + (w + i) * 528))[0]);
        float Lsum = 0.f; f32x4 O = (f32x4){0.f, 0.f, 0.f, 0.f};
#pragma unroll
        for (int i = 0; i < 4; ++i) { const LAS float* s = (const LAS float*)(L + (w + i) * 528); const float f = __expf(s[0] - M); Lsum += s[1] * f; O = O + *(const LAS f32x4*)(s + 4 + 4 * e4) * f; }
        *(v2u*)(MIXC + row * D + MIX + head * XD + 4 * e4) = pk4(O * (1.f / Lsum)); }
    LDS_BARRIER();
}

__device__ __forceinline__ void xattn_sample_unit(int lane, const bf16* PROJ, int xq_off, bf16* MIXC, const float* Kb, const float* Vb, int b, int head) {
    const size_t row = MP + b; const int fr = lane & 15, q4 = lane >> 4, e4 = lane & 31, mr = lane >> 5;
    const float scale = 0.08838834764831845f;
    bf16x8 qf[4];
#pragma unroll
    for (int ks = 0; ks < 4; ++ks) { const v4u raw = *(const v4u*)(PROJ + row * LDP + xq_off + head * XD + ks * 32 + q4 * 8);
        v4u o; o.x = pk2_hw(bflo(raw.x) * scale, bfhi(raw.x) * scale); o.y = pk2_hw(bflo(raw.y) * scale, bfhi(raw.y) * scale); o.z = pk2_hw(bflo(raw.z) * scale, bfhi(raw.z) * scale); o.w = pk2_hw(bflo(raw.w) * scale, bfhi(raw.w) * scale);
        qf[ks] = __builtin_bit_cast(bf16x8, o); }
    f32x4 sT[16];
#pragma unroll
    for (int mt = 0; mt < 16; ++mt) { f32x4 acc = (f32x4){0.f, 0.f, 0.f, 0.f};
        const float* kp = Kb + (size_t)(mt * 16 + fr) * XDIM + head * XD + q4 * 8;
        f32x4 x0[4], x1[4];
#pragma unroll
        for (int ks = 0; ks < 4; ++ks) { x0[ks] = *(const f32x4*)(kp + ks * 32); x1[ks] = *(const f32x4*)(kp + ks * 32 + 4); }
#pragma unroll
        for (int ks = 0; ks < 4; ++ks) { v4u aw; aw.x = pk2_hw(x0[ks].x, x0[ks].y); aw.y = pk2_hw(x0[ks].z, x0[ks].w); aw.z = pk2_hw(x1[ks].x, x1[ks].y); aw.w = pk2_hw(x1[ks].z, x1[ks].w);
            acc = MFMA16(__builtin_bit_cast(bf16x8, aw), qf[ks], acc); }
        sT[mt] = acc; }
    float mx = -3.0e38f;
#pragma unroll
    for (int mt = 0; mt < 16; ++mt) mx = fmaxf(mx, fmaxf(fmaxf(sT[mt].x, sT[mt].y), fmaxf(sT[mt].z, sT[mt].w)));
    mx = fmaxf(mx, __shfl_xor(mx, 16)); mx = fmaxf(mx, __shfl_xor(mx, 32));
    float l = 0.f;
#pragma unroll
    for (int mt = 0; mt < 16; ++mt) {
#pragma unroll
        for (int q = 0; q < 4; ++q) { const float p = __expf(sT[mt][q] - mx); sT[mt][q] = p; l += p; } }
    l += __shfl_xor(l, 16); l += __shfl_xor(l, 32);
    f32x4 o = (f32x4){0.f, 0.f, 0.f, 0.f};
    const float* vp = Vb + head * XD + 4 * e4;
#pragma unroll
    for (int mt = 0; mt < 16; ++mt) {
#pragma unroll
        for (int i = 0; i < 8; ++i) { const int m0 = mt * 16 + 2 * i;
            const int src = ((2 * i) >> 2) * 16;
            const float pa = __shfl(sT[mt][2 * (i & 1)], src);
            const float pb = __shfl(sT[mt][2 * (i & 1) + 1], src);
            const f32x4 vx = *(const f32x4*)(vp + (size_t)(m0 + mr) * XDIM);
            o = o + vx * (mr ? pb : pa); } }
    o.x += __shfl_xor(o.x, 32); o.y += __shfl_xor(o.y, 32); o.z += __shfl_xor(o.z, 32); o.w += __shfl_xor(o.w, 32);
    if (lane < 32) *(v2u*)(MIXC + row * D + MIX + head * XD + 4 * e4) = pk4(o * (1.f / l));
}


__device__ __forceinline__ long rw_prev_row(int row) { return row < MP ? (((row & (SEQ - 1)) == 0) ? -1L : (long)row - 1) : (long)row + NSMP; }
__device__ __forceinline__ f32x4 ld_bf4(const bf16* p) { return bf4(*(const v2u*)p); }
__device__ __forceinline__ f32x4 ld_bf4_prev(const bf16* PROJ, long prow, int col) { return prow >= 0 ? bf4(*(const v2u*)(PROJ + (size_t)prow * LDP + col)) : (f32x4){0.f, 0.f, 0.f, 0.f}; }
__device__ __forceinline__ float ftanh(float x) { return 1.f - 2.f * __builtin_amdgcn_rcpf(1.f + __expf(2.f * x)); }
__device__ __forceinline__ float quad_sum(float x) {
    x += __builtin_bit_cast(float, __builtin_amdgcn_mov_dpp(__builtin_bit_cast(int, x), 0xB1, 0xF, 0xF, true));
    x += __builtin_bit_cast(float, __builtin_amdgcn_mov_dpp(__builtin_bit_cast(int, x), 0x4E, 0xF, 0xF, true));
    return x;
}

constexpr int RC_LI = 0, RC_RAW = 46080, RC_XCH = RC_RAW + 3 * 9216;
__device__ __forceinline__ void rwkv_prep_unit(Frame& F, const Args& A, int j, int r0, int h_lo, int h_hi) {
    const ldsp L = F.lds; const int tid = fresh_tid(), w = __builtin_amdgcn_readfirstlane(tid >> 6), lane = tid & 63, fr = lane & 15, q4 = lane >> 4;
    const int it = w >> 1, jh = w & 1;
    constexpr bool sample = true;
    const bf16* PROJ = (const bf16*)(F.ws + WS_PROJ);
    const float* mu = A.in[20] + (size_t)j * B_MIXC; const float* w0 = A.in[21] + (size_t)j * MIX; const float* a0 = A.in[23] + (size_t)j * MIX;
    const float* k_k = A.in[26] + (size_t)j * MIX; const float* k_a = A.in[27] + (size_t)j * MIX; const float* r_k = A.in[28] + (size_t)j * MIX;
    const bf16* LW = (const bf16*)(F.ws + WS_LW) + (size_t)j * MIX * LORA_K;
    float* RR = (float*)(F.ws + WS_RR); float* RK = (float*)(F.ws + WS_RK); float* RV = (float*)(F.ws + WS_RV); float* RKK = (float*)(F.ws + WS_RKK);
    float* RKA = (float*)(F.ws + WS_RKA); float* RWd = (float*)(F.ws + WS_RW); float* RG = (float*)(F.ws + WS_RG); float* BON = (float*)(F.ws + WS_BONUS);
    __syncthreads();
    for (int itr = 0; itr < 11; ++itr) { const int idx = itr * NTHR + tid;
        if (idx < 64 * 88) { const int t = idx / 88, c4 = idx - t * 88, col = 4 * c4; const int row = r0 + t; const long prow = rw_prev_row(row);
            const f32x4 P = ld_bf4(PROJ + (size_t)row * LDP + B_LORA_OFF + col), Pp = ld_bf4_prev(PROJ, prow, B_LORA_OFF + col);
            const f32x4 m4 = *(const f32x4*)(mu + 4608 + col);
            f32x4 xs = P + (Pp - P) * m4;
            if (col < 64) { xs.x = ftanh(xs.x); xs.y = ftanh(xs.y); xs.z = ftanh(xs.z); xs.w = ftanh(xs.w); }
            else if (col >= 128) { xs.x = fsigmoid(xs.x); xs.y = fsigmoid(xs.y); xs.z = fsigmoid(xs.z); xs.w = fsigmoid(xs.w); }
            *(LAS v2u*)(L + RC_LI + t * 720 + col * 2) = pk4(xs); } }
#pragma unroll 1
    for (int h = h_lo; h < h_hi; ++h) {
        __syncthreads();
        { const int row = tid >> 3, c8 = tid & 7;
#pragma unroll
          for (int x = 0; x < 3; ++x) { const v4u val = *(const v4u*)(PROJ + (size_t)(r0 + row) * LDP + x * 1536 + h * 64 + c8 * 8);
              *(LAS v4u*)(L + RC_RAW + x * 9216 + (row + 1) * 128 + c8 * 16) = val; }
          if (tid < 8) { const long prow = sample ? -1L : rw_prev_row(r0);
#pragma unroll
              for (int x = 0; x < 3; ++x) { v4u val = (v4u){0u, 0u, 0u, 0u}; if (prow >= 0) val = *(const v4u*)(PROJ + (size_t)prow * LDP + x * 1536 + h * 64 + tid * 8);
                  *(LAS v4u*)(L + RC_RAW + x * 9216 + tid * 16) = val; } } }
        f32x4 aw[2], aa[2], ag[2];
#pragma unroll
        for (int u = 0; u < 2; ++u) { aw[u] = (f32x4){0.f, 0.f, 0.f, 0.f}; aa[u] = aw[u]; ag[u] = aw[u]; }
        { const bf16* lw0 = LW + (size_t)(h * 64 + (2 * jh) * 16 + fr) * LORA_K + q4 * 8; const ldsp li = L + RC_LI + (it * 16 + fr) * 720 + q4 * 16;
#pragma unroll
          for (int ks = 0; ks < 11; ++ks) { const bf16x8 afr = *(LAS bf16x8*)(li + ks * 64);
#pragma unroll
              for (int u = 0; u < 2; ++u) { const bf16x8 bfr = *(const bf16x8*)(lw0 + (size_t)u * 16 * LORA_K + ks * 32);
                  if (ks < 2) aw[u] = MFMA16(afr, bfr, aw[u]); else if (ks < 4) aa[u] = MFMA16(afr, bfr, aa[u]); else ag[u] = MFMA16(afr, bfr, ag[u]); } } }
        __syncthreads();
        float xr[2][4], xk[2][4], xv[2][4], dw[2][4], av[2][4], kkr[2][4];
        float nrm[4] = {0.f, 0.f, 0.f, 0.f}, bon[4] = {0.f, 0.f, 0.f, 0.f};
#pragma unroll
        for (int u = 0; u < 2; ++u) { const int c = (2 * jh + u) * 16 + fr, ch = h * 64 + c;
            const float mur = mu[ch], muk = mu[1536 + ch], muv = mu[3072 + ch], w0c = w0[ch], a0c = a0[ch], kkc = k_k[ch], kac = k_a[ch], rkc = r_k[ch];
#pragma unroll
            for (int e = 0; e < 4; ++e) { const int t = it * 16 + 4 * q4 + e;
                const float cr = bf2f(*(LAS unsigned short*)(L + RC_RAW + (t + 1) * 128 + c * 2)), ck = bf2f(*(LAS unsigned short*)(L + RC_RAW + 9216 + (t + 1) * 128 + c * 2)),
                            cv = bf2f(*(LAS unsigned short*)(L + RC_RAW + 18432 + (t + 1) * 128 + c * 2));
                float pr, pk, pv;
                if (sample) { const bf16* pp = PROJ + (size_t)(r0 + t + NSMP) * LDP + ch; pr = bf2f(pp[0]); pk = bf2f(pp[1536]); pv = bf2f(pp[3072]); }
                else { pr = bf2f(*(LAS unsigned short*)(L + RC_RAW + t * 128 + c * 2)); pk = bf2f(*(LAS unsigned short*)(L + RC_RAW + 9216 + t * 128 + c * 2)); pv = bf2f(*(LAS unsigned short*)(L + RC_RAW + 18432 + t * 128 + c * 2)); }
                const float r_ = cr + (pr - cr) * mur, k_ = ck + (pk - ck) * muk, v_ = cv + (pv - cv) * muv;
                const float x = -(w0c + aw[u][e]);
                const float sp = fmaxf(x, 0.f) + __logf(1.f + __expf(-fabsf(x)));
                dw[u][e] = -__expf(-sp - 0.5f);
                const float a = fsigmoid(a0c + aa[u][e]);
                const float kr_ = k_ * kkc, kp = k_ * (1.f + (a - 1.f) * kac);
                xr[u][e] = r_; xk[u][e] = kp; xv[u][e] = v_; av[u][e] = a; kkr[u][e] = kr_;
                nrm[e] += kr_ * kr_; bon[e] += r_ * kp * rkc; } }
#pragma unroll
        for (int e = 0; e < 4; ++e) {
#pragma unroll
            for (int m = 1; m < 16; m <<= 1) { nrm[e] += __shfl_xor(nrm[e], m); bon[e] += __shfl_xor(bon[e], m); } }
        if (fr == 0) {
#pragma unroll
            for (int e = 0; e < 4; ++e) { ((LAS float*)(L + RC_XCH))[(w * 2 + 0) * 16 + 4 * q4 + e] = nrm[e]; ((LAS float*)(L + RC_XCH))[(w * 2 + 1) * 16 + 4 * q4 + e] = bon[e]; } }
        __syncthreads();
#pragma unroll
        for (int e = 0; e < 4; ++e) { nrm[e] += ((LAS float*)(L + RC_XCH))[((w ^ 1) * 2 + 0) * 16 + 4 * q4 + e]; bon[e] += ((LAS float*)(L + RC_XCH))[((w ^ 1) * 2 + 1) * 16 + 4 * q4 + e];
            nrm[e] = 1.f / fmaxf(sqrtf(nrm[e]), 1e-12f); }
#pragma unroll
        for (int u = 0; u < 2; ++u) { const int c = (2 * jh + u) * 16 + fr, ch = h * 64 + c;
#pragma unroll
            for (int e = 0; e < 4; ++e) { const size_t o = (size_t)(r0 + it * 16 + 4 * q4 + e) * MIX + ch;
                const float kk = kkr[u][e] * nrm[e];
                RR[o] = xr[u][e]; RK[o] = xk[u][e]; RV[o] = xv[u][e]; RKK[o] = kk; RKA[o] = kk * av[u][e]; RWd[o] = __expf(dw[u][e]); RG[o] = ag[u][e]; } }
        if (fr == 0 && jh == 0) {
#pragma unroll
            for (int e = 0; e < 4; ++e) BON[(size_t)(r0 + it * 16 + 4 * q4 + e) * BH + h] = bon[e]; }
    }
    __syncthreads();
}

__device__ __forceinline__ void rwkv_sample_unit(Frame& F, const Args& A, int lane, int j, int b, int h) {
    const float* RWd = (const float*)(F.ws + WS_RW); const float* RKK = (const float*)(F.ws + WS_RKK); const float* RKA = (const float*)(F.ws + WS_RKA);
    const float* RK = (const float*)(F.ws + WS_RK); const float* RR = (const float*)(F.ws + WS_RR); const float* RV = (const float*)(F.ws + WS_RV);
    const float* RG = (const float*)(F.ws + WS_RG); const float* BON = (const float*)(F.ws + WS_BONUS); bf16* MIXC = (bf16*)(F.ws + WS_MIXC);
    const float* lnx_g = A.in[29] + (size_t)j * MIX; const float* lnx_b = A.in[30] + (size_t)j * MIX;
    const size_t row = MP + b; const int chan = h * BHD; const int vr = lane >> 4, kc = lane & 15;
    const size_t vo = row * MIX + chan + 4 * kc;
    const f32x4 w4 = *(const f32x4*)(RWd + vo), kk4 = *(const f32x4*)(RKK + vo), ka4 = *(const f32x4*)(RKA + vo), k4 = *(const f32x4*)(RK + vo), r4 = *(const f32x4*)(RR + vo);
    const float* S0 = A.in[5] + ((size_t)(j * NSMP + b) * BH + h) * (BHD * BHD);
    float* S1 = F.out + O_SRS + ((size_t)(j * NSMP + b) * BH + h) * (BHD * BHD);
    float myo = 0.f, osum = 0.f, osq = 0.f;
#pragma unroll
    for (int vb = 0; vb < 16; ++vb) { const int v = 4 * vb + vr;
        f32x4 S = *(const f32x4*)(S0 + (size_t)v * BHD + 4 * kc);
        float sa = (S.x * kk4.x + S.y * kk4.y) + (S.z * kk4.z + S.w * kk4.w);
#pragma unroll
        for (int m = 1; m < 16; m <<= 1) sa += __shfl_xor(sa, m);
        sa = -sa;
        const float vv = RV[row * MIX + chan + v];
        S = S * w4 + ka4 * sa + k4 * vv;
        *(f32x4*)(S1 + (size_t)v * BHD + 4 * kc) = S;
        float o = (S.x * r4.x + S.y * r4.y) + (S.z * r4.z + S.w * r4.w);
#pragma unroll
        for (int m = 1; m < 16; m <<= 1) o += __shfl_xor(o, m);
        osum += o; osq += o * o;
        myo = (kc == vb) ? o : myo; }
    osum += __shfl_xor(osum, 16); osum += __shfl_xor(osum, 32); osq += __shfl_xor(osq, 16); osq += __shfl_xor(osq, 32);
    const float mean = osum * (1.f / 64.f); const float var = fmaxf(osq * (1.f / 64.f) - mean * mean, 0.f);
    const float rstd = 1.f / sqrtf(var + GN_EPS);
    const int ch = chan + 4 * kc + vr;
    const float on = (myo - mean) * rstd * lnx_g[ch] + lnx_b[ch];
    const float bonus = BON[row * BH + h] * RV[row * MIX + ch];
    MIXC[row * D + ch] = (bf16)f2bf((on + bonus) * RG[row * MIX + ch]);
}


#ifndef PROBE_SUB
#define PROBE_SUB 0
#endif
constexpr int RK_LI = 0, RK_XCH = 46080, RK_TOT = 47104, RK_LD = 51200, RK_WC = 55296, RK_TILE = 55552, TBYTES = 9216;
#define TBUF(p) (L + RK_TILE + (p) * TBYTES)
__device__ __forceinline__ f32x4 mm_tile(ldsp Ab, ldsp Bb, int ia, int jb, int fr, int q4) {
    f32x4 acc = (f32x4){0.f, 0.f, 0.f, 0.f};
#pragma unroll
    for (int ks = 0; ks < 2; ++ks) { const bf16x8 a = *(LAS bf16x8*)(Ab + (ia * 16 + fr) * 144 + ks * 64 + q4 * 16); const bf16x8 b = *(LAS bf16x8*)(Bb + (jb * 16 + fr) * 144 + ks * 64 + q4 * 16); acc = MFMA16(a, b, acc); }
    return acc;
}
__device__ __forceinline__ void st_tileT(ldsp buf, int ia, int jb, int fr, int q4, f32x4 v) { *(LAS v2u*)(buf + (jb * 16 + fr) * 144 + (ia * 16 + 4 * q4) * 2) = pk4(v); }

__device__ __forceinline__ void rwkv_chunk_unit(Frame& F, const Args& A, int j, int b, int cidx, int h_lo, int h_hi) {
    const ldsp L = F.lds; const int tid = fresh_tid(), w = __builtin_amdgcn_readfirstlane(tid >> 6), lane = tid & 63, fr = lane & 15, q4 = lane >> 4;
    const int it = w >> 1, jh = w & 1, grp = it * 4 + q4, i0 = it * 16 + 4 * q4;
    const int r0 = b * SEQ + cidx * 64;
    const bf16* PROJ = (const bf16*)(F.ws + WS_PROJ);
    const float* mu = A.in[20] + (size_t)j * B_MIXC; const float* w0 = A.in[21] + (size_t)j * MIX; const float* a0 = A.in[23] + (size_t)j * MIX;
    const float* k_k = A.in[26] + (size_t)j * MIX; const float* k_a = A.in[27] + (size_t)j * MIX; const float* r_k = A.in[28] + (size_t)j * MIX;
    const float* lnx_b = A.in[30] + (size_t)j * MIX;
    const bf16* LW = (const bf16*)(F.ws + WS_LW) + (size_t)j * MIX * LORA_K;
    __syncthreads();
#pragma unroll 2
    for (int itr = 0; itr < 11; ++itr) { const int idx = itr * NTHR + tid;
        if (idx < 64 * 88) { const int t = idx / 88, c4 = idx - t * 88, col = 4 * c4; const int row = r0 + t; const long prow = rw_prev_row(row);
            const f32x4 P = ld_bf4(PROJ + (size_t)row * LDP + B_LORA_OFF + col), Pp = ld_bf4_prev(PROJ, prow, B_LORA_OFF + col);
            const f32x4 m4 = *(const f32x4*)(mu + 4608 + col);
            f32x4 xs = P + (Pp - P) * m4;
            if (col < 64) { xs.x = ftanh(xs.x); xs.y = ftanh(xs.y); xs.z = ftanh(xs.z); xs.w = ftanh(xs.w); }
            else if (col >= 128) { xs.x = fsigmoid(xs.x); xs.y = fsigmoid(xs.y); xs.z = fsigmoid(xs.z); xs.w = fsigmoid(xs.w); }
            *(LAS v2u*)(L + RK_LI + t * 720 + col * 2) = pk4(xs); } }
    for (int i = tid; i < TBYTES / 16; i += NTHR) *(LAS v4u*)(TBUF(7) + i * 16) = (v4u){0u, 0u, 0u, 0u};
#pragma unroll 1
    for (int h = h_lo; h < h_hi; ++h) {
        unsigned char* rec = F.ws + WS_REC + ((size_t)(b * BH + h) * 32 + cidx) * REC_BYTES;
        LDS_BARRIER();
        { const int row = tid >> 3, c8 = tid & 7;
#pragma unroll
          for (int x = 0; x < 3; ++x) { const v4u val = *(const v4u*)(PROJ + (size_t)(r0 + row) * LDP + x * 1536 + h * 64 + c8 * 8);
              *(LAS v4u*)(TBUF(8 + x) + (row + 1) * 128 + c8 * 16) = val; }
          if (tid < 8) { const long prow = rw_prev_row(r0);
#pragma unroll
              for (int x = 0; x < 3; ++x) { v4u val = (v4u){0u, 0u, 0u, 0u}; if (prow >= 0) val = *(const v4u*)(PROJ + (size_t)prow * LDP + x * 1536 + h * 64 + tid * 8);
                  *(LAS v4u*)(TBUF(8 + x) + tid * 16) = val; } } }
        f32x4 aw[2], aa[2], ag[2];
#pragma unroll
        for (int u = 0; u < 2; ++u) { aw[u] = (f32x4){0.f, 0.f, 0.f, 0.f}; aa[u] = aw[u]; ag[u] = aw[u]; }
        { const bf16* lw0 = LW + (size_t)(h * 64 + (2 * jh) * 16 + fr) * LORA_K + q4 * 8; const ldsp li = L + RK_LI + (it * 16 + fr) * 720 + q4 * 16;
          bf16x8 bfrs[11][2];
#pragma unroll
          for (int ks = 0; ks < 11; ++ks)
#pragma unroll
              for (int u = 0; u < 2; ++u) bfrs[ks][u] = *(const bf16x8*)(lw0 + (size_t)u * 16 * LORA_K + ks * 32);
          __builtin_amdgcn_sched_barrier(0);
#pragma unroll
          for (int ks = 0; ks < 11; ++ks) { const bf16x8 afr = *(LAS bf16x8*)(li + ks * 64);
#pragma unroll
              for (int u = 0; u < 2; ++u) { const bf16x8 bfr = bfrs[ks][u];
                  if (ks < 2) aw[u] = MFMA16(afr, bfr, aw[u]); else if (ks < 4) aa[u] = MFMA16(afr, bfr, aa[u]); else ag[u] = MFMA16(afr, bfr, ag[u]); }
          } }
        LDS_BARRIER();
        float xr[2][4], kp[2][4], xv[2][4], dw[2][4], av[2][4], kkr[2][4];
        float nrm[4] = {0.f, 0.f, 0.f, 0.f}, bon[4] = {0.f, 0.f, 0.f, 0.f};
#pragma unroll
        for (int u = 0; u < 2; ++u) { const int c = (2 * jh + u) * 16 + fr, ch = h * 64 + c;
            const float mur = mu[ch], muk = mu[1536 + ch], muv = mu[3072 + ch], w0c = w0[ch], a0c = a0[ch], kkc = k_k[ch], kac = k_a[ch], rkc = r_k[ch];
            float run = 0.f;
#pragma unroll
            for (int e = 0; e < 4; ++e) { const int t = i0 + e;
                const float cr = bf2f(*(LAS unsigned short*)(TBUF(8) + (t + 1) * 128 + c * 2)), ck = bf2f(*(LAS unsigned short*)(TBUF(9) + (t + 1) * 128 + c * 2)), cv = bf2f(*(LAS unsigned short*)(TBUF(10) + (t + 1) * 128 + c * 2));
                const float pr = bf2f(*(LAS unsigned short*)(TBUF(8) + t * 128 + c * 2)), pk = bf2f(*(LAS unsigned short*)(TBUF(9) + t * 128 + c * 2)), pv = bf2f(*(LAS unsigned short*)(TBUF(10) + t * 128 + c * 2));
                const float r_ = cr + (pr - cr) * mur, k_ = ck + (pk - ck) * muk, v_ = cv + (pv - cv) * muv;
                const float x = -(w0c + aw[u][e]);
                const float sp = fmaxf(x, 0.f) + __logf(1.f + __expf(-fabsf(x)));
                const float lw = -__expf(-sp - 0.5f);
                run += lw; dw[u][e] = lw;
                const float a = fsigmoid(a0c + aa[u][e]);
                const float kr_ = k_ * kkc, kp_ = k_ * (1.f + (a - 1.f) * kac);
                xr[u][e] = r_; kp[u][e] = kp_; xv[u][e] = v_; av[u][e] = a; kkr[u][e] = kr_;
                nrm[e] += kr_ * kr_; bon[e] += r_ * kp_ * rkc; }
            ((LAS float*)(L + RK_TOT))[grp * 64 + c] = run; __builtin_amdgcn_sched_barrier(0); }
#pragma unroll
        for (int e = 0; e < 4; ++e) {
#pragma unroll
            for (int m = 1; m < 16; m <<= 1) { nrm[e] += __shfl_xor(nrm[e], m); bon[e] += __shfl_xor(bon[e], m); } }
        if (fr == 0) {
#pragma unroll
            for (int e = 0; e < 4; ++e) { ((LAS float*)(L + RK_XCH))[(w * 2 + 0) * 16 + 4 * q4 + e] = nrm[e]; ((LAS float*)(L + RK_XCH))[(w * 2 + 1) * 16 + 4 * q4 + e] = bon[e]; } }
        LDS_BARRIER();
#pragma unroll
        for (int e = 0; e < 4; ++e) { nrm[e] += ((LAS float*)(L + RK_XCH))[((w ^ 1) * 2 + 0) * 16 + 4 * q4 + e]; bon[e] += ((LAS float*)(L + RK_XCH))[((w ^ 1) * 2 + 1) * 16 + 4 * q4 + e];
            nrm[e] = 1.f / fmaxf(sqrtf(nrm[e]), 1e-12f); }
        f32x4 gbar[2];
#pragma unroll
        for (int u = 0; u < 2; ++u) { const int jt = 2 * jh + u, c = jt * 16 + fr, ch = h * 64 + c;
            float off = 0.f, tot = 0.f;
#pragma unroll
            for (int gp = 0; gp < 16; ++gp) { const float tv = ((LAS float*)(L + RK_TOT))[gp * 64 + c]; tot += tv; off += (gp < grp) ? tv : 0.f; }
            const float lnb = lnx_b[ch];
            f32x4 al, bb, vv4, gv, bv; float cum = off;
#pragma unroll
            for (int e = 0; e < 4; ++e) { const int t = i0 + e;
                cum += dw[u][e];
                const float eW = __expf(cum), eWm = __expf(cum - dw[u][e]), eInv = __expf(-cum), eBar = __expf(tot - cum);
                const float kk = kkr[u][e] * nrm[e], bq = kk * av[u][e];
                const float alpha = kk * eWm, rho = xr[u][e] * eW, beta = bq * eInv, gamma = kp[u][e] * eInv;
                *(LAS unsigned short*)(TBUF(0) + t * 144 + c * 2) = (unsigned short)f2bf(alpha);
                *(LAS unsigned short*)(TBUF(1) + t * 144 + c * 2) = (unsigned short)f2bf(beta);
                *(LAS unsigned short*)(TBUF(2) + t * 144 + c * 2) = (unsigned short)f2bf(gamma);
                *(LAS unsigned short*)(TBUF(3) + t * 144 + c * 2) = (unsigned short)f2bf(rho);
                al[e] = alpha; bb[e] = bq * eBar; gbar[u][e] = kp[u][e] * eBar; vv4[e] = xv[u][e];
                gv[e] = ag[u][e]; bv[e] = (lnb + bon[e] * xv[u][e]) * ag[u][e]; }
            *(LAS v2u*)(TBUF(4) + c * 144 + i0 * 2) = pk4(al);
            *(LAS v2u*)(TBUF(5) + c * 144 + i0 * 2) = pk4(bb);
            *(LAS v2u*)(TBUF(6) + c * 144 + i0 * 2) = pk4(vv4);
            if (grp == 0) ((LAS float*)(L + RK_WC))[c] = __expf(tot);
            const int ti = it * 4 + jt;
            *(v2u*)(rec + 4 * 8192 + (size_t)(ti * 64 + lane) * 8) = pk4(gv);
            *(v2u*)(rec + 5 * 8192 + (size_t)(ti * 64 + lane) * 8) = pk4(bv);
            __builtin_amdgcn_sched_barrier(0); }
        LDS_BARRIER();
        f32x4 n2r[2], etr[2], e2tr[2];
        { int tl_ = lane; asm volatile("" : "+v"(tl_)); const int fr = tl_ & 15, q4 = tl_ >> 4, i0 = it * 16 + 4 * q4; (void)i0;
        { bf16x8 aB[2], aA[2], aG[2];
#pragma unroll
          for (int ks = 0; ks < 2; ++ks) { const int o = (it * 16 + fr) * 144 + ks * 64 + q4 * 16; aA[ks] = *(LAS bf16x8*)(TBUF(0) + o); aB[ks] = *(LAS bf16x8*)(TBUF(1) + o); aG[ks] = *(LAS bf16x8*)(TBUF(2) + o); }
#pragma unroll
          for (int u = 0; u < 2; ++u) { const int jt = 2 * jh + u, jx = jt * 16 + fr;
              f32x4 m1 = (f32x4){0.f, 0.f, 0.f, 0.f}, m2 = m1, n1 = m1, n2 = m1;
#pragma unroll
              for (int ks = 0; ks < 2; ++ks) { const int o = (jt * 16 + fr) * 144 + ks * 64 + q4 * 16;
                  const bf16x8 bA = *(LAS bf16x8*)(TBUF(0) + o), bG = *(LAS bf16x8*)(TBUF(2) + o), bR = *(LAS bf16x8*)(TBUF(3) + o);
                  m1 = MFMA16(aB[ks], bA, m1); m2 = MFMA16(aA[ks], bG, m2); n1 = MFMA16(aB[ks], bR, n1); n2 = MFMA16(aG[ks], bR, n2); }
#pragma unroll
              for (int r = 0; r < 4; ++r) { const int ix = i0 + r; m1[r] = (ix < jx) ? m1[r] : 0.f; m2[r] = (jx < ix) ? m2[r] : 0.f; n1[r] = (ix <= jx) ? n1[r] : 0.f; n2[r] = (ix <= jx) ? n2[r] : 0.f; }
              if (it == jt) {
#pragma unroll
                  for (int r = 0; r < 4; ++r) ((LAS float*)(L + RK_LD))[(it * 16 + 4 * q4 + r) * 16 + fr] = m1[r];
                  m1 = (f32x4){0.f, 0.f, 0.f, 0.f}; }
              st_tileT(TBUF(8), it, jt, fr, q4, m1); st_tileT(TBUF(9), it, jt, fr, q4, m2); st_tileT(TBUF(10), it, jt, fr, q4, n1);
              n2r[u] = n2; } }
        LDS_BARRIER();
        for (int idx = tid; idx < 576; idx += NTHR) { const int row = idx / 9, chn = idx - row * 9; if ((chn >> 1) != (row >> 4)) *(LAS v4u*)(TBUF(2) + row * 144 + chn * 16) = (v4u){0u, 0u, 0u, 0u}; }
        if (w == 0) { const int bI = lane >> 4, cc = lane & 15; const LAS float* Ld = (const LAS float*)(L + RK_LD) + bI * 256;
            float x[16];
#pragma unroll
            for (int s = 15; s >= 0; --s) { float acc = (s == cc) ? 1.f : 0.f;
#pragma unroll
                for (int m = s + 1; m < 16; ++m) acc -= Ld[s * 16 + m] * x[m];
                x[s] = acc; __builtin_amdgcn_sched_barrier(0); }
            v4u o0, o1; o0.x = pk2(x[0], x[1]); o0.y = pk2(x[2], x[3]); o0.z = pk2(x[4], x[5]); o0.w = pk2(x[6], x[7]); o1.x = pk2(x[8], x[9]); o1.y = pk2(x[10], x[11]); o1.z = pk2(x[12], x[13]); o1.w = pk2(x[14], x[15]);
            *(LAS v4u*)(TBUF(7) + (bI * 16 + cc) * 144 + bI * 32) = o0; *(LAS v4u*)(TBUF(7) + (bI * 16 + cc) * 144 + bI * 32 + 16) = o1;
#pragma unroll
            for (int s = 0; s < 16; ++s) *(LAS unsigned short*)(TBUF(2) + (bI * 16 + s) * 144 + (bI * 16 + cc) * 2) = (unsigned short)f2bf(x[s]); }
        LDS_BARRIER();
        }
        { int tl_ = lane; asm volatile("" : "+v"(tl_)); const int fr = tl_ & 15, q4 = tl_ >> 4, i0 = it * 16 + 4 * q4; (void)i0;
#pragma unroll
        for (int u = 0; u < 2; ++u) { const int jt = 2 * jh + u;
            const f32x4 e1 = mm_tile(TBUF(2), TBUF(8), it, jt, fr, q4); st_tileT(TBUF(0), it, jt, fr, q4, e1);
            const f32x4 e2 = mm_tile(TBUF(8), TBUF(2), it, jt, fr, q4); st_tileT(TBUF(1), it, jt, fr, q4, e2); etr[u] = e2; }
        LDS_BARRIER();
#pragma unroll
        for (int u = 0; u < 2; ++u) { const int jt = 2 * jh + u; e2tr[u] = mm_tile(TBUF(0), TBUF(1), it, jt, fr, q4); st_tileT(TBUF(2), it, jt, fr, q4, e2tr[u]); }
        LDS_BARRIER();
#pragma unroll
        for (int u = 0; u < 2; ++u) { const int jt = 2 * jh + u; const f32x4 e3 = mm_tile(TBUF(0), TBUF(2), it, jt, fr, q4);
            f32x4 f = e2tr[u] - etr[u] - e3;
            if (it == jt) {
#pragma unroll
                for (int r = 0; r < 4; ++r) f[r] += (4 * q4 + r == fr) ? 1.f : 0.f; }
            st_tileT(TBUF(8), it, jt, fr, q4, f); }
        LDS_BARRIER();
#pragma unroll
        for (int u = 0; u < 2; ++u) { const int jt = 2 * jh + u; st_tileT(TBUF(2), it, jt, fr, q4, mm_tile(TBUF(8), TBUF(7), it, jt, fr, q4)); }
        LDS_BARRIER();
        }
        { int tl_ = lane; asm volatile("" : "+v"(tl_)); const int fr = tl_ & 15, q4 = tl_ >> 4, i0 = it * 16 + 4 * q4; (void)i0;
#pragma unroll
        for (int u = 0; u < 2; ++u) { const int jt = 2 * jh + u;
            st_tileT(TBUF(0), it, jt, fr, q4, mm_tile(TBUF(2), TBUF(4), it, jt, fr, q4));
            st_tileT(TBUF(1), it, jt, fr, q4, mm_tile(TBUF(2), TBUF(9), it, jt, fr, q4)); }
        LDS_BARRIER();
#pragma unroll
        for (int u = 0; u < 2; ++u) { const int jt = 2 * jh + u;
            const f32x4 g1n = mm_tile(TBUF(0), TBUF(10), it, jt, fr, q4), g2n = mm_tile(TBUF(1), TBUF(10), it, jt, fr, q4);
            const f32x4 g1b = mm_tile(TBUF(0), TBUF(5), it, jt, fr, q4), g2b = mm_tile(TBUF(1), TBUF(5), it, jt, fr, q4);
            const f32x4 rterm = bf4(*(LAS v2u*)(TBUF(3) + (jt * 16 + fr) * 144 + i0 * 2));
            f32x4 q1 = -g1b;
            if (it == jt) { const float wc = ((LAS float*)(L + RK_WC))[jt * 16 + fr];
#pragma unroll
                for (int r = 0; r < 4; ++r) q1[r] += (4 * q4 + r == fr) ? wc : 0.f; }
            st_tileT(TBUF(8), it, jt, fr, q4, rterm - g1n);
            st_tileT(TBUF(9), it, jt, fr, q4, q1);
            st_tileT(TBUF(2), it, jt, fr, q4, n2r[u] - g2n);
            st_tileT(TBUF(4), it, jt, fr, q4, gbar[u] - g2b); }
        LDS_BARRIER();
#pragma unroll
        for (int u = 0; u < 2; ++u) { const int jt = 2 * jh + u, ti = it * 4 + jt;
            *(v2u*)(rec + 2 * 8192 + (size_t)(ti * 64 + lane) * 8) = pk4(mm_tile(TBUF(4), TBUF(6), it, jt, fr, q4));
            *(v2u*)(rec + 3 * 8192 + (size_t)(ti * 64 + lane) * 8) = pk4(mm_tile(TBUF(2), TBUF(6), it, jt, fr, q4)); }
        { const int row = tid >> 3, c8 = tid & 7;
          *(v4u*)(rec + row * 128 + c8 * 16) = *(LAS v4u*)(TBUF(8) + row * 144 + c8 * 16);
          *(v4u*)(rec + 8192 + row * 128 + c8 * 16) = *(LAS v4u*)(TBUF(9) + row * 144 + c8 * 16); }
        }
    }
    __syncthreads();
}

constexpr int CH_S = 0, CH_Q = 9216;
__device__ __forceinline__ void rwkv_chain_unit(Frame& F, int b, int h, float* state_out) {
    const ldsp L = F.lds; const int tid = fresh_tid(), w = __builtin_amdgcn_readfirstlane(tid >> 6), lane = tid & 63, fr = lane & 15, q4 = lane >> 4;
    const int it = w >> 1, jh = w & 1;
    unsigned char* recb = F.ws + WS_REC + ((size_t)(b * BH + h) * 32) * REC_BYTES;
    const int row = tid >> 3, c8 = tid & 7;
    const size_t qoff = 8192 + row * 128 + c8 * 16, uoff0 = 2 * 8192 + (size_t)((it * 4 + 2 * jh) * 64 + lane) * 8, uoff1 = uoff0 + 512, soff = 6 * 8192 + row * 128 + c8 * 16;
    __syncthreads();
    for (int i = tid; i < TBYTES / 16; i += NTHR) *(LAS v4u*)(L + CH_S + i * 16) = (v4u){0u, 0u, 0u, 0u};
    v4u qreg[4]; v2u ureg[4][2];
#pragma unroll
    for (int i = 0; i < 3; ++i) { const unsigned char* rc = recb + (size_t)i * REC_BYTES; qreg[i] = *(const v4u*)(rc + qoff); ureg[i][0] = *(const v2u*)(rc + uoff0); ureg[i][1] = *(const v2u*)(rc + uoff1); }
    f32x4 acc[2];
#pragma unroll 1
    for (int cc = 0; cc < 8; ++cc) {
#pragma unroll
        for (int i = 0; i < 4; ++i) { const int c = 4 * cc + i;
            unsigned char* rec = recb + (size_t)c * REC_BYTES;
            *(LAS v4u*)(L + CH_Q + row * 144 + c8 * 16) = qreg[i];
            const f32x4 uu0 = bf4(ureg[i][0]), uu1 = bf4(ureg[i][1]);
            if (c + 3 < 32) { const unsigned char* rn = rec + 3 * REC_BYTES; const int s3 = (i + 3) & 3;
                qreg[s3] = *(const v4u*)(rn + qoff); ureg[s3][0] = *(const v2u*)(rn + uoff0); ureg[s3][1] = *(const v2u*)(rn + uoff1); }
            LDS_BARRIER();
            *(v4u*)(rec + soff) = *(LAS v4u*)(L + CH_S + row * 144 + c8 * 16);
            acc[0] = uu0 + mm_tile(L + CH_Q, L + CH_S, it, 2 * jh, fr, q4);
            acc[1] = uu1 + mm_tile(L + CH_Q, L + CH_S, it, 2 * jh + 1, fr, q4);
            LDS_BARRIER();
            st_tileT(L + CH_S, it, 2 * jh, fr, q4, acc[0]); st_tileT(L + CH_S, it, 2 * jh + 1, fr, q4, acc[1]); }
    }
#pragma unroll
    for (int u = 0; u < 2; ++u) *(f32x4*)(state_out + (size_t)((2 * jh + u) * 16 + fr) * BHD + it * 16 + 4 * q4) = acc[u];
    __syncthreads();
}

constexpr int RO_STG = 0, RO_LD = 1552;
__device__ __forceinline__ void rwkv_out_unit(Frame& F, const Args& A, int j, int b, int cidx, int h_lo) {
    const ldsp L = F.lds; const int tid = fresh_tid(), w = __builtin_amdgcn_readfirstlane(tid >> 6), lane = tid & 63, fr = lane & 15, q4 = lane >> 4;
    const int it = w & 3, hsel = w >> 2;
    const float* lnx_g = A.in[29] + (size_t)j * MIX;
    bf16* MIXC = (bf16*)(F.ws + WS_MIXC);
    const int r0 = b * SEQ + cidx * 64;
    __syncthreads();
#pragma unroll 1
    for (int hp = 0; hp < 6; ++hp) { const int hl = 2 * hp + hsel, h = h_lo + hl;
        const unsigned char* rec = F.ws + WS_REC + ((size_t)(b * BH + h) * 32 + cidx) * REC_BYTES;
        bf16x8 pa[2];
#pragma unroll
        for (int ks = 0; ks < 2; ++ks) pa[ks] = *(const bf16x8*)(rec + (it * 16 + fr) * 128 + ks * 64 + q4 * 16);
        f32x4 o[4]; float s1[4] = {0.f, 0.f, 0.f, 0.f}, s2[4] = {0.f, 0.f, 0.f, 0.f};
#pragma unroll
        for (int jt = 0; jt < 4; ++jt) { f32x4 acc = bf4(*(const v2u*)(rec + 3 * 8192 + (size_t)((it * 4 + jt) * 64 + lane) * 8));
#pragma unroll
            for (int ks = 0; ks < 2; ++ks) { const bf16x8 sb = *(const bf16x8*)(rec + 6 * 8192 + (jt * 16 + fr) * 128 + ks * 64 + q4 * 16); acc = MFMA16(pa[ks], sb, acc); }
            o[jt] = acc;
#pragma unroll
            for (int r = 0; r < 4; ++r) { s1[r] += acc[r]; s2[r] += acc[r] * acc[r]; } }
#pragma unroll
        for (int r = 0; r < 4; ++r) {
#pragma unroll
            for (int m = 1; m < 16; m <<= 1) { s1[r] += __shfl_xor(s1[r], m); s2[r] += __shfl_xor(s2[r], m); } }
        float mean[4], rstd[4];
#pragma unroll
        for (int r = 0; r < 4; ++r) { mean[r] = s1[r] * (1.f / 64.f); const float var = fmaxf(s2[r] * (1.f / 64.f) - mean[r] * mean[r], 0.f); rstd[r] = 1.f / sqrtf(var + GN_EPS); }
#pragma unroll
        for (int jt = 0; jt < 4; ++jt) { const int vch = jt * 16 + fr; const float lg = lnx_g[h * 64 + vch];
            const f32x4 gv = bf4(*(const v2u*)(rec + 4 * 8192 + (size_t)((it * 4 + jt) * 64 + lane) * 8)), bv = bf4(*(const v2u*)(rec + 5 * 8192 + (size_t)((it * 4 + jt) * 64 + lane) * 8));
#pragma unroll
            for (int r = 0; r < 4; ++r) { const float val = (o[jt][r] - mean[r]) * rstd[r] * lg * gv[r] + bv[r];
                *(LAS unsigned short*)(L + RO_STG + (it * 16 + 4 * q4 + r) * RO_LD + (hl * 64 + vch) * 2) = (unsigned short)f2bf(val); } }
    }
    __syncthreads();
    for (int i = tid; i < 64 * 96; i += NTHR) { const int t = i / 96, c16 = i - t * 96;
        *(v4u*)(MIXC + (size_t)(r0 + t) * D + h_lo * 64 + c16 * 8) = *(LAS v4u*)(L + RO_STG + t * RO_LD + c16 * 16); }
    __syncthreads();
}


constexpr int PH_PER_PAIR = 12, N_PHASES = 1 + 2 * PH_PER_PAIR + 1;
#ifndef MK_N_LAUNCHES
#define MK_N_LAUNCHES 1


#endif
#ifndef PROBE_K
#define PROBE_K 0
#endif
#ifndef PROBE_P0
#define PROBE_P0 0
#endif
#ifndef PROBE_SUB
#define PROBE_SUB 0
#endif

__global__ void __launch_bounds__(NTHR, 2) fwd_kernel(Args args) {
    extern __shared__ __attribute__((aligned(16))) unsigned char lds_raw[];
    Frame F;
    F.lds = (ldsp)lds_raw;
    F.tid = threadIdx.x; F.lane = F.tid & 63; F.wave = __builtin_amdgcn_readfirstlane(F.tid >> 6);
    F.G = gridDim.x; { const int bx = blockIdx.x; F.vcu = (F.G % 8 == 0) ? (bx % 8) * (F.G / 8) + bx / 8 : bx; }
    F.ws = args.ws; F.out = args.out;
    volatile LAS unsigned* MISC = (volatile LAS unsigned*)(F.lds + MISC_OFF);
    for (int u = F.tid; u < (LDS_BYTES - LDSCTL_OFF) / 4; u += NTHR) ((LAS unsigned*)(F.lds + LDSCTL_OFF))[u] = 0u;
    __syncthreads();
    const int lo = args.ph_lo, hi = args.ph_hi;
    const bool multi = (hi - lo) > 1;
    XcdBarrier bar; bar.bar = (unsigned*)(F.ws + WS_CTL) + CW_BAR; bar.x = 0; bar.st = nullptr;
    if (multi) bar = xcd_barrier_post((unsigned*)(F.ws + WS_CTL) + CW_BAR, MISC + 8);
#define IN(k) (lo <= (k) && (k) < hi)
#define SEAM(k) do { if (IN((k) + 1)) xcd_barrier(bar); } while (0)

    bf16* const H = (bf16*)(F.ws + WS_H); bf16* const PROJ = (bf16*)(F.ws + WS_PROJ); bf16* const MIXC = (bf16*)(F.ws + WS_MIXC); bf16* const ACT = (bf16*)(F.ws + WS_ACT);
    float* const X = (float*)(F.ws + WS_X); const float* const Xs = X + (size_t)MP * D;
    const int blk = blockIdx.x;

#define PH(k, ...) if (IN(base + (k))) { __VA_ARGS__ if constexpr (((PROBE_K) >> (k)) & 1) { __VA_ARGS__ } SEAM(base + (k)); }
    if (IN(0)) { p0_prologue(F, args); if constexpr (PROBE_P0) { p0_prologue(F, args); } SEAM(0); }

    for (int j = 0; j < 2; ++j) {
        const int base = 1 + j * PH_PER_PAIR;
        const int la = 2 * j, lb = 2 * j + 1;
        const bf16* const WinA = (const bf16*)(F.ws + WS_WINA + (size_t)j * SZ_WINA); const bf16* const WoutA = (const bf16*)(F.ws + WS_WOUTA + (size_t)j * SZ_WSQ);
        const bf16* const WinB = (const bf16*)(F.ws + WS_WINB + (size_t)j * SZ_WINB); const bf16* const WoutB = (const bf16*)(F.ws + WS_WOUTB + (size_t)j * SZ_WSQ);
        PH(0,
            { unsigned* sflag = (unsigned*)(F.ws + WS_CTL) + CW_SFLAG + 64 * la;
              if (blk >= 256 - SN_BLOCKS) { const int ftw = fresh_tid(); sample_rows_prepare(F, nullptr, nullptr, ss_slot(F.ws, 2 * la), sflag, (blk - (256 - SN_BLOCKS)) * NWAVES + __builtin_amdgcn_readfirstlane(ftw >> 6)); }
              run_gemm_sample(F, H, WinA, A_IN, D, EpiBf<0>{PROJ, LDP, ss_slot(F.ws, 2 * la)}, sflag); }
            if (j == 0) run_gemm(F, (const bf16*)(F.ws + WS_MEMN), (const bf16*)(F.ws + WS_WKV), 1024, 4096, D, EpiMemKV{F.out}, 128);
        )
        PH(1,
            { const float* Kp = F.out + O_MK + (size_t)la * (1024 * 512); const float* Vp = F.out + O_MV + (size_t)la * (1024 * 512);
            if (blk < 96) { const int bh = blk < 48 ? blk : blk - 48, b = bh / AH, h = bh % AH;
                hgrn_prompt_unit(F, PROJ, MIXC, args.in[16], args.in[17] + (size_t)j * MIX, F.out + O_SHP + ((size_t)(j * NB + b) * AH + h) * (AHD * AHD), j, b, h, blk < 48 ? HG_SPLIT : 0, blk < 48 ? SEQ / 64 : HG_SPLIT);
                if (PROBE_SUB == 10) hgrn_prompt_unit(F, PROJ, MIXC, args.in[16], args.in[17] + (size_t)j * MIX, F.out + O_SHP + ((size_t)(j * NB + b) * AH + h) * (AHD * AHD), j, b, h, blk < 48 ? HG_SPLIT : 0, blk < 48 ? SEQ / 64 : HG_SPLIT); }
            else { if (blk < 224) { const int u = blk - 96, b = u >> 5, head = (u >> 3) & 3, qp = u & 7;
                    xattn_prompt_unit(F, PROJ, A_XQ_OFF, MIXC, Kp + (size_t)b * NMEM * XDIM, Vp + (size_t)b * NMEM * XDIM, b, head, qp); }
                const int nw = (F.G - 96) * NWAVES; const int ft = fresh_tid(); F.lane = ft & 63; F.wave = __builtin_amdgcn_readfirstlane(ft >> 6);
                const int prio = blk >= 224 ? blk - 224 : blk - 96 + 32;
                for (int rep14 = 0; rep14 < (PROBE_SUB == 14 ? 2 : 1); ++rep14)
                for (int u = prio * NWAVES + F.wave; u < NSMP * AH + NSMP * XH; u += nw) {
                    if (u < NSMP * AH) { const int b = u / AH, h = u % AH;
                        hgrn_sample_unit(F.lane, PROJ, MIXC, args.in[16], args.in[17] + (size_t)j * MIX, args.in[4] + ((size_t)(j * NSMP + b) * AH + h) * (AHD * AHD),
                                         F.out + O_SHS + ((size_t)(j * NSMP + b) * AH + h) * (AHD * AHD), j, b, h); }
                    else { const int q = u - NSMP * AH, b = q >> 2, head = q & 3;
                        xattn_sample_unit(F.lane, PROJ, A_XQ_OFF, MIXC, args.in[2] + ((size_t)(la * NSMP + b) * NMEM) * XDIM, args.in[3] + ((size_t)(la * NSMP + b) * NMEM) * XDIM, b, head); } } }
            { __syncthreads();
                convert_items_dyn(F, args, args.git[2 + 2 * j], args.git[3 + 2 * j], (unsigned*)(F.ws + WS_CTL) + CW_CQ + 512 * j + 64 * (blk & 7), blk & 7); __syncthreads(); } }
        )
        if (IN(base + 2)) { run_gemm(F, MIXC, WoutA, MP, D, D, EpiResid<false>{X, D, H, ss_slot(F.ws, 2 * la + 1), nullptr}, 0);
              skinny_gemm<0, 2>(F, MIXC + (size_t)MP * D, D, nullptr, WoutA, D, 64 * (blk & 31), (blk >> 5) & 1, 512 * (blk >> 6), 512, X, D, MP); SEAM(base + 2); }
        if (PROBE_SUB == 12 && IN(base + 3)) { run_gemm(F, H, WoutA, MP, D, D, EpiDummy{(float*)PROJ, D}, 0); }
        if (PROBE_SUB == 13 && IN(base + 3)) { run_gemm(F, H, (const bf16*)(F.ws + WS_W1 + (size_t)la * SZ_WFF), MP, 4096, D, EpiDummy{(float*)PROJ, 4096}, 0); }
        PH(3, if (blk & 1) skinny_gemm<1, 1>(F, Xs, D, nullptr, (const bf16*)(F.ws + WS_W1 + (size_t)la * SZ_WFF), D, 64 * (blk >> 1), blk & 1, 0, D, ACT, DFF, MP);
              run_gemm(F, H, (const bf16*)(F.ws + WS_W1 + (size_t)la * SZ_WFF), MP, DFF, D, EpiBf<2>{ACT, DFF, nullptr}, 0);
              if (!(blk & 1)) skinny_gemm<1, 1>(F, Xs, D, nullptr, (const bf16*)(F.ws + WS_W1 + (size_t)la * SZ_WFF), D, 64 * (blk >> 1), blk & 1, 0, D, ACT, DFF, MP);
              if (PROBE_SUB == 5) skinny_gemm<1, 1>(F, Xs, D, nullptr, (const bf16*)(F.ws + WS_W1 + (size_t)la * SZ_WFF), D, 64 * (blk >> 1), blk & 1, 0, D, ACT, DFF, MP); )
        if (IN(base + 4)) { if (PROBE_SUB == 9) run_gemm(F, ACT, (const bf16*)(F.ws + WS_W2 + (size_t)la * SZ_WFF), MP, D, DFF, EpiDummy{(float*)PROJ, D}, 0);
              run_gemm(F, ACT, (const bf16*)(F.ws + WS_W2 + (size_t)la * SZ_WFF), MP, D, DFF, EpiResid<true>{X, D, H, ss_slot(F.ws, 2 * lb), ss_slot(F.ws, 2 * la + 1)}, 0);
              skinny_gemm<0, 2>(F, ACT + (size_t)MP * DFF, DFF, nullptr, (const bf16*)(F.ws + WS_W2 + (size_t)la * SZ_WFF), DFF, 64 * (blk & 31), (blk >> 5) & 1, 2048 * (blk >> 6), 2048, X, D, MP); SEAM(base + 4); }
        PH(5, { unsigned* sflag = (unsigned*)(F.ws + WS_CTL) + CW_SFLAG + 64 * lb;
              if (blk >= 256 - SN_BLOCKS) { const int ftw = fresh_tid(); sample_rows_prepare(F, args.in[6] + (size_t)j * NSMP * D, args.in[8] + (size_t)lb * D, ss_slot(F.ws, 2 * lb), sflag, (blk - (256 - SN_BLOCKS)) * NWAVES + __builtin_amdgcn_readfirstlane(ftw >> 6)); }
              run_gemm_sample_early(F, H, WinB, B_INP, D, EpiBf<0>{PROJ, LDP, ss_slot(F.ws, 2 * lb)}, sflag, (unsigned*)(F.ws + WS_CTL) + CW_PDONE + 64 * j); }
              if (blk >= 192) {
                  const int ft = fresh_tid(); const int ln = ft & 63, gwv = (blk - 192) * NWAVES + __builtin_amdgcn_readfirstlane(ft >> 6);
                  for (int r = gwv; r < NB + NSMP; r += 64 * NWAVES) { const int row = r < NB ? r * SEQ + SEQ - 1 : MP + (r - NB);
                      float* dst = r < NB ? F.out + O_SSP + (size_t)(j * NB + r) * D : F.out + O_SSS + (size_t)(j * NSMP + (r - NB)) * D;
                      norm_row(X + (size_t)row * D, args.in[8] + (size_t)lb * D, ln, nullptr, dst, nullptr, nullptr); } }
              if (blk >= 214) { wait_counter((const unsigned*)(F.ws + WS_CTL) + CW_PDONE + 64 * j, B_INP / 256);
                  const int idx = blk - 214, h0 = idx < 36 ? idx : 36 + 2 * (idx - 36), nh = idx < 36 ? 1 : 2;
                  rwkv_prep_unit(F, args, j, (128 + h0 / 24) * 64, h0 % 24, h0 % 24 + nh); } )
        PH(6,
            rwkv_chunk_unit(F, args, j, blk >> 6, (blk >> 1) & 31, (blk & 1) * 12, (blk & 1) * 12 + 12);
        )
        PH(7,
            { const float* Kp = F.out + O_MK + (size_t)lb * (1024 * 512); const float* Vp = F.out + O_MV + (size_t)lb * (1024 * 512);
            if (blk < 96) { const int b = blk / BH, h = blk % BH; rwkv_chain_unit(F, b, h, F.out + O_SRP + ((size_t)(j * NB + b) * BH + h) * (BHD * BHD));
                if (PROBE_SUB == 7) rwkv_chain_unit(F, b, h, F.out + O_SRP + ((size_t)(j * NB + b) * BH + h) * (BHD * BHD)); }
            else if (blk < 224) { const int u = blk - 96, b = u >> 5, head = (u >> 3) & 3, qp = u & 7;
                    xattn_prompt_unit(F, PROJ, B_XQ_OFF, MIXC, Kp + (size_t)b * NMEM * XDIM, Vp + (size_t)b * NMEM * XDIM, b, head, qp);
                    if (PROBE_SUB == 17) xattn_prompt_unit(F, PROJ, B_XQ_OFF, MIXC, Kp + (size_t)b * NMEM * XDIM, Vp + (size_t)b * NMEM * XDIM, b, head, qp); }
            __syncthreads();
            xattn_sample_pair(F, PROJ, B_XQ_OFF, MIXC, args.in[2] + (size_t)lb * NSMP * NMEM * XDIM, args.in[3] + (size_t)lb * NSMP * NMEM * XDIM, 2 * blk);
            { const int nw = F.G * NWAVES; const int ft = fresh_tid(); F.lane = ft & 63; F.wave = __builtin_amdgcn_readfirstlane(ft >> 6);
              const int prio = blk >= 224 ? blk - 224 : (blk >= 96 ? blk - 96 + 128 : blk + 32);
              for (int u = prio * NWAVES + F.wave; u < NSMP * BH; u += nw) rwkv_sample_unit(F, args, F.lane, j, u / BH, u % BH); } }
        )
        PH(8, rwkv_out_unit(F, args, j, blk >> 6, (blk >> 1) & 31, (blk & 1) * 12); )
        if (IN(base + 9)) { run_gemm(F, MIXC, WoutB, MP, D, D, EpiResid<false>{X, D, H, ss_slot(F.ws, 2 * lb + 1), nullptr}, 0);
               skinny_gemm<0, 2>(F, MIXC + (size_t)MP * D, D, nullptr, WoutB, D, 64 * (blk & 31), (blk >> 5) & 1, 512 * (blk >> 6), 512, X, D, MP); SEAM(base + 9); }
        PH(10, if (blk & 1) skinny_gemm<1, 1>(F, Xs, D, nullptr, (const bf16*)(F.ws + WS_W1 + (size_t)lb * SZ_WFF), D, 64 * (blk >> 1), blk & 1, 0, D, ACT, DFF, MP);
              run_gemm(F, H, (const bf16*)(F.ws + WS_W1 + (size_t)lb * SZ_WFF), MP, DFF, D, EpiBf<2>{ACT, DFF, nullptr}, 0);
              if (!(blk & 1)) skinny_gemm<1, 1>(F, Xs, D, nullptr, (const bf16*)(F.ws + WS_W1 + (size_t)lb * SZ_WFF), D, 64 * (blk >> 1), blk & 1, 0, D, ACT, DFF, MP);
               if (PROBE_SUB == 5) skinny_gemm<1, 1>(F, Xs, D, nullptr, (const bf16*)(F.ws + WS_W1 + (size_t)lb * SZ_WFF), D, 64 * (blk >> 1), blk & 1, 0, D, ACT, DFF, MP); )
        if (IN(base + 11)) { if (PROBE_SUB == 9) run_gemm(F, ACT, (const bf16*)(F.ws + WS_W2 + (size_t)lb * SZ_WFF), MP, D, DFF, EpiDummy{(float*)PROJ, D}, 0);
              run_gemm(F, ACT, (const bf16*)(F.ws + WS_W2 + (size_t)lb * SZ_WFF), MP, D, DFF, EpiResid<true>{X, D, H, ss_slot(F.ws, 2 * lb + 2), ss_slot(F.ws, 2 * lb + 1)}, 0);
               skinny_gemm<0, 2>(F, ACT + (size_t)MP * DFF, DFF, nullptr, (const bf16*)(F.ws + WS_W2 + (size_t)lb * SZ_WFF), DFF, 64 * (blk & 31), (blk >> 5) & 1, 2048 * (blk >> 6), 2048, X, D, MP); SEAM(base + 11); }
    }
    if (IN(N_PHASES - 1)) { norm_phase(F, args, args.in[10], false, true, -1); }
#undef PH
#undef IN
#undef SEAM
}

static int add_job(Job* jobs, int& n, int& items, const float* src, bf16* dst, int ldw, int K, int ncols, int ldt, int koff, int row_off, const float* gain = nullptr) {
    Job J{}; J.src = src; J.dst = dst; J.gain = gain; J.ldw = ldw; J.K = K; J.ncols = ncols; J.ldt = ldt; J.koff = koff; J.row_off = row_off; J.item0 = items; J.pad = 0;
    jobs[n++] = J; items += ((K + 63) / 64) * ((ncols + 63) / 64); return n;
}

extern "C" void kernel_launch(void* const* d_in, const int* in_sizes, int n_in, void* d_out, int out_size, void* d_ws, size_t ws_size, hipStream_t stream) {
    static int ready = 0;
    if (ready == 0) {
        if (n_in != 33 || (size_t)out_size != O_END || ws_size < WS_END) { fprintf(stderr, "kernel_launch: unexpected shapes: n_in %d out %d ws %zu (need %zu)\n", n_in, out_size, ws_size, (size_t)WS_END); ready = -1; return; }
        if (hipFuncSetAttribute((const void*)fwd_kernel, hipFuncAttributeMaxDynamicSharedMemorySize, LDS_BYTES) != hipSuccess) { fprintf(stderr, "kernel_launch: hipFuncSetAttribute failed\n"); ready = -1; return; }
        int per_cu = 0;
        if (hipOccupancyMaxActiveBlocksPerMultiprocessor(&per_cu, (const void*)fwd_kernel, NTHR, LDS_BYTES) != hipSuccess || per_cu < 1) fprintf(stderr, "kernel_launch: occupancy query says %d\n", per_cu);
        (void)hipGetLastError();
        ready = 1;
    }
    if (ready < 0) return;
    unsigned char* ws = (unsigned char*)d_ws;
    (void)hipMemsetAsync(ws + WS_CTL, 0, CTL_BYTES, stream);
    Args a{};
    for (int i = 0; i < 33; ++i) a.in[i] = (const float*)d_in[i];
    a.out = (float*)d_out; a.ws = ws;
    int n = 0, items = 0;
    const float* a_w_in = a.in[14]; const float* a_w_out = a.in[15]; const float* b_w_in = a.in[18]; const float* b_w_out = a.in[19];
    const float* w1 = a.in[31]; const float* w2 = a.in[32]; const float* wk = a.in[12]; const float* wv = a.in[13];
    auto job_a_in = [&](int j) { add_job(a.jobs, n, items, a_w_in + (size_t)j * D * A_IN, (bf16*)(ws + WS_WINA + j * SZ_WINA), A_IN, D, A_IN, D, 0, 0, a.in[8] + (size_t)(2 * j) * D); };
    auto job_a_out = [&](int j) { add_job(a.jobs, n, items, a_w_out + (size_t)j * D * D, (bf16*)(ws + WS_WOUTA + j * SZ_WSQ), D, D, D, D, 0, 0); };
    auto job_b = [&](int j) {
        const float* bw = b_w_in + (size_t)j * D * B_IN; bf16* bd = (bf16*)(ws + WS_WINB + j * SZ_WINB); const float* gB = a.in[8] + (size_t)(2 * j + 1) * D;
        add_job(a.jobs, n, items, bw, bd, B_IN, D, 4608, D, 0, 0, gB);
        add_job(a.jobs, n, items, bw + B_MIXC, bd, B_IN, D, XDIM, D, 0, B_XQ_OFF, gB);
        add_job(a.jobs, n, items, bw + 4608, bd, B_IN, D, LORA_K, D, 0, B_LORA_OFF, gB);
        add_job(a.jobs, n, items, b_w_out + (size_t)j * D * D, (bf16*)(ws + WS_WOUTB + j * SZ_WSQ), D, D, D, D, 0, 0);
        bf16* lw = (bf16*)(ws + WS_LW + j * SZ_LW);
        add_job(a.jobs, n, items, a.in[22] + (size_t)j * 64 * MIX, lw, MIX, 64, MIX, LORA_K, 0, 0);
        add_job(a.jobs, n, items, a.in[24] + (size_t)j * 64 * MIX, lw, MIX, 64, MIX, LORA_K, 64, 0);
        add_job(a.jobs, n, items, a.in[25] + (size_t)j * 224 * MIX, lw, MIX, 224, MIX, LORA_K, 128, 0); };
    auto job_mlp = [&](int l) {
        add_job(a.jobs, n, items, w1 + (size_t)l * D * DFF, (bf16*)(ws + WS_W1 + l * SZ_WFF), DFF, D, DFF, D, 0, 0, a.in[9] + (size_t)l * D);
        add_job(a.jobs, n, items, w2 + (size_t)l * DFF * D, (bf16*)(ws + WS_W2 + l * SZ_WFF), D, DFF, D, DFF, 0, 0); };
    a.git[0] = 0;
    job_a_in(0);
    for (int l = 0; l < 4; ++l) {
        add_job(a.jobs, n, items, wk + (size_t)l * D * XDIM, (bf16*)(ws + WS_WKV + l * SZ_WKV), XDIM, D, XDIM, D, 0, 0);
        add_job(a.jobs, n, items, wv + (size_t)l * D * XDIM, (bf16*)(ws + WS_WKV + l * SZ_WKV), XDIM, D, XDIM, D, 0, XDIM); }
    a.git[1] = items;
    job_a_out(0); job_mlp(0); job_b(0); job_mlp(1); job_a_in(1);
    a.git[3] = items; a.git[2] = a.git[1] + (int)((a.git[3] - a.git[1]) * 0.0f);
    job_a_out(1); job_mlp(2); job_b(1); job_mlp(3);
    a.git[5] = items; a.git[4] = a.git[3] + (int)((a.git[5] - a.git[3]) * 0.0f);
    a.njobs = n; a.nitems = items;
    const int grid = 256;
#if MK_N_LAUNCHES == 1
    a.ph_lo = 0; a.ph_hi = N_PHASES;
    hipLaunchKernelGGL(fwd_kernel, dim3(grid), dim3(NTHR), LDS_BYTES, stream, a);
#else
    for (int p = 0; p < N_PHASES; ++p) { a.ph_lo = p; a.ph_hi = p + 1; hipLaunchKernelGGL(fwd_kernel, dim3(grid), dim3(NTHR), LDS_BYTES, stream, a); }
#endif
    const hipError_t le = hipPeekAtLastError();
    if (le != hipSuccess) fprintf(stderr, "kernel_launch: launch failed: %s\n", hipGetErrorName(le));
}
```

```cpp
#include <hip/hip_runtime.h>
#include <cstdio>
#include <cstdint>
#define MK_N_LAUNCHES 1
#define PROBE_K 0
#define PROBE_P0 0
#define PROBE_SUB 0
namespace pg8 {
#define PG8_LAS __attribute__((address_space(3)))
typedef unsigned short bf16_t;
typedef short bf16x8 __attribute__((ext_vector_type(8)));
typedef float f32x4 __attribute__((ext_vector_type(4)));
typedef unsigned u32x4 __attribute__((ext_vector_type(4)));
constexpr int BM = 256, BK = 64, HALF = 128, HTB = HALF * BK * 2  , STAGE_BYTES = 8 * HTB, NXCD = 8, WGM = 4;

__host__ __device__ __forceinline__ int lds_byte(int r, int c) { const int st = (r >> 4) * 2 + (c >> 5), rr = r & 15, cc = c & 31, ob = rr * 64 + cc * 2; return st * 1024 + (ob ^ (((ob >> 9) & 1) << 5)); }
__host__ __device__ __forceinline__ void stage_rc(int b, int& R, int& C) { const int st = b / 1024, sb = b % 1024, swz = sb ^ (((sb >> 9) & 1) << 5); R = (st >> 1) * 16 + swz / 64; C = (st & 1) * 32 + (swz % 64) / 2; }
__host__ __device__ __forceinline__ int perm32(int rho) { const int n = rho >> 4, i = rho & 15; return 8 * (i >> 2) + 4 * n + (i & 3); }

struct Unit { int pm, pn; };
struct Gemm { const bf16_t* A; const bf16_t* Bt; int M, N, K; };

struct StaticOrder {
    int nM, nN, nwg, G, c;
    __host__ __device__ void init(int M, int N, int G_, int c_) { nM = M / BM; nN = N / BM; nwg = nM * nN; G = G_; c = c_; }
    __host__ __device__ bool next(int i, Unit& u) const {
        const long L = (long)i * G + c; if (L >= nwg) return false;
        int wgid = (int)L; { const int q = nwg / NXCD, r = nwg % NXCD, xcd = wgid % NXCD, off = wgid / NXCD; wgid = (xcd < r ? xcd * (q + 1) : r * (q + 1) + (xcd - r) * q) + off; }
        const int nig = WGM * nN, gid = wgid / nig, fm = gid * WGM, gsz = (nM - fm) < WGM ? (nM - fm) : WGM;
        u.pm = fm + ((wgid % nig) % gsz); u.pn = (wgid % nig) / gsz; return true;
    }
    __device__ __forceinline__ void a_ready(const Unit&) const {}
    __device__ __forceinline__ void done(const Unit&) const {}
};

__device__ __forceinline__ unsigned cvt_pk_bf16(float lo, float hi) { unsigned r; asm volatile("v_cvt_pk_bf16_f32 %0, %1, %2" : "=v"(r) : "v"(lo), "v"(hi)); return r; }
typedef float f32x2 __attribute__((ext_vector_type(2)));
template <class Epi, class Sched, bool ALIGN_EPI = false, bool SP2 = false>
__device__ __forceinline__ void gemm_phase(PG8_LAS unsigned char* lds, const Gemm g, const Sched& S, const Epi& E) {
    int tid_ = threadIdx.x; asm volatile("" : "+v"(tid_));
    const int tid = tid_, wid = __builtin_amdgcn_readfirstlane(tid >> 6), lane = tid & 63, wr = wid >> 2, wc = wid & 3, fr = lane & 15, fq = lane >> 4;
    const int K = g.K, nt = K / BK;
    unsigned voffA[2], voffB[2];
#pragma unroll
    for (int i = 0; i < 2; ++i) { int R, C; stage_rc(tid * 16 + i * 8192, R, C); const int Rb = Epi::PERM ? ((R & ~31) + perm32(R & 31)) : R;
        voffA[i] = (unsigned)(R * K + C) * 2u; voffB[i] = (unsigned)(Rb * K + C) * 2u; }
    const size_t kstep = (size_t)(BK * 2);
    const size_t hstep = (size_t)HALF * K * 2;
    const size_t tstep = 2 * hstep;
    const unsigned ldsw = (unsigned)wid * 1024u;
    const int aoff = lds_byte(wr * 64 + fr, fq * 8), boff = lds_byte(wc * 32 + fr, fq * 8);
#define PG8_SA(b, h) (((b) * 2 + (h)) * HTB)
#define PG8_SB(b, h) ((4 + (b) * 2 + (h)) * HTB)
#define PG8_STAGE(bufoff, gbase, voff) do { _Pragma("unroll") for (int _i = 0; _i < 2; ++_i) \
        __builtin_amdgcn_global_load_lds((const unsigned*)((const char*)(gbase) + (voff)[_i]), (PG8_LAS unsigned*)(lds + (bufoff) + ldsw + _i * 8192), 16, 0, 0); } while (0)
#define PG8_LDA(dst, b, h) do { _Pragma("unroll") for (int m = 0; m < 4; ++m) _Pragma("unroll") for (int k = 0; k < 2; ++k) dst[m][k] = *(const PG8_LAS bf16x8*)(lds + PG8_SA(b, h) + aoff + m * 2048 + k * 1024); } while (0)
#define PG8_LDB(dst, b, h) do { _Pragma("unroll") for (int n = 0; n < 2; ++n) _Pragma("unroll") for (int k = 0; k < 2; ++k) dst[n][k] = *(const PG8_LAS bf16x8*)(lds + PG8_SB(b, h) + boff + n * 2048 + k * 1024); } while (0)
#define PG8_MMA(ai, bj, At, Bt) do { __builtin_amdgcn_s_setprio(1); _Pragma("unroll") for (int m = 0; m < 4; ++m) _Pragma("unroll") for (int n = 0; n < 2; ++n) _Pragma("unroll") for (int k = 0; k < 2; ++k) \
        acc[ai][bj][m][n] = __builtin_amdgcn_mfma_f32_16x16x32_bf16(Bt[n][k], At[m][k], acc[ai][bj][m][n], 0, 0, 0); __builtin_amdgcn_s_setprio(0); } while (0)
#define PG8_WAIT_V(n) asm volatile("s_waitcnt vmcnt(" #n ")" ::: "memory")
#define PG8_WAIT_L(n) asm volatile("s_waitcnt lgkmcnt(" #n ")" ::: "memory")
#define PG8_BAR __builtin_amdgcn_s_barrier()
#define PG8_SCHED __builtin_amdgcn_sched_barrier(0)
    Unit cur, nxt; int ui = 0;
    if (!S.next(0, cur)) return;
    f32x4 acc[2][2][4][2];
#pragma unroll
    for (int a = 0; a < 2; ++a)
#pragma unroll
        for (int b = 0; b < 2; ++b)
#pragma unroll
            for (int m = 0; m < 4; ++m)
#pragma unroll
                for (int n = 0; n < 2; ++n) acc[a][b][m][n] = (f32x4){0.f, 0.f, 0.f, 0.f};
    bf16x8 At[4][2], B0[2][2], B1[2][2];
    const char* cA = (const char*)g.A + (size_t)cur.pm * tstep; const char* cB = (const char*)g.Bt + (size_t)cur.pn * tstep;
    S.a_ready(cur);
    if constexpr (SP2) {
        PG8_STAGE(PG8_SB(0, 0), cB, voffB); PG8_STAGE(PG8_SB(0, 1), cB + hstep, voffB); PG8_STAGE(PG8_SA(0, 0), cA, voffA); PG8_STAGE(PG8_SA(0, 1), cA + hstep, voffA);
        if (wr == 1) PG8_BAR;
        PG8_WAIT_V(2); PG8_BAR;
        PG8_STAGE(PG8_SB(1, 0), cB + kstep, voffB); PG8_STAGE(PG8_SA(1, 0), cA + kstep, voffA); PG8_STAGE(PG8_SB(1, 1), cB + hstep + kstep, voffB);
        PG8_WAIT_V(6); PG8_BAR;
    } else {
        PG8_STAGE(PG8_SB(0, 0), cB, voffB); PG8_STAGE(PG8_SA(0, 0), cA, voffA); PG8_STAGE(PG8_SB(0, 1), cB + hstep, voffB); PG8_STAGE(PG8_SA(0, 1), cA + hstep, voffA);
        if (wr == 1) PG8_BAR;
        PG8_WAIT_V(4); PG8_BAR;
        PG8_STAGE(PG8_SB(1, 0), cB + kstep, voffB); PG8_STAGE(PG8_SA(1, 0), cA + kstep, voffA); PG8_STAGE(PG8_SB(1, 1), cB + hstep + kstep, voffB);
        PG8_WAIT_V(6); PG8_BAR;
    }
    for (;;) {
        const bool has_next = S.next(ui + 1, nxt);
        const char* nA = has_next ? (const char*)g.A + (size_t)nxt.pm * tstep : cA; const char* nB = has_next ? (const char*)g.Bt + (size_t)nxt.pn * tstep : cB;
        for (int t = 0; t < nt; t += 2) {
            const bool last = (t == nt - 2);
            const char* a1 = cA + (size_t)(t + 1) * kstep;
            const char* a2 = last ? nA : cA + (size_t)(t + 2) * kstep; const char* b2 = last ? nB : cB + (size_t)(t + 2) * kstep;
            const char* a3 = a2 + kstep; const char* b3 = b2 + kstep;
            if (last && has_next) S.a_ready(nxt);
            if constexpr (SP2) {
            PG8_LDB(B0, 0, 0); PG8_LDB(B1, 0, 1); PG8_SCHED; PG8_LDA(At, 0, 0); PG8_STAGE(PG8_SA(1, 1), a1 + hstep, voffA);
            PG8_WAIT_V(8); PG8_WAIT_L(0); PG8_BAR; PG8_MMA(0, 0, At, B0); PG8_MMA(0, 1, At, B1); PG8_BAR; PG8_SCHED;
            PG8_LDA(At, 0, 1); PG8_STAGE(PG8_SB(0, 0), b2, voffB); PG8_STAGE(PG8_SB(0, 1), b2 + hstep, voffB); PG8_STAGE(PG8_SA(0, 0), a2, voffA);
            PG8_WAIT_V(8); PG8_WAIT_L(0); PG8_BAR; PG8_MMA(1, 0, At, B0); PG8_MMA(1, 1, At, B1); PG8_BAR; PG8_SCHED;
            PG8_LDB(B0, 1, 0); PG8_LDB(B1, 1, 1); PG8_SCHED; PG8_LDA(At, 1, 0); PG8_STAGE(PG8_SA(0, 1), a2 + hstep, voffA);
            PG8_WAIT_V(8); PG8_WAIT_L(0); PG8_BAR; PG8_MMA(0, 0, At, B0); PG8_MMA(0, 1, At, B1); PG8_BAR; PG8_SCHED;
            PG8_LDA(At, 1, 1); PG8_STAGE(PG8_SB(1, 0), b3, voffB); PG8_STAGE(PG8_SB(1, 1), b3 + hstep, voffB); PG8_STAGE(PG8_SA(1, 0), a3, voffA);
            PG8_WAIT_V(8); PG8_WAIT_L(0); PG8_BAR; PG8_MMA(1, 0, At, B0); PG8_MMA(1, 1, At, B1); PG8_BAR; PG8_SCHED;
            } else {
            PG8_LDB(B0, 0, 0); PG8_SCHED; PG8_LDA(At, 0, 0); PG8_STAGE(PG8_SA(1, 1), a1 + hstep, voffA);
            PG8_WAIT_L(8); PG8_BAR; PG8_WAIT_L(0); PG8_MMA(0, 0, At, B0); PG8_BAR; PG8_SCHED;
            PG8_LDB(B1, 0, 1); PG8_STAGE(PG8_SB(0, 0), b2, voffB);
            PG8_BAR; PG8_WAIT_L(0); PG8_MMA(0, 1, At, B1); PG8_BAR;
            PG8_LDA(At, 0, 1); PG8_STAGE(PG8_SA(0, 0), a2, voffA);
            PG8_BAR; PG8_WAIT_L(0); PG8_MMA(1, 0, At, B0); PG8_BAR; PG8_SCHED;
            PG8_STAGE(PG8_SB(0, 1), b2 + hstep, voffB);
            PG8_WAIT_V(6); PG8_BAR; PG8_MMA(1, 1, At, B1); PG8_BAR;
            PG8_LDB(B0, 1, 0); PG8_SCHED; PG8_LDA(At, 1, 0); PG8_STAGE(PG8_SA(0, 1), a2 + hstep, voffA);
            PG8_WAIT_L(8); PG8_BAR; PG8_WAIT_L(0); PG8_MMA(0, 0, At, B0); PG8_BAR; PG8_SCHED;
            PG8_LDB(B1, 1, 1); PG8_STAGE(PG8_SB(1, 0), b3, voffB);
            PG8_BAR; PG8_WAIT_L(0); PG8_MMA(0, 1, At, B1); PG8_BAR;
            PG8_LDA(At, 1, 1); PG8_STAGE(PG8_SA(1, 0), a3, voffA);
            PG8_BAR; PG8_WAIT_L(0); PG8_MMA(1, 0, At, B0); PG8_BAR; PG8_SCHED;
            PG8_STAGE(PG8_SB(1, 1), b3 + hstep, voffB);
            PG8_WAIT_V(6); PG8_BAR; PG8_MMA(1, 1, At, B1); PG8_BAR;
            }
        }
        if constexpr (ALIGN_EPI) { if (wr == 0) PG8_BAR; }
        if constexpr (!Epi::AFTER_DRAIN) { E(acc, cur, wr, wc, fr, fq); S.done(cur); }
        if (!has_next) break;
#pragma unroll
        for (int a = 0; a < 2; ++a)
#pragma unroll
            for (int b = 0; b < 2; ++b)
#pragma unroll
                for (int m = 0; m < 4; ++m)
#pragma unroll
                    for (int n = 0; n < 2; ++n) acc[a][b][m][n] = (f32x4){0.f, 0.f, 0.f, 0.f};
        cur = nxt; cA = nA; cB = nB; ++ui;
        if constexpr (ALIGN_EPI) { if (wr == 1) PG8_BAR; }
    }
    PG8_WAIT_V(0);
    if constexpr (!ALIGN_EPI) { if (wr == 0) PG8_BAR; }
    PG8_BAR;
    if constexpr (Epi::AFTER_DRAIN) { E.fused(acc, cur, wr, wc, fr, fq, lds, wid, lane); S.done(cur); }
#undef PG8_SA
#undef PG8_SB
#undef PG8_STAGE
#undef PG8_LDA
#undef PG8_LDB
#undef PG8_MMA
#undef PG8_WAIT_V
#undef PG8_WAIT_L
#undef PG8_BAR
#undef PG8_SCHED
}
}


#define GAS __attribute__((address_space(1)))
#define LAS __attribute__((address_space(3)))
typedef unsigned short bf16;
typedef unsigned v4u __attribute__((ext_vector_type(4)));
typedef unsigned v2u __attribute__((ext_vector_type(2)));
typedef float f32x4 __attribute__((ext_vector_type(4)));
typedef float f32x2 __attribute__((ext_vector_type(2)));
typedef short bf16x8 __attribute__((ext_vector_type(8)));
typedef LAS unsigned char* ldsp;

constexpr int NWAVES = 8, NTHR = 512;
constexpr int D = 2048, SEQ = 2048, NB = 4, MP = 8192, NSMP = 128, MR = 8320, MT = 8448;
constexpr int NMEM = 256, XH = 4, XD = 128, XDIM = 512, MIX = 1536;
constexpr int AH = 12, AHD = 128, A_IN = 6656, LDP = 6656;
constexpr int BH = 24, BHD = 64, B_IN = 5472, B_INP = 5632, B_MIXC = 4960;
constexpr int DFF = 8192;
constexpr int LORA_K = 352;
constexpr int A_XQ_OFF = 6144;
constexpr int B_XQ_OFF = 4608;
constexpr int B_LORA_OFF = 5120;
constexpr float RMS_EPS = 1e-6f, GN_EPS = 64e-5f;

constexpr size_t O_YP = 0, O_YS = 16777216, O_MK = 17039360, O_MV = 19136512, O_SHP = 21233664, O_SRP = 22806528,
                 O_SSP = 23592960, O_SHS = 23609344, O_SRS = 73940992, O_SSS = 99106816, O_END = 99631104;

constexpr size_t al256(size_t x) { return (x + 255) & ~(size_t)255; }
constexpr size_t WS_CTL = 0, CTL_BYTES = 1u << 20;
constexpr size_t SZ_WINA = (size_t)A_IN * D * 2, SZ_WSQ = (size_t)D * D * 2, SZ_WINB = (size_t)B_INP * D * 2, SZ_WFF = (size_t)DFF * D * 2,
                 SZ_WKV = (size_t)1024 * D * 2, SZ_LW = (size_t)MIX * LORA_K * 2;
constexpr size_t WS_WINA = WS_CTL + CTL_BYTES;
constexpr size_t WS_WOUTA = WS_WINA + 2 * SZ_WINA;
constexpr size_t WS_WINB = WS_WOUTA + 2 * SZ_WSQ;
constexpr size_t WS_WOUTB = WS_WINB + 2 * SZ_WINB;
constexpr size_t WS_W1 = WS_WOUTB + 2 * SZ_WSQ;
constexpr size_t WS_W2 = WS_W1 + 4 * SZ_WFF;
constexpr size_t WS_WKV = WS_W2 + 4 * SZ_WFF;
constexpr size_t WS_LW = WS_WKV + 4 * SZ_WKV;
constexpr size_t WS_X = al256(WS_LW + 2 * SZ_LW);
constexpr size_t WS_H = WS_X + (size_t)MT * D * 4;
constexpr size_t WS_PROJ = WS_H + (size_t)MT * D * 2;
constexpr size_t WS_MIXC = WS_PROJ + (size_t)MT * LDP * 2;
constexpr size_t WS_ACT = WS_MIXC + (size_t)MT * D * 2;
constexpr size_t WS_MEMN = WS_ACT + (size_t)MT * DFF * 2;
constexpr size_t SZ_RW = (size_t)MT * MIX * 4;
constexpr size_t WS_RR = WS_MEMN + (size_t)1024 * D * 2;
constexpr size_t WS_RK = WS_RR + SZ_RW, WS_RV = WS_RK + SZ_RW, WS_RKK = WS_RV + SZ_RW, WS_RKA = WS_RKK + SZ_RW, WS_RW = WS_RKA + SZ_RW,
                 WS_RG = WS_RW + SZ_RW, WS_RO = WS_RG + SZ_RW;
constexpr size_t WS_BONUS = WS_RO + SZ_RW;
constexpr size_t WS_REC = al256(WS_BONUS + (size_t)MT * BH * 4);
constexpr size_t REC_BYTES = 7 * 8192;
constexpr size_t WS_END = al256(WS_REC + (size_t)NB * BH * 32 * REC_BYTES);

constexpr int CW_BAR = 4096;
constexpr int CW_CQ = 3072;
constexpr int CW_PDONE = 2560;
#ifndef HG_SPLIT
#define HG_SPLIT 16
#endif
constexpr int CW_SFLAG = 2048;
constexpr size_t CTL_SS = 65536;
typedef unsigned long long u64;
constexpr float SS_FIX = 1048576.f, SS_UNFIX = 1.f / 1048576.f;
__device__ __forceinline__ u64* ss_slot(unsigned char* ws, int s) { return (u64*)(ws + WS_CTL + CTL_SS) + (size_t)s * MT; }

constexpr int RING_BYTES = 159744, LDSCTL_OFF = RING_BYTES, MISC_OFF = LDSCTL_OFF + 320, LDS_BYTES = RING_BYTES + 1024;

#define LDS_WAIT() asm volatile("s_waitcnt lgkmcnt(0)" ::: "memory")
#define LDS_BARRIER() do { asm volatile("s_waitcnt lgkmcnt(0)" ::: "memory"); __builtin_amdgcn_s_barrier(); asm volatile("" ::: "memory"); } while (0)
#define VM_WAIT() asm volatile("s_waitcnt vmcnt(0)" ::: "memory")
typedef __bf16 bf16x2_t __attribute__((ext_vector_type(2)));
__device__ __forceinline__ unsigned pk2_hw(float lo, float hi) { f32x2 v = {lo, hi}; const bf16x2_t b = __builtin_convertvector(v, bf16x2_t); return __builtin_bit_cast(unsigned, b); }
__device__ __forceinline__ unsigned f2bf(float f) { return (__builtin_bit_cast(unsigned, f) + 0x8000u) >> 16; }
__device__ __forceinline__ unsigned pk2(float lo, float hi) { return __builtin_amdgcn_perm(__builtin_bit_cast(unsigned, hi) + 0x8000u, __builtin_bit_cast(unsigned, lo) + 0x8000u, 0x07060302u); }
__device__ __forceinline__ float bf2f(unsigned short b) { return __builtin_bit_cast(float, ((unsigned)b) << 16); }
__device__ __forceinline__ float bflo(unsigned w) { return __builtin_bit_cast(float, w << 16); }
__device__ __forceinline__ float bfhi(unsigned w) { return __builtin_bit_cast(float, w & 0xffff0000u); }
__device__ __forceinline__ f32x4 bf4(v2u w) { return (f32x4){bflo(w.x), bfhi(w.x), bflo(w.y), bfhi(w.y)}; }
__device__ __forceinline__ v2u pk4(f32x4 v) { v2u r; r.x = pk2(v.x, v.y); r.y = pk2(v.z, v.w); return r; }
__device__ __forceinline__ float wave_sum(float v) {
#pragma unroll
    for (int o = 1; o < 64; o <<= 1) v += __shfl_xor(v, o);
    return v;
}
__device__ __forceinline__ float wave_max(float v) {
#pragma unroll
    for (int o = 1; o < 64; o <<= 1) v = fmaxf(v, __shfl_xor(v, o));
    return v;
}
__device__ __forceinline__ float fsigmoid(float x) { return __builtin_amdgcn_rcpf(1.f + __expf(-x)); }
__device__ __forceinline__ int sw128(int r, int c) { return r * 256 + ((c ^ (r & 15)) << 4); }
__device__ __forceinline__ int sw64(int r, int c) { return r * 128 + ((c ^ ((r >> 1) & 7)) << 4); }
__device__ __forceinline__ int sw256(int r, int c) { return r * 512 + ((c ^ (r & 15)) << 4); }
#define MFMA16(a, b, c) __builtin_amdgcn_mfma_f32_16x16x32_bf16((a), (b), (c), 0, 0, 0)

#define XB_TMO      128
#define XB_XCNT(j)  (256  + 64 * (j))
#define XB_XSUB(j)  (1280 + 64 * (j))
#define XB_XGEN(j)  (2304 + 64 * (j))
#define XB_TOP      3328
#define XB_TOPGEN   3392
#define XCD_BAR_WORDS 3456
#define XB_SPIN_CAP (1u << 18)
__device__ __forceinline__ unsigned xb_ld(unsigned* p)              { return __hip_atomic_load(p, __ATOMIC_RELAXED, __HIP_MEMORY_SCOPE_AGENT); }
__device__ __forceinline__ unsigned xb_add(unsigned* p, unsigned v) { return __hip_atomic_fetch_add(p, v, __ATOMIC_RELAXED, __HIP_MEMORY_SCOPE_AGENT); }
__device__ __forceinline__ unsigned xb_xcc_id() { return (unsigned)__builtin_amdgcn_s_getreg((3 << 11) | 20) & 0xFu; }
#define XB_SPIN(cond, bar) do { unsigned _sp = 0; while (cond) { __builtin_amdgcn_s_sleep(1); \
    if ((++_sp & 255u) == 0u) { if (xb_ld(&(bar)[XB_TMO])) break; if (_sp > XB_SPIN_CAP) { atomicAdd(&(bar)[XB_TMO], 1u); break; } } } } while (0)
struct XcdBarrier { unsigned* bar; unsigned x; volatile LAS unsigned* st; };
__device__ __forceinline__ XcdBarrier xcd_barrier_post(unsigned* bar, volatile LAS unsigned* st) {
    XcdBarrier b; b.bar = bar; b.x = xb_xcc_id(); b.st = st;
    if (threadIdx.x == 0) (void)xb_add(&bar[XB_XCNT(b.x)], 1u);
    return b;
}
__device__ __forceinline__ void xcd_barrier_complete(unsigned* bar, unsigned x, unsigned& nloc, unsigned& nx) {
    const unsigned G = gridDim.x * gridDim.y * gridDim.z;
    unsigned sum, cnt, mine, sp = 0u;
    for (;;) {
        sum = 0u; cnt = 0u; mine = 0u;
#pragma unroll
        for (unsigned j = 0; j < 16; ++j) { const unsigned c = xb_ld(&bar[XB_XCNT(j)]); sum += c; cnt += (c > 0u) ? 1u : 0u; mine = (j == x) ? c : mine; }
        if (sum == G) break;
        __builtin_amdgcn_s_sleep(1);
        if ((++sp & 255u) == 0u) { if (xb_ld(&bar[XB_TMO])) break; if (sp > XB_SPIN_CAP) { atomicAdd(&bar[XB_TMO], 1u); break; } }
    }
    nloc = mine > 0u ? mine : 1u; nx = cnt > 0u ? cnt : 1u;
}
__device__ __forceinline__ void xcd_barrier(const XcdBarrier& b) {
    asm volatile("s_waitcnt vmcnt(0)" ::: "memory");
    __syncthreads();
    if (threadIdx.x == 0) {
        unsigned* bar = b.bar;
        __builtin_amdgcn_s_waitcnt(0);
        unsigned nloc = b.st[0], nx = b.st[1];
        if (nloc == 0u) { xcd_barrier_complete(bar, b.x, nloc, nx); b.st[0] = nloc; b.st[1] = nx; }
        const unsigned old = xb_add(&bar[XB_XSUB(b.x)], 1u);
        const unsigned gen = old / nloc;
        if (old + 1u == (gen + 1u) * nloc) {
            __builtin_amdgcn_fence(__ATOMIC_RELEASE, "agent");
            asm volatile("s_waitcnt vmcnt(0)" ::: "memory");
            const unsigned og = xb_add(&bar[XB_TOP], 1u);
            const unsigned tg = og / nx;
            if (og + 1u == (tg + 1u) * nx) xb_add(&bar[XB_TOPGEN], 1u);
            else XB_SPIN(xb_ld(&bar[XB_TOPGEN]) == tg, bar);
            __builtin_amdgcn_fence(__ATOMIC_ACQUIRE, "agent");
            xb_add(&bar[XB_XGEN(b.x)], 1u);
            asm volatile("s_waitcnt vmcnt(0)" ::: "memory");
        } else {
            XB_SPIN(xb_ld(&bar[XB_XGEN(b.x)]) == gen, bar);
            __builtin_amdgcn_fence(__ATOMIC_ACQUIRE, "agent");
            asm volatile("s_waitcnt vmcnt(0)" ::: "memory");
        }
    }
    __syncthreads();
}

__device__ __forceinline__ float atomic_add_agent(float* p, float v) { return __hip_atomic_fetch_add(p, v, __ATOMIC_RELAXED, __HIP_MEMORY_SCOPE_AGENT); }
template <int ACT> struct EpiBf {
    static constexpr bool PERM = true, AFTER_DRAIN = false;
    bf16* O; int ldc; const u64* ss;
    __device__ __forceinline__ void operator()(const pg8::f32x4 (&acc)[2][2][4][2], const pg8::Unit& u, int wr, int wc, int fr, int fq) const {
        const int row0 = u.pm * 256 + wr * 64 + fr, col0 = u.pn * 256 + wc * 32 + 8 * fq;
#pragma unroll
        for (int ai = 0; ai < 2; ++ai)
#pragma unroll
            for (int m = 0; m < 4; ++m) { const int row = row0 + ai * 128 + m * 16; bf16* rowp = O + (size_t)row * ldc + col0;
                const float rs = (ACT == 2) ? 1.f : __builtin_amdgcn_rsqf((float)ss[row] * (SS_UNFIX / D) + RMS_EPS);
#pragma unroll
                for (int bj = 0; bj < 2; ++bj) { pg8::f32x4 v0 = acc[ai][bj][m][0] * rs, v1 = acc[ai][bj][m][1] * rs;
                    if (ACT >= 1) {
#pragma unroll
                        for (int q = 0; q < 4; ++q) { const float a = fmaxf(v0[q], 0.f), b = fmaxf(v1[q], 0.f); v0[q] = a * a; v1[q] = b * b; } }
                    pg8::u32x4 w; w.x = pg8::cvt_pk_bf16(v0[0], v0[1]); w.y = pg8::cvt_pk_bf16(v0[2], v0[3]); w.z = pg8::cvt_pk_bf16(v1[0], v1[1]); w.w = pg8::cvt_pk_bf16(v1[2], v1[3]);
                    *(pg8::u32x4*)(rowp + bj * 128) = w; }
                __builtin_amdgcn_sched_barrier(0); }
    }
};
template <bool SCL> struct EpiResid {
    static constexpr bool PERM = false, AFTER_DRAIN = false;
    float* X; int ldc; bf16* Hb; u64* ssq; const u64* scl;
    __device__ __forceinline__ void operator()(const pg8::f32x4 (&acc)[2][2][4][2], const pg8::Unit& u, int wr, int wc, int fr, int fq) const {
        const int row0 = u.pm * 256 + wr * 64 + fr, col0 = u.pn * 256 + wc * 32 + 4 * fq; u64 rets[8];
#pragma unroll
        for (int ai = 0; ai < 2; ++ai) {
            pg8::f32x4 xin[4][4]; float r2v[4];
#pragma unroll
            for (int m = 0; m < 4; ++m) { const int row = row0 + ai * 128 + m * 16; const float* rowp = X + (size_t)row * ldc + col0;
                r2v[m] = SCL ? (float)scl[row] : 0.f;
#pragma unroll
                for (int q = 0; q < 4; ++q) xin[m][q] = *(const pg8::f32x4*)(rowp + (q >> 1) * 128 + (q & 1) * 16); }
            __builtin_amdgcn_sched_barrier(0);
#pragma unroll
            for (int m = 0; m < 4; ++m) { const int row = row0 + ai * 128 + m * 16; float* rowp = X + (size_t)row * ldc + col0; bf16* hp = Hb + (size_t)row * ldc + col0;
                const float r2 = SCL ? __builtin_amdgcn_rcpf(r2v[m] * (SS_UNFIX / D) + RMS_EPS) : 1.f;
                float s = 0.f;
#pragma unroll
                for (int bj = 0; bj < 2; ++bj)
#pragma unroll
                    for (int n = 0; n < 2; ++n) { const pg8::f32x4 x = xin[m][bj * 2 + n] + acc[ai][bj][m][n] * r2; *(pg8::f32x4*)(rowp + bj * 128 + n * 16) = x;
                        v2u hw; hw.x = pg8::cvt_pk_bf16(x[0], x[1]); hw.y = pg8::cvt_pk_bf16(x[2], x[3]); *(v2u*)(hp + bj * 128 + n * 16) = hw;
                        s += (x[0] * x[0] + x[1] * x[1]) + (x[2] * x[2] + x[3] * x[3]); }
                s += __shfl_xor(s, 16); s += __shfl_xor(s, 32);
                rets[ai * 4 + m] = 0;
                if (fq == 0) rets[ai * 4 + m] = __hip_atomic_fetch_add(ssq + row, (u64)(s * SS_FIX + 0.5f), __ATOMIC_RELAXED, __HIP_MEMORY_SCOPE_AGENT); }
            __builtin_amdgcn_sched_barrier(0); }
#pragma unroll
        for (int g = 0; g < 8; ++g) asm volatile("" :: "v"(rets[g]));
    }
};
struct EpiMemKV {
    static constexpr bool PERM = false, AFTER_DRAIN = false;
    float* out;
    __device__ __forceinline__ void operator()(const pg8::f32x4 (&acc)[2][2][4][2], const pg8::Unit& u, int wr, int wc, int fr, int fq) const {
        const int layer = u.pn >> 2, kv = (u.pn >> 1) & 1, c0 = (u.pn & 1) * 256 + wc * 32 + 4 * fq;
        float* base = out + (kv ? O_MV : O_MK) + (size_t)layer * (1024 * 512);
        const int row0 = u.pm * 256 + wr * 64 + fr;
#pragma unroll
        for (int ai = 0; ai < 2; ++ai)
#pragma unroll
            for (int m = 0; m < 4; ++m) { float* rowp = base + (size_t)(row0 + ai * 128 + m * 16) * 512 + c0;
#pragma unroll
                for (int bj = 0; bj < 2; ++bj)
#pragma unroll
                    for (int n = 0; n < 2; ++n) *(pg8::f32x4*)(rowp + bj * 128 + n * 16) = acc[ai][bj][m][n]; }
    }
};
struct EpiDummy {
    static constexpr bool PERM = false, AFTER_DRAIN = false;
    float* C; int ldc;
    __device__ __forceinline__ void operator()(const pg8::f32x4 (&acc)[2][2][4][2], const pg8::Unit& u, int wr, int wc, int fr, int fq) const {
        const int row0 = u.pm * 256 + wr * 64 + fr, col0 = u.pn * 256 + wc * 32 + 4 * fq;
#pragma unroll
        for (int ai = 0; ai < 2; ++ai)
#pragma unroll
            for (int m = 0; m < 4; ++m) { float* rowp = C + (size_t)(row0 + ai * 128 + m * 16) * ldc + col0;
#pragma unroll
                for (int bj = 0; bj < 2; ++bj)
#pragma unroll
                    for (int n = 0; n < 2; ++n) *(pg8::f32x4*)(rowp + bj * 128 + n * 16) = acc[ai][bj][m][n]; }
    }
};
struct RotOrder : pg8::StaticOrder {};

struct Job { const float* src; bf16* dst; const float* gain; int ldw, K, ncols, ldt, koff, row_off, item0, pad; };
constexpr int NJOBS = 34;
struct Args { const float* in[33]; float* out; unsigned char* ws; Job jobs[NJOBS]; int git[6]; int njobs, nitems, ph_lo, ph_hi, pad2[2]; };

__device__ __forceinline__ int fresh_tid() { int t = threadIdx.x; asm volatile("" : "+v"(t)); return t; }
struct Frame {
    ldsp lds;
    int tid, lane, wave, G, vcu;
    unsigned char* ws; float* out;
};


__device__ __forceinline__ void norm_row(const float* src, const float* g, int lane, bf16* hdst, float* fdst, float* xcopy, float* f2) {
    const f32x4* xr = (const f32x4*)src + lane; const f32x4* gr = (const f32x4*)g + lane;
    f32x4 v[8]; float s = 0.f;
#pragma unroll
    for (int j = 0; j < 8; ++j) { v[j] = xr[64 * j]; s += (v[j].x * v[j].x + v[j].y * v[j].y) + (v[j].z * v[j].z + v[j].w * v[j].w); }
    s = wave_sum(s);
    const float rstd = 1.f / sqrtf(s * (1.f / D) + RMS_EPS);
    f32x4 gv[8];
#pragma unroll
    for (int j = 0; j < 8; ++j) gv[j] = gr[64 * j];
    if (xcopy) {
#pragma unroll
        for (int j = 0; j < 8; ++j) ((f32x4*)xcopy + lane)[64 * j] = v[j]; }
#pragma unroll
    for (int j = 0; j < 8; ++j) { const f32x4 y = v[j] * rstd * gv[j];
        if (hdst) ((v2u*)hdst + lane)[64 * j] = pk4(y);
        if (fdst) ((f32x4*)fdst + lane)[64 * j] = y;
        if (f2) ((f32x4*)f2 + lane)[64 * j] = y; }
}

__device__ __forceinline__ void norm_phase(Frame& F0, const Args& A, const float* g, bool first, bool final, int shift_j) {
    Frame F = F0; F.tid = fresh_tid(); F.lane = F.tid & 63; F.wave = __builtin_amdgcn_readfirstlane(F.tid >> 6);
    const int gw = F.vcu * NWAVES + F.wave, NGW = F.G * NWAVES;
    float* X = (float*)(F.ws + WS_X); bf16* H = (bf16*)(F.ws + WS_H);
    for (int row = gw; row < MR; row += NGW) {
        const float* src = first ? (row < MP ? A.in[0] + (size_t)row * D : A.in[1] + (size_t)(row - MP) * D) : X + (size_t)row * D;
        float* f2 = nullptr;
        if (shift_j >= 0) {
            if (row < MP) { if ((row & (SEQ - 1)) == SEQ - 1) f2 = F.out + O_SSP + (size_t)(shift_j * NB + (row >> 11)) * D; }
            else f2 = F.out + O_SSS + (size_t)(shift_j * NSMP + (row - MP)) * D;
        }
        norm_row(src, g, F.lane, final ? nullptr : H + (size_t)row * D, final ? F.out + O_YP + (size_t)row * D : nullptr, first ? X + (size_t)row * D : nullptr, f2);
    }
    if (shift_j >= 0) {
        const float* sh = A.in[6] + (size_t)shift_j * NSMP * D;
        for (int r = gw; r < NSMP; r += NGW) { const f32x4* xr = (const f32x4*)(sh + (size_t)r * D) + F.lane; v2u* o = (v2u*)(H + (size_t)(MR + r) * D) + F.lane;
#pragma unroll
            for (int j = 0; j < 8; ++j) o[64 * j] = pk4(xr[64 * j]); }
    }
}

struct CvtMeta { int j, k0, n0, hg; };
__device__ __forceinline__ CvtMeta cvt_load(const Args& A, int it, int lane, f32x4 (&v0)[8], f32x4 (&v1)[8], float (&g0)[8], float (&g1)[8]) {
    int j = 0;
    for (int q = 1; q < A.njobs; ++q) if (it >= A.jobs[q].item0) j = q;
    const Job& J = A.jobs[j]; const int item = it - J.item0;
    const int nblk = (J.ncols + 63) / 64, kb = item / nblk, nb = item - kb * nblk, k0 = 64 * kb, n0 = 64 * nb;
    const int n4 = 4 * (lane & 15), kp = lane >> 4; const float* gp = J.gain ? J.gain : J.src;
    const int nc = min(n0 + n4, J.ncols - 4);
#pragma unroll
    for (int i = 0; i < 8; ++i) { const int k = min(k0 + 8 * i + 2 * kp, J.K - 2);
        v0[i] = *(const f32x4*)(J.src + (size_t)k * J.ldw + nc);
        v1[i] = *(const f32x4*)(J.src + (size_t)(k + 1) * J.ldw + nc);
        g0[i] = gp[k]; g1[i] = gp[k + 1]; }
    return CvtMeta{j, k0, n0, J.gain != nullptr ? 1 : 0};
}
__device__ __forceinline__ void convert_items(Frame& F, const Args& A, int it_lo, int it_hi, int wk, int nworkers) {
    const int tid = fresh_tid(), lane = tid & 63, w = __builtin_amdgcn_readfirstlane(tid >> 6);
    LAS unsigned* scr = (LAS unsigned*)(F.lds + w * 8448);
    const int n4 = 4 * (lane & 15), kp = lane >> 4, c = lane & 7;
    f32x4 v0[8], v1[8]; float g0[8], g1[8]; CvtMeta m{0, 0, 0, 0};
    int it = it_lo + wk;
    if (it < it_hi) m = cvt_load(A, it, lane, v0, v1, g0, g1);
    while (it < it_hi) {
#pragma unroll
        for (int i = 0; i < 8; ++i) { LAS unsigned* s = scr + n4 * 33 + 4 * i + kp; const f32x4 x0 = v0[i] * (m.hg ? g0[i] : 1.f), x1 = v1[i] * (m.hg ? g1[i] : 1.f);
            s[0] = pk2(x0.x, x1.x); s[33] = pk2(x0.y, x1.y); s[66] = pk2(x0.z, x1.z); s[99] = pk2(x0.w, x1.w); }
        const CvtMeta cur = m; const int nxt = it + nworkers;
        if (nxt < it_hi) m = cvt_load(A, nxt, lane, v0, v1, g0, g1);
        LDS_WAIT(); asm volatile("" ::: "memory");
        const Job& J = A.jobs[cur.j];
        if (cur.k0 + 8 * c < J.K) {
#pragma unroll
            for (int jn = 0; jn < 8; ++jn) { const int n = jn * 8 + (lane >> 3); const LAS unsigned* s = scr + n * 33 + 4 * c;
                v4u o; o.x = s[0]; o.y = s[1]; o.z = s[2]; o.w = s[3];
                if (cur.n0 + n < J.ncols) *(v4u*)(J.dst + (size_t)(J.row_off + cur.n0 + n) * J.ldt + J.koff + cur.k0 + 8 * c) = o; } }
        LDS_WAIT(); asm volatile("" ::: "memory");
        it = nxt;
    }
}
__device__ __forceinline__ void cvt_store(const Args& A, const CvtMeta cur, LAS unsigned* scr, int lane, int c) {
    const Job& J = A.jobs[cur.j];
    if (cur.k0 + 8 * c < J.K) {
#pragma unroll
        for (int jn = 0; jn < 8; ++jn) { const int n = jn * 8 + (lane >> 3); const LAS unsigned* s = scr + n * 33 + 4 * c;
            v4u o; o.x = s[0]; o.y = s[1]; o.z = s[2]; o.w = s[3];
            if (cur.n0 + n < J.ncols) *(v4u*)(J.dst + (size_t)(J.row_off + cur.n0 + n) * J.ldt + J.koff + cur.k0 + 8 * c) = o; } }
}
__device__ __forceinline__ void convert_items_dyn(Frame& F, const Args& A, int it_lo, int it_hi, unsigned* ctr, int q) {
    const int tid = fresh_tid(), lane = tid & 63, w = __builtin_amdgcn_readfirstlane(tid >> 6);
    LAS unsigned* scr = (LAS unsigned*)(F.lds + w * 8448);
    const int n4 = 4 * (lane & 15), kp = lane >> 4, c = lane & 7;
    f32x4 v0[8], v1[8]; float g0[8], g1[8]; CvtMeta m{0, 0, 0, 0};
    unsigned av = 0u;
    if (lane == 0) av = __hip_atomic_fetch_add(ctr, 2u, __ATOMIC_RELAXED, __HIP_MEMORY_SCOPE_AGENT);
    const int first = (int)__builtin_amdgcn_readfirstlane(av);
    int it = it_lo + 2 * (8 * first + q), tnext = first + 1;
    if (lane == 0) av = __hip_atomic_fetch_add(ctr, 1u, __ATOMIC_RELAXED, __HIP_MEMORY_SCOPE_AGENT);
    if (it < it_hi) m = cvt_load(A, it, lane, v0, v1, g0, g1);
    while (it < it_hi) {
#pragma unroll
        for (int i = 0; i < 8; ++i) { LAS unsigned* s = scr + n4 * 33 + 4 * i + kp; const f32x4 x0 = v0[i] * (m.hg ? g0[i] : 1.f), x1 = v1[i] * (m.hg ? g1[i] : 1.f);
            s[0] = pk2(x0.x, x1.x); s[33] = pk2(x0.y, x1.y); s[66] = pk2(x0.z, x1.z); s[99] = pk2(x0.w, x1.w); }
        const CvtMeta cur = m;
        int nxt;
        if (((it - it_lo) & 1) == 0) nxt = it + 1;
        else { nxt = it_lo + 2 * (8 * tnext + q);
            tnext = (int)__builtin_amdgcn_readfirstlane(av);
            if (lane == 0) av = __hip_atomic_fetch_add(ctr, 1u, __ATOMIC_RELAXED, __HIP_MEMORY_SCOPE_AGENT); }
        if (nxt < it_hi) m = cvt_load(A, nxt, lane, v0, v1, g0, g1);
        LDS_WAIT(); asm volatile("" ::: "memory");
        cvt_store(A, cur, scr, lane, c);
        LDS_WAIT(); asm volatile("" ::: "memory");
        it = nxt;
    }
}
__device__ __forceinline__ void p0_prologue(Frame& F0, const Args& A) {
    Frame F = F0; F.tid = fresh_tid(); F.lane = F.tid & 63; F.wave = __builtin_amdgcn_readfirstlane(F.tid >> 6);
    const int gw = F.vcu * NWAVES + F.wave, NGW = F.G * NWAVES;
    convert_items(F, A, 0, A.git[1], gw, NGW);
    for (int jj = 0; jj < 2; ++jj) { v4u* z = (v4u*)(F.ws + WS_WINB + jj * SZ_WINB + (size_t)B_IN * D * 2); const int n16 = (B_INP - B_IN) * D * 2 / 16;
        for (int i = gw * 64 + F.lane; i < n16; i += NGW * 64) z[i] = (v4u){0u, 0u, 0u, 0u}; }
    bf16* MEMN = (bf16*)(F.ws + WS_MEMN);
    for (int row = gw; row < NB * NMEM; row += NGW) norm_row(A.in[7] + (size_t)row * D, A.in[11], F.lane, MEMN + (size_t)row * D, nullptr, nullptr, nullptr);
    { float* X = (float*)(F.ws + WS_X); bf16* H = (bf16*)(F.ws + WS_H); u64* ss0 = ss_slot(F.ws, 0);
      for (int row = gw; row < MR; row += NGW) {
          const float* src = row < MP ? A.in[0] + (size_t)row * D : A.in[1] + (size_t)(row - MP) * D;
          const f32x4* xr = (const f32x4*)src + F.lane; float s = 0.f;
          f32x4 vr[8];
#pragma unroll
          for (int jj = 0; jj < 8; ++jj) vr[jj] = xr[64 * jj];
#pragma unroll
          for (int jj = 0; jj < 8; ++jj) { const f32x4 v = vr[jj]; s += (v.x * v.x + v.y * v.y) + (v.z * v.z + v.w * v.w);
              ((f32x4*)(X + (size_t)row * D) + F.lane)[64 * jj] = v; ((v2u*)(H + (size_t)row * D) + F.lane)[64 * jj] = pk4(v); }
          s = wave_sum(s); if (F.lane == 0) ss0[row] = (u64)(s * SS_FIX + 0.5f); } }
}

#ifndef GEMM_ALIGN
#define GEMM_ALIGN true
#endif
#ifndef GEMM_SP2
#define GEMM_SP2 true
#endif
template <class Epi> __device__ __forceinline__ void run_gemm(Frame& F, const bf16* Am, const bf16* Bt, int M, int N, int K, const Epi& E, int rot) {
    pg8::Gemm g{Am, Bt, M, N, K}; pg8::StaticOrder S; S.init(M, N, F.G, (int)((blockIdx.x + rot) % F.G));
    pg8::gemm_phase<Epi, pg8::StaticOrder, GEMM_ALIGN, GEMM_SP2>(F.lds, g, S, E);
}

constexpr int SK_RED = 0, SK_SSQ = 131072;
template <int AMODE, int EMODE> __device__ __forceinline__ void skinny_gemm(Frame& F, const void* Aptr, int lda, const float* gain, const bf16* Bt, int ldb, int n0, int rh, int k0, int klen, void* outp, int ldc, int orow0) {
    const ldsp L = F.lds; const int tid = fresh_tid(), w = __builtin_amdgcn_readfirstlane(tid >> 6), lane = tid & 63, fr = lane & 15, q4 = lane >> 4;
    const int kw = klen >> 3, kb = k0 + w * kw, nks = kw >> 5;
    f32x4 acc[4][4]; float ssq[4];
#pragma unroll
    for (int rt = 0; rt < 4; ++rt) { ssq[rt] = 0.f;
#pragma unroll
        for (int ct = 0; ct < 4; ++ct) acc[rt][ct] = (f32x4){0.f, 0.f, 0.f, 0.f}; }
    const bf16* bp = Bt + (size_t)(n0 + fr) * ldb + kb + q4 * 8;
    __syncthreads();
#pragma unroll 2
    for (int ks = 0; ks < nks; ++ks) {
        bf16x8 bq[4];
#pragma unroll
        for (int ct = 0; ct < 4; ++ct) bq[ct] = *(const bf16x8*)(bp + (size_t)ct * 16 * ldb + ks * 32);
        bf16x8 a[4];
        if (AMODE == 0) { const bf16* ap = (const bf16*)Aptr + (size_t)(rh * 64 + fr) * lda + kb + q4 * 8 + ks * 32;
#pragma unroll
            for (int rt = 0; rt < 4; ++rt) a[rt] = *(const bf16x8*)(ap + (size_t)rt * 16 * lda); }
        else { const float* ap = (const float*)Aptr + (size_t)(rh * 64 + fr) * lda + kb + q4 * 8 + ks * 32;
            f32x4 g0 = (f32x4){1.f, 1.f, 1.f, 1.f}, g1 = g0;
            if (AMODE == 2) { const f32x4 t0 = *(const f32x4*)(gain + kb + q4 * 8 + ks * 32), t1 = *(const f32x4*)(gain + kb + q4 * 8 + ks * 32 + 4);
                g0 = (f32x4){__builtin_amdgcn_rcpf(t0.x), __builtin_amdgcn_rcpf(t0.y), __builtin_amdgcn_rcpf(t0.z), __builtin_amdgcn_rcpf(t0.w)};
                g1 = (f32x4){__builtin_amdgcn_rcpf(t1.x), __builtin_amdgcn_rcpf(t1.y), __builtin_amdgcn_rcpf(t1.z), __builtin_amdgcn_rcpf(t1.w)}; }
            f32x4 x0[4], x1[4];
#pragma unroll
            for (int rt = 0; rt < 4; ++rt) { x0[rt] = *(const f32x4*)(ap + (size_t)rt * 16 * lda); x1[rt] = *(const f32x4*)(ap + (size_t)rt * 16 * lda + 4); }
#pragma unroll
            for (int rt = 0; rt < 4; ++rt) { f32x4 y0 = x0[rt], y1 = x1[rt];
                if (AMODE == 2) { y0 = y0 * g0; y1 = y1 * g1; }
                if (AMODE == 1) ssq[rt] += (y0.x * y0.x + y0.y * y0.y) + (y0.z * y0.z + y0.w * y0.w) + (y1.x * y1.x + y1.y * y1.y) + (y1.z * y1.z + y1.w * y1.w);
                v4u aw; aw.x = pk2(y0.x, y0.y); aw.y = pk2(y0.z, y0.w); aw.z = pk2(y1.x, y1.y); aw.w = pk2(y1.z, y1.w);
                a[rt] = __builtin_bit_cast(bf16x8, aw); } }
#pragma unroll
        for (int rt = 0; rt < 4; ++rt)
#pragma unroll
            for (int ct = 0; ct < 4; ++ct) acc[rt][ct] = MFMA16(bq[ct], a[rt], acc[rt][ct]);
    }
#pragma unroll
    for (int rt = 0; rt < 4; ++rt)
#pragma unroll
        for (int ct = 0; ct < 4; ++ct) *(LAS f32x4*)(L + SK_RED + ((w * 16 + rt * 4 + ct) * 64 + lane) * 16) = acc[rt][ct];
    if (AMODE == 1) {
#pragma unroll
        for (int rt = 0; rt < 4; ++rt) { float s = ssq[rt]; s += __shfl_xor(s, 16); s += __shfl_xor(s, 32); if (q4 == 0) ((LAS float*)(L + SK_SSQ))[(w * 4 + rt) * 16 + fr] = s; } }
    __syncthreads();
    const int rto = w >> 1, cto = 2 * (w & 1);
    f32x4 r0 = (f32x4){0.f, 0.f, 0.f, 0.f}, r1 = r0; float st = 0.f;
#pragma unroll
    for (int sw = 0; sw < 8; ++sw) { r0 = r0 + *(LAS f32x4*)(L + SK_RED + ((sw * 16 + rto * 4 + cto) * 64 + lane) * 16); r1 = r1 + *(LAS f32x4*)(L + SK_RED + ((sw * 16 + rto * 4 + cto + 1) * 64 + lane) * 16);
        if (AMODE == 1) st += ((LAS float*)(L + SK_SSQ))[(sw * 4 + rto) * 16 + fr]; }
    if (AMODE == 1) { const float rs = __builtin_amdgcn_rsqf(st * (1.f / D) + RMS_EPS); r0 = r0 * rs; r1 = r1 * rs; }
    const int m = orow0 + rh * 64 + 16 * rto + fr, c0 = n0 + cto * 16 + q4 * 4;
    if (EMODE == 2) { float* o = (float*)outp + (size_t)m * ldc + c0; float ret = 0.f;
#pragma unroll
        for (int r = 0; r < 4; ++r) { ret += atomic_add_agent(o + r, r0[r]); ret += atomic_add_agent(o + 16 + r, r1[r]); }
        asm volatile("" :: "v"(ret)); }
    else { if (EMODE == 1) {
#pragma unroll
            for (int r = 0; r < 4; ++r) { const float x0 = fmaxf(r0[r], 0.f), x1 = fmaxf(r1[r], 0.f); r0[r] = x0 * x0; r1[r] = x1 * x1; } }
        bf16* o = (bf16*)outp + (size_t)m * ldc + c0; *(v2u*)o = pk4(r0); *(v2u*)(o + 16) = pk4(r1); }
    __syncthreads();
}

constexpr int SN_BLOCKS = 16;
__device__ __forceinline__ void sample_rows_prepare(Frame& F, const float* shift, const float* gain, u64* ssq, unsigned* flag, int wv) {
    const int tid = fresh_tid(), lane = tid & 63;
    const float* X = (const float*)(F.ws + WS_X); bf16* H = (bf16*)(F.ws + WS_H);
    { const int row = MP + wv; const f32x4* xr = (const f32x4*)(X + (size_t)row * D) + lane; float s = 0.f;
      f32x4 vr[8];
#pragma unroll
      for (int jj = 0; jj < 8; ++jj) vr[jj] = xr[64 * jj];
#pragma unroll
      for (int jj = 0; jj < 8; ++jj) { const f32x4 v = vr[jj]; s += (v.x * v.x + v.y * v.y) + (v.z * v.z + v.w * v.w); ((v2u*)(H + (size_t)row * D) + lane)[64 * jj] = pk4(v); }
      s = wave_sum(s); if (lane == 0) ssq[row] = (u64)(s * SS_FIX + 0.5f); }
    if (shift) { const int row = MR + wv; const f32x4* xr = (const f32x4*)(shift + (size_t)wv * D) + lane; const f32x4* gr = (const f32x4*)gain + lane;
        f32x4 vr[8], gq[8];
#pragma unroll
        for (int jj = 0; jj < 8; ++jj) { vr[jj] = xr[64 * jj]; gq[jj] = gr[64 * jj]; }
#pragma unroll
        for (int jj = 0; jj < 8; ++jj) { const f32x4 v = vr[jj], g = gq[jj];
            ((v2u*)(H + (size_t)row * D) + lane)[64 * jj] = pk4((f32x4){v.x * __builtin_amdgcn_rcpf(g.x), v.y * __builtin_amdgcn_rcpf(g.y), v.z * __builtin_amdgcn_rcpf(g.z), v.w * __builtin_amdgcn_rcpf(g.w)}); }
        if (lane == 0) { u64 one = (u64)((double)D * (1.0 - (double)RMS_EPS) * (double)SS_FIX + 0.5); asm volatile("" : "+s"(one)); ssq[row] = one; } }
    asm volatile("s_waitcnt vmcnt(0)" ::: "memory");
    __syncthreads();
    if (tid == 0) { __builtin_amdgcn_fence(__ATOMIC_RELEASE, "agent"); asm volatile("s_waitcnt vmcnt(0)" ::: "memory");
        (void)__hip_atomic_fetch_add(flag, 1u, __ATOMIC_RELAXED, __HIP_MEMORY_SCOPE_AGENT); }
}
struct SampleOrder : pg8::StaticOrder {
    const unsigned* flag;
    __device__ __forceinline__ void a_ready(const pg8::Unit& u) const {
        if (u.pm == MP / 256) {
            if (__builtin_amdgcn_readfirstlane(threadIdx.x >> 6) == 0) {
                int polls = 0;
                while ((unsigned)__builtin_amdgcn_readfirstlane(__hip_atomic_load(flag, __ATOMIC_RELAXED, __HIP_MEMORY_SCOPE_AGENT)) < (unsigned)SN_BLOCKS) { polls = __builtin_amdgcn_readfirstlane(polls + 1); if (polls > (1 << 18)) break; __builtin_amdgcn_s_sleep(2); }
                __builtin_amdgcn_fence(__ATOMIC_ACQUIRE, "agent");
                asm volatile("s_waitcnt vmcnt(0)" ::: "memory"); }
            asm volatile("" ::: "memory"); __builtin_amdgcn_s_barrier(); asm volatile("" ::: "memory");
        }
    }
};
struct SampleOrderEarly : SampleOrder {
    unsigned* donectr;
    __device__ bool next(int i, pg8::Unit& u) const {
        long Lq = (long)i * G + c; if (Lq >= nwg) return false;
        if (Lq >= 214 && Lq < 214 + nN) { u.pm = nM - 1; u.pn = (int)Lq - 214; return true; }
        if (Lq >= 551 && ((Lq - 551) & 7) == 0 && (Lq - 551) / 8 < nN) Lq = 214 + (Lq - 551) / 8;
        int wgid = (int)Lq; { const int q = nwg / pg8::NXCD, r = nwg % pg8::NXCD, xcd = wgid % pg8::NXCD, off = wgid / pg8::NXCD; wgid = (xcd < r ? xcd * (q + 1) : r * (q + 1) + (xcd - r) * q) + off; }
        const int nig = pg8::WGM * nN, gid = wgid / nig, fm = gid * pg8::WGM, gsz = (nM - fm) < pg8::WGM ? (nM - fm) : pg8::WGM;
        u.pm = fm + ((wgid % nig) % gsz); u.pn = (wgid % nig) / gsz; return true;
    }
    __device__ __forceinline__ void done(const pg8::Unit& u) const {
        if (u.pm == MP / 256) {
            asm volatile("s_waitcnt vmcnt(0)" ::: "memory"); __builtin_amdgcn_s_barrier(); asm volatile("" ::: "memory");
            if (threadIdx.x == 0) { __builtin_amdgcn_fence(__ATOMIC_RELEASE, "agent"); asm volatile("s_waitcnt vmcnt(0)" ::: "memory");
                (void)__hip_atomic_fetch_add(donectr, 1u, __ATOMIC_RELAXED, __HIP_MEMORY_SCOPE_AGENT); }
        }
    }
};
template <class Epi> __device__ __forceinline__ void run_gemm_sample_early(Frame& F, const bf16* Am, const bf16* Bt, int N, int K, const Epi& E, const unsigned* flag, unsigned* donectr) {
    pg8::Gemm g{Am, Bt, MT, N, K}; SampleOrderEarly S; S.init(MT, N, F.G, (int)blockIdx.x); S.flag = flag; S.donectr = donectr;
    pg8::gemm_phase<Epi, SampleOrderEarly, GEMM_ALIGN, GEMM_SP2>(F.lds, g, S, E);
}
__device__ __forceinline__ void wait_counter(const unsigned* ctr, unsigned target) {
    if (__builtin_amdgcn_readfirstlane(threadIdx.x >> 6) == 0) { int polls = 0;
        while ((unsigned)__builtin_amdgcn_readfirstlane(__hip_atomic_load(ctr, __ATOMIC_RELAXED, __HIP_MEMORY_SCOPE_AGENT)) < target) { polls = __builtin_amdgcn_readfirstlane(polls + 1); if (polls > (1 << 18)) break; __builtin_amdgcn_s_sleep(2); }
        __builtin_amdgcn_fence(__ATOMIC_ACQUIRE, "agent"); asm volatile("s_waitcnt vmcnt(0)" ::: "memory"); }
    __syncthreads();
    __builtin_amdgcn_fence(__ATOMIC_ACQUIRE, "agent"); asm volatile("s_waitcnt vmcnt(0)" ::: "memory");
}
template <class Epi> __device__ __forceinline__ void run_gemm_sample(Frame& F, const bf16* Am, const bf16* Bt, int N, int K, const Epi& E, const unsigned* flag) {
    pg8::Gemm g{Am, Bt, MT, N, K}; SampleOrder S; S.init(MT, N, F.G, (int)blockIdx.x); S.flag = flag;
    pg8::gemm_phase<Epi, SampleOrder, GEMM_ALIGN, GEMM_SP2>(F.lds, g, S, E);
}

constexpr int HG_QT = 0, HG_KT = 16384, HG_QH = 32768, HG_KHT = 49152, HG_VT = 65536, HG_ATT = 81920, HG_ST = 90112, HG_TOT = 122880, HG_DEC = 124928, HG_SS = 125440, HG_DEC2 = 126976;

__device__ __forceinline__ float lower_bound(const float* lb_logits, int j, int ch) {
    if (j == 0) return 0.f;
    const float l0 = lb_logits[ch], l1 = lb_logits[MIX + ch];
    return 1.f / (1.f + __expf(l0 - l1));
}
__device__ __forceinline__ void sig2(float x, float& sp, float& sn) { const float e = __expf(-fabsf(x)), r = __builtin_amdgcn_rcpf(1.f + e); const float big = r, small = e * r; sp = x >= 0.f ? big : small; sn = x >= 0.f ? small : big; }
__device__ __forceinline__ float fsilu(float x) { float sp, sn; sig2(x, sp, sn); return x * sp; }

__device__ __forceinline__ void hgrn_prompt_unit(Frame& F, const bf16* PROJ, bf16* MIXC, const float* lb_logits, const float* onorm_g, float* state_out, int j, int b, int h, int c_lo, int c_hi) {
    const ldsp L = F.lds; const int tid = fresh_tid(), w = __builtin_amdgcn_readfirstlane(tid >> 6), lane = tid & 63, fr = lane & 15, q4 = lane >> 4;
    const int ek = tid & 127, etq = tid >> 7;
    const float lbk = lower_bound(lb_logits, j, h * 128 + ek), oml = 1.f - lbk;
    f32x4 Sacc[8];
#pragma unroll
    for (int i = 0; i < 8; ++i) Sacc[i] = (f32x4){0.f, 0.f, 0.f, 0.f};
    for (int i = tid; i < 32768 / 16; i += NTHR) *(LAS v4u*)(L + HG_ST + i * 16) = (v4u){0u, 0u, 0u, 0u};
    __syncthreads();
    const int tt = w & 3, vh = w >> 2;
    unsigned short rq[16], rf[16], rv[16];
    if (c_lo > 0) {
        { const bf16* pq = PROJ + ((size_t)b * SEQ + etq * 16) * LDP + h * 128 + ek;
#pragma unroll
          for (int i = 0; i < 16; ++i) { rf[i] = pq[(size_t)i * LDP + 1536]; rv[i] = pq[(size_t)i * LDP + 3072]; } }
#pragma unroll 1
        for (int c = 0; c < c_lo; ++c) {
            int tl_ = tid; asm volatile("" : "+v"(tl_));
            const int lane = tl_ & 63, fr = lane & 15, q4 = lane >> 4, ek = tl_ & 127, etq = tl_ >> 7;
            const int kbuf = (c & 1) ? HG_QT : HG_KHT, vbuf = (c & 1) ? HG_KT : HG_VT, dbuf = (c & 1) ? HG_DEC2 : HG_DEC;
            float fv[16], vv[16];
#pragma unroll
            for (int i = 0; i < 16; ++i) { fv[i] = bf2f(rf[i]); vv[i] = bf2f(rv[i]); }
            float bl[16], kv[16]; float run = 0.f;
#pragma unroll
            for (int i = 0; i < 16; ++i) { float sp, sn; sig2(fv[i], sp, sn); const float fg = lbk + oml * sp; run += __logf(fmaxf(fg, 1e-30f)); bl[i] = run; kv[i] = oml * sn; }
            ((LAS float*)(L + HG_TOT))[etq * 128 + ek] = run;
            LDS_BARRIER();
            const float t0 = ((LAS float*)(L + HG_TOT))[ek], t1 = ((LAS float*)(L + HG_TOT))[128 + ek], t2 = ((LAS float*)(L + HG_TOT))[256 + ek], t3 = ((LAS float*)(L + HG_TOT))[384 + ek];
            const float bend = (t0 + t1) + (t2 + t3);
            const float rem = bend - ((etq > 0 ? t0 : 0.f) + (etq > 1 ? t1 : 0.f) + (etq > 2 ? t2 : 0.f));
            float kh[16];
#pragma unroll
            for (int i = 0; i < 16; ++i) kh[i] = kv[i] * __expf(fminf(rem - bl[i], 0.f));
            { v4u o0, o1;
              o0.x = pk2(kh[0], kh[1]); o0.y = pk2(kh[2], kh[3]); o0.z = pk2(kh[4], kh[5]); o0.w = pk2(kh[6], kh[7]);
              o1.x = pk2(kh[8], kh[9]); o1.y = pk2(kh[10], kh[11]); o1.z = pk2(kh[12], kh[13]); o1.w = pk2(kh[14], kh[15]);
              *(LAS v4u*)(L + kbuf + sw64(ek, etq * 2)) = o0; *(LAS v4u*)(L + kbuf + sw64(ek, etq * 2 + 1)) = o1;
              o0.x = pk2(vv[0], vv[1]); o0.y = pk2(vv[2], vv[3]); o0.z = pk2(vv[4], vv[5]); o0.w = pk2(vv[6], vv[7]);
              o1.x = pk2(vv[8], vv[9]); o1.y = pk2(vv[10], vv[11]); o1.z = pk2(vv[12], vv[13]); o1.w = pk2(vv[14], vv[15]);
              *(LAS v4u*)(L + vbuf + sw64(ek, etq * 2)) = o0; *(LAS v4u*)(L + vbuf + sw64(ek, etq * 2 + 1)) = o1; }
            if (etq == 0) ((LAS float*)(L + dbuf))[ek] = __expf(bend);
            LDS_BARRIER();
            if (c + 1 < c_lo) { const bf16* pq = PROJ + ((size_t)b * SEQ + (c + 1) * 64 + etq * 16) * LDP + h * 128 + ek;
#pragma unroll
                for (int i = 0; i < 16; ++i) { rf[i] = pq[(size_t)i * LDP + 1536]; rv[i] = pq[(size_t)i * LDP + 3072]; } }
            { const f32x4 dec = *(LAS f32x4*)(L + dbuf + (16 * w + q4 * 4) * 4);
#pragma unroll
              for (int vt = 0; vt < 8; ++vt) Sacc[vt] = Sacc[vt] * dec;
#pragma unroll
              for (int ks = 0; ks < 2; ++ks) { const bf16x8 a = *(LAS bf16x8*)(L + kbuf + sw64(16 * w + fr, ks * 4 + q4));
#pragma unroll
                  for (int vt = 0; vt < 8; ++vt) { const bf16x8 bv = *(LAS bf16x8*)(L + vbuf + sw64(16 * vt + fr, ks * 4 + q4)); Sacc[vt] = MFMA16(a, bv, Sacc[vt]); } } }
            __builtin_amdgcn_sched_barrier(0);
        }
        { int tl_ = tid; asm volatile("" : "+v"(tl_)); const int lane = tl_ & 63, fr = lane & 15, q4 = lane >> 4; const int k0 = 16 * w + q4 * 4;
#pragma unroll
          for (int vt = 0; vt < 8; ++vt) *(LAS v2u*)(L + HG_ST + sw128(16 * vt + fr, k0 >> 3) + (k0 & 7) * 2) = pk4(Sacc[vt]); }
    }
    { const bf16* pq = PROJ + ((size_t)b * SEQ + c_lo * 64 + etq * 16) * LDP + h * 128 + ek;
#pragma unroll
      for (int i = 0; i < 16; ++i) { rq[i] = pq[(size_t)i * LDP]; rf[i] = pq[(size_t)i * LDP + 1536]; rv[i] = pq[(size_t)i * LDP + 3072]; } }
#pragma unroll 1
    for (int c = c_lo; c < c_hi; ++c) {
        int tl_ = tid; asm volatile("" : "+v"(tl_));
        const int lane = tl_ & 63, fr = lane & 15, q4 = lane >> 4, ek = tl_ & 127, etq = tl_ >> 7;
        const size_t row0 = (size_t)b * SEQ + c * 64;
        float qv[16], fv[16], vv[16];
#pragma unroll
        for (int i = 0; i < 16; ++i) { qv[i] = bf2f(rq[i]); fv[i] = bf2f(rf[i]); vv[i] = bf2f(rv[i]); }
        float bl[16], kv[16]; float run = 0.f;
#pragma unroll
        for (int i = 0; i < 16; ++i) { float sp, sn; sig2(fv[i], sp, sn); const float fg = lbk + oml * sp; run += __logf(fmaxf(fg, 1e-30f)); bl[i] = run; kv[i] = oml * sn; }
        ((LAS float*)(L + HG_TOT))[etq * 128 + ek] = run;
        LDS_BARRIER();
        const float t0 = ((LAS float*)(L + HG_TOT))[ek], t1 = ((LAS float*)(L + HG_TOT))[128 + ek], t2 = ((LAS float*)(L + HG_TOT))[256 + ek], t3 = ((LAS float*)(L + HG_TOT))[384 + ek];
        const float off = (etq > 0 ? t0 : 0.f) + (etq > 1 ? t1 : 0.f) + (etq > 2 ? t2 : 0.f);
        const float mref = t0 + t1, bend = mref + t2 + t3, ebm = __expf(t2 + t3);
        float kh[16];
#pragma unroll
        for (int i = 0; i < 16; ++i) { const int t = etq * 16 + i; const float bt = off + bl[i];
            const float d = fminf(fmaxf(bt - mref, -60.f), 60.f), e1 = __expf(d), e2 = __builtin_amdgcn_rcpf(e1);
            const float sq = fsilu(qv[i]);
            const int a = sw128(t, ek >> 3) + (ek & 7) * 2;
            *(LAS unsigned short*)(L + HG_QT + a) = (unsigned short)f2bf(sq * e1);
            *(LAS unsigned short*)(L + HG_KT + a) = (unsigned short)f2bf(kv[i] * e2);
            *(LAS unsigned short*)(L + HG_QH + a) = (unsigned short)f2bf(sq * __expf(bt));
            kh[i] = kv[i] * (ebm * e2); }
        { v4u o0, o1;
          o0.x = pk2(kh[0], kh[1]); o0.y = pk2(kh[2], kh[3]); o0.z = pk2(kh[4], kh[5]); o0.w = pk2(kh[6], kh[7]);
          o1.x = pk2(kh[8], kh[9]); o1.y = pk2(kh[10], kh[11]); o1.z = pk2(kh[12], kh[13]); o1.w = pk2(kh[14], kh[15]);
          *(LAS v4u*)(L + HG_KHT + sw64(ek, etq * 2)) = o0; *(LAS v4u*)(L + HG_KHT + sw64(ek, etq * 2 + 1)) = o1;
          o0.x = pk2(vv[0], vv[1]); o0.y = pk2(vv[2], vv[3]); o0.z = pk2(vv[4], vv[5]); o0.w = pk2(vv[6], vv[7]);
          o1.x = pk2(vv[8], vv[9]); o1.y = pk2(vv[10], vv[11]); o1.z = pk2(vv[12], vv[13]); o1.w = pk2(vv[14], vv[15]);
          *(LAS v4u*)(L + HG_VT + sw64(ek, etq * 2)) = o0; *(LAS v4u*)(L + HG_VT + sw64(ek, etq * 2 + 1)) = o1; }
        if (etq == 0) ((LAS float*)(L + HG_DEC))[ek] = __expf(bend);
        LDS_BARRIER();
        v2u gate_raw[4];
#pragma unroll
        for (int i = 0; i < 4; ++i) gate_raw[i] = *(const v2u*)(PROJ + (row0 + tt * 16 + fr) * LDP + 4608 + h * 128 + (4 * vh + i) * 16 + q4 * 4);
        if (c + 1 < c_hi) { const bf16* pq = PROJ + (row0 + 64 + etq * 16) * LDP + h * 128 + ek;
#pragma unroll
            for (int i = 0; i < 16; ++i) { rq[i] = pq[(size_t)i * LDP]; rf[i] = pq[(size_t)i * LDP + 1536]; rv[i] = pq[(size_t)i * LDP + 3072]; } }
#pragma unroll
        for (int u = 0; u < 2; ++u) { const int st = w >> 1, ttl = 2 * (w & 1) + u;
            f32x4 acc = (f32x4){0.f, 0.f, 0.f, 0.f};
            if (st <= ttl) {
#pragma unroll
                for (int ks = 0; ks < 4; ++ks) { const bf16x8 a = *(LAS bf16x8*)(L + HG_KT + sw128(st * 16 + fr, ks * 4 + q4)); const bf16x8 bq = *(LAS bf16x8*)(L + HG_QT + sw128(ttl * 16 + fr, ks * 4 + q4)); acc = MFMA16(a, bq, acc); } }
            const int t = ttl * 16 + fr, s0 = st * 16 + q4 * 4;
#pragma unroll
            for (int r = 0; r < 4; ++r) if (s0 + r > t) acc[r] = 0.f;
            *(LAS v2u*)(L + HG_ATT + sw64(t, s0 >> 3) + (s0 & 7) * 2) = pk4(acc); }
        f32x4 oT[4];
#pragma unroll
        for (int i = 0; i < 4; ++i) oT[i] = (f32x4){0.f, 0.f, 0.f, 0.f};
#pragma unroll
        for (int ks = 0; ks < 4; ++ks) { const bf16x8 bq = *(LAS bf16x8*)(L + HG_QH + sw128(tt * 16 + fr, ks * 4 + q4));
#pragma unroll
            for (int i = 0; i < 4; ++i) { const bf16x8 a = *(LAS bf16x8*)(L + HG_ST + sw128((4 * vh + i) * 16 + fr, ks * 4 + q4)); oT[i] = MFMA16(a, bq, oT[i]); } }
        { const f32x4 dec = *(LAS f32x4*)(L + HG_DEC + (16 * w + q4 * 4) * 4);
#pragma unroll
          for (int vt = 0; vt < 8; ++vt) Sacc[vt] = Sacc[vt] * dec;
#pragma unroll
          for (int ks = 0; ks < 2; ++ks) { const bf16x8 a = *(LAS bf16x8*)(L + HG_KHT + sw64(16 * w + fr, ks * 4 + q4));
#pragma unroll
              for (int vt = 0; vt < 8; ++vt) { const bf16x8 bv = *(LAS bf16x8*)(L + HG_VT + sw64(16 * vt + fr, ks * 4 + q4)); Sacc[vt] = MFMA16(a, bv, Sacc[vt]); } } }
        LDS_BARRIER();
        { const int k0 = 16 * w + q4 * 4;
#pragma unroll
          for (int vt = 0; vt < 8; ++vt) *(LAS v2u*)(L + HG_ST + sw128(16 * vt + fr, k0 >> 3) + (k0 & 7) * 2) = pk4(Sacc[vt]); }
#pragma unroll
        for (int ks = 0; ks < 2; ++ks) { const bf16x8 bq = *(LAS bf16x8*)(L + HG_ATT + sw64(tt * 16 + fr, ks * 4 + q4));
#pragma unroll
            for (int i = 0; i < 4; ++i) { const bf16x8 a = *(LAS bf16x8*)(L + HG_VT + sw64((4 * vh + i) * 16 + fr, ks * 4 + q4)); oT[i] = MFMA16(a, bq, oT[i]); } }
        float ss = 0.f;
#pragma unroll
        for (int i = 0; i < 4; ++i) ss += (oT[i].x * oT[i].x + oT[i].y * oT[i].y) + (oT[i].z * oT[i].z + oT[i].w * oT[i].w);
        ss += __shfl_xor(ss, 16); ss += __shfl_xor(ss, 32);
        if (q4 == 0) ((LAS float*)(L + HG_SS))[w * 16 + fr] = ss;
        LDS_BARRIER();
        const float tot = ((LAS float*)(L + HG_SS))[w * 16 + fr] + ((LAS float*)(L + HG_SS))[(w ^ 4) * 16 + fr];
        const float rstd = 1.f / sqrtf(tot * (1.f / 128.f) + RMS_EPS);
        const size_t row = row0 + tt * 16 + fr;
#pragma unroll
        for (int i = 0; i < 4; ++i) { const int ch = h * 128 + (4 * vh + i) * 16 + q4 * 4;
            const f32x4 gon = *(const f32x4*)(onorm_g + ch); const f32x4 gate = bf4(gate_raw[i]);
            f32x4 o = oT[i] * rstd * gon;
            o.x *= fsilu(gate.x); o.y *= fsilu(gate.y); o.z *= fsilu(gate.z); o.w *= fsilu(gate.w);
            *(v2u*)(MIXC + row * D + ch) = pk4(o); }
    }
    if (c_hi == SEQ / 64) {
#pragma unroll
        for (int vt = 0; vt < 8; ++vt)
#pragma unroll
            for (int r = 0; r < 4; ++r) state_out[(size_t)(16 * w + q4 * 4 + r) * 128 + 16 * vt + fr] = Sacc[vt][r]; }
    __syncthreads();
}

__device__ __forceinline__ void hgrn_sample_unit(int lane, const bf16* PROJ, bf16* MIXC, const float* lb_logits, const float* onorm_g, const float* S0, float* S1, int j, int b, int h) {
    const size_t row = MP + b; const int vq = lane & 31, kr = lane >> 5;
    float fg[2], kvv[2], sq[2];
#pragma unroll
    for (int u = 0; u < 2; ++u) { const int k = lane + 64 * u; const bf16* p = PROJ + row * LDP + h * 128 + k;
        const float q = bf2f(p[0]), f = bf2f(p[1536]); const float lbk = lower_bound(lb_logits, j, h * 128 + k);
        float sp, sn; sig2(f, sp, sn); fg[u] = fmaxf(lbk + (1.f - lbk) * sp, 1e-30f); kvv[u] = (1.f - lbk) * sn; sq[u] = fsilu(q); }
    const f32x4 v4 = bf4(*(const v2u*)(PROJ + row * LDP + 3072 + h * 128 + 4 * vq));
    f32x4 o = (f32x4){0.f, 0.f, 0.f, 0.f};
#pragma unroll 1
    for (int ib = 0; ib < 8; ++ib) {
        f32x4 Sv[8];
#pragma unroll
        for (int i = 0; i < 8; ++i) Sv[i] = *(const f32x4*)(S0 + (size_t)(2 * (ib * 8 + i) + kr) * 128 + 4 * vq);
        __builtin_amdgcn_sched_barrier(0);
        const bool lowh = ib < 4;
#pragma unroll
        for (int i = 0; i < 8; ++i) { const int it = ib * 8 + i, k = 2 * it + kr; const int src = k & 63;
            const float fgk = __shfl(lowh ? fg[0] : fg[1], src), kvk = __shfl(lowh ? kvv[0] : kvv[1], src), sqk = __shfl(lowh ? sq[0] : sq[1], src);
            const f32x4 Sn = Sv[i] * fgk + v4 * kvk;
            *(f32x4*)(S1 + (size_t)k * 128 + 4 * vq) = Sn;
            o = o + Sn * sqk; } }
    o.x += __shfl_xor(o.x, 32); o.y += __shfl_xor(o.y, 32); o.z += __shfl_xor(o.z, 32); o.w += __shfl_xor(o.w, 32);
    float ss = (o.x * o.x + o.y * o.y) + (o.z * o.z + o.w * o.w);
#pragma unroll
    for (int m = 1; m < 32; m <<= 1) ss += __shfl_xor(ss, m);
    const float rstd = 1.f / sqrtf(ss * (1.f / 128.f) + RMS_EPS);
    if (lane < 32) { const int ch = h * 128 + 4 * vq;
        const f32x4 gon = *(const f32x4*)(onorm_g + ch); const f32x4 gate = bf4(*(const v2u*)(PROJ + row * LDP + 4608 + ch));
        f32x4 r = o * rstd * gon; r.x *= fsilu(gate.x); r.y *= fsilu(gate.y); r.z *= fsilu(gate.z); r.w *= fsilu(gate.w);
        *(v2u*)(MIXC + row * D + ch) = pk4(r); }
}

constexpr int XA_K = 0, XA_KLD = 272, XA_VT = 256 * 272, XA_VLD = 520;
__device__ __forceinline__ void xattn_prompt_unit(Frame& F, const bf16* PROJ, int xq_off, bf16* MIXC, const float* Kb, const float* Vb, int b, int head, int qpart) {
    const ldsp L = F.lds; const int tid = fresh_tid(), w = __builtin_amdgcn_readfirstlane(tid >> 6), lane = tid & 63, fr = lane & 15, q4 = lane >> 4;
    __syncthreads();
#pragma unroll 1
    for (int hb = 0; hb < 2; ++hb) {
        f32x4 kx[8], vx[8];
#pragma unroll
        for (int i = 0; i < 8; ++i) { const int idx = (hb * 8 + i) * NTHR + tid, m = idx >> 5, e4 = idx & 31;
            kx[i] = *(const f32x4*)(Kb + (size_t)m * XDIM + head * XD + 4 * e4); vx[i] = *(const f32x4*)(Vb + (size_t)m * XDIM + head * XD + 4 * e4); }
        __builtin_amdgcn_sched_barrier(0);
#pragma unroll
        for (int i = 0; i < 8; ++i) { const int idx = (hb * 8 + i) * NTHR + tid, m = idx >> 5, e4 = idx & 31;
            *(LAS v2u*)(L + XA_K + m * XA_KLD + e4 * 8) = pk4(kx[i]);
#pragma unroll
            for (int q = 0; q < 4; ++q) { const int e = 4 * e4 + q; *(LAS unsigned short*)(L + XA_VT + e * XA_VLD + m * 2) = (unsigned short)f2bf(vx[i][q]); } }
        __builtin_amdgcn_sched_barrier(0); }
    __syncthreads();
    const float scale = 0.08838834764831845f;
    const ldsp kbase = L + XA_K + fr * XA_KLD + q4 * 16; const ldsp vbase = L + XA_VT + fr * XA_VLD + q4 * 8;
#pragma unroll 1
    for (int qt = 0; qt < 2; ++qt) {
        const size_t r = (size_t)b * SEQ + qpart * 256 + qt * 128 + w * 16 + fr;
        bf16x8 qf[4];
#pragma unroll
        for (int ks = 0; ks < 4; ++ks) qf[ks] = *(const bf16x8*)(PROJ + r * LDP + xq_off + head * XD + ks * 32 + q4 * 8);
        f32x4 sT[16];
#pragma unroll
        for (int mt = 0; mt < 16; ++mt) { f32x4 acc = (f32x4){0.f, 0.f, 0.f, 0.f};
#pragma unroll
            for (int ks = 0; ks < 4; ++ks) { const bf16x8 a = *(LAS bf16x8*)(kbase + mt * 16 * XA_KLD + ks * 64); acc = MFMA16(a, qf[ks], acc); }
            sT[mt] = acc; __builtin_amdgcn_sched_barrier(0); }
        float mx = -3.0e38f;
#pragma unroll
        for (int mt = 0; mt < 16; ++mt) mx = fmaxf(mx, fmaxf(fmaxf(sT[mt].x, sT[mt].y), fmaxf(sT[mt].z, sT[mt].w)));
        mx = fmaxf(mx, __shfl_xor(mx, 16)); mx = fmaxf(mx, __shfl_xor(mx, 32));
        float l = 0.f;
#pragma unroll
        for (int mt = 0; mt < 16; ++mt) {
#pragma unroll
            for (int q = 0; q < 4; ++q) { const float p = __expf((sT[mt][q] - mx) * scale); sT[mt][q] = p; l += p; } }
        l += __shfl_xor(l, 16); l += __shfl_xor(l, 32);
        const float inv = 1.f / l;
        f32x4 oT[8];
#pragma unroll
        for (int et = 0; et < 8; ++et) oT[et] = (f32x4){0.f, 0.f, 0.f, 0.f};
#pragma unroll
        for (int s = 0; s < 8; ++s) {
            v4u pw; pw.x = pk2(sT[2 * s].x, sT[2 * s].y); pw.y = pk2(sT[2 * s].z, sT[2 * s].w); pw.z = pk2(sT[2 * s + 1].x, sT[2 * s + 1].y); pw.w = pk2(sT[2 * s + 1].z, sT[2 * s + 1].w);
            const bf16x8 pf = __builtin_bit_cast(bf16x8, pw);
#pragma unroll
            for (int et = 0; et < 8; ++et) {
                const v2u a0 = *(LAS v2u*)(vbase + et * 16 * XA_VLD + s * 64);
                const v2u a1 = *(LAS v2u*)(vbase + et * 16 * XA_VLD + s * 64 + 32);
                v4u aw; aw.x = a0.x; aw.y = a0.y; aw.z = a1.x; aw.w = a1.y;
                oT[et] = MFMA16(__builtin_bit_cast(bf16x8, aw), pf, oT[et]); }
            __builtin_amdgcn_sched_barrier(0); }
#pragma unroll
        for (int et = 0; et < 8; ++et) *(v2u*)(MIXC + r * D + MIX + head * XD + et * 16 + q4 * 4) = pk4(oT[et] * inv);
    }
    __syncthreads();
}
__device__ __forceinline__ void xattn_sample_pair(Frame& F, const bf16* PROJ, int xq_off, bf16* MIXC, const float* Kall, const float* Vall, int unit0) {
    const ldsp L = F.lds; const int tid = fresh_tid(), w = __builtin_amdgcn_readfirstlane(tid >> 6), lane = tid & 63;
    const int unit = unit0 + (w >> 2), mp = w & 3, b = unit >> 2, head = unit & 3;
    const size_t row = MP + b; const int fr = lane & 15, q4 = lane >> 4, e4 = lane & 31, mr = lane >> 5;
    const float* Kb = Kall + (size_t)b * NMEM * XDIM; const float* Vb = Vall + (size_t)b * NMEM * XDIM;
    const float scale = 0.08838834764831845f;
    bf16x8 qf[4];
#pragma unroll
    for (int ks = 0; ks < 4; ++ks) { const v4u raw = *(const v4u*)(PROJ + row * LDP + xq_off + head * XD + ks * 32 + q4 * 8);
        v4u o; o.x = pk2_hw(bflo(raw.x) * scale, bfhi(raw.x) * scale); o.y = pk2_hw(bflo(raw.y) * scale, bfhi(raw.y) * scale); o.z = pk2_hw(bflo(raw.z) * scale, bfhi(raw.z) * scale); o.w = pk2_hw(bflo(raw.w) * scale, bfhi(raw.w) * scale);
        qf[ks] = __builtin_bit_cast(bf16x8, o); }
    f32x4 sT[4];
#pragma unroll
    for (int i = 0; i < 4; ++i) { f32x4 acc = (f32x4){0.f, 0.f, 0.f, 0.f};
        const float* kp = Kb + (size_t)(mp * 64 + i * 16 + fr) * XDIM + head * XD + q4 * 8;
        f32x4 x0[4], x1[4];
#pragma unroll
        for (int ks = 0; ks < 4; ++ks) { x0[ks] = *(const f32x4*)(kp + ks * 32); x1[ks] = *(const f32x4*)(kp + ks * 32 + 4); }
#pragma unroll
        for (int ks = 0; ks < 4; ++ks) { v4u aw; aw.x = pk2_hw(x0[ks].x, x0[ks].y); aw.y = pk2_hw(x0[ks].z, x0[ks].w); aw.z = pk2_hw(x1[ks].x, x1[ks].y); aw.w = pk2_hw(x1[ks].z, x1[ks].w);
            acc = MFMA16(__builtin_bit_cast(bf16x8, aw), qf[ks], acc); }
        sT[i] = acc; }
    float mx = -3.0e38f;
#pragma unroll
    for (int i = 0; i < 4; ++i) mx = fmaxf(mx, fmaxf(fmaxf(sT[i].x, sT[i].y), fmaxf(sT[i].z, sT[i].w)));
    mx = fmaxf(mx, __shfl_xor(mx, 16)); mx = fmaxf(mx, __shfl_xor(mx, 32));
    float l = 0.f;
#pragma unroll
    for (int i = 0; i < 4; ++i) {
#pragma unroll
        for (int q = 0; q < 4; ++q) { const float p = __expf(sT[i][q] - mx); sT[i][q] = p; l += p; } }
    l += __shfl_xor(l, 16); l += __shfl_xor(l, 32);
    f32x4 o = (f32x4){0.f, 0.f, 0.f, 0.f};
    const float* vp = Vb + head * XD + 4 * e4;
#pragma unroll
    for (int i = 0; i < 4; ++i) {
#pragma unroll
        for (int ii = 0; ii < 8; ++ii) { const int m0 = mp * 64 + i * 16 + 2 * ii; const int src = ((2 * ii) >> 2) * 16;
            const float pa = __shfl(sT[i][2 * (ii & 1)], src), pb = __shfl(sT[i][2 * (ii & 1) + 1], src);
            const f32x4 vx = *(const f32x4*)(vp + (size_t)(m0 + mr) * XDIM);
            o = o + vx * (mr ? pb : pa); } }
    o.x += __shfl_xor(o.x, 32); o.y += __shfl_xor(o.y, 32); o.z += __shfl_xor(o.z, 32); o.w += __shfl_xor(o.w, 32);
    LAS float* slot = (LAS float*)(L + w * 528);
    if (lane == 0) { slot[0] = mx; slot[1] = l; }
    if (lane < 32) *(LAS f32x4*)(slot + 4 + 4 * e4) = o;
    LDS_BARRIER();
    if (mp == 0 && lane < 32) { float M = -3.0e38f;
#pragma unroll
        for (int i = 0; i < 4; ++i) M = fmaxf(M, ((LAS float*)(L + (w + i) * 528))[0]);
        float Lsum = 0.f; f32x4 O = (f32x4){0.f, 0.f, 0.f, 0.f};
#pragma unroll
        for (int i = 0; i < 4; ++i) { const LAS float* s = (const LAS float*)(L + (w + i) * 528); const float f = __expf(s[0] - M); Lsum += s[1] * f; O = O + *(const LAS f32x4*)(s + 4 + 4 * e4) * f; }
        *(v2u*)(MIXC + row * D + MIX + head * XD + 4 * e4) = pk4(O * (1.f / Lsum)); }
    LDS_BARRIER();
}

__device__ __forceinline__ void xattn_sample_unit(int lane, const bf16* PROJ, int xq_off, bf16* MIXC, const float* Kb, const float* Vb, int b, int head) {
    const size_t row = MP + b; const int fr = lane & 15, q4 = lane >> 4, e4 = lane & 31, mr = lane >> 5;
    const float scale = 0.08838834764831845f;
    bf16x8 qf[4];
#pragma unroll
    for (int ks = 0; ks < 4; ++ks) { const v4u raw = *(const v4u*)(PROJ + row * LDP + xq_off + head * XD + ks * 32 + q4 * 8);
        v4u o; o.x = pk2_hw(bflo(raw.x) * scale, bfhi(raw.x) * scale); o.y = pk2_hw(bflo(raw.y) * scale, bfhi(raw.y) * scale); o.z = pk2_hw(bflo(raw.z) * scale, bfhi(raw.z) * scale); o.w = pk2_hw(bflo(raw.w) * scale, bfhi(raw.w) * scale);
        qf[ks] = __builtin_bit_cast(bf16x8, o); }
    f32x4 sT[16];
#pragma unroll
    for (int mt = 0; mt < 16; ++mt) { f32x4 acc = (f32x4){0.f, 0.f, 0.f, 0.f};
        const float* kp = Kb + (size_t)(mt * 16 + fr) * XDIM + head * XD + q4 * 8;
        f32x4 x0[4], x1[4];
#pragma unroll
        for (int ks = 0; ks < 4; ++ks) { x0[ks] = *(const f32x4*)(kp + ks * 32); x1[ks] = *(const f32x4*)(kp + ks * 32 + 4); }
#pragma unroll
        for (int ks = 0; ks < 4; ++ks) { v4u aw; aw.x = pk2_hw(x0[ks].x, x0[ks].y); aw.y = pk2_hw(x0[ks].z, x0[ks].w); aw.z = pk2_hw(x1[ks].x, x1[ks].y); aw.w = pk2_hw(x1[ks].z, x1[ks].w);
            acc = MFMA16(__builtin_bit_cast(bf16x8, aw), qf[ks], acc); }
        sT[mt] = acc; }
    float mx = -3.0e38f;
#pragma unroll
    for (int mt = 0; mt < 16; ++mt) mx = fmaxf(mx, fmaxf(fmaxf(sT[mt].x, sT[mt].y), fmaxf(sT[mt].z, sT[mt].w)));
    mx = fmaxf(mx, __shfl_xor(mx, 16)); mx = fmaxf(mx, __shfl_xor(mx, 32));
    float l = 0.f;
#pragma unroll
    for (int mt = 0; mt < 16; ++mt) {
#pragma unroll
        for (int q = 0; q < 4; ++q) { const float p = __expf(sT[mt][q] - mx); sT[mt][q] = p; l += p; } }
    l += __shfl_xor(l, 16); l += __shfl_xor(l, 32);
    f32x4 o = (f32x4){0.f, 0.f, 0.f, 0.f};
    const float* vp = Vb + head * XD + 4 * e4;
#pragma unroll
    for (int mt = 0; mt < 16; ++mt) {
#pragma unroll
        for (int i = 0; i < 8; ++i) { const int m0 = mt * 16 + 2 * i;
            const int src = ((2 * i) >> 2) * 16;
            const float pa = __shfl(sT[mt][2 * (i & 1)], src);
            const float pb = __shfl(sT[mt][2 * (i & 1) + 1], src);
            const f32x4 vx = *(const f32x4*)(vp + (size_t)(m0 + mr) * XDIM);
            o = o + vx * (mr ? pb : pa); } }
    o.x += __shfl_xor(o.x, 32); o.y += __shfl_xor(o.y, 32); o.z += __shfl_xor(o.z, 32); o.w += __shfl_xor(o.w, 32);
    if (lane < 32) *(v2u*)(MIXC + row * D + MIX + head * XD + 4 * e4) = pk4(o * (1.f / l));
}


__device__ __forceinline__ long rw_prev_row(int row) { return row < MP ? (((row & (SEQ - 1)) == 0) ? -1L : (long)row - 1) : (long)row + NSMP; }
__device__ __forceinline__ f32x4 ld_bf4(const bf16* p) { return bf4(*(const v2u*)p); }
__device__ __forceinline__ f32x4 ld_bf4_prev(const bf16* PROJ, long prow, int col) { return prow >= 0 ? bf4(*(const v2u*)(PROJ + (size_t)prow * LDP + col)) : (f32x4){0.f, 0.f, 0.f, 0.f}; }
__device__ __forceinline__ float ftanh(float x) { return 1.f - 2.f * __builtin_amdgcn_rcpf(1.f + __expf(2.f * x)); }
__device__ __forceinline__ float quad_sum(float x) {
    x += __builtin_bit_cast(float, __builtin_amdgcn_mov_dpp(__builtin_bit_cast(int, x), 0xB1, 0xF, 0xF, true));
    x += __builtin_bit_cast(float, __builtin_amdgcn_mov_dpp(__builtin_bit_cast(int, x), 0x4E, 0xF, 0xF, true));
    return x;
}

constexpr int RC_LI = 0, RC_RAW = 46080, RC_XCH = RC_RAW + 3 * 9216;
__device__ __forceinline__ void rwkv_prep_unit(Frame& F, const Args& A, int j, int r0, int h_lo, int h_hi) {
    const ldsp L = F.lds; const int tid = fresh_tid(), w = __builtin_amdgcn_readfirstlane(tid >> 6), lane = tid & 63, fr = lane & 15, q4 = lane >> 4;
    const int it = w >> 1, jh = w & 1;
    constexpr bool sample = true;
    const bf16* PROJ = (const bf16*)(F.ws + WS_PROJ);
    const float* mu = A.in[20] + (size_t)j * B_MIXC; const float* w0 = A.in[21] + (size_t)j * MIX; const float* a0 = A.in[23] + (size_t)j * MIX;
    const float* k_k = A.in[26] + (size_t)j * MIX; const float* k_a = A.in[27] + (size_t)j * MIX; const float* r_k = A.in[28] + (size_t)j * MIX;
    const bf16* LW = (const bf16*)(F.ws + WS_LW) + (size_t)j * MIX * LORA_K;
    float* RR = (float*)(F.ws + WS_RR); float* RK = (float*)(F.ws + WS_RK); float* RV = (float*)(F.ws + WS_RV); float* RKK = (float*)(F.ws + WS_RKK);
    float* RKA = (float*)(F.ws + WS_RKA); float* RWd = (float*)(F.ws + WS_RW); float* RG = (float*)(F.ws + WS_RG); float* BON = (float*)(F.ws + WS_BONUS);
    __syncthreads();
    for (int itr = 0; itr < 11; ++itr) { const int idx = itr * NTHR + tid;
        if (idx < 64 * 88) { const int t = idx / 88, c4 = idx - t * 88, col = 4 * c4; const int row = r0 + t; const long prow = rw_prev_row(row);
            const f32x4 P = ld_bf4(PROJ + (size_t)row * LDP + B_LORA_OFF + col), Pp = ld_bf4_prev(PROJ, prow, B_LORA_OFF + col);
            const f32x4 m4 = *(const f32x4*)(mu + 4608 + col);
            f32x4 xs = P + (Pp - P) * m4;
            if (col < 64) { xs.x = ftanh(xs.x); xs.y = ftanh(xs.y); xs.z = ftanh(xs.z); xs.w = ftanh(xs.w); }
            else if (col >= 128) { xs.x = fsigmoid(xs.x); xs.y = fsigmoid(xs.y); xs.z = fsigmoid(xs.z); xs.w = fsigmoid(xs.w); }
            *(LAS v2u*)(L + RC_LI + t * 720 + col * 2) = pk4(xs); } }
#pragma unroll 1
    for (int h = h_lo; h < h_hi; ++h) {
        __syncthreads();
        { const int row = tid >> 3, c8 = tid & 7;
#pragma unroll
          for (int x = 0; x < 3; ++x) { const v4u val = *(const v4u*)(PROJ + (size_t)(r0 + row) * LDP + x * 1536 + h * 64 + c8 * 8);
              *(LAS v4u*)(L + RC_RAW + x * 9216 + (row + 1) * 128 + c8 * 16) = val; }
          if (tid < 8) { const long prow = sample ? -1L : rw_prev_row(r0);
#pragma unroll
              for (int x = 0; x < 3; ++x) { v4u val = (v4u){0u, 0u, 0u, 0u}; if (prow >= 0) val = *(const v4u*)(PROJ + (size_t)prow * LDP + x * 1536 + h * 64 + tid * 8);
                  *(LAS v4u*)(L + RC_RAW + x * 9216 + tid * 16) = val; } } }
        f32x4 aw[2], aa[2], ag[2];
#pragma unroll
        for (int u = 0; u < 2; ++u) { aw[u] = (f32x4){0.f, 0.f, 0.f, 0.f}; aa[u] = aw[u]; ag[u] = aw[u]; }
        { const bf16* lw0 = LW + (size_t)(h * 64 + (2 * jh) * 16 + fr) * LORA_K + q4 * 8; const ldsp li = L + RC_LI + (it * 16 + fr) * 720 + q4 * 16;
#pragma unroll
          for (int ks = 0; ks < 11; ++ks) { const bf16x8 afr = *(LAS bf16x8*)(li + ks * 64);
#pragma unroll
              for (int u = 0; u < 2; ++u) { const bf16x8 bfr = *(const bf16x8*)(lw0 + (size_t)u * 16 * LORA_K + ks * 32);
                  if (ks < 2) aw[u] = MFMA16(afr, bfr, aw[u]); else if (ks < 4) aa[u] = MFMA16(afr, bfr, aa[u]); else ag[u] = MFMA16(afr, bfr, ag[u]); } } }
        __syncthreads();
        float xr[2][4], xk[2][4], xv[2][4], dw[2][4], av[2][4], kkr[2][4];
        float nrm[4] = {0.f, 0.f, 0.f, 0.f}, bon[4] = {0.f, 0.f, 0.f, 0.f};
#pragma unroll
        for (int u = 0; u < 2; ++u) { const int c = (2 * jh + u) * 16 + fr, ch = h * 64 + c;
            const float mur = mu[ch], muk = mu[1536 + ch], muv = mu[3072 + ch], w0c = w0[ch], a0c = a0[ch], kkc = k_k[ch], kac = k_a[ch], rkc = r_k[ch];
#pragma unroll
            for (int e = 0; e < 4; ++e) { const int t = it * 16 + 4 * q4 + e;
                const float cr = bf2f(*(LAS unsigned short*)(L + RC_RAW + (t + 1) * 128 + c * 2)), ck = bf2f(*(LAS unsigned short*)(L + RC_RAW + 9216 + (t + 1) * 128 + c * 2)),
                            cv = bf2f(*(LAS unsigned short*)(L + RC_RAW + 18432 + (t + 1) * 128 + c * 2));
                float pr, pk, pv;
                if (sample) { const bf16* pp = PROJ + (size_t)(r0 + t + NSMP) * LDP + ch; pr = bf2f(pp[0]); pk = bf2f(pp[1536]); pv = bf2f(pp[3072]); }
                else { pr = bf2f(*(LAS unsigned short*)(L + RC_RAW + t * 128 + c * 2)); pk = bf2f(*(LAS unsigned short*)(L + RC_RAW + 9216 + t * 128 + c * 2)); pv = bf2f(*(LAS unsigned short*)(L + RC_RAW + 18432 + t * 128 + c * 2)); }
                const float r_ = cr + (pr - cr) * mur, k_ = ck + (pk - ck) * muk, v_ = cv + (pv - cv) * muv;
                const float x = -(w0c + aw[u][e]);
                const float sp = fmaxf(x, 0.f) + __logf(1.f + __expf(-fabsf(x)));
                dw[u][e] = -__expf(-sp - 0.5f);
                const float a = fsigmoid(a0c + aa[u][e]);
                const float kr_ = k_ * kkc, kp = k_ * (1.f + (a - 1.f) * kac);
                xr[u][e] = r_; xk[u][e] = kp; xv[u][e] = v_; av[u][e] = a; kkr[u][e] = kr_;
                nrm[e] += kr_ * kr_; bon[e] += r_ * kp * rkc; } }
#pragma unroll
        for (int e = 0; e < 4; ++e) {
#pragma unroll
            for (int m = 1; m < 16; m <<= 1) { nrm[e] += __shfl_xor(nrm[e], m); bon[e] += __shfl_xor(bon[e], m); } }
        if (fr == 0) {
#pragma unroll
            for (int e = 0; e < 4; ++e) { ((LAS float*)(L + RC_XCH))[(w * 2 + 0) * 16 + 4 * q4 + e] = nrm[e]; ((LAS float*)(L + RC_XCH))[(w * 2 + 1) * 16 + 4 * q4 + e] = bon[e]; } }
        __syncthreads();
#pragma unroll
        for (int e = 0; e < 4; ++e) { nrm[e] += ((LAS float*)(L + RC_XCH))[((w ^ 1) * 2 + 0) * 16 + 4 * q4 + e]; bon[e] += ((LAS float*)(L + RC_XCH))[((w ^ 1) * 2 + 1) * 16 + 4 * q4 + e];
            nrm[e] = 1.f / fmaxf(sqrtf(nrm[e]), 1e-12f); }
#pragma unroll
        for (int u = 0; u < 2; ++u) { const int c = (2 * jh + u) * 16 + fr, ch = h * 64 + c;
#pragma unroll
            for (int e = 0; e < 4; ++e) { const size_t o = (size_t)(r0 + it * 16 + 4 * q4 + e) * MIX + ch;
                const float kk = kkr[u][e] * nrm[e];
                RR[o] = xr[u][e]; RK[o] = xk[u][e]; RV[o] = xv[u][e]; RKK[o] = kk; RKA[o] = kk * av[u][e]; RWd[o] = __expf(dw[u][e]); RG[o] = ag[u][e]; } }
        if (fr == 0 && jh == 0) {
#pragma unroll
            for (int e = 0; e < 4; ++e) BON[(size_t)(r0 + it * 16 + 4 * q4 + e) * BH + h] = bon[e]; }
    }
    __syncthreads();
}

__device__ __forceinline__ void rwkv_sample_unit(Frame& F, const Args& A, int lane, int j, int b, int h) {
    const float* RWd = (const float*)(F.ws + WS_RW); const float* RKK = (const float*)(F.ws + WS_RKK); const float* RKA = (const float*)(F.ws + WS_RKA);
    const float* RK = (const float*)(F.ws + WS_RK); const float* RR = (const float*)(F.ws + WS_RR); const float* RV = (const float*)(F.ws + WS_RV);
    const float* RG = (const float*)(F.ws + WS_RG); const float* BON = (const float*)(F.ws + WS_BONUS); bf16* MIXC = (bf16*)(F.ws + WS_MIXC);
    const float* lnx_g = A.in[29] + (size_t)j * MIX; const float* lnx_b = A.in[30] + (size_t)j * MIX;
    const size_t row = MP + b; const int chan = h * BHD; const int vr = lane >> 4, kc = lane & 15;
    const size_t vo = row * MIX + chan + 4 * kc;
    const f32x4 w4 = *(const f32x4*)(RWd + vo), kk4 = *(const f32x4*)(RKK + vo), ka4 = *(const f32x4*)(RKA + vo), k4 = *(const f32x4*)(RK + vo), r4 = *(const f32x4*)(RR + vo);
    const float* S0 = A.in[5] + ((size_t)(j * NSMP + b) * BH + h) * (BHD * BHD);
    float* S1 = F.out + O_SRS + ((size_t)(j * NSMP + b) * BH + h) * (BHD * BHD);
    float myo = 0.f, osum = 0.f, osq = 0.f;
#pragma unroll
    for (int vb = 0; vb < 16; ++vb) { const int v = 4 * vb + vr;
        f32x4 S = *(const f32x4*)(S0 + (size_t)v * BHD + 4 * kc);
        float sa = (S.x * kk4.x + S.y * kk4.y) + (S.z * kk4.z + S.w * kk4.w);
#pragma unroll
        for (int m = 1; m < 16; m <<= 1) sa += __shfl_xor(sa, m);
        sa = -sa;
        const float vv = RV[row * MIX + chan + v];
        S = S * w4 + ka4 * sa + k4 * vv;
        *(f32x4*)(S1 + (size_t)v * BHD + 4 * kc) = S;
        float o = (S.x * r4.x + S.y * r4.y) + (S.z * r4.z + S.w * r4.w);
#pragma unroll
        for (int m = 1; m < 16; m <<= 1) o += __shfl_xor(o, m);
        osum += o; osq += o * o;
        myo = (kc == vb) ? o : myo; }
    osum += __shfl_xor(osum, 16); osum += __shfl_xor(osum, 32); osq += __shfl_xor(osq, 16); osq += __shfl_xor(osq, 32);
    const float mean = osum * (1.f / 64.f); const float var = fmaxf(osq * (1.f / 64.f) - mean * mean, 0.f);
    const float rstd = 1.f / sqrtf(var + GN_EPS);
    const int ch = chan + 4 * kc + vr;
    const float on = (myo - mean) * rstd * lnx_g[ch] + lnx_b[ch];
    const float bonus = BON[row * BH + h] * RV[row * MIX + ch];
    MIXC[row * D + ch] = (bf16)f2bf((on + bonus) * RG[row * MIX + ch]);
}


#ifndef PROBE_SUB
#define PROBE_SUB 0
#endif
constexpr int RK_LI = 0, RK_XCH = 46080, RK_TOT = 47104, RK_LD = 51200, RK_WC = 55296, RK_TILE = 55552, TBYTES = 9216;
#define TBUF(p) (L + RK_TILE + (p) * TBYTES)
__device__ __forceinline__ f32x4 mm_tile(ldsp Ab, ldsp Bb, int ia, int jb, int fr, int q4) {
    f32x4 acc = (f32x4){0.f, 0.f, 0.f, 0.f};
#pragma unroll
    for (int ks = 0; ks < 2; ++ks) { const bf16x8 a = *(LAS bf16x8*)(Ab + (ia * 16 + fr) * 144 + ks * 64 + q4 * 16); const bf16x8 b = *(LAS bf16x8*)(Bb + (jb * 16 + fr) * 144 + ks * 64 + q4 * 16); acc = MFMA16(a, b, acc); }
    return acc;
}
__device__ __forceinline__ void st_tileT(ldsp buf, int ia, int jb, int fr, int q4, f32x4 v) { *(LAS v2u*)(buf + (jb * 16 + fr) * 144 + (ia * 16 + 4 * q4) * 2) = pk4(v); }

__device__ __forceinline__ void rwkv_chunk_unit(Frame& F, const Args& A, int j, int b, int cidx, int h_lo, int h_hi) {
    const ldsp L = F.lds; const int tid = fresh_tid(), w = __builtin_amdgcn_readfirstlane(tid >> 6), lane = tid & 63, fr = lane & 15, q4 = lane >> 4;
    const int it = w >> 1, jh = w & 1, grp = it * 4 + q4, i0 = it * 16 + 4 * q4;
    const int r0 = b * SEQ + cidx * 64;
    const bf16* PROJ = (const bf16*)(F.ws + WS_PROJ);
    const float* mu = A.in[20] + (size_t)j * B_MIXC; const float* w0 = A.in[21] + (size_t)j * MIX; const float* a0 = A.in[23] + (size_t)j * MIX;
    const float* k_k = A.in[26] + (size_t)j * MIX; const float* k_a = A.in[27] + (size_t)j * MIX; const float* r_k = A.in[28] + (size_t)j * MIX;
    const float* lnx_b = A.in[30] + (size_t)j * MIX;
    const bf16* LW = (const bf16*)(F.ws + WS_LW) + (size_t)j * MIX * LORA_K;
    __syncthreads();
#pragma unroll 2
    for (int itr = 0; itr < 11; ++itr) { const int idx = itr * NTHR + tid;
        if (idx < 64 * 88) { const int t = idx / 88, c4 = idx - t * 88, col = 4 * c4; const int row = r0 + t; const long prow = rw_prev_row(row);
            const f32x4 P = ld_bf4(PROJ + (size_t)row * LDP + B_LORA_OFF + col), Pp = ld_bf4_prev(PROJ, prow, B_LORA_OFF + col);
            const f32x4 m4 = *(const f32x4*)(mu + 4608 + col);
            f32x4 xs = P + (Pp - P) * m4;
            if (col < 64) { xs.x = ftanh(xs.x); xs.y = ftanh(xs.y); xs.z = ftanh(xs.z); xs.w = ftanh(xs.w); }
            else if (col >= 128) { xs.x = fsigmoid(xs.x); xs.y = fsigmoid(xs.y); xs.z = fsigmoid(xs.z); xs.w = fsigmoid(xs.w); }
            *(LAS v2u*)(L + RK_LI + t * 720 + col * 2) = pk4(xs); } }
    for (int i = tid; i < TBYTES / 16; i += NTHR) *(LAS v4u*)(TBUF(7) + i * 16) = (v4u){0u, 0u, 0u, 0u};
#pragma unroll 1
    for (int h = h_lo; h < h_hi; ++h) {
        unsigned char* rec = F.ws + WS_REC + ((size_t)(b * BH + h) * 32 + cidx) * REC_BYTES;
        LDS_BARRIER();
        { const int row = tid >> 3, c8 = tid & 7;
#pragma unroll
          for (int x = 0; x < 3; ++x) { const v4u val = *(const v4u*)(PROJ + (size_t)(r0 + row) * LDP + x * 1536 + h * 64 + c8 * 8);
              *(LAS v4u*)(TBUF(8 + x) + (row + 1) * 128 + c8 * 16) = val; }
          if (tid < 8) { const long prow = rw_prev_row(r0);
#pragma unroll
              for (int x = 0; x < 3; ++x) { v4u val = (v4u){0u, 0u, 0u, 0u}; if (prow >= 0) val = *(const v4u*)(PROJ + (size_t)prow * LDP + x * 1536 + h * 64 + tid * 8);
                  *(LAS v4u*)(TBUF(8 + x) + tid * 16) = val; } } }
        f32x4 aw[2], aa[2], ag[2];
#pragma unroll
        for (int u = 0; u < 2; ++u) { aw[u] = (f32x4){0.f, 0.f, 0.f, 0.f}; aa[u] = aw[u]; ag[u] = aw[u]; }
        { const bf16* lw0 = LW + (size_t)(h * 64 + (2 * jh) * 16 + fr) * LORA_K + q4 * 8; const ldsp li = L + RK_LI + (it * 16 + fr) * 720 + q4 * 16;
          bf16x8 bfrs[11][2];
#pragma unroll
          for (int ks = 0; ks < 11; ++ks)
#pragma unroll
              for (int u = 0; u < 2; ++u) bfrs[ks][u] = *(const bf16x8*)(lw0 + (size_t)u * 16 * LORA_K + ks * 32);
          __builtin_amdgcn_sched_barrier(0);
#pragma unroll
          for (int ks = 0; ks < 11; ++ks) { const bf16x8 afr = *(LAS bf16x8*)(li + ks * 64);
#pragma unroll
              for (int u = 0; u < 2; ++u) { const bf16x8 bfr = bfrs[ks][u];
                  if (ks < 2) aw[u] = MFMA16(afr, bfr, aw[u]); else if (ks < 4) aa[u] = MFMA16(afr, bfr, aa[u]); else ag[u] = MFMA16(afr, bfr, ag[u]); }
          } }
        LDS_BARRIER();
        float xr[2][4], kp[2][4], xv[2][4], dw[2][4], av[2][4], kkr[2][4];
        float nrm[4] = {0.f, 0.f, 0.f, 0.f}, bon[4] = {0.f, 0.f, 0.f, 0.f};
#pragma unroll
        for (int u = 0; u < 2; ++u) { const int c = (2 * jh + u) * 16 + fr, ch = h * 64 + c;
            const float mur = mu[ch], muk = mu[1536 + ch], muv = mu[3072 + ch], w0c = w0[ch], a0c = a0[ch], kkc = k_k[ch], kac = k_a[ch], rkc = r_k[ch];
            float run = 0.f;
#pragma unroll
            for (int e = 0; e < 4; ++e) { const int t = i0 + e;
                const float cr = bf2f(*(LAS unsigned short*)(TBUF(8) + (t + 1) * 128 + c * 2)), ck = bf2f(*(LAS unsigned short*)(TBUF(9) + (t + 1) * 128 + c * 2)), cv = bf2f(*(LAS unsigned short*)(TBUF(10) + (t + 1) * 128 + c * 2));
                const float pr = bf2f(*(LAS unsigned short*)(TBUF(8) + t * 128 + c * 2)), pk = bf2f(*(LAS unsigned short*)(TBUF(9) + t * 128 + c * 2)), pv = bf2f(*(LAS unsigned short*)(TBUF(10) + t * 128 + c * 2));
                const float r_ = cr + (pr - cr) * mur, k_ = ck + (pk - ck) * muk, v_ = cv + (pv - cv) * muv;
                const float x = -(w0c + aw[u][e]);
                const float sp = fmaxf(x, 0.f) + __logf(1.f + __expf(-fabsf(x)));
                const float lw = -__expf(-sp - 0.5f);
                run += lw; dw[u][e] = lw;
                const float a = fsigmoid(a0c + aa[u][e]);
                const float kr_ = k_ * kkc, kp_ = k_ * (1.f + (a - 1.f) * kac);
                xr[u][e] = r_; kp[u][e] = kp_; xv[u][e] = v_; av[u][e] = a; kkr[u][e] = kr_;
                nrm[e] += kr_ * kr_; bon[e] += r_ * kp_ * rkc; }
            ((LAS float*)(L + RK_TOT))[grp * 64 + c] = run; __builtin_amdgcn_sched_barrier(0); }
#pragma unroll
        for (int e = 0; e < 4; ++e) {
#pragma unroll
            for (int m = 1; m < 16; m <<= 1) { nrm[e] += __shfl_xor(nrm[e], m); bon[e] += __shfl_xor(bon[e], m); } }
        if (fr == 0) {
#pragma unroll
            for (int e = 0; e < 4; ++e) { ((LAS float*)(L + RK_XCH))[(w * 2 + 0) * 16 + 4 * q4 + e] = nrm[e]; ((LAS float*)(L + RK_XCH))[(w * 2 + 1) * 16 + 4 * q4 + e] = bon[e]; } }
        LDS_BARRIER();
#pragma unroll
        for (int e = 0; e < 4; ++e) { nrm[e] += ((LAS float*)(L + RK_XCH))[((w ^ 1) * 2 + 0) * 16 + 4 * q4 + e]; bon[e] += ((LAS float*)(L + RK_XCH))[((w ^ 1) * 2 + 1) * 16 + 4 * q4 + e];
            nrm[e] = 1.f / fmaxf(sqrtf(nrm[e]), 1e-12f); }
        f32x4 gbar[2];
#pragma unroll
        for (int u = 0; u < 2; ++u) { const int jt = 2 * jh + u, c = jt * 16 + fr, ch = h * 64 + c;
            float off = 0.f, tot = 0.f;
#pragma unroll
            for (int gp = 0; gp < 16; ++gp) { const float tv = ((LAS float*)(L + RK_TOT))[gp * 64 + c]; tot += tv; off += (gp < grp) ? tv : 0.f; }
            const float lnb = lnx_b[ch];
            f32x4 al, bb, vv4, gv, bv; float cum = off;
#pragma unroll
            for (int e = 0; e < 4; ++e) { const int t = i0 + e;
                cum += dw[u][e];
                const float eW = __expf(cum), eWm = __expf(cum - dw[u][e]), eInv = __expf(-cum), eBar = __expf(tot - cum);
                const float kk = kkr[u][e] * nrm[e], bq = kk * av[u][e];
                const float alpha = kk * eWm, rho = xr[u][e] * eW, beta = bq * eInv, gamma = kp[u][e] * eInv;
                *(LAS unsigned short*)(TBUF(0) + t * 144 + c * 2) = (unsigned short)f2bf(alpha);
                *(LAS unsigned short*)(TBUF(1) + t * 144 + c * 2) = (unsigned short)f2bf(beta);
                *(LAS unsigned short*)(TBUF(2) + t * 144 + c * 2) = (unsigned short)f2bf(gamma);
                *(LAS unsigned short*)(TBUF(3) + t * 144 + c * 2) = (unsigned short)f2bf(rho);
                al[e] = alpha; bb[e] = bq * eBar; gbar[u][e] = kp[u][e] * eBar; vv4[e] = xv[u][e];
                gv[e] = ag[u][e]; bv[e] = (lnb + bon[e] * xv[u][e]) * ag[u][e]; }
            *(LAS v2u*)(TBUF(4) + c * 144 + i0 * 2) = pk4(al);
            *(LAS v2u*)(TBUF(5) + c * 144 + i0 * 2) = pk4(bb);
            *(LAS v2u*)(TBUF(6) + c * 144 + i0 * 2) = pk4(vv4);
            if (grp == 0) ((LAS float*)(L + RK_WC))[c] = __expf(tot);
            const int ti = it * 4 + jt;
            *(v2u*)(rec + 4 * 8192 + (size_t)(ti * 64 + lane) * 8) = pk4(gv);
            *(v2u*)(rec + 5 * 8192 + (size_t)(ti * 64 + lane) * 8) = pk4(bv);
            __builtin_amdgcn_sched_barrier(0); }
        LDS_BARRIER();
        f32x4 n2r[2], etr[2], e2tr[2];
        { int tl_ = lane; asm volatile("" : "+v"(tl_)); const int fr = tl_ & 15, q4 = tl_ >> 4, i0 = it * 16 + 4 * q4; (void)i0;
        { bf16x8 aB[2], aA[2], aG[2];
#pragma unroll
          for (int ks = 0; ks < 2; ++ks) { const int o = (it * 16 + fr) * 144 + ks * 64 + q4 * 16; aA[ks] = *(LAS bf16x8*)(TBUF(0) + o); aB[ks] = *(LAS bf16x8*)(TBUF(1) + o); aG[ks] = *(LAS bf16x8*)(TBUF(2) + o); }
#pragma unroll
          for (int u = 0; u < 2; ++u) { const int jt = 2 * jh + u, jx = jt * 16 + fr;
              f32x4 m1 = (f32x4){0.f, 0.f, 0.f, 0.f}, m2 = m1, n1 = m1, n2 = m1;
#pragma unroll
              for (int ks = 0; ks < 2; ++ks) { const int o = (jt * 16 + fr) * 144 + ks * 64 + q4 * 16;
                  const bf16x8 bA = *(LAS bf16x8*)(TBUF(0) + o), bG = *(LAS bf16x8*)(TBUF(2) + o), bR = *(LAS bf16x8*)(TBUF(3) + o);
                  m1 = MFMA16(aB[ks], bA, m1); m2 = MFMA16(aA[ks], bG, m2); n1 = MFMA16(aB[ks], bR, n1); n2 = MFMA16(aG[ks], bR, n2); }
#pragma unroll
              for (int r = 0; r < 4; ++r) { const int ix = i0 + r; m1[r] = (ix < jx) ? m1[r] : 0.f; m2[r] = (jx < ix) ? m2[r] : 0.f; n1[r] = (ix <= jx) ? n1[r] : 0.f; n2[r] = (ix <= jx) ? n2[r] : 0.f; }
              if (it == jt) {
#pragma unroll
                  for (int r = 0; r < 4; ++r) ((LAS float*)(L + RK_LD))[(it * 16 + 4 * q4 + r) * 16 + fr] = m1[r];
                  m1 = (f32x4){0.f, 0.f, 0.f, 0.f}; }
              st_tileT(TBUF(8), it, jt, fr, q4, m1); st_tileT(TBUF(9), it, jt, fr, q4, m2); st_tileT(TBUF(10), it, jt, fr, q4, n1);
              n2r[u] = n2; } }
        LDS_BARRIER();
        for (int idx = tid; idx < 576; idx += NTHR) { const int row = idx / 9, chn = idx - row * 9; if ((chn >> 1) != (row >> 4)) *(LAS v4u*)(TBUF(2) + row * 144 + chn * 16) = (v4u){0u, 0u, 0u, 0u}; }
        if (w == 0) { const int bI = lane >> 4, cc = lane & 15; const LAS float* Ld = (const LAS float*)(L + RK_LD) + bI * 256;
            float x[16];
#pragma unroll
            for (int s = 15; s >= 0; --s) { float acc = (s == cc) ? 1.f : 0.f;
#pragma unroll
                for (int m = s + 1; m < 16; ++m) acc -= Ld[s * 16 + m] * x[m];
                x[s] = acc; __builtin_amdgcn_sched_barrier(0); }
            v4u o0, o1; o0.x = pk2(x[0], x[1]); o0.y = pk2(x[2], x[3]); o0.z = pk2(x[4], x[5]); o0.w = pk2(x[6], x[7]); o1.x = pk2(x[8], x[9]); o1.y = pk2(x[10], x[11]); o1.z = pk2(x[12], x[13]); o1.w = pk2(x[14], x[15]);
            *(LAS v4u*)(TBUF(7) + (bI * 16 + cc) * 144 + bI * 32) = o0; *(LAS v4u*)(TBUF(7) + (bI * 16 + cc) * 144 + bI * 32 + 16) = o1;
#pragma unroll
            for (int s = 0; s < 16; ++s) *(LAS unsigned short*)(TBUF(2) + (bI * 16 + s) * 144 + (bI * 16 + cc) * 2) = (unsigned short)f2bf(x[s]); }
        LDS_BARRIER();
        }
        { int tl_ = lane; asm volatile("" : "+v"(tl_)); const int fr = tl_ & 15, q4 = tl_ >> 4, i0 = it * 16 + 4 * q4; (void)i0;
#pragma unroll
        for (int u = 0; u < 2; ++u) { const int jt = 2 * jh + u;
            const f32x4 e1 = mm_tile(TBUF(2), TBUF(8), it, jt, fr, q4); st_tileT(TBUF(0), it, jt, fr, q4, e1);
            const f32x4 e2 = mm_tile(TBUF(8), TBUF(2), it, jt, fr, q4); st_tileT(TBUF(1), it, jt, fr, q4, e2); etr[u] = e2; }
        LDS_BARRIER();
#pragma unroll
        for (int u = 0; u < 2; ++u) { const int jt = 2 * jh + u; e2tr[u] = mm_tile(TBUF(0), TBUF(1), it, jt, fr, q4); st_tileT(TBUF(2), it, jt, fr, q4, e2tr[u]); }
        LDS_BARRIER();
#pragma unroll
        for (int u = 0; u < 2; ++u) { const int jt = 2 * jh + u; const f32x4 e3 = mm_tile(TBUF(0), TBUF(2), it, jt, fr, q4);
            f32x4 f = e2tr[u] - etr[u] - e3;
            if (it == jt) {
#pragma unroll
                for (int r = 0; r < 4; ++r) f[r] += (4 * q4 + r == fr) ? 1.f : 0.f; }
            st_tileT(TBUF(8), it, jt, fr, q4, f); }
        LDS_BARRIER();
#pragma unroll
        for (int u = 0; u < 2; ++u) { const int jt = 2 * jh + u; st_tileT(TBUF(2), it, jt, fr, q4, mm_tile(TBUF(8), TBUF(7), it, jt, fr, q4)); }
        LDS_BARRIER();
        }
        { int tl_ = lane; asm volatile("" : "+v"(tl_)); const int fr = tl_ & 15, q4 = tl_ >> 4, i0 = it * 16 + 4 * q4; (void)i0;
#pragma unroll
        for (int u = 0; u < 2; ++u) { const int jt = 2 * jh + u;
            st_tileT(TBUF(0), it, jt, fr, q4, mm_tile(TBUF(2), TBUF(4), it, jt, fr, q4));
            st_tileT(TBUF(1), it, jt, fr, q4, mm_tile(TBUF(2), TBUF(9), it, jt, fr, q4)); }
        LDS_BARRIER();
#pragma unroll
        for (int u = 0; u < 2; ++u) { const int jt = 2 * jh + u;
            const f32x4 g1n = mm_tile(TBUF(0), TBUF(10), it, jt, fr, q4), g2n = mm_tile(TBUF(1), TBUF(10), it, jt, fr, q4);
            const f32x4 g1b = mm_tile(TBUF(0), TBUF(5), it, jt, fr, q4), g2b = mm_tile(TBUF(1), TBUF(5), it, jt, fr, q4);
            const f32x4 rterm = bf4(*(LAS v2u*)(TBUF(3) + (jt * 16 + fr) * 144 + i0 * 2));
            f32x4 q1 = -g1b;
            if (it == jt) { const float wc = ((LAS float*)(L + RK_WC))[jt * 16 + fr];
#pragma unroll
                for (int r = 0; r < 4; ++r) q1[r] += (4 * q4 + r == fr) ? wc : 0.f; }
            st_tileT(TBUF(8), it, jt, fr, q4, rterm - g1n);
            st_tileT(TBUF(9), it, jt, fr, q4, q1);
            st_tileT(TBUF(2), it, jt, fr, q4, n2r[u] - g2n);
            st_tileT(TBUF(4), it, jt, fr, q4, gbar[u] - g2b); }
        LDS_BARRIER();
#pragma unroll
        for (int u = 0; u < 2; ++u) { const int jt = 2 * jh + u, ti = it * 4 + jt;
            *(v2u*)(rec + 2 * 8192 + (size_t)(ti * 64 + lane) * 8) = pk4(mm_tile(TBUF(4), TBUF(6), it, jt, fr, q4));
            *(v2u*)(rec + 3 * 8192 + (size_t)(ti * 64 + lane) * 8) = pk4(mm_tile(TBUF(2), TBUF(6), it, jt, fr, q4)); }
        { const int row = tid >> 3, c8 = tid & 7;
          *(v4u*)(rec + row * 128 + c8 * 16) = *(LAS v4u*)(TBUF(8) + row * 144 + c8 * 16);
          *(v4u*)(rec + 8192 + row * 128 + c8 * 16) = *(LAS v4u*)(TBUF(9) + row * 144 + c8 * 16); }
        }
    }
    __syncthreads();
}

constexpr int CH_S = 0, CH_Q = 9216;
__device__ __forceinline__ void rwkv_chain_unit(Frame& F, int b, int h, float* state_out) {
    const ldsp L = F.lds; const int tid = fresh_tid(), w = __builtin_amdgcn_readfirstlane(tid >> 6), lane = tid & 63, fr = lane & 15, q4 = lane >> 4;
    const int it = w >> 1, jh = w & 1;
    unsigned char* recb = F.ws + WS_REC + ((size_t)(b * BH + h) * 32) * REC_BYTES;
    const int row = tid >> 3, c8 = tid & 7;
    const size_t qoff = 8192 + row * 128 + c8 * 16, uoff0 = 2 * 8192 + (size_t)((it * 4 + 2 * jh) * 64 + lane) * 8, uoff1 = uoff0 + 512, soff = 6 * 8192 + row * 128 + c8 * 16;
    __syncthreads();
    for (int i = tid; i < TBYTES / 16; i += NTHR) *(LAS v4u*)(L + CH_S + i * 16) = (v4u){0u, 0u, 0u, 0u};
    v4u qreg[4]; v2u ureg[4][2];
#pragma unroll
    for (int i = 0; i < 3; ++i) { const unsigned char* rc = recb + (size_t)i * REC_BYTES; qreg[i] = *(const v4u*)(rc + qoff); ureg[i][0] = *(const v2u*)(rc + uoff0); ureg[i][1] = *(const v2u*)(rc + uoff1); }
    f32x4 acc[2];
#pragma unroll 1
    for (int cc = 0; cc < 8; ++cc) {
#pragma unroll
        for (int i = 0; i < 4; ++i) { const int c = 4 * cc + i;
            unsigned char* rec = recb + (size_t)c * REC_BYTES;
            *(LAS v4u*)(L + CH_Q + row * 144 + c8 * 16) = qreg[i];
            const f32x4 uu0 = bf4(ureg[i][0]), uu1 = bf4(ureg[i][1]);
            if (c + 3 < 32) { const unsigned char* rn = rec + 3 * REC_BYTES; const int s3 = (i + 3) & 3;
                qreg[s3] = *(const v4u*)(rn + qoff); ureg[s3][0] = *(const v2u*)(rn + uoff0); ureg[s3][1] = *(const v2u*)(rn + uoff1); }
            LDS_BARRIER();
            *(v4u*)(rec + soff) = *(LAS v4u*)(L + CH_S + row * 144 + c8 * 16);
            acc[0] = uu0 + mm_tile(L + CH_Q, L + CH_S, it, 2 * jh, fr, q4);
            acc[1] = uu1 + mm_tile(L + CH_Q, L + CH_S, it, 2 * jh + 1, fr, q4);
            LDS_BARRIER();
            st_tileT(L + CH_S, it, 2 * jh, fr, q4, acc[0]); st_tileT(L + CH_S, it, 2 * jh + 1, fr, q4, acc[1]); }
    }
#pragma unroll
    for (int u = 0; u < 2; ++u) *(f32x4*)(state_out + (size_t)((2 * jh + u) * 16 + fr) * BHD + it * 16 + 4 * q4) = acc[u];
    __syncthreads();
}

constexpr int RO_STG = 0, RO_LD = 1552;
__device__ __forceinline__ void rwkv_out_unit(Frame& F, const Args& A, int j, int b, int cidx, int h_lo) {
    const ldsp L = F.lds; const int tid = fresh_tid(), w = __builtin_amdgcn_readfirstlane(tid >> 6), lane = tid & 63, fr = lane & 15, q4 = lane >> 4;
    const int it = w & 3, hsel = w >> 2;
    const float* lnx_g = A.in[29] + (size_t)j * MIX;
    bf16* MIXC = (bf16*)(F.ws + WS_MIXC);
    const int r0 = b * SEQ + cidx * 64;
    __syncthreads();
#pragma unroll 1
    for (int hp = 0; hp < 6; ++hp) { const int hl = 2 * hp + hsel, h = h_lo + hl;
        const unsigned char* rec = F.ws + WS_REC + ((size_t)(b * BH + h) * 32 + cidx) * REC_BYTES;
        bf16x8 pa[2], sbv[4][2]; v2u ov[4], gvr[4], bvr[4];
#pragma unroll
        for (int ks = 0; ks < 2; ++ks) pa[ks] = *(const bf16x8*)(rec + (it * 16 + fr) * 128 + ks * 64 + q4 * 16);
#pragma unroll
        for (int jt = 0; jt < 4; ++jt) { ov[jt] = *(const v2u*)(rec + 3 * 8192 + (size_t)((it * 4 + jt) * 64 + lane) * 8);
#pragma unroll
            for (int ks = 0; ks < 2; ++ks) sbv[jt][ks] = *(const bf16x8*)(rec + 6 * 8192 + (jt * 16 + fr) * 128 + ks * 64 + q4 * 16);
            gvr[jt] = *(const v2u*)(rec + 4 * 8192 + (size_t)((it * 4 + jt) * 64 + lane) * 8); bvr[jt] = *(const v2u*)(rec + 5 * 8192 + (size_t)((it * 4 + jt) * 64 + lane) * 8); }
        __builtin_amdgcn_sched_barrier(0);
        f32x4 o[4]; float s1[4] = {0.f, 0.f, 0.f, 0.f}, s2[4] = {0.f, 0.f, 0.f, 0.f};
#pragma unroll
        for (int jt = 0; jt < 4; ++jt) { f32x4 acc = bf4(ov[jt]);
#pragma unroll
            for (int ks = 0; ks < 2; ++ks) acc = MFMA16(pa[ks], sbv[jt][ks], acc);
            o[jt] = acc;
#pragma unroll
            for (int r = 0; r < 4; ++r) { s1[r] += acc[r]; s2[r] += acc[r] * acc[r]; } }
#pragma unroll
        for (int r = 0; r < 4; ++r) {
#pragma unroll
            for (int m = 1; m < 16; m <<= 1) { s1[r] += __shfl_xor(s1[r], m); s2[r] += __shfl_xor(s2[r], m); } }
        float mean[4], rstd[4];
#pragma unroll
        for (int r = 0; r < 4; ++r) { mean[r] = s1[r] * (1.f / 64.f); const float var = fmaxf(s2[r] * (1.f / 64.f) - mean[r] * mean[r], 0.f); rstd[r] = 1.f / sqrtf(var + GN_EPS); }
#pragma unroll
        for (int jt = 0; jt < 4; ++jt) { const int vch = jt * 16 + fr; const float lg = lnx_g[h * 64 + vch];
            const f32x4 gv = bf4(gvr[jt]), bv = bf4(bvr[jt]);
#pragma unroll
            for (int r = 0; r < 4; ++r) { const float val = (o[jt][r] - mean[r]) * rstd[r] * lg * gv[r] + bv[r];
                *(LAS unsigned short*)(L + RO_STG + (it * 16 + 4 * q4 + r) * RO_LD + (hl * 64 + vch) * 2) = (unsigned short)f2bf(val); } }
    }
    __syncthreads();
    for (int i = tid; i < 64 * 96; i += NTHR) { const int t = i / 96, c16 = i - t * 96;
        *(v4u*)(MIXC + (size_t)(r0 + t) * D + h_lo * 64 + c16 * 8) = *(LAS v4u*)(L + RO_STG + t * RO_LD + c16 * 16); }
    __syncthreads();
}


constexpr int PH_PER_PAIR = 12, N_PHASES = 1 + 2 * PH_PER_PAIR + 1;
#ifndef MK_N_LAUNCHES
#define MK_N_LAUNCHES 1


#endif
#ifndef PROBE_K
#define PROBE_K 0
#endif
#ifndef PROBE_P0
#define PROBE_P0 0
#endif
#ifndef PROBE_SUB
#define PROBE_SUB 0
#endif

__global__ void __launch_bounds__(NTHR, 2) fwd_kernel(Args args) {
    extern __shared__ __attribute__((aligned(16))) unsigned char lds_raw[];
    Frame F;
    F.lds = (ldsp)lds_raw;
    F.tid = threadIdx.x; F.lane = F.tid & 63; F.wave = __builtin_amdgcn_readfirstlane(F.tid >> 6);
    F.G = gridDim.x; { const int bx = blockIdx.x; F.vcu = (F.G % 8 == 0) ? (bx % 8) * (F.G / 8) + bx / 8 : bx; }
    F.ws = args.ws; F.out = args.out;
    volatile LAS unsigned* MISC = (volatile LAS unsigned*)(F.lds + MISC_OFF);
    for (int u = F.tid; u < (LDS_BYTES - LDSCTL_OFF) / 4; u += NTHR) ((LAS unsigned*)(F.lds + LDSCTL_OFF))[u] = 0u;
    __syncthreads();
    const int lo = args.ph_lo, hi = args.ph_hi;
    const bool multi = (hi - lo) > 1;
    XcdBarrier bar; bar.bar = (unsigned*)(F.ws + WS_CTL) + CW_BAR; bar.x = 0; bar.st = nullptr;
    if (multi) bar = xcd_barrier_post((unsigned*)(F.ws + WS_CTL) + CW_BAR, MISC + 8);
#define IN(k) (lo <= (k) && (k) < hi)
#define SEAM(k) do { if (IN((k) + 1)) xcd_barrier(bar); } while (0)

    bf16* const H = (bf16*)(F.ws + WS_H); bf16* const PROJ = (bf16*)(F.ws + WS_PROJ); bf16* const MIXC = (bf16*)(F.ws + WS_MIXC); bf16* const ACT = (bf16*)(F.ws + WS_ACT);
    float* const X = (float*)(F.ws + WS_X); const float* const Xs = X + (size_t)MP * D;
    const int blk = blockIdx.x;

#define PH(k, ...) if (IN(base + (k))) { __VA_ARGS__ if constexpr (((PROBE_K) >> (k)) & 1) { __VA_ARGS__ } SEAM(base + (k)); }
    if (IN(0)) { p0_prologue(F, args); if constexpr (PROBE_P0) { p0_prologue(F, args); } SEAM(0); }

    for (int j = 0; j < 2; ++j) {
        const int base = 1 + j * PH_PER_PAIR;
        const int la = 2 * j, lb = 2 * j + 1;
        const bf16* const WinA = (const bf16*)(F.ws + WS_WINA + (size_t)j * SZ_WINA); const bf16* const WoutA = (const bf16*)(F.ws + WS_WOUTA + (size_t)j * SZ_WSQ);
        const bf16* const WinB = (const bf16*)(F.ws + WS_WINB + (size_t)j * SZ_WINB); const bf16* const WoutB = (const bf16*)(F.ws + WS_WOUTB + (size_t)j * SZ_WSQ);
        PH(0,
            { unsigned* sflag = (unsigned*)(F.ws + WS_CTL) + CW_SFLAG + 64 * la;
              if (blk >= 256 - SN_BLOCKS) { const int ftw = fresh_tid(); sample_rows_prepare(F, nullptr, nullptr, ss_slot(F.ws, 2 * la), sflag, (blk - (256 - SN_BLOCKS)) * NWAVES + __builtin_amdgcn_readfirstlane(ftw >> 6)); }
              run_gemm_sample(F, H, WinA, A_IN, D, EpiBf<0>{PROJ, LDP, ss_slot(F.ws, 2 * la)}, sflag); }
            if (j == 0) run_gemm(F, (const bf16*)(F.ws + WS_MEMN), (const bf16*)(F.ws + WS_WKV), 1024, 4096, D, EpiMemKV{F.out}, 128);
        )
        PH(1,
            { const float* Kp = F.out + O_MK + (size_t)la * (1024 * 512); const float* Vp = F.out + O_MV + (size_t)la * (1024 * 512);
            if (blk < 96) { const int bh = blk < 48 ? blk : blk - 48, b = bh / AH, h = bh % AH;
                hgrn_prompt_unit(F, PROJ, MIXC, args.in[16], args.in[17] + (size_t)j * MIX, F.out + O_SHP + ((size_t)(j * NB + b) * AH + h) * (AHD * AHD), j, b, h, blk < 48 ? HG_SPLIT : 0, blk < 48 ? SEQ / 64 : HG_SPLIT);
                if (PROBE_SUB == 10) hgrn_prompt_unit(F, PROJ, MIXC, args.in[16], args.in[17] + (size_t)j * MIX, F.out + O_SHP + ((size_t)(j * NB + b) * AH + h) * (AHD * AHD), j, b, h, blk < 48 ? HG_SPLIT : 0, blk < 48 ? SEQ / 64 : HG_SPLIT); }
            else { if (blk < 224) { const int u = blk - 96, b = u >> 5, head = (u >> 3) & 3, qp = u & 7;
                    xattn_prompt_unit(F, PROJ, A_XQ_OFF, MIXC, Kp + (size_t)b * NMEM * XDIM, Vp + (size_t)b * NMEM * XDIM, b, head, qp); }
                const int nw = (F.G - 96) * NWAVES; const int ft = fresh_tid(); F.lane = ft & 63; F.wave = __builtin_amdgcn_readfirstlane(ft >> 6);
                const int prio = blk >= 224 ? blk - 224 : blk - 96 + 32;
                for (int rep14 = 0; rep14 < (PROBE_SUB == 14 ? 2 : 1); ++rep14)
                for (int u = prio * NWAVES + F.wave; u < NSMP * AH + NSMP * XH; u += nw) {
                    if (u < NSMP * AH) { const int b = u / AH, h = u % AH;
                        hgrn_sample_unit(F.lane, PROJ, MIXC, args.in[16], args.in[17] + (size_t)j * MIX, args.in[4] + ((size_t)(j * NSMP + b) * AH + h) * (AHD * AHD),
                                         F.out + O_SHS + ((size_t)(j * NSMP + b) * AH + h) * (AHD * AHD), j, b, h); }
                    else { const int q = u - NSMP * AH, b = q >> 2, head = q & 3;
                        xattn_sample_unit(F.lane, PROJ, A_XQ_OFF, MIXC, args.in[2] + ((size_t)(la * NSMP + b) * NMEM) * XDIM, args.in[3] + ((size_t)(la * NSMP + b) * NMEM) * XDIM, b, head); } } }
            { __syncthreads();
                convert_items_dyn(F, args, args.git[2 + 2 * j], args.git[3 + 2 * j], (unsigned*)(F.ws + WS_CTL) + CW_CQ + 512 * j + 64 * (blk & 7), blk & 7); __syncthreads(); } }
        )
        if (IN(base + 2)) { run_gemm(F, MIXC, WoutA, MP, D, D, EpiResid<false>{X, D, H, ss_slot(F.ws, 2 * la + 1), nullptr}, 0);
              skinny_gemm<0, 2>(F, MIXC + (size_t)MP * D, D, nullptr, WoutA, D, 64 * (blk & 31), (blk >> 5) & 1, 512 * (blk >> 6), 512, X, D, MP); SEAM(base + 2); }
        if (PROBE_SUB == 12 && IN(base + 3)) { run_gemm(F, H, WoutA, MP, D, D, EpiDummy{(float*)PROJ, D}, 0); }
        if (PROBE_SUB == 13 && IN(base + 3)) { run_gemm(F, H, (const bf16*)(F.ws + WS_W1 + (size_t)la * SZ_WFF), MP, 4096, D, EpiDummy{(float*)PROJ, 4096}, 0); }
        PH(3, if (blk & 1) skinny_gemm<1, 1>(F, Xs, D, nullptr, (const bf16*)(F.ws + WS_W1 + (size_t)la * SZ_WFF), D, 64 * (blk >> 1), blk & 1, 0, D, ACT, DFF, MP);
              run_gemm(F, H, (const bf16*)(F.ws + WS_W1 + (size_t)la * SZ_WFF), MP, DFF, D, EpiBf<2>{ACT, DFF, nullptr}, 0);
              if (!(blk & 1)) skinny_gemm<1, 1>(F, Xs, D, nullptr, (const bf16*)(F.ws + WS_W1 + (size_t)la * SZ_WFF), D, 64 * (blk >> 1), blk & 1, 0, D, ACT, DFF, MP);
              if (PROBE_SUB == 5) skinny_gemm<1, 1>(F, Xs, D, nullptr, (const bf16*)(F.ws + WS_W1 + (size_t)la * SZ_WFF), D, 64 * (blk >> 1), blk & 1, 0, D, ACT, DFF, MP); )
        if (IN(base + 4)) { if (PROBE_SUB == 9) run_gemm(F, ACT, (const bf16*)(F.ws + WS_W2 + (size_t)la * SZ_WFF), MP, D, DFF, EpiDummy{(float*)PROJ, D}, 0);
              run_gemm(F, ACT, (const bf16*)(F.ws + WS_W2 + (size_t)la * SZ_WFF), MP, D, DFF, EpiResid<true>{X, D, H, ss_slot(F.ws, 2 * lb), ss_slot(F.ws, 2 * la + 1)}, 0);
              skinny_gemm<0, 2>(F, ACT + (size_t)MP * DFF, DFF, nullptr, (const bf16*)(F.ws + WS_W2 + (size_t)la * SZ_WFF), DFF, 64 * (blk & 31), (blk >> 5) & 1, 2048 * (blk >> 6), 2048, X, D, MP); SEAM(base + 4); }
        PH(5, { unsigned* sflag = (unsigned*)(F.ws + WS_CTL) + CW_SFLAG + 64 * lb;
              if (blk >= 256 - SN_BLOCKS) { const int ftw = fresh_tid(); sample_rows_prepare(F, args.in[6] + (size_t)j * NSMP * D, args.in[8] + (size_t)lb * D, ss_slot(F.ws, 2 * lb), sflag, (blk - (256 - SN_BLOCKS)) * NWAVES + __builtin_amdgcn_readfirstlane(ftw >> 6)); }
              run_gemm_sample_early(F, H, WinB, B_INP, D, EpiBf<0>{PROJ, LDP, ss_slot(F.ws, 2 * lb)}, sflag, (unsigned*)(F.ws + WS_CTL) + CW_PDONE + 64 * j); }
              if (blk >= 192) {
                  const int ft = fresh_tid(); const int ln = ft & 63, gwv = (blk - 192) * NWAVES + __builtin_amdgcn_readfirstlane(ft >> 6);
                  for (int r = gwv; r < NB + NSMP; r += 64 * NWAVES) { const int row = r < NB ? r * SEQ + SEQ - 1 : MP + (r - NB);
                      float* dst = r < NB ? F.out + O_SSP + (size_t)(j * NB + r) * D : F.out + O_SSS + (size_t)(j * NSMP + (r - NB)) * D;
                      norm_row(X + (size_t)row * D, args.in[8] + (size_t)lb * D, ln, nullptr, dst, nullptr, nullptr); } }
              if (blk >= 214) { wait_counter((const unsigned*)(F.ws + WS_CTL) + CW_PDONE + 64 * j, B_INP / 256);
                  const int idx = blk - 214, h0 = idx < 36 ? idx : 36 + 2 * (idx - 36), nh = idx < 36 ? 1 : 2;
                  rwkv_prep_unit(F, args, j, (128 + h0 / 24) * 64, h0 % 24, h0 % 24 + nh); } )
        PH(6,
            rwkv_chunk_unit(F, args, j, blk >> 6, (blk >> 1) & 31, (blk & 1) * 12, (blk & 1) * 12 + 12);
        )
        PH(7,
            { const float* Kp = F.out + O_MK + (size_t)lb * (1024 * 512); const float* Vp = F.out + O_MV + (size_t)lb * (1024 * 512);
            if (blk < 96) { const int b = blk / BH, h = blk % BH; rwkv_chain_unit(F, b, h, F.out + O_SRP + ((size_t)(j * NB + b) * BH + h) * (BHD * BHD));
                if (PROBE_SUB == 7) rwkv_chain_unit(F, b, h, F.out + O_SRP + ((size_t)(j * NB + b) * BH + h) * (BHD * BHD)); }
            else if (blk < 224) { const int u = blk - 96, b = u >> 5, head = (u >> 3) & 3, qp = u & 7;
                    xattn_prompt_unit(F, PROJ, B_XQ_OFF, MIXC, Kp + (size_t)b * NMEM * XDIM, Vp + (size_t)b * NMEM * XDIM, b, head, qp);
                    if (PROBE_SUB == 17) xattn_prompt_unit(F, PROJ, B_XQ_OFF, MIXC, Kp + (size_t)b * NMEM * XDIM, Vp + (size_t)b * NMEM * XDIM, b, head, qp); }
            __syncthreads();
            xattn_sample_pair(F, PROJ, B_XQ_OFF, MIXC, args.in[2] + (size_t)lb * NSMP * NMEM * XDIM, args.in[3] + (size_t)lb * NSMP * NMEM * XDIM, 2 * blk);
            { const int nw = F.G * NWAVES; const int ft = fresh_tid(); F.lane = ft & 63; F.wave = __builtin_amdgcn_readfirstlane(ft >> 6);
              const int prio = blk >= 224 ? blk - 224 : (blk >= 96 ? blk - 96 + 128 : blk + 32);
              for (int u = prio * NWAVES + F.wave; u < NSMP * BH; u += nw) rwkv_sample_unit(F, args, F.lane, j, u / BH, u % BH); } }
        )
        PH(8, rwkv_out_unit(F, args, j, blk >> 6, (blk >> 1) & 31, (blk & 1) * 12); )
        if (IN(base + 9)) { run_gemm(F, MIXC, WoutB, MP, D, D, EpiResid<false>{X, D, H, ss_slot(F.ws, 2 * lb + 1), nullptr}, 0);
               skinny_gemm<0, 2>(F, MIXC + (size_t)MP * D, D, nullptr, WoutB, D, 64 * (blk & 31), (blk >> 5) & 1, 512 * (blk >> 6), 512, X, D, MP); SEAM(base + 9); }
        PH(10, if (blk & 1) skinny_gemm<1, 1>(F, Xs, D, nullptr, (const bf16*)(F.ws + WS_W1 + (size_t)lb * SZ_WFF), D, 64 * (blk >> 1), blk & 1, 0, D, ACT, DFF, MP);
              run_gemm(F, H, (const bf16*)(F.ws + WS_W1 + (size_t)lb * SZ_WFF), MP, DFF, D, EpiBf<2>{ACT, DFF, nullptr}, 0);
              if (!(blk & 1)) skinny_gemm<1, 1>(F, Xs, D, nullptr, (const bf16*)(F.ws + WS_W1 + (size_t)lb * SZ_WFF), D, 64 * (blk >> 1), blk & 1, 0, D, ACT, DFF, MP);
               if (PROBE_SUB == 5) skinny_gemm<1, 1>(F, Xs, D, nullptr, (const bf16*)(F.ws + WS_W1 + (size_t)lb * SZ_WFF), D, 64 * (blk >> 1), blk & 1, 0, D, ACT, DFF, MP); )
        if (IN(base + 11)) { if (PROBE_SUB == 9) run_gemm(F, ACT, (const bf16*)(F.ws + WS_W2 + (size_t)lb * SZ_WFF), MP, D, DFF, EpiDummy{(float*)PROJ, D}, 0);
              run_gemm(F, ACT, (const bf16*)(F.ws + WS_W2 + (size_t)lb * SZ_WFF), MP, D, DFF, EpiResid<true>{X, D, H, ss_slot(F.ws, 2 * lb + 2), ss_slot(F.ws, 2 * lb + 1)}, 0);
               skinny_gemm<0, 2>(F, ACT + (size_t)MP * DFF, DFF, nullptr, (const bf16*)(F.ws + WS_W2 + (size_t)lb * SZ_WFF), DFF, 64 * (blk & 31), (blk >> 5) & 1, 2048 * (blk >> 6), 2048, X, D, MP); SEAM(base + 11); }
    }
    if (IN(N_PHASES - 1)) { norm_phase(F, args, args.in[10], false, true, -1); }
#undef PH
#undef IN
#undef SEAM
}

static int add_job(Job* jobs, int& n, int& items, const float* src, bf16* dst, int ldw, int K, int ncols, int ldt, int koff, int row_off, const float* gain = nullptr) {
    Job J{}; J.src = src; J.dst = dst; J.gain = gain; J.ldw = ldw; J.K = K; J.ncols = ncols; J.ldt = ldt; J.koff = koff; J.row_off = row_off; J.item0 = items; J.pad = 0;
    jobs[n++] = J; items += ((K + 63) / 64) * ((ncols + 63) / 64); return n;
}

extern "C" void kernel_launch(void* const* d_in, const int* in_sizes, int n_in, void* d_out, int out_size, void* d_ws, size_t ws_size, hipStream_t stream) {
    static int ready = 0;
    if (ready == 0) {
        if (n_in != 33 || (size_t)out_size != O_END || ws_size < WS_END) { fprintf(stderr, "kernel_launch: unexpected shapes: n_in %d out %d ws %zu (need %zu)\n", n_in, out_size, ws_size, (size_t)WS_END); ready = -1; return; }
        if (hipFuncSetAttribute((const void*)fwd_kernel, hipFuncAttributeMaxDynamicSharedMemorySize, LDS_BYTES) != hipSuccess) { fprintf(stderr, "kernel_launch: hipFuncSetAttribute failed\n"); ready = -1; return; }
        int per_cu = 0;
        if (hipOccupancyMaxActiveBlocksPerMultiprocessor(&per_cu, (const void*)fwd_kernel, NTHR, LDS_BYTES) != hipSuccess || per_cu < 1) fprintf(stderr, "kernel_launch: occupancy query says %d\n", per_cu);
        (void)hipGetLastError();
        ready = 1;
    }
    if (ready < 0) return;
    unsigned char* ws = (unsigned char*)d_ws;
    (void)hipMemsetAsync(ws + WS_CTL, 0, CTL_BYTES, stream);
    Args a{};
    for (int i = 0; i < 33; ++i) a.in[i] = (const float*)d_in[i];
    a.out = (float*)d_out; a.ws = ws;
    int n = 0, items = 0;
    const float* a_w_in = a.in[14]; const float* a_w_out = a.in[15]; const float* b_w_in = a.in[18]; const float* b_w_out = a.in[19];
    const float* w1 = a.in[31]; const float* w2 = a.in[32]; const float* wk = a.in[12]; const float* wv = a.in[13];
    auto job_a_in = [&](int j) { add_job(a.jobs, n, items, a_w_in + (size_t)j * D * A_IN, (bf16*)(ws + WS_WINA + j * SZ_WINA), A_IN, D, A_IN, D, 0, 0, a.in[8] + (size_t)(2 * j) * D); };
    auto job_a_out = [&](int j) { add_job(a.jobs, n, items, a_w_out + (size_t)j * D * D, (bf16*)(ws + WS_WOUTA + j * SZ_WSQ), D, D, D, D, 0, 0); };
    auto job_b = [&](int j) {
        const float* bw = b_w_in + (size_t)j * D * B_IN; bf16* bd = (bf16*)(ws + WS_WINB + j * SZ_WINB); const float* gB = a.in[8] + (size_t)(2 * j + 1) * D;
        add_job(a.jobs, n, items, bw, bd, B_IN, D, 4608, D, 0, 0, gB);
        add_job(a.jobs, n, items, bw + B_MIXC, bd, B_IN, D, XDIM, D, 0, B_XQ_OFF, gB);
        add_job(a.jobs, n, items, bw + 4608, bd, B_IN, D, LORA_K, D, 0, B_LORA_OFF, gB);
        add_job(a.jobs, n, items, b_w_out + (size_t)j * D * D, (bf16*)(ws + WS_WOUTB + j * SZ_WSQ), D, D, D, D, 0, 0);
        bf16* lw = (bf16*)(ws + WS_LW + j * SZ_LW);
        add_job(a.jobs, n, items, a.in[22] + (size_t)j * 64 * MIX, lw, MIX, 64, MIX, LORA_K, 0, 0);
        add_job(a.jobs, n, items, a.in[24] + (size_t)j * 64 * MIX, lw, MIX, 64, MIX, LORA_K, 64, 0);
        add_job(a.jobs, n, items, a.in[25] + (size_t)j * 224 * MIX, lw, MIX, 224, MIX, LORA_K, 128, 0); };
    auto job_mlp = [&](int l) {
        add_job(a.jobs, n, items, w1 + (size_t)l * D * DFF, (bf16*)(ws + WS_W1 + l * SZ_WFF), DFF, D, DFF, D, 0, 0, a.in[9] + (size_t)l * D);
        add_job(a.jobs, n, items, w2 + (size_t)l * DFF * D, (bf16*)(ws + WS_W2 + l * SZ_WFF), D, DFF, D, DFF, 0, 0); };
    a.git[0] = 0;
    job_a_in(0);
    for (int l = 0; l < 4; ++l) {
        add_job(a.jobs, n, items, wk + (size_t)l * D * XDIM, (bf16*)(ws + WS_WKV + l * SZ_WKV), XDIM, D, XDIM, D, 0, 0);
        add_job(a.jobs, n, items, wv + (size_t)l * D * XDIM, (bf16*)(ws + WS_WKV + l * SZ_WKV), XDIM, D, XDIM, D, 0, XDIM); }
    a.git[1] = items;
    job_a_out(0); job_mlp(0); job_b(0); job_mlp(1); job_a_in(1);
    a.git[3] = items; a.git[2] = a.git[1] + (int)((a.git[3] - a.git[1]) * 0.0f);
    job_a_out(1); job_mlp(2); job_b(1); job_mlp(3);
    a.git[5] = items; a.git[4] = a.git[3] + (int)((a.git[5] - a.git[3]) * 0.0f);
    a.njobs = n; a.nitems = items;
    const int grid = 256;
#if MK_N_LAUNCHES == 1
    a.ph_lo = 0; a.ph_hi = N_PHASES;
    hipLaunchKernelGGL(fwd_kernel, dim3(grid), dim3(NTHR), LDS_BYTES, stream, a);
#else
    for (int p = 0; p < N_PHASES; ++p) { a.ph_lo = p; a.ph_hi = p + 1; hipLaunchKernelGGL(fwd_kernel, dim3(grid), dim3(NTHR), LDS_BYTES, stream, a); }
#endif
    const hipError_t le = hipPeekAtLastError();
    if (le != hipSuccess) fprintf(stderr, "kernel_launch: launch failed: %s\n", hipGetErrorName(le));
}
```
